# Optimizing an MI355X kernel written in HIP

```python
import math
import jax, jax.numpy as jnp
from jax import lax
import numpy as np

D_MODEL = 1024
BATCH = 2
SEQ = 8192
DEPTH = 1

ROPE_THETA = 500000.0
NORM_EPS = 1e-6
NEG_INF = -1e30
BLK = 128

A_HEADS = 8
HEAD_DIM = 64
A_ROT_DIM = HEAD_DIM // 4
DIL_PATTERNS = ((128, 1), (512, 4), (2048, 16))
A_WIDTH = A_HEADS * HEAD_DIM

B_HEADS = 8
MLA_Q_RANK = 256
MLA_KV_RANK = 128
MLA_NOPE = 64
MLA_ROPE = 32
MLA_V = 64
B_WIDTH = B_HEADS * MLA_V

MIX_WIDTH = A_WIDTH + B_WIDTH
IN_SPLITS = (A_WIDTH, A_WIDTH, A_WIDTH, MLA_Q_RANK, MLA_KV_RANK, MLA_ROPE)
IN_WIDTH = sum(IN_SPLITS)

PEER_HEADS = 8
PEER_NKEYS = 128
PEER_EXPERTS = PEER_NKEYS * PEER_NKEYS
PEER_QDIM = 256
PEER_TOPK = 16
PEER_CHUNK = 128

kernel_name = "hybrid_dilated_mla_peer_layer"


def rmsnorm(x, g):
    xf = x.astype(jnp.float32)
    y = xf * lax.rsqrt(jnp.mean(xf * xf, axis=-1, keepdims=True) + NORM_EPS)
    return (y * g.astype(jnp.float32)).astype(x.dtype)


def rope(x, pos, rot_dim):
    half = rot_dim // 2
    inv = ROPE_THETA ** (-jnp.arange(half, dtype=jnp.float32) / half)
    ang = pos.astype(jnp.float32)[..., None] * inv
    cos = jnp.cos(ang)[:, :, None, :]
    sin = jnp.sin(ang)[:, :, None, :]
    xr = x[..., :rot_dim].astype(jnp.float32)
    x1, x2 = xr[..., :half], xr[..., half:]
    rot = jnp.concatenate([x1 * cos - x2 * sin, x2 * cos + x1 * sin], axis=-1).astype(x.dtype)
    return jnp.concatenate([rot, x[..., rot_dim:]], axis=-1)


def dilated_window_attention(q, k, v, window, dilation):
    b, s, h, e = q.shape
    span = window // dilation
    L = s // dilation
    nb = -(-L // BLK)
    Lp = nb * BLK

    def to_sub(t):
        t = t.reshape(b, L, dilation, h, e).transpose(0, 2, 1, 3, 4)
        return jnp.pad(t, ((0, 0), (0, 0), (0, Lp - L), (0, 0), (0, 0)))

    def band(t):
        t = jnp.pad(t, ((0, 0), (0, 0), (BLK, 0), (0, 0), (0, 0))).reshape(b, dilation, nb + 1, BLK, h, e)
        return jnp.concatenate([t[:, :, :-1], t[:, :, 1:]], axis=3)

    qb = to_sub(q).reshape(b, dilation, nb, BLK, h, e)
    kb = band(to_sub(k))
    vb = band(to_sub(v))
    scores = jnp.einsum('bdnqhe,bdnkhe->bdnhqk', qb, kb).astype(jnp.float32) * (e ** -0.5)
    qi = jnp.arange(BLK)[:, None]
    kj = jnp.arange(2 * BLK)[None, :]
    dist = qi + BLK - kj
    kpos = (jnp.arange(nb)[:, None, None] - 1) * BLK + kj[None]
    valid = (dist >= 0)[None] & (dist <= span)[None] & (kpos >= 0)
    scores = jnp.where(valid[None, None, :, None], scores, NEG_INF)
    m = jnp.max(scores, axis=-1, keepdims=True)
    p = jnp.exp(scores - m)
    den = jnp.sum(p, axis=-1)
    o = jnp.einsum('bdnhqk,bdnkhe->bdnqhe', p, vb.astype(jnp.float32))
    o = o / den.transpose(0, 1, 2, 4, 3)[..., None]
    lse = (m[..., 0] + jnp.log(den)).transpose(0, 1, 2, 4, 3)
    o = o.reshape(b, dilation, Lp, h, e)[:, :, :L].transpose(0, 2, 1, 3, 4).reshape(b, s, h, e)
    lse = lse.reshape(b, dilation, Lp, h)[:, :, :L].transpose(0, 2, 1, 3).reshape(b, s, h)
    return o, lse


def causal_attention_blocked(q, k, v):
    b, s, h, e = q.shape
    ev = v.shape[-1]
    nb = s // BLK
    scale = e ** -0.5
    qb = q.reshape(b, nb, BLK, h, e).transpose(1, 0, 2, 3, 4)
    kpos = jnp.arange(s)
    vf = v.astype(jnp.float32)

    def one_block(args):
        qblk, i = args
        sc = jnp.einsum('bqhe,bkhe->bhqk', qblk, k).astype(jnp.float32) * scale
        qpos = i * BLK + jnp.arange(BLK)
        sc = jnp.where(kpos[None, :] <= qpos[:, None], sc, NEG_INF)
        p = jax.nn.softmax(sc, axis=-1)
        return jnp.einsum('bhqk,bkhe->bqhe', p, vf)

    o = lax.map(one_block, (qb, jnp.arange(nb)))
    return o.transpose(1, 0, 2, 3, 4).reshape(b, s, h, ev)


def peer(hn, w_pq, sub_keys, u_emb, v_emb):
    b, s, d = hn.shape
    t = hn.reshape(b * s, d)
    q = (t @ w_pq).reshape(-1, PEER_HEADS, 2, PEER_QDIM // 2).astype(jnp.float32)
    sc = jnp.einsum('thpc,hpnc->thpn', q, sub_keys.astype(jnp.float32))
    vals, idx = lax.top_k(sc, PEER_TOPK)
    cand = vals[:, :, 0, :, None] + vals[:, :, 1, None, :]
    best, flat = lax.top_k(cand.reshape(cand.shape[0], PEER_HEADS, PEER_TOPK * PEER_TOPK), PEER_TOPK)
    i1 = jnp.take_along_axis(idx[:, :, 0], flat // PEER_TOPK, axis=-1)
    i2 = jnp.take_along_axis(idx[:, :, 1], flat % PEER_TOPK, axis=-1)
    expert = i1 * PEER_NKEYS + i2
    gate = jax.nn.softmax(best, axis=-1)
    nc = t.shape[0] // PEER_CHUNK

    def one_chunk(args):
        tc, ec, gc = args
        u_sel = u_emb[ec]
        act = jax.nn.gelu(jnp.einsum('td,thkd->thk', tc, u_sel).astype(jnp.float32), approximate=False)
        return jnp.einsum('thk,thkd->td', (act * gc).astype(tc.dtype), v_emb[ec])

    out = lax.map(one_chunk, (t.reshape(nc, PEER_CHUNK, d),
                              expert.reshape(nc, PEER_CHUNK, PEER_HEADS, PEER_TOPK),
                              gate.reshape(nc, PEER_CHUNK, PEER_HEADS, PEER_TOPK)))
    return out.reshape(b, s, d)


def setup_inputs(seed: int = 0) -> dict:
    key = jax.random.key(seed)
    ks = jax.random.split(key, 17)
    nrm = lambda k, shape, scale: jax.random.normal(k, shape, jnp.float32) * scale
    gain = lambda k, shape: 1.0 + 0.02 * jax.random.normal(k, shape, jnp.float32)
    x = jax.random.normal(ks[0], (BATCH, SEQ, D_MODEL), jnp.float32)
    offset = jax.random.randint(ks[1], (BATCH, 1), 0, 1024, dtype=jnp.int32)
    positions = (jnp.arange(SEQ, dtype=jnp.int32)[None, :] + offset).astype(jnp.int32)
    return {
        "x": x,
        "positions": positions,
        "g_mix": gain(ks[2], (DEPTH, D_MODEL)),
        "w_in": nrm(ks[3], (DEPTH, D_MODEL, IN_WIDTH), D_MODEL ** -0.5),
        "g_cq": gain(ks[4], (DEPTH, MLA_Q_RANK)),
        "w_uq": nrm(ks[5], (DEPTH, MLA_Q_RANK, B_HEADS * (MLA_NOPE + MLA_ROPE)), MLA_Q_RANK ** -0.5),
        "g_ckv": gain(ks[6], (DEPTH, MLA_KV_RANK)),
        "w_ukv": nrm(ks[7], (DEPTH, MLA_KV_RANK, B_HEADS * (MLA_NOPE + MLA_V)), MLA_KV_RANK ** -0.5),
        "w_out": nrm(ks[8], (DEPTH, MIX_WIDTH, D_MODEL), MIX_WIDTH ** -0.5),
        "g_ffn": gain(ks[9], (DEPTH, D_MODEL)),
        "w_pq": nrm(ks[10], (DEPTH, D_MODEL, PEER_HEADS * PEER_QDIM), D_MODEL ** -0.5),
        "sub_keys": nrm(ks[11], (DEPTH, PEER_HEADS, 2, PEER_NKEYS, PEER_QDIM // 2), (PEER_QDIM // 2) ** -0.5),
        "u_emb": nrm(ks[12], (DEPTH, PEER_EXPERTS, D_MODEL), D_MODEL ** -0.5),
        "v_emb": nrm(ks[13], (DEPTH, PEER_EXPERTS, D_MODEL), PEER_HEADS ** -0.5),
        "g_final": gain(ks[14], (D_MODEL,)),
    }


def reference(x, positions, g_mix, w_in, g_cq, w_uq, g_ckv, w_ukv, w_out, g_ffn,
              w_pq, sub_keys, u_emb, v_emb, g_final):
    b, s, _ = x.shape
    offs = np.cumsum(IN_SPLITS)[:-1].tolist()
    h = x
    for l in range(DEPTH):
        hn = rmsnorm(h, g_mix[l])
        proj = hn @ w_in[l]
        qa, ka, va, cq, ckv, kr = jnp.split(proj, offs, axis=-1)

        qa = rope(qa.reshape(b, s, A_HEADS, HEAD_DIM), positions, A_ROT_DIM)
        ka = rope(ka.reshape(b, s, A_HEADS, HEAD_DIM), positions, A_ROT_DIM)
        va = va.reshape(b, s, A_HEADS, HEAD_DIM)
        outs, lses = [], []
        for window, dilation in DIL_PATTERNS:
            o_i, lse_i = dilated_window_attention(qa, ka, va, window, dilation)
            outs.append(o_i)
            lses.append(lse_i)
        wts = jax.nn.softmax(jnp.stack(lses, axis=0), axis=0)
        o_a = jnp.einsum('pbsh,pbshe->bshe', wts, jnp.stack(outs, axis=0)).astype(h.dtype)

        qm = (rmsnorm(cq, g_cq[l]) @ w_uq[l]).reshape(b, s, B_HEADS, MLA_NOPE + MLA_ROPE)
        q_m = jnp.concatenate([qm[..., :MLA_NOPE], rope(qm[..., MLA_NOPE:], positions, MLA_ROPE)], axis=-1)
        kv = (rmsnorm(ckv, g_ckv[l]) @ w_ukv[l]).reshape(b, s, B_HEADS, MLA_NOPE + MLA_V)
        k_rope = rope(kr[:, :, None, :], positions, MLA_ROPE)
        k_m = jnp.concatenate([kv[..., :MLA_NOPE],
                               jnp.broadcast_to(k_rope, (b, s, B_HEADS, MLA_ROPE))], axis=-1)
        o_m = causal_attention_blocked(q_m, k_m, kv[..., MLA_NOPE:]).astype(h.dtype)

        mixed = jnp.concatenate([o_a.reshape(b, s, A_WIDTH), o_m.reshape(b, s, B_WIDTH)], axis=-1)
        h = h + mixed @ w_out[l]

        h = h + peer(rmsnorm(h, g_ffn[l]), w_pq[l], sub_keys[l], u_emb[l], v_emb[l])
    return rmsnorm(h, g_final)
```

```cpp
#include <hip/hip_runtime.h>
#include <hip/hip_bf16.h>
#include <math.h>
#include <stdio.h>
#include <stdint.h>

#define LAS __attribute__((address_space(3)))
#define GAS __attribute__((address_space(1)))
typedef unsigned short bf16_t;
typedef short bf16x8 __attribute__((ext_vector_type(8)));
typedef short s16x4 __attribute__((ext_vector_type(4)));
typedef float f32x2 __attribute__((ext_vector_type(2)));
typedef float f32x4 __attribute__((ext_vector_type(4)));
typedef float f32x16 __attribute__((ext_vector_type(16)));
typedef unsigned u32x2 __attribute__((ext_vector_type(2)));
typedef unsigned u32x4 __attribute__((ext_vector_type(4)));
typedef __bf16 bf16x2_t __attribute__((ext_vector_type(2)));
typedef _Float16 f16x2_t __attribute__((ext_vector_type(2)));
typedef int v8i __attribute__((ext_vector_type(8)));

constexpr int DM = 1024, NB = 2, SEQ = 8192, T = NB * SEQ;
constexpr int INW = 1952;
constexpr float EPS = 1e-6f;
constexpr float LOG2E = 1.4426950408889634f;
constexpr float QA_SCALE = 0.125f * LOG2E;
constexpr float QM_SCALE = 0.10206207261596577f * LOG2E;

constexpr size_t MiB = 1u << 20;
constexpr size_t WS_CTL = 0, CTL_ZERO_BYTES = 64 * 1024;
constexpr size_t WS_COSA = 1 * MiB, WS_SINA = WS_COSA + 512 * 1024, WS_COSM = 2 * MiB, WS_SINM = 3 * MiB;
constexpr size_t WS_WIN = 4 * MiB, WS_WCOMB = 8 * MiB, WS_WOUT = 12 * MiB, WS_WUQ = 14 * MiB, WS_WUKV = 14 * MiB + 512 * 1024;
constexpr size_t WS_SSQQ = 15 * MiB, WS_SSQKV = 15 * MiB + 512 * 1024;
constexpr size_t WS_U8 = 16 * MiB, WS_V8 = 32 * MiB;
constexpr size_t WS_HN = 80 * MiB, WS_MIXED = 80 * MiB;
constexpr size_t WS_QA = 112 * MiB, WS_KA = 128 * MiB, WS_VA = 144 * MiB;
constexpr size_t WS_CQ = 160 * MiB, WS_CKV = 168 * MiB, WS_KR = 172 * MiB;
constexpr size_t WS_QM = 176 * MiB, WS_KN = 200 * MiB, WS_VM = 216 * MiB;
constexpr size_t WS_SSQH = 232 * MiB;
constexpr size_t WS_HB = 112 * MiB, WS_SC = 144 * MiB;
constexpr size_t WS_HB8 = 208 * MiB;
constexpr size_t WS_ZP = 48 * MiB, WS_PEROW = 80 * MiB, WS_PESLOT = 84 * MiB, WS_PG = 88 * MiB, WS_SSQY = 96 * MiB, WS_RSTDH = 97 * MiB, WS_PE2 = 176 * MiB, WS_PA2 = 180 * MiB;
constexpr size_t WS_OP = 144 * MiB;
constexpr float SU = 256.f, SX = 16.f, SV = 64.f;
constexpr size_t WS_END = 234 * MiB;
static_assert(WS_KA == WS_QA + 16 * MiB && WS_VA == WS_KA + 16 * MiB && WS_VM == WS_KN + 16 * MiB, "epilogues address Ka/Va and Vm relative to Qa and Kn");

__device__ __forceinline__ unsigned pk_bf16(float lo, float hi) { f32x2 v = {lo, hi}; bf16x2_t b = __builtin_convertvector(v, bf16x2_t); return __builtin_bit_cast(unsigned, b); }
__device__ __forceinline__ unsigned pk_f16(float lo, float hi) { f32x2 v = {lo, hi}; f16x2_t b = __builtin_convertvector(v, f16x2_t); return __builtin_bit_cast(unsigned, b); }
__device__ __forceinline__ unsigned pk_fp8x4(float a, float b, float c, float d) { int w = __builtin_amdgcn_cvt_pk_fp8_f32(a, b, 0, false); w = __builtin_amdgcn_cvt_pk_fp8_f32(c, d, w, true); return (unsigned)w; }
__device__ __forceinline__ float bf_lo(unsigned w) { return __builtin_bit_cast(float, w << 16); }
__device__ __forceinline__ float bf_hi(unsigned w) { return __builtin_bit_cast(float, w & 0xffff0000u); }
__device__ __forceinline__ float wave_sum(float v) {
#pragma unroll
    for (int o = 1; o < 64; o <<= 1) v += __shfl_xor(v, o);
    return v;
}
__device__ __forceinline__ int crow(int r, int hi) { return (r & 3) + 8 * (r >> 2) + 4 * hi; }
__device__ __forceinline__ void glds16(const void* gsrc, unsigned lds_dst) { unsigned keep;
    asm volatile("s_mov_b32 %0, m0\n\ts_mov_b32 m0, %2\n\ts_nop 0\n\tglobal_load_lds_dwordx4 %1, off\n\ts_mov_b32 m0, %0" : "=&s"(keep) : "v"(gsrc), "s"(lds_dst) : "memory"); }

#define STAGE 6


namespace pg8 {
#define PG8_LAS __attribute__((address_space(3)))
typedef unsigned short bf16_t;
typedef short bf16x8 __attribute__((ext_vector_type(8)));
typedef float f32x4 __attribute__((ext_vector_type(4)));
typedef unsigned u32x4 __attribute__((ext_vector_type(4)));
constexpr int BM = 256, BK = 64, HALF = 128, HTB = HALF * BK * 2  , STAGE_BYTES = 8 * HTB, NXCD = 8, WGM = 8;

__host__ __device__ __forceinline__ int lds_byte(int r, int c) { const int st = (r >> 4) * 2 + (c >> 5), rr = r & 15, cc = c & 31, ob = rr * 64 + cc * 2; return st * 1024 + (ob ^ (((ob >> 9) & 1) << 5)); }
__host__ __device__ __forceinline__ void stage_rc(int b, int& R, int& C) { const int st = b / 1024, sb = b % 1024, swz = sb ^ (((sb >> 9) & 1) << 5); R = (st >> 1) * 16 + swz / 64; C = (st & 1) * 32 + (swz % 64) / 2; }
__host__ __device__ __forceinline__ int perm32(int rho) { const int n = rho >> 4, i = rho & 15; return 8 * (i >> 2) + 4 * n + (i & 3); }

struct Unit { int pm, pn; };
struct Gemm { const bf16_t* A; const bf16_t* Bt; int M, N, K; };

struct StaticOrder {
    int nM, nN, nwg, G, c;
    __host__ __device__ void init(int M, int N, int G_, int c_) { nM = M / BM; nN = N / BM; nwg = nM * nN; G = G_; c = c_; }
    __host__ __device__ bool next(int i, Unit& u) const {
        const long L = (long)i * G + c; if (L >= nwg) return false;
        int wgid = (int)L; { const int q = nwg / NXCD, r = nwg % NXCD, xcd = wgid % NXCD, off = wgid / NXCD; wgid = (xcd < r ? xcd * (q + 1) : r * (q + 1) + (xcd - r) * q) + off; }
        const int nig = WGM * nN, gid = wgid / nig, fm = gid * WGM, gsz = (nM - fm) < WGM ? (nM - fm) : WGM;
        u.pm = fm + ((wgid % nig) % gsz); u.pn = (wgid % nig) / gsz; return true;
    }
    __device__ __forceinline__ void a_ready(const Unit&) const {}
    __device__ __forceinline__ void done(const Unit&) const {}
};


__device__ __forceinline__ unsigned cvt_pk_bf16(float lo, float hi) { unsigned r; asm volatile("v_cvt_pk_bf16_f32 %0, %1, %2" : "=v"(r) : "v"(lo), "v"(hi)); return r; }
typedef float f32x2 __attribute__((ext_vector_type(2)));

__device__ __forceinline__ void load8(const float* p, float (&o)[8]);

template <class Epi, class Sched, bool ALIGN_EPI = false, bool SP2 = false>
__device__ __forceinline__ void gemm_phase(PG8_LAS unsigned char* lds, const Gemm g, const Sched& S, const Epi& E) {
    const int tid = threadIdx.x, wid = __builtin_amdgcn_readfirstlane(tid >> 6), lane = tid & 63, wr = wid >> 2, wc = wid & 3, fr = lane & 15, fq = lane >> 4;
    const int K = g.K, nt = K / BK;
    unsigned voffA[2], voffB[2];
#pragma unroll
    for (int i = 0; i < 2; ++i) { int R, C; stage_rc(tid * 16 + i * 8192, R, C); const int Rb = Epi::PERM ? ((R & ~31) + perm32(R & 31)) : R;
        voffA[i] = (unsigned)(R * K + C) * 2u; voffB[i] = (unsigned)(Rb * K + C) * 2u; }
    const size_t kstep = (size_t)(BK * 2);
    const size_t hstep = (size_t)HALF * K * 2;
    const size_t tstep = 2 * hstep;
    const unsigned ldsw = (unsigned)wid * 1024u;
    const int aoff = lds_byte(wr * 64 + fr, fq * 8), boff = lds_byte(wc * 32 + fr, fq * 8);
#define PG8_SA(b, h) (((b) * 2 + (h)) * HTB)
#define PG8_SB(b, h) ((4 + (b) * 2 + (h)) * HTB)
#define PG8_STAGE(bufoff, gbase, voff) do { _Pragma("unroll") for (int _i = 0; _i < 2; ++_i) \
        __builtin_amdgcn_global_load_lds((const unsigned*)((const char*)(gbase) + (voff)[_i]), (PG8_LAS unsigned*)(lds + (bufoff) + ldsw + _i * 8192), 16, 0, 0); } while (0)
#define PG8_LDA(dst, b, h) do { _Pragma("unroll") for (int m = 0; m < 4; ++m) _Pragma("unroll") for (int k = 0; k < 2; ++k) dst[m][k] = *(const PG8_LAS bf16x8*)(lds + PG8_SA(b, h) + aoff + m * 2048 + k * 1024); } while (0)
#define PG8_LDB(dst, b, h) do { _Pragma("unroll") for (int n = 0; n < 2; ++n) _Pragma("unroll") for (int k = 0; k < 2; ++k) dst[n][k] = *(const PG8_LAS bf16x8*)(lds + PG8_SB(b, h) + boff + n * 2048 + k * 1024); } while (0)
#define PG8_MMA(ai, bj, At, Bt) do { __builtin_amdgcn_s_setprio(1); _Pragma("unroll") for (int m = 0; m < 4; ++m) _Pragma("unroll") for (int n = 0; n < 2; ++n) _Pragma("unroll") for (int k = 0; k < 2; ++k) \
        acc[ai][bj][m][n] = __builtin_amdgcn_mfma_f32_16x16x32_bf16(Bt[n][k], At[m][k], acc[ai][bj][m][n], 0, 0, 0); __builtin_amdgcn_s_setprio(0); } while (0)
#define PG8_WAIT_V(n) asm volatile("s_waitcnt vmcnt(" #n ")" ::: "memory")
#define PG8_WAIT_L(n) asm volatile("s_waitcnt lgkmcnt(" #n ")" ::: "memory")
#define PG8_BAR __builtin_amdgcn_s_barrier()
#define PG8_SCHED __builtin_amdgcn_sched_barrier(0)
    Unit cur, nxt; int ui = 0;
    if (!S.next(0, cur)) return;
    f32x4 acc[2][2][4][2];
#pragma unroll
    for (int a = 0; a < 2; ++a)
#pragma unroll
        for (int b = 0; b < 2; ++b)
#pragma unroll
            for (int m = 0; m < 4; ++m)
#pragma unroll
                for (int n = 0; n < 2; ++n) acc[a][b][m][n] = (f32x4){0.f, 0.f, 0.f, 0.f};
    bf16x8 At[4][2], B0[2][2], B1[2][2];
    const char* cA = (const char*)g.A + (size_t)cur.pm * tstep; const char* cB = (const char*)g.Bt + (size_t)cur.pn * tstep;
    S.a_ready(cur);
    if constexpr (SP2) {
        PG8_STAGE(PG8_SB(0, 0), cB, voffB); PG8_STAGE(PG8_SB(0, 1), cB + hstep, voffB); PG8_STAGE(PG8_SA(0, 0), cA, voffA); PG8_STAGE(PG8_SA(0, 1), cA + hstep, voffA);
        if (wr == 1) PG8_BAR;
        PG8_WAIT_V(2); PG8_BAR;
        PG8_STAGE(PG8_SB(1, 0), cB + kstep, voffB); PG8_STAGE(PG8_SA(1, 0), cA + kstep, voffA); PG8_STAGE(PG8_SB(1, 1), cB + hstep + kstep, voffB);
        PG8_WAIT_V(6); PG8_BAR;
    } else {
        PG8_STAGE(PG8_SB(0, 0), cB, voffB); PG8_STAGE(PG8_SA(0, 0), cA, voffA); PG8_STAGE(PG8_SB(0, 1), cB + hstep, voffB); PG8_STAGE(PG8_SA(0, 1), cA + hstep, voffA);
        if (wr == 1) PG8_BAR;
        PG8_WAIT_V(4); PG8_BAR;
        PG8_STAGE(PG8_SB(1, 0), cB + kstep, voffB); PG8_STAGE(PG8_SA(1, 0), cA + kstep, voffA); PG8_STAGE(PG8_SB(1, 1), cB + hstep + kstep, voffB);
        PG8_WAIT_V(6); PG8_BAR;
    }
    for (;;) {
        const bool has_next = S.next(ui + 1, nxt);
        const char* nA = has_next ? (const char*)g.A + (size_t)nxt.pm * tstep : cA; const char* nB = has_next ? (const char*)g.Bt + (size_t)nxt.pn * tstep : cB;
        for (int t = 0; t < nt; t += 2) {
            const bool last = (t == nt - 2);
            const char* a1 = cA + (size_t)(t + 1) * kstep;
            const char* a2 = last ? nA : cA + (size_t)(t + 2) * kstep; const char* b2 = last ? nB : cB + (size_t)(t + 2) * kstep;
            const char* a3 = a2 + kstep; const char* b3 = b2 + kstep;
            if (last && has_next) S.a_ready(nxt);
            if constexpr (SP2) {
            PG8_LDB(B0, 0, 0); PG8_LDB(B1, 0, 1); PG8_SCHED; PG8_LDA(At, 0, 0); PG8_STAGE(PG8_SA(1, 1), a1 + hstep, voffA);
            PG8_WAIT_V(8); PG8_WAIT_L(0); PG8_BAR; PG8_MMA(0, 0, At, B0); PG8_MMA(0, 1, At, B1); PG8_BAR; PG8_SCHED;
            PG8_LDA(At, 0, 1); PG8_STAGE(PG8_SB(0, 0), b2, voffB); PG8_STAGE(PG8_SB(0, 1), b2 + hstep, voffB); PG8_STAGE(PG8_SA(0, 0), a2, voffA);
            PG8_WAIT_V(8); PG8_WAIT_L(0); PG8_BAR; PG8_MMA(1, 0, At, B0); PG8_MMA(1, 1, At, B1); PG8_BAR; PG8_SCHED;
            PG8_LDB(B0, 1, 0); PG8_LDB(B1, 1, 1); PG8_SCHED; PG8_LDA(At, 1, 0); PG8_STAGE(PG8_SA(0, 1), a2 + hstep, voffA);
            PG8_WAIT_V(8); PG8_WAIT_L(0); PG8_BAR; PG8_MMA(0, 0, At, B0); PG8_MMA(0, 1, At, B1); PG8_BAR; PG8_SCHED;
            PG8_LDA(At, 1, 1); PG8_STAGE(PG8_SB(1, 0), b3, voffB); PG8_STAGE(PG8_SB(1, 1), b3 + hstep, voffB); PG8_STAGE(PG8_SA(1, 0), a3, voffA);
            PG8_WAIT_V(8); PG8_WAIT_L(0); PG8_BAR; PG8_MMA(1, 0, At, B0); PG8_MMA(1, 1, At, B1); PG8_BAR; PG8_SCHED;
            } else {
            PG8_LDB(B0, 0, 0); PG8_SCHED; PG8_LDA(At, 0, 0); PG8_STAGE(PG8_SA(1, 1), a1 + hstep, voffA);
            PG8_WAIT_L(8); PG8_BAR; PG8_WAIT_L(0); PG8_MMA(0, 0, At, B0); PG8_BAR; PG8_SCHED;
            PG8_LDB(B1, 0, 1); PG8_STAGE(PG8_SB(0, 0), b2, voffB);
            PG8_BAR; PG8_WAIT_L(0); PG8_MMA(0, 1, At, B1); PG8_BAR;
            PG8_LDA(At, 0, 1); PG8_STAGE(PG8_SA(0, 0), a2, voffA);
            PG8_BAR; PG8_WAIT_L(0); PG8_MMA(1, 0, At, B0); PG8_BAR; PG8_SCHED;
            PG8_STAGE(PG8_SB(0, 1), b2 + hstep, voffB);
            PG8_WAIT_V(6); PG8_BAR; PG8_MMA(1, 1, At, B1); PG8_BAR;
            PG8_LDB(B0, 1, 0); PG8_SCHED; PG8_LDA(At, 1, 0); PG8_STAGE(PG8_SA(0, 1), a2 + hstep, voffA);
            PG8_WAIT_L(8); PG8_BAR; PG8_WAIT_L(0); PG8_MMA(0, 0, At, B0); PG8_BAR; PG8_SCHED;
            PG8_LDB(B1, 1, 1); PG8_STAGE(PG8_SB(1, 0), b3, voffB);
            PG8_BAR; PG8_WAIT_L(0); PG8_MMA(0, 1, At, B1); PG8_BAR;
            PG8_LDA(At, 1, 1); PG8_STAGE(PG8_SA(1, 0), a3, voffA);
            PG8_BAR; PG8_WAIT_L(0); PG8_MMA(1, 0, At, B0); PG8_BAR; PG8_SCHED;
            PG8_STAGE(PG8_SB(1, 1), b3 + hstep, voffB);
            PG8_WAIT_V(6); PG8_BAR; PG8_MMA(1, 1, At, B1); PG8_BAR;
            }
        }
        if constexpr (ALIGN_EPI) { if (wr == 0) PG8_BAR; }
        if constexpr (!Epi::AFTER_DRAIN) { E(acc, cur, wr, wc, fr, fq); S.done(cur); }
        if (!has_next) break;
#pragma unroll
        for (int a = 0; a < 2; ++a)
#pragma unroll
            for (int b = 0; b < 2; ++b)
#pragma unroll
                for (int m = 0; m < 4; ++m)
#pragma unroll
                    for (int n = 0; n < 2; ++n) acc[a][b][m][n] = (f32x4){0.f, 0.f, 0.f, 0.f};
        cur = nxt; cA = nA; cB = nB; ++ui;
        if constexpr (ALIGN_EPI) { if (wr == 1) PG8_BAR; }
    }
    PG8_WAIT_V(0);
    if constexpr (!ALIGN_EPI) { if (wr == 0) PG8_BAR; }
    PG8_BAR;
    if constexpr (Epi::AFTER_DRAIN) { E.fused(acc, cur, wr, wc, fr, fq, lds, wid, lane); S.done(cur); }
#undef PG8_SA
#undef PG8_SB
#undef PG8_STAGE
#undef PG8_LDA
#undef PG8_LDB
#undef PG8_MMA
#undef PG8_WAIT_V
#undef PG8_WAIT_L
#undef PG8_BAR
#undef PG8_SCHED
}
}

namespace pg8 {
#define EPI_V8(ai, bj, m) { acc[ai][bj][m][0][0], acc[ai][bj][m][0][1], acc[ai][bj][m][0][2], acc[ai][bj][m][0][3], acc[ai][bj][m][1][0], acc[ai][bj][m][1][1], acc[ai][bj][m][1][2], acc[ai][bj][m][1][3] }
__device__ __forceinline__ u32x4 pack8(const float (&v)[8], float s) { u32x4 w; w.x = pk_bf16(v[0] * s, v[1] * s); w.y = pk_bf16(v[2] * s, v[3] * s); w.z = pk_bf16(v[4] * s, v[5] * s); w.w = pk_bf16(v[6] * s, v[7] * s); return w; }
__device__ __forceinline__ float ssq8(const float (&v)[8]) { return ((v[0] * v[0] + v[1] * v[1]) + (v[2] * v[2] + v[3] * v[3])) + ((v[4] * v[4] + v[5] * v[5]) + (v[6] * v[6] + v[7] * v[7])); }
__device__ __forceinline__ void load8(const float* p, float (&o)[8]) { const f32x4 a = *(const f32x4*)p, b = *(const f32x4*)(p + 4); o[0] = a.x; o[1] = a.y; o[2] = a.z; o[3] = a.w; o[4] = b.x; o[5] = b.y; o[6] = b.z; o[7] = b.w; }

struct EpiProj {
    static constexpr bool PERM = true, AFTER_DRAIN = false;
    bf16_t *Qa, *Ka, *Va, *Cq, *Ckv, *Kr; float *ssq_q, *ssq_kv; const float *cosA, *sinA, *cosM, *sinM;
    __device__ __forceinline__ void operator()(const f32x4 (&acc)[2][2][4][2], const Unit& u, int wr, int wc, int fr, int fq) const {
        const int pn = u.pn, rowb = u.pm * BM + wr * 64 + fr;
        if (pn < 6) {
            const int kind = pn >> 1;
            bf16_t* dst = Qa + (size_t)kind * (size_t)(8u << 20);
            const float sc = kind == 0 ? QA_SCALE : 1.f;
            const bool ropew = (kind < 2) && ((wc & 1) == 0);
            float cq[2][8], sq[2][8];
            if (ropew) {
#pragma unroll
                for (int g = 0; g < 2; ++g) { const size_t r_ = (size_t)(rowb + g * 16) * 8; load8(cosA + r_, cq[g]); load8(sinA + r_, sq[g]); }
            }
#pragma unroll
            for (int ai = 0; ai < 2; ++ai)
#pragma unroll
                for (int m = 0; m < 4; ++m) {
                    const int row = rowb + ai * HALF + m * 16;
                    float cs[8], sn[8];
                    if (ropew) {
#pragma unroll
                        for (int i = 0; i < 8; ++i) { cs[i] = cq[m & 1][i]; sn[i] = sq[m & 1][i]; }
                        if (ai * 4 + m + 2 < 8) { const int g2 = ai * 4 + m + 2; const size_t r_ = (size_t)(rowb + (g2 >> 2) * HALF + (g2 & 3) * 16) * 8; load8(cosA + r_, cq[m & 1]); load8(sinA + r_, sq[m & 1]); }
                    }
#pragma unroll
                    for (int bj = 0; bj < 2; ++bj) {
                        float v[8] = EPI_V8(ai, bj, m);
                        if (ropew) {
#pragma unroll
                            for (int i = 0; i < 8; ++i) { const float pv = __shfl_xor(v[i], 16); if (fq == 0) v[i] = v[i] * cs[i] - pv * sn[i]; else if (fq == 1) v[i] = v[i] * cs[i] + pv * sn[i]; }
                        }
                        *(u32x4*)(dst + ((size_t)((row >> 13) * 8 + (pn & 1) * 4 + bj * 2 + (wc >> 1)) * SEQ + (row & (SEQ - 1))) * 64 + (wc & 1) * 32 + fq * 8) = pack8(v, sc);
                    }
                }
        } else if (pn == 6) {
#pragma unroll
            for (int ai = 0; ai < 2; ++ai)
#pragma unroll
                for (int m = 0; m < 4; ++m) {
                    const int row = rowb + ai * HALF + m * 16;
#pragma unroll
                    for (int bj = 0; bj < 2; ++bj) {
                        float v[8] = EPI_V8(ai, bj, m);
                        float s = ssq8(v); s += __shfl_xor(s, 16); s += __shfl_xor(s, 32);
                        if (fq == 0) ssq_q[(size_t)row * 8 + bj * 4 + wc] = s;
                        *(u32x4*)(Cq + (size_t)row * 256 + bj * HALF + wc * 32 + fq * 8) = pack8(v, 1.f);
                    }
                }
        } else {
#pragma unroll
            for (int ai = 0; ai < 2; ++ai)
#pragma unroll
                for (int m = 0; m < 4; ++m) {
                    const int row = rowb + ai * HALF + m * 16;
                    {
                        float v[8] = EPI_V8(ai, 0, m);
                        float s = ssq8(v); s += __shfl_xor(s, 16); s += __shfl_xor(s, 32);
                        if (fq == 0) ssq_kv[(size_t)row * 4 + wc] = s;
                        *(u32x4*)(Ckv + (size_t)row * 128 + wc * 32 + fq * 8) = pack8(v, 1.f);
                    }
                    if (wc == 0) {
                        float v[8] = EPI_V8(ai, 1, m);
                        float cs[8], sn[8];
                        load8(cosM + (size_t)row * 16 + 8 * (fq & 1), cs); load8(sinM + (size_t)row * 16 + 8 * (fq & 1), sn);
#pragma unroll
                        for (int i = 0; i < 8; ++i) { const float pv = __shfl_xor(v[i], 32); v[i] = (fq < 2) ? (v[i] * cs[i] - pv * sn[i]) : (v[i] * cs[i] + pv * sn[i]); }
                        *(u32x4*)(Kr + (size_t)row * 32 + fq * 8) = pack8(v, 1.f);
                    }
                }
        }
    }
};

struct EpiQm {
    static constexpr bool PERM = true, AFTER_DRAIN = false;
    bf16_t* Qm; const float* ssq_q; const float *cosM, *sinM;
    __device__ __forceinline__ void operator()(const f32x4 (&acc)[2][2][4][2], const Unit& u, int wr, int wc, int fr, int fq) const {
        const int pn = u.pn, rowb = u.pm * BM + wr * 64 + fr;
        f32x2 qa[8];
#pragma unroll
        for (int g = 0; g < 8; ++g) qa[g] = *(const f32x2*)(ssq_q + (size_t)(rowb + (g >> 2) * HALF + (g & 3) * 16) * 8 + 2 * fq);
        float cq[2][8], sq[2][8];
#pragma unroll
        for (int g = 0; g < 2; ++g) { const size_t r_ = (size_t)(rowb + g * 16) * 16 + 8 * (fq & 1); load8(cosM + r_, cq[g]); load8(sinM + r_, sq[g]); }
#pragma unroll
        for (int ai = 0; ai < 2; ++ai)
#pragma unroll
            for (int m = 0; m < 4; ++m) {
                const int row = rowb + ai * HALF + m * 16, g = ai * 4 + m;
                float ssum = qa[g].x + qa[g].y; ssum += __shfl_xor(ssum, 16); ssum += __shfl_xor(ssum, 32);
                const float rs = 1.0f / sqrtf(ssum * (1.f / 256.f) + EPS);
                float cs[8], sn[8];
#pragma unroll
                for (int i = 0; i < 8; ++i) { cs[i] = cq[m & 1][i]; sn[i] = sq[m & 1][i]; }
                if (g + 2 < 8) { const int g2 = g + 2; const size_t r_ = (size_t)(rowb + (g2 >> 2) * HALF + (g2 & 3) * 16) * 16 + 8 * (fq & 1); load8(cosM + r_, cq[m & 1]); load8(sinM + r_, sq[m & 1]); }
#pragma unroll
                for (int bj = 0; bj < 2; ++bj) {
                    const int g32 = pn * 8 + bj * 4 + wc;
                    const bool ropew = (g32 % 3) == 2;
                    float v[8] = EPI_V8(ai, bj, m);
#pragma unroll
                    for (int i = 0; i < 8; ++i) v[i] *= rs;
                    if (ropew) {
#pragma unroll
                        for (int i = 0; i < 8; ++i) { const float pv = __shfl_xor(v[i], 32); v[i] = (fq < 2) ? (v[i] * cs[i] - pv * sn[i]) : (v[i] * cs[i] + pv * sn[i]); }
                    }
                    *(u32x4*)(Qm + (size_t)row * 768 + pn * BM + bj * HALF + wc * 32 + fq * 8) = pack8(v, QM_SCALE);
                }
                asm volatile("" ::: "memory");
            }
    }
};

struct EpiKv {
    static constexpr bool PERM = true, AFTER_DRAIN = false;
    bf16_t *Kn, *Vm; const float* ssq_kv;
    __device__ __forceinline__ void operator()(const f32x4 (&acc)[2][2][4][2], const Unit& u, int wr, int wc, int fr, int fq) const {
        const int pn = u.pn, rowb = u.pm * BM + wr * 64 + fr;
        bf16_t* dst = Kn + (size_t)(wc >> 1) * (size_t)(8u << 20);
        const int within = (wc & 1) * 32 + fq * 8;
        f32x4 q4a[8];
#pragma unroll
        for (int g = 0; g < 8; ++g) q4a[g] = *(const f32x4*)(ssq_kv + (size_t)(rowb + (g >> 2) * HALF + (g & 3) * 16) * 4);
#pragma unroll
        for (int ai = 0; ai < 2; ++ai)
#pragma unroll
            for (int m = 0; m < 4; ++m) {
                const int row = rowb + ai * HALF + m * 16;
                const f32x4 q4 = q4a[ai * 4 + m];
                const float rs = 1.0f / sqrtf(((q4.x + q4.y) + (q4.z + q4.w)) * (1.f / 128.f) + EPS);
#pragma unroll
                for (int bj = 0; bj < 2; ++bj) {
                    float v[8] = EPI_V8(ai, bj, m);
                    *(u32x4*)(dst + ((size_t)((row >> 13) * 8 + pn * 2 + bj) * SEQ + (row & (SEQ - 1))) * 64 + within) = pack8(v, rs);
                }
            }
    }
};

struct EpiOut {
    static constexpr bool PERM = true, AFTER_DRAIN = false;
    const float* x; bf16_t* Hb; unsigned char* Hb8; float* ssq_h;
    __device__ __forceinline__ void operator()(const f32x4 (&acc)[2][2][4][2], const Unit& u, int wr, int wc, int fr, int fq) const {
        const int pn = u.pn, rowb = u.pm * BM + wr * 64 + fr;
        float xq[8][8];
#define XPIECE(t_) (x + (size_t)(rowb + ((t_) >> 3) * HALF + (((t_) >> 1) & 3) * 16) * DM + pn * BM + ((t_) & 1) * HALF + wc * 32 + fq * 8)
#pragma unroll
        for (int t = 0; t < 8; ++t) load8(XPIECE(t), xq[t]);
#pragma unroll
        for (int ai = 0; ai < 2; ++ai)
#pragma unroll
            for (int m = 0; m < 4; ++m) {
                const int row = rowb + ai * HALF + m * 16;
#pragma unroll
                for (int bj = 0; bj < 2; ++bj) {
                    const int col = pn * BM + bj * HALF + wc * 32 + fq * 8, t = (ai * 4 + m) * 2 + bj;
                    float v[8] = EPI_V8(ai, bj, m);
#pragma unroll
                    for (int i = 0; i < 8; ++i) v[i] += xq[t & 7][i];
                    if (t + 8 < 16) load8(XPIECE(t + 8), xq[t & 7]);
                    float s = ssq8(v); s += __shfl_xor(s, 16); s += __shfl_xor(s, 32);
                    if (fq == 0) ssq_h[(size_t)row * 32 + pn * 8 + bj * 4 + wc] = s;
                    *(u32x4*)(Hb + (size_t)row * DM + col) = pack8(v, 1.f);
                    { u32x2 w8; w8.x = pk_fp8x4(v[0] * SX, v[1] * SX, v[2] * SX, v[3] * SX); w8.y = pk_fp8x4(v[4] * SX, v[5] * SX, v[6] * SX, v[7] * SX); *(u32x2*)(Hb8 + (size_t)(col >> 7) * ((size_t)T * 128) + (size_t)row * 128 + (col & 127)) = w8; }
                }
            }
#undef XPIECE
    }
};

struct EpiSc {
    static constexpr bool PERM = true, AFTER_DRAIN = false;
    bf16_t* Sc; const float* ssq_h;
    __device__ __forceinline__ void operator()(const f32x4 (&acc)[2][2][4][2], const Unit& u, int wr, int wc, int fr, int fq) const {
        const int pn = u.pn, rowb = u.pm * BM + wr * 64 + fr;
        f32x4 q[8][2];
#pragma unroll
        for (int g = 0; g < 8; ++g) { const float* qp = ssq_h + (size_t)(rowb + (g >> 2) * HALF + (g & 3) * 16) * 32 + 8 * fq; q[g][0] = *(const f32x4*)qp; q[g][1] = *(const f32x4*)(qp + 4); }
#pragma unroll
        for (int ai = 0; ai < 2; ++ai)
#pragma unroll
            for (int m = 0; m < 4; ++m) {
                const int row = rowb + ai * HALF + m * 16, g = ai * 4 + m;
                float s = ((q[g][0].x + q[g][0].y) + (q[g][0].z + q[g][0].w)) + ((q[g][1].x + q[g][1].y) + (q[g][1].z + q[g][1].w));
                s += __shfl_xor(s, 16); s += __shfl_xor(s, 32);
                const float rs = 1.0f / sqrtf(s * (1.f / 1024.f) + EPS);
#pragma unroll
                for (int bj = 0; bj < 2; ++bj) {
                    float v[8] = EPI_V8(ai, bj, m);
                    u32x4 w; w.x = pk_f16(v[0] * rs, v[1] * rs); w.y = pk_f16(v[2] * rs, v[3] * rs); w.z = pk_f16(v[4] * rs, v[5] * rs); w.w = pk_f16(v[6] * rs, v[7] * rs);
                    *(u32x4*)(Sc + (size_t)row * 2048 + pn * BM + bj * HALF + wc * 32 + fq * 8) = w;
                }
            }
    }
};
#undef EPI_V8
}

namespace att {
constexpr float NEGM = -1.0e30f;
__device__ __forceinline__ s16x4 vtr(const LAS unsigned char* p) { typedef short v4i16_t __attribute__((ext_vector_type(4))); return __builtin_bit_cast(s16x4, __builtin_amdgcn_ds_read_tr16_b64_v4i16((LAS v4i16_t*)p)); }
__device__ __forceinline__ void swap32(unsigned& a, unsigned& b) { asm volatile("s_nop 1\n\tv_permlane32_swap_b32 %0, %1" : "+v"(a), "+v"(b)); }
__device__ __forceinline__ float swapmax(float v) { unsigned a = __builtin_bit_cast(unsigned, v), b = a; swap32(a, b); return fmaxf(__builtin_bit_cast(float, a), __builtin_bit_cast(float, b)); }
__device__ __forceinline__ float swapsum(float v) { unsigned a = __builtin_bit_cast(unsigned, v), b = a; swap32(a, b); return __builtin_bit_cast(float, a) + __builtin_bit_cast(float, b); }
__device__ __forceinline__ float max3f(float a, float b, float c) { float r; asm("v_max3_f32 %0, %1, %2, %3" : "=v"(r) : "v"(a), "v"(b), "v"(c)); return r; }
constexpr float THR = 8.0f;
__device__ __forceinline__ bf16x8 pack_p(const f32x16& p, int s) {
    u32x4 w; w.x = pk_bf16(p[8 * s + 0], p[8 * s + 1]); w.y = pk_bf16(p[8 * s + 2], p[8 * s + 3]); w.z = pk_bf16(p[8 * s + 4], p[8 * s + 5]); w.w = pk_bf16(p[8 * s + 6], p[8 * s + 7]);
    return __builtin_bit_cast(bf16x8, w);
}
__device__ __forceinline__ void pv_block(f32x16& o, const LAS unsigned char* vbase, const bf16x8& pb0, const bf16x8& pb1) {
    const s16x4 l0 = vtr(vbase), h0 = vtr(vbase + 8 * 64), l1 = vtr(vbase + 16 * 64), h1 = vtr(vbase + 24 * 64);
    const bf16x8 a0 = {l0[0], l0[1], l0[2], l0[3], h0[0], h0[1], h0[2], h0[3]}, a1 = {l1[0], l1[1], l1[2], l1[3], h1[0], h1[1], h1[2], h1[3]};
    o = __builtin_amdgcn_mfma_f32_32x32x16_bf16(a0, pb0, o, 0, 0, 0);
    o = __builtin_amdgcn_mfma_f32_32x32x16_bf16(a1, pb1, o, 0, 0, 0);
}
__device__ __forceinline__ void store_o(bf16_t* orow, const f32x16& o0, const f32x16& o1, float inv, int hi) {
#pragma unroll
    for (int g = 0; g < 4; ++g) {
        u32x2 a, b; a.x = pk_bf16(o0[4 * g] * inv, o0[4 * g + 1] * inv); a.y = pk_bf16(o0[4 * g + 2] * inv, o0[4 * g + 3] * inv);
        b.x = pk_bf16(o1[4 * g] * inv, o1[4 * g + 1] * inv); b.y = pk_bf16(o1[4 * g + 2] * inv, o1[4 * g + 3] * inv);
        *(u32x2*)(orow + 8 * g + 4 * hi) = a; *(u32x2*)(orow + 32 + 8 * g + 4 * hi) = b;
    }
}

constexpr int KROW = 208;
constexpr int TK = 128, KBYTES = TK * KROW, VBYTES = 2 * TK * 64, BUFB = KBYTES + VBYTES;
constexpr int MLA_LDS = 2 * BUFB;
__device__ __forceinline__ float rowmax64(const f32x16& s0, const f32x16& s1) {
    float mx = max3f(s0[0], s1[0], s0[1]);
#pragma unroll
    for (int r = 1; r < 15; r += 2) { mx = max3f(mx, s1[r], s0[r + 1]); mx = max3f(mx, s1[r + 1], s0[r + 2 < 16 ? r + 2 : 15]); }
    mx = max3f(mx, s1[15], s0[15]);
    return swapmax(mx);
}
__device__ __forceinline__ void rescale64(float mx, f32x16& s0, f32x16& s1, float& m, float& l, f32x16& o0, f32x16& o1) {
    if (__builtin_amdgcn_ballot_w64(mx > THR) != 0ull) {
        const float dl = fmaxf(mx, 0.f), alpha = __builtin_amdgcn_exp2f(-dl);
        m += dl; l *= alpha;
#pragma unroll
        for (int r = 0; r < 16; ++r) { s0[r] -= dl; s1[r] -= dl; o0[r] *= alpha; o1[r] *= alpha; }
    }
}
__device__ __forceinline__ void exp64(f32x16& s0, f32x16& s1, float& l) {
    float rs = 0.f;
#pragma unroll
    for (int r = 0; r < 16; ++r) { s0[r] = __builtin_amdgcn_exp2f(s0[r]); s1[r] = __builtin_amdgcn_exp2f(s1[r]); rs += s0[r] + s1[r]; }
    l += rs;
}
__device__ __forceinline__ void sm64(f32x16& s0, f32x16& s1, float& m, float& l, f32x16& o0, f32x16& o1, f32x16& t0, f32x16& t1, bool adj_other) {
    float mx = max3f(s0[0], s1[0], s0[1]);
#pragma unroll
    for (int r = 1; r < 15; r += 2) { mx = max3f(mx, s1[r], s0[r + 1]); mx = max3f(mx, s1[r + 1], s0[r + 2 < 16 ? r + 2 : 15]); }
    mx = max3f(mx, s1[15], s0[15]);
    mx = swapmax(mx);
    if (__builtin_amdgcn_ballot_w64(mx > THR) != 0ull) {
        const float dl = fmaxf(mx, 0.f), alpha = __builtin_amdgcn_exp2f(-dl);
        m += dl; l *= alpha;
#pragma unroll
        for (int r = 0; r < 16; ++r) { s0[r] -= dl; s1[r] -= dl; o0[r] *= alpha; o1[r] *= alpha; }
        if (adj_other) {
#pragma unroll
            for (int r = 0; r < 16; ++r) { t0[r] -= dl; t1[r] -= dl; }
        }
    }
    float rs = 0.f;
#pragma unroll
    for (int r = 0; r < 16; ++r) { s0[r] = __builtin_amdgcn_exp2f(s0[r]); s1[r] = __builtin_amdgcn_exp2f(s1[r]); rs += s0[r] + s1[r]; }
    l += rs;
}
constexpr int MLA_G_OFF = 2 * (TK * 208 + 2 * TK * 64), MLA_PIECE_OFF = MLA_G_OFF + 4096;
__device__ __forceinline__ void mla_unit(LAS unsigned char* lds, const bf16_t* __restrict__ Qm, const bf16_t* __restrict__ Kn, const bf16_t* __restrict__ Kr, const bf16_t* __restrict__ Vm,
                                         bf16_t* __restrict__ Mixed, int b, int h, int qb,
                                         const float* __restrict__ u_emb, const float* __restrict__ v_emb, const float* __restrict__ g_ffn, unsigned char* __restrict__ U8, unsigned char* __restrict__ V8, int slot0) {
    const int tid = threadIdx.x, lane = tid & 63, wid = __builtin_amdgcn_readfirstlane(tid >> 6), r32 = lane & 31, hi = lane >> 5;
    const size_t tok0 = (size_t)b * SEQ;
    const int qpos = 256 * qb + 32 * wid + r32;
    bf16x8 qf[6];
    { const bf16_t* qrow = Qm + (tok0 + qpos) * 768 + h * 96 + 8 * hi;
#pragma unroll
      for (int ds = 0; ds < 6; ++ds) qf[ds] = *(const bf16x8*)(qrow + 16 * ds); }
    float m = 0.f, l = 0.f; f32x16 o0 = {}, o1 = {};
    const int nt = 2 * (qb + 1);
    const int wq0 = 256 * qb + 32 * wid, wqlast = wq0 + 31;
    const int srow = tid >> 3, sch = tid & 7, rrow = tid >> 2, rch = tid & 3;
    const bf16_t* gkn = Kn + ((size_t)(b * 8 + h) * SEQ + srow) * 64 + sch * 8;
    const bf16_t* gv = Vm + ((size_t)(b * 8 + h) * SEQ + srow) * 64 + sch * 8;
    const bf16_t* gkr = Kr + (tok0 + rrow) * 32 + rch * 8;
    const int wkn = srow * KROW + sch * 16, wkr = rrow * KROW + 128 + rch * 16, wv = KBYTES + (sch >> 2) * (TK * 64) + srow * 64 + (sch & 3) * 16;
    const int kfrag = r32 * KROW + hi * 16;
    const int i16 = lane & 15, vfrag = KBYTES + (4 * hi + (i16 >> 2)) * 64 + (16 * ((lane >> 4) & 1) + 4 * (i16 & 3)) * 2;
    u32x4 rk0, rk1, rv0, rv1, rr;
#define MLA_LOAD(t) do { const size_t adv_ = (size_t)(t) * TK; rk0 = *(const u32x4*)(gkn + adv_ * 64); rk1 = *(const u32x4*)(gkn + (adv_ + 64) * 64); \
        rv0 = *(const u32x4*)(gv + adv_ * 64); rv1 = *(const u32x4*)(gv + (adv_ + 64) * 64); rr = *(const u32x4*)(gkr + adv_ * 32); } while (0)
#define MLA_STORE(bp) do { LAS unsigned char* b_ = (bp); *(LAS u32x4*)(b_ + wkn) = rk0; *(LAS u32x4*)(b_ + wkn + 64 * KROW) = rk1; *(LAS u32x4*)(b_ + wv) = rv0; *(LAS u32x4*)(b_ + wv + 64 * 64) = rv1; *(LAS u32x4*)(b_ + wkr) = rr; } while (0)
    MLA_LOAD(0); MLA_STORE(lds);
    for (int u = tid; u < DM / 4; u += 512) *(LAS f32x4*)(lds + MLA_G_OFF + 16 * u) = *(const f32x4*)(g_ffn + 4 * u);
    LAS unsigned char* piece = lds + MLA_PIECE_OFF + wid * 1024;
    const unsigned piece_u = (unsigned)__builtin_amdgcn_readfirstlane((int)(unsigned)(uintptr_t)piece);
    __syncthreads();
    for (int kt = 0; kt < nt; ++kt) {
        const LAS unsigned char* buf = lds + (kt & 1) * BUFB;
        if (kt + 1 < nt) MLA_LOAD(kt + 1);
        const int pid = slot0 + 8 * kt + wid;
        if (pid < 131072) glds16(((pid >> 16) ? v_emb : u_emb) + (size_t)(pid & 65535) * 256 + 4 * lane, piece_u);
        if (TK * kt + 127 <= wq0) {
            f32x16 a0, a1, b0, b1;
            { const float nm = -m; a0 = (f32x16){nm, nm, nm, nm, nm, nm, nm, nm, nm, nm, nm, nm, nm, nm, nm, nm}; a1 = a0; }
#pragma unroll
            for (int ds = 0; ds < 6; ++ds) {
                const bf16x8 k0 = *(const LAS bf16x8*)(buf + kfrag + ds * 32), k1 = *(const LAS bf16x8*)(buf + kfrag + 32 * KROW + ds * 32);
                a0 = __builtin_amdgcn_mfma_f32_32x32x16_bf16(k0, qf[ds], a0, 0, 0, 0);
                a1 = __builtin_amdgcn_mfma_f32_32x32x16_bf16(k1, qf[ds], a1, 0, 0, 0);
            }
            rescale64(rowmax64(a0, a1), a0, a1, m, l, o0, o1);
            { const float nm = -m; b0 = (f32x16){nm, nm, nm, nm, nm, nm, nm, nm, nm, nm, nm, nm, nm, nm, nm, nm}; b1 = b0; }
#pragma unroll
            for (int ds = 0; ds < 6; ++ds) {
                const bf16x8 k2 = *(const LAS bf16x8*)(buf + kfrag + 64 * KROW + ds * 32), k3 = *(const LAS bf16x8*)(buf + kfrag + 96 * KROW + ds * 32);
                b0 = __builtin_amdgcn_mfma_f32_32x32x16_bf16(k2, qf[ds], b0, 0, 0, 0);
                b1 = __builtin_amdgcn_mfma_f32_32x32x16_bf16(k3, qf[ds], b1, 0, 0, 0);
            }
            exp64(a0, a1, l);
            { const bf16x8 p00 = pack_p(a0, 0), p01 = pack_p(a0, 1), p10 = pack_p(a1, 0), p11 = pack_p(a1, 1);
              pv_block(o0, buf + vfrag, p00, p01); pv_block(o0, buf + vfrag + 2048, p10, p11);
              pv_block(o1, buf + vfrag + TK * 64, p00, p01); pv_block(o1, buf + vfrag + TK * 64 + 2048, p10, p11); }
            const float mxb = rowmax64(b0, b1);
            rescale64(mxb, b0, b1, m, l, o0, o1);
            exp64(b0, b1, l);
            { const bf16x8 p00 = pack_p(b0, 0), p01 = pack_p(b0, 1), p10 = pack_p(b1, 0), p11 = pack_p(b1, 1);
              pv_block(o0, buf + vfrag + 4096, p00, p01); pv_block(o0, buf + vfrag + 6144, p10, p11);
              pv_block(o1, buf + vfrag + TK * 64 + 4096, p00, p01); pv_block(o1, buf + vfrag + TK * 64 + 6144, p10, p11); }
        } else if (TK * kt <= wqlast) {
            const bool needB = TK * kt + 64 <= wqlast;
            const float nm = -m; const f32x16 negm = {nm, nm, nm, nm, nm, nm, nm, nm, nm, nm, nm, nm, nm, nm, nm, nm};
            f32x16 a0 = negm, a1 = negm, b0 = negm, b1 = negm;
#pragma unroll
            for (int ds = 0; ds < 6; ++ds) {
                const bf16x8 k0 = *(const LAS bf16x8*)(buf + kfrag + ds * 32), k1 = *(const LAS bf16x8*)(buf + kfrag + 32 * KROW + ds * 32);
                a0 = __builtin_amdgcn_mfma_f32_32x32x16_bf16(k0, qf[ds], a0, 0, 0, 0);
                a1 = __builtin_amdgcn_mfma_f32_32x32x16_bf16(k1, qf[ds], a1, 0, 0, 0);
            }
            if (needB) {
#pragma unroll
                for (int ds = 0; ds < 6; ++ds) {
                    const bf16x8 k2 = *(const LAS bf16x8*)(buf + kfrag + 64 * KROW + ds * 32), k3 = *(const LAS bf16x8*)(buf + kfrag + 96 * KROW + ds * 32);
                    b0 = __builtin_amdgcn_mfma_f32_32x32x16_bf16(k2, qf[ds], b0, 0, 0, 0);
                    b1 = __builtin_amdgcn_mfma_f32_32x32x16_bf16(k3, qf[ds], b1, 0, 0, 0);
                }
            }
#pragma unroll
            for (int r = 0; r < 16; ++r) { const int kp = TK * kt + crow(r, hi); if (kp > qpos) a0[r] = NEGM; if (kp + 32 > qpos) a1[r] = NEGM; if (kp + 64 > qpos) b0[r] = NEGM; if (kp + 96 > qpos) b1[r] = NEGM; }
            sm64(a0, a1, m, l, o0, o1, b0, b1, needB);
            { const bf16x8 p00 = pack_p(a0, 0), p01 = pack_p(a0, 1), p10 = pack_p(a1, 0), p11 = pack_p(a1, 1);
              pv_block(o0, buf + vfrag, p00, p01); pv_block(o0, buf + vfrag + 2048, p10, p11);
              pv_block(o1, buf + vfrag + TK * 64, p00, p01); pv_block(o1, buf + vfrag + TK * 64 + 2048, p10, p11); }
            if (needB) {
                sm64(b0, b1, m, l, o0, o1, a0, a1, false);
                const bf16x8 p00 = pack_p(b0, 0), p01 = pack_p(b0, 1), p10 = pack_p(b1, 0), p11 = pack_p(b1, 1);
                pv_block(o0, buf + vfrag + 4096, p00, p01); pv_block(o0, buf + vfrag + 6144, p10, p11);
                pv_block(o1, buf + vfrag + TK * 64 + 4096, p00, p01); pv_block(o1, buf + vfrag + TK * 64 + 6144, p10, p11);
            }
        }
        if (kt + 1 < nt) MLA_STORE(lds + ((kt + 1) & 1) * BUFB);
        if (pid < 131072) {
            asm volatile("s_waitcnt vmcnt(0)" ::: "memory");
            const f32x4 xv = *(const LAS f32x4*)(piece + 16 * lane);
            const int idx = pid & 65535, col = (idx & 3) * 256 + 4 * lane;
            f32x4 sc = {SV, SV, SV, SV};
            if ((pid >> 16) == 0) { const f32x4 gv_ = *(const LAS f32x4*)(lds + MLA_G_OFF + 4 * col); sc = (f32x4){gv_.x * SU, gv_.y * SU, gv_.z * SU, gv_.w * SU}; }
            unsigned char* dst = ((pid >> 16) ? V8 : U8) + (size_t)(col >> 7) * ((size_t)16384 * 128) + (size_t)(idx >> 2) * 128 + (col & 127);
            *(unsigned*)dst = pk_fp8x4(xv.x * sc.x, xv.y * sc.y, xv.z * sc.z, xv.w * sc.w);
        }
        __syncthreads();
    }
#undef MLA_LOAD
#undef MLA_STORE
    l = swapsum(l);
    store_o(Mixed + (tok0 + qpos) * DM + 512 + h * 64, o0, o1, 1.0f / l, hi);
}

constexpr int DIL_KR = 144, DIL_VR = 160, DIL_VOFF = 32 * DIL_KR, DIL_WLDS = 32 * DIL_KR + 32 * DIL_VR;
constexpr int DIL_SROW = 132, DIL_STATE_OFF = 8 * DIL_WLDS;
struct DilBlk { u32x4 k[4]; u32x4 v[4]; };
__device__ __forceinline__ void dil_load(DilBlk& B, const bf16_t* __restrict__ Ka, const bf16_t* __restrict__ Va, size_t hrow0  , int rd, int dl  , int imax, int idx0, int lane) {
#pragma unroll
    for (int i = 0; i < 4; ++i) {
        int ik = idx0 + 8 * i + (lane >> 3); ik = ik < 0 ? 0 : ik; ik = ik > imax ? imax : ik;
        const size_t off = (hrow0 + ((size_t)ik << dl) + rd) * 64 + 8 * (lane & 7);
        B.k[i] = *(const u32x4*)(Ka + off); B.v[i] = *(const u32x4*)(Va + off);
    }
}
__device__ __forceinline__ void pv_block_p(f32x16& o, const LAS unsigned char* vbase, const bf16x8& pb0, const bf16x8& pb1) {
    const s16x4 l0 = vtr(vbase), h0 = vtr(vbase + 8 * DIL_VR), l1 = vtr(vbase + 16 * DIL_VR), h1 = vtr(vbase + 24 * DIL_VR);
    const bf16x8 a0 = {l0[0], l0[1], l0[2], l0[3], h0[0], h0[1], h0[2], h0[3]}, a1 = {l1[0], l1[1], l1[2], l1[3], h1[0], h1[1], h1[2], h1[3]};
    o = __builtin_amdgcn_mfma_f32_32x32x16_bf16(a0, pb0, o, 0, 0, 0);
    o = __builtin_amdgcn_mfma_f32_32x32x16_bf16(a1, pb1, o, 0, 0, 0);
}
template <bool MASK>
__device__ __forceinline__ void dil_step(const DilBlk& B, LAS unsigned char* wl, const bf16x8 (&qf)[4], float& m, float& l, f32x16& o0, f32x16& o1, int A, int idx0, int lane) {
    const int r32 = lane & 31, hi = lane >> 5;
    {
        LAS unsigned char* kp = wl + (lane >> 3) * DIL_KR + (lane & 7) * 16;
        LAS unsigned char* vp = wl + DIL_VOFF + (lane >> 3) * DIL_VR + (lane & 7) * 16;
#pragma unroll
        for (int i = 0; i < 4; ++i) { *(LAS u32x4*)(kp + 8 * i * DIL_KR) = B.k[i]; *(LAS u32x4*)(vp + 8 * i * DIL_VR) = B.v[i]; }
    }
    const float nm = -m;
    f32x16 s = {nm, nm, nm, nm, nm, nm, nm, nm, nm, nm, nm, nm, nm, nm, nm, nm};
    { const LAS unsigned char* kfr = wl + r32 * DIL_KR + 16 * hi;
#pragma unroll
      for (int ds = 0; ds < 4; ++ds) s = __builtin_amdgcn_mfma_f32_32x32x16_bf16(*(const LAS bf16x8*)(kfr + 32 * ds), qf[ds], s, 0, 0, 0); }
    if (MASK) {
        const int qi = A + r32;
#pragma unroll
        for (int r = 0; r < 16; ++r) { const int ki = idx0 + crow(r, hi), dist = qi - ki; if (ki < 0 || dist < 0 || dist > 128) s[r] = NEGM; }
    }
    float mx = max3f(s[0], s[1], s[2]);
#pragma unroll
    for (int r = 3; r < 15; r += 2) mx = max3f(mx, s[r], s[r + 1]);
    mx = fmaxf(mx, s[15]);
    mx = swapmax(mx);
    if (__builtin_amdgcn_ballot_w64(mx > THR) != 0ull) {
        const float dl_ = fmaxf(mx, 0.f), alpha = __builtin_amdgcn_exp2f(-dl_);
        m += dl_; l *= alpha;
#pragma unroll
        for (int r = 0; r < 16; ++r) { s[r] -= dl_; o0[r] *= alpha; o1[r] *= alpha; }
    }
    float rs = 0.f;
#pragma unroll
    for (int r = 0; r < 16; ++r) { s[r] = __builtin_amdgcn_exp2f(s[r]); rs += s[r]; }
    l += rs;
    const bf16x8 p0 = pack_p(s, 0), p1 = pack_p(s, 1);
    const int i16 = lane & 15;
    const LAS unsigned char* vb = wl + DIL_VOFF + (4 * hi + (i16 >> 2)) * DIL_VR + (16 * ((lane >> 4) & 1) + 4 * (i16 & 3)) * 2;
    pv_block_p(o0, vb, p0, p1);
    pv_block_p(o1, vb + 64, p0, p1);
}
__device__ __forceinline__ void dil_unit(LAS unsigned char* wl, const bf16_t* __restrict__ Qa, const bf16_t* __restrict__ Ka, const bf16_t* __restrict__ Va, bf16_t* __restrict__ Mixed, LAS unsigned char* state,
                                         int b, int h, int p0, int dl, bool first, bool last, int lane, int pflags = 0) {
    const int r32 = lane & 31, hi = lane >> 5;
    const size_t tok0 = (size_t)b * SEQ, hrow0 = (size_t)(b * 8 + h) * SEQ;
    const int qpos = p0 + (r32 << dl);
    const int rd = p0 & ((1 << dl) - 1), A = p0 >> dl, imax = (SEQ - 1 - rd) >> dl;
    DilBlk b0, b1, b2;
#define DLOAD(B_, k_) dil_load(B_, Ka, Va, hrow0, rd, dl, imax, A - 128 + 32 * (k_), lane)
#define DSTEP(MK_, B_, k_) dil_step<MK_>(B_, wl, qf, m, l, o0, o1, A, A - 128 + 32 * (k_), lane)
    DLOAD(b0, 0); DLOAD(b1, 1);
    bf16x8 qf[4];
    { const bf16_t* qrow = Qa + (hrow0 + qpos) * 64 + 8 * hi;
#pragma unroll
      for (int ds = 0; ds < 4; ++ds) qf[ds] = *(const bf16x8*)(qrow + 16 * ds); }
    float m = 0.f, l = 0.f; f32x16 o0 = {}, o1 = {};
    LAS unsigned* st = (LAS unsigned*)(state + ((qpos & 511) * DIL_SROW));
    if (!first) {
        m = __builtin_bit_cast(float, st[32]); l = hi ? 0.f : 1.f;
#pragma unroll
        for (int g = 0; g < 4; ++g) {
            const unsigned a0 = st[4 * g + 2 * hi], a1 = st[4 * g + 2 * hi + 1], c0 = st[16 + 4 * g + 2 * hi], c1 = st[16 + 4 * g + 2 * hi + 1];
            o0[4 * g] = bf_lo(a0); o0[4 * g + 1] = bf_hi(a0); o0[4 * g + 2] = bf_lo(a1); o0[4 * g + 3] = bf_hi(a1);
            o1[4 * g] = bf_lo(c0); o1[4 * g + 1] = bf_hi(c0); o1[4 * g + 2] = bf_lo(c1); o1[4 * g + 3] = bf_hi(c1);
        }
    }
    const bool early = A - 96 < 0;
#ifdef PROBE_LO
    if (pflags & 32) { o0[0] += __builtin_bit_cast(float, b0.k[0].x ^ b1.k[0].x ^ b0.v[3].w ^ b1.v[3].w); l = 1.f; } else {
#endif
    DLOAD(b2, 2);
    DSTEP(true, b0, 0);
    DLOAD(b0, 3);
    if (early) DSTEP(true, b1, 1); else DSTEP(false, b1, 1);
    DLOAD(b1, 4);
    if (early) DSTEP(true, b2, 2); else DSTEP(false, b2, 2);
    if (early) DSTEP(true, b0, 3); else DSTEP(false, b0, 3);
    DSTEP(true, b1, 4);
#ifdef PROBE_LO
    }
#endif
#undef DLOAD
#undef DSTEP
    l = swapsum(l);
    const float inv = 1.0f / l;
    if (last) store_o(Mixed + (tok0 + qpos) * DM + h * 64, o0, o1, inv, hi);
    else {
#pragma unroll
        for (int g = 0; g < 4; ++g) {
            st[4 * g + 2 * hi] = pk_bf16(o0[4 * g] * inv, o0[4 * g + 1] * inv); st[4 * g + 2 * hi + 1] = pk_bf16(o0[4 * g + 2] * inv, o0[4 * g + 3] * inv);
            st[16 + 4 * g + 2 * hi] = pk_bf16(o1[4 * g] * inv, o1[4 * g + 1] * inv); st[16 + 4 * g + 2 * hi + 1] = pk_bf16(o1[4 * g + 2] * inv, o1[4 * g + 3] * inv);
        }
        if (hi == 0) st[32] = __builtin_bit_cast(unsigned, m + __builtin_amdgcn_logf(l));
    }
}
__device__ __forceinline__ void dil_segment(LAS unsigned char* lds, const bf16_t* __restrict__ Qa, const bf16_t* __restrict__ Ka, const bf16_t* __restrict__ Va, bf16_t* __restrict__ Mixed,
                                            int sg, int wave, int lane, int pflags = 0) {
    const int seg = sg & 15, h = (sg >> 4) & 7, b = sg >> 7, base = 512 * seg;
    LAS unsigned char* wl = lds + wave * DIL_WLDS;
#pragma unroll 1
    for (int pass = 0; pass < ((pflags & 64) ? 1 : 3); ++pass) {
        const int dl = 2 * pass;
#pragma unroll 1
        for (int j = wave; j < 16; j += 8) {
            const int rd = j & ((1 << dl) - 1), cj = j >> dl;
            dil_unit(wl, Qa, Ka, Va, Mixed, lds + DIL_STATE_OFF, b, h, base + rd + ((32 * cj) << dl), dl, pass == 0, pass == 2, lane, pflags);
        }
        if (pass < 2) __syncthreads();
    }
}
}

namespace peer {
__device__ __forceinline__ void ins16(unsigned (&L)[16], unsigned key) {
#pragma unroll
    for (int i = 0; i < 16; ++i) { const unsigned hi_ = L[i] > key ? L[i] : key; key = L[i] > key ? key : L[i]; L[i] = hi_; }
}
__device__ __forceinline__ void ce(unsigned& a, unsigned& b) { const unsigned hi_ = a > b ? a : b, lo_ = a > b ? b : a; a = hi_; b = lo_; }
__device__ __forceinline__ void sort8(unsigned (&v)[8]) {
    ce(v[0], v[1]); ce(v[2], v[3]); ce(v[4], v[5]); ce(v[6], v[7]); ce(v[0], v[2]); ce(v[1], v[3]); ce(v[4], v[6]); ce(v[5], v[7]); ce(v[1], v[2]); ce(v[5], v[6]);
    ce(v[0], v[4]); ce(v[3], v[7]); ce(v[1], v[5]); ce(v[2], v[6]); ce(v[1], v[4]); ce(v[3], v[6]); ce(v[2], v[4]); ce(v[3], v[5]); ce(v[3], v[4]);
}
__device__ __forceinline__ void bmerge16(unsigned (&v)[16]) {
#pragma unroll
    for (int k = 8; k >= 1; k >>= 1)
#pragma unroll
        for (int i = 0; i < 16; ++i) if ((i & k) == 0) ce(v[i], v[i + k]);
}
__device__ __forceinline__ float dec16(unsigned key) { const unsigned s = key >> 16; const unsigned b = (s & 0x8000u) ? (s & 0x7fffu) : (~s & 0xffffu); return (float)__builtin_bit_cast(_Float16, (unsigned short)b); }
__device__ __forceinline__ unsigned enc32(float f) { const unsigned u = __builtin_bit_cast(unsigned, f); return (u & 0x80000000u) ? ~u : (u | 0x80000000u); }
__device__ __forceinline__ float dec32(unsigned s) { const unsigned u = (s & 0x80000000u) ? (s & 0x7fffffffu) : ~s; return __builtin_bit_cast(float, u); }
__device__ __forceinline__ float gelu1(float v) {
    const float av = fabsf(v), t = __builtin_amdgcn_rcpf(av * 0.2316418882f + 1.0f);
    float q = t * 0.5307027145f + (-0.7265760135f); q = q * t + 0.7107068705f; q = q * t + (-0.142248368f); q = q * t + 0.127414796f; q = q * t;
    const float e = __builtin_amdgcn_exp2f((v * v) * (-0.72134752044f));
    const float mm = v * (q * e);
    return v < 0.f ? mm : v - mm;
}
struct CandTab { unsigned char i[52], j[52]; };
__host__ __device__ constexpr CandTab make_cands() {
    CandTab t{}; int n = 0;
    for (int i = 0; i < 16; ++i) for (int j = 0; j < 16; ++j) if ((i + 1) * (j + 1) <= 16) { t.i[n] = (unsigned char)i; t.j[n] = (unsigned char)j; ++n; }
    for (; n < 52; ++n) { t.i[n] = 15; t.j[n] = 15; }
    return t;
}

}

namespace peer2 {
__device__ __forceinline__ int ld_of(int j) { const int rho = 16 * ((j >> 2) & 3) + 4 * ((j >> 4) & 3) + (j & 3); return (j >> 6) * 64 + (rho & 7) * 8 + (rho >> 3); }

__device__ __forceinline__ void topk_phase(LAS unsigned char* lds, const bf16_t* __restrict__ Sc, const float* __restrict__ ssq_h, unsigned short* __restrict__ Pe_slot, unsigned short* __restrict__ Pe_ld,
                                           float* __restrict__ Pg, float* __restrict__ rstd_h, int gw, int ngw) {
    const int lane = threadIdx.x & 63, wid = __builtin_amdgcn_readfirstlane(threadIdx.x >> 6);
    LAS unsigned char* tile = lds + wid * 12288;
    LAS unsigned* lists = (LAS unsigned*)(tile + 8192);
    constexpr peer::CandTab CT = peer::make_cands();
    u32x4 nx[8];
#define TK_LOAD(g_, hh_) do { _Pragma("unroll") for (int i_ = 0; i_ < 8; ++i_) { const int s_ = 8 * i_ + (lane >> 3); \
        nx[i_] = *(const u32x4*)(Sc + (size_t)(4 * (g_) + (s_ >> 4)) * 2048 + (s_ & 15) * 128 + (hh_) * 64 + (lane & 7) * 8); } } while (0)
#define TK_WRITE() do { _Pragma("unroll") for (int i_ = 0; i_ < 8; ++i_) { const int s_ = 8 * i_ + (lane >> 3); *(LAS u32x4*)(tile + s_ * 128 + (((lane & 7) ^ (s_ & 7)) << 4)) = nx[i_]; } } while (0)
    if (gw < T / 4) TK_LOAD(gw, 0);
    for (int g = gw; g < T / 4; g += ngw) {
        const int t4 = lane >> 4, hp = lane & 15, tok = 4 * g + t4;
        unsigned L[16];
        {
            const LAS unsigned char* seg = tile + lane * 128;
#pragma unroll 1
            for (int gq = 0; gq < 8; ++gq) {
                if (gq == 0) { TK_WRITE(); TK_LOAD(g, 1); }
                if (gq == 4) { TK_WRITE(); if (g + ngw < T / 4) TK_LOAD(g + ngw, 0); }
                const int c0 = 2 * (gq & 3);
                const u32x4 w0 = *(const LAS u32x4*)(seg + ((c0 ^ (lane & 7)) << 4)), w1 = *(const LAS u32x4*)(seg + (((c0 + 1) ^ (lane & 7)) << 4));
                unsigned ka[8], kb[8];
#pragma unroll
                for (int e = 0; e < 8; ++e) {
                    const unsigned wa = (e >> 1) == 0 ? w0.x : ((e >> 1) == 1 ? w0.y : ((e >> 1) == 2 ? w0.z : w0.w)), wb = (e >> 1) == 0 ? w1.x : ((e >> 1) == 1 ? w1.y : ((e >> 1) == 2 ? w1.z : w1.w));
                    const unsigned ba = (e & 1) ? (wa >> 16) : (wa & 0xffffu), bb = (e & 1) ? (wb >> 16) : (wb & 0xffffu);
                    const unsigned sa = (ba & 0x8000u) ? (~ba & 0xffffu) : (ba | 0x8000u), sb = (bb & 0x8000u) ? (~bb & 0xffffu) : (bb | 0x8000u);
                    ka[e] = (sa << 16) | (unsigned)(127 - (16 * gq + e)); kb[e] = (sb << 16) | (unsigned)(127 - (16 * gq + 8 + e));
                }
                peer::sort8(ka); peer::sort8(kb);
                unsigned G[16];
#pragma unroll
                for (int i = 0; i < 8; ++i) { G[i] = ka[i]; G[8 + i] = kb[7 - i]; }
                peer::bmerge16(G);
                if (gq == 0) {
#pragma unroll
                    for (int i = 0; i < 16; ++i) L[i] = G[i];
                } else {
#pragma unroll
                    for (int i = 0; i < 16; ++i) L[i] = L[i] > G[15 - i] ? L[i] : G[15 - i];
                    peer::bmerge16(L);
                }
            }
        }
#pragma unroll
        for (int i = 0; i < 16; ++i) lists[lane * 16 + i] = L[i];
        const int p = hp & 1;
        float av[16], bv[16];
#pragma unroll
        for (int i = 0; i < 16; ++i) { const unsigned o = __shfl_xor(L[i], 1); av[i] = peer::dec16(p ? o : L[i]); bv[i] = peer::dec16(p ? L[i] : o); }
        unsigned M[16];
        {
            unsigned C[32];
#pragma unroll
            for (int k = 0; k < 25; ++k) {
                const int i0 = CT.i[2 * k], j0 = CT.j[2 * k], i1 = CT.i[2 * k + 1], j1 = CT.j[2 * k + 1];
                const float s0 = av[i0] + bv[j0], s1 = av[i1] + bv[j1];
                const float sm = p ? s1 : s0; const unsigned fl = p ? (unsigned)(i1 * 16 + j1) : (unsigned)(i0 * 16 + j0);
                C[k] = (peer::enc32(sm) & 0xffffff00u) | (255u - fl);
            }
#pragma unroll
            for (int k = 25; k < 32; ++k) C[k] = 0u;
            unsigned g0[8], g1[8], g2[8], g3[8];
#pragma unroll
            for (int i = 0; i < 8; ++i) { g0[i] = C[i]; g1[i] = C[8 + i]; g2[i] = C[16 + i]; g3[i] = C[24 + i]; }
            peer::sort8(g0); peer::sort8(g1); peer::sort8(g2); peer::sort8(g3);
            unsigned H[16];
#pragma unroll
            for (int i = 0; i < 8; ++i) { M[i] = g0[i]; M[8 + i] = g1[7 - i]; H[i] = g2[i]; H[8 + i] = g3[7 - i]; }
            peer::bmerge16(M); peer::bmerge16(H);
#pragma unroll
            for (int i = 0; i < 16; ++i) M[i] = M[i] > H[15 - i] ? M[i] : H[15 - i];
            peer::bmerge16(M);
        }
        unsigned R[16];
#pragma unroll
        for (int k = 0; k < 16; ++k) { const unsigned o = __shfl_xor(M[15 - k], 1); R[k] = M[k] > o ? M[k] : o; }
        float rv[16], mx = -INFINITY;
#pragma unroll
        for (int k = 0; k < 16; ++k) { rv[k] = peer::dec32(R[k] & 0xffffff00u); mx = fmaxf(mx, rv[k]); }
        float sum = 0.f;
#pragma unroll
        for (int k = 0; k < 16; ++k) { rv[k] = __builtin_amdgcn_exp2f((rv[k] - mx) * LOG2E); sum += rv[k]; }
        const float isum = 1.0f / sum;
        {
            const int h = hp >> 1;
            const LAS unsigned* la = lists + (lane & ~1) * 16; const LAS unsigned* lb = lists + (lane | 1) * 16;
#pragma unroll
            for (int k = 0; k < 8; ++k) {
                const unsigned fl = 255u - (R[k] & 0xffu);
                const unsigned i1 = 127u - (la[fl >> 4] & 0x7fu), i2 = 127u - (lb[fl & 15u] & 0x7fu);
                const int j = h * 16 + p * 8 + k, sl = j;
                const unsigned short e = (unsigned short)(i1 * 128u + i2);
                Pe_slot[(size_t)tok * 128 + sl] = e;
                Pe_ld[(size_t)tok * 128 + ld_of(j)] = e;
                Pg[(size_t)tok * 128 + sl] = rv[k] * isum;
            }
        }
        if (hp == 0) {
            float s = 0.f;
#pragma unroll
            for (int k = 0; k < 8; ++k) { const f32x4 q = *(const f32x4*)(ssq_h + (size_t)tok * 32 + 4 * k); s += (q.x + q.y) + (q.z + q.w); }
            rstd_h[tok] = 1.0f / sqrtf(s * (1.f / 1024.f) + EPS);
        }
    }
#undef TK_LOAD
#undef TK_WRITE
}

struct UG { u32x4 v[8]; };
struct UIDS { u32x4 e0, e1, b0, b1; };
__device__ __forceinline__ void u_ids(UIDS& I, const unsigned short* __restrict__ Pe_ld, const unsigned char* __restrict__ Hx, int tok, int lane) {
    const u32x4* ip = (const u32x4*)(Pe_ld + (size_t)tok * 128 + (lane >> 3) * 8);
    I.e0 = ip[0]; I.e1 = ip[8];
    const unsigned char* hrow = Hx + (size_t)tok * 128 + 32 * (lane >> 4);
    I.b0 = *(const u32x4*)hrow; I.b1 = *(const u32x4*)(hrow + 16);
}
__device__ __forceinline__ void u_gather(UG& F, const u32x4& w, const unsigned char* __restrict__ Ul  , unsigned emask, unsigned loff = 0u  ) {
#pragma unroll
    for (int i = 0; i < 8; ++i) {
        const unsigned word = (i >> 1) == 0 ? w.x : ((i >> 1) == 1 ? w.y : ((i >> 1) == 2 ? w.z : w.w));
        const unsigned e = ((i & 1) ? (word >> 16) : (word & 0xffffu)) & emask;
        F.v[i] = *(const u32x4*)(Ul + (e * 128u + loff));
    }
}
template <int PM = 0> __device__ __forceinline__ void u_compute(u32x4& z0, u32x4& z1, const UG& F, const u32x4& b0, const u32x4& b1, LAS unsigned char* hl  , int lane) {
    if (PM == 0) {
        LAS unsigned char* wp = hl + (lane >> 3) * 128 + (((lane & 7) ^ (lane >> 3)) << 4);
#pragma unroll
        for (int i = 0; i < 8; ++i) *(LAS u32x4*)(wp + i * 1024) = F.v[i];
    }
    const v8i bfr = {(int)b0.x, (int)b0.y, (int)b0.z, (int)b0.w, (int)b1.x, (int)b1.y, (int)b1.z, (int)b1.w};
    const int r16 = lane & 15, kb = lane >> 4;
    const LAS unsigned char* rp = hl + r16 * 128;
    const int p0 = ((2 * kb) ^ (r16 & 7)) << 4, p1 = ((2 * kb + 1) ^ (r16 & 7)) << 4;
    f32x4 acc[4];
#pragma unroll
    for (int g = 0; g < 4; ++g) {
        u32x4 a0, a1; if (PM == 0) { a0 = *(const LAS u32x4*)(rp + g * 2048 + p0); a1 = *(const LAS u32x4*)(rp + g * 2048 + p1); } else { a0 = F.v[2 * g]; a1 = F.v[2 * g + 1]; }
        const v8i afr = {(int)a0.x, (int)a0.y, (int)a0.z, (int)a0.w, (int)a1.x, (int)a1.y, (int)a1.z, (int)a1.w};
        acc[g] = __builtin_amdgcn_mfma_scale_f32_16x16x128_f8f6f4(afr, bfr, (f32x4){0.f, 0.f, 0.f, 0.f}, 0, 0, 0, 0, 0, 0);
    }
    z0.x = pk_bf16(acc[0][0], acc[0][1]); z0.y = pk_bf16(acc[0][2], acc[0][3]); z0.z = pk_bf16(acc[1][0], acc[1][1]); z0.w = pk_bf16(acc[1][2], acc[1][3]);
    z1.x = pk_bf16(acc[2][0], acc[2][1]); z1.y = pk_bf16(acc[2][2], acc[2][3]); z1.z = pk_bf16(acc[3][0], acc[3][1]); z1.w = pk_bf16(acc[3][2], acc[3][3]);
}
constexpr int U_REC = 512, U_CH = 16, U_STAGE = 8192, U_WLDS = U_STAGE + U_CH * U_REC;
template <int PM = 0> __device__ __forceinline__ void u_phase(LAS unsigned char* lds, const unsigned char* __restrict__ Hb8, const unsigned char* __restrict__ U8, const unsigned short* __restrict__ Pe_ld, bf16_t* __restrict__ Zp, int x, int wg, int nwg, unsigned emask = 0xffffu) {
    const int lane = threadIdx.x & 63, wid = __builtin_amdgcn_readfirstlane(threadIdx.x >> 6);
    LAS unsigned char* wl = lds + wid * U_WLDS;
    LAS unsigned char* rb = wl + U_STAGE;
    const unsigned rb_u = (unsigned)__builtin_amdgcn_readfirstlane((int)(unsigned)(uintptr_t)rb);
    const unsigned char* Hx = Hb8 + (size_t)x * ((size_t)T * 128);
    const unsigned char* Ul = U8 + (size_t)x * ((size_t)16384 * 128); const unsigned loff = 16u * (lane & 7);
    bf16_t* Zx = Zp + (size_t)x * T * 128;
    const int n = (T - wg + nwg - 1) / nwg;
    if (n <= 0) return;
    const int nch = (n + U_CH - 1) / U_CH;
#define UTOK(k) (wg + ((k) < n ? (k) : n - 1) * nwg)
#define USB() __builtin_amdgcn_sched_barrier(0)
    const int w32 = lane & 31, sub = lane >> 5;
    const unsigned char* rbase = w32 < 16 ? (const unsigned char*)Pe_ld + 16 * w32 : (w32 < 24 ? Hx + 16 * (w32 - 16) : (const unsigned char*)Pe_ld);
    const unsigned rstride = (w32 >= 16 && w32 < 24) ? 128u : 256u;
#pragma unroll 1
    for (int c = 0; c < nch; ++c) {
#pragma unroll
        for (int i = 0; i < U_CH / 2; ++i)
            glds16(rbase + (size_t)UTOK(c * U_CH + 2 * i + sub) * rstride, rb_u + i * 1024);
        asm volatile("s_waitcnt vmcnt(0)" ::: "memory");
        UG f0, f1;
        { const u32x4 e0 = *(const LAS u32x4*)(rb + (lane >> 3) * 16); u_gather(f0, e0, Ul, emask, loff); }
#pragma unroll 1
        for (int i = 0; i < U_CH; ++i) {
            const int k = c * U_CH + i;
            const LAS unsigned char* rec = rb + i * U_REC;
            const LAS unsigned char* nrec = (i + 1 < U_CH) ? rec + U_REC : rec;
            const u32x4 e1 = *(const LAS u32x4*)(rec + 128 + (lane >> 3) * 16), e0n = *(const LAS u32x4*)(nrec + (lane >> 3) * 16);
            const u32x4 bk0 = *(const LAS u32x4*)(rec + 256 + 32 * (lane >> 4)), bk1 = *(const LAS u32x4*)(rec + 256 + 32 * (lane >> 4) + 16);
            u32x4 za, zb, zc, zd;
            u_gather(f1, e1, Ul, emask, loff);
            USB(); u_compute<PM>(za, zb, f0, bk0, bk1, wl, lane); USB();
            u_gather(f0, e0n, Ul, emask, loff);
            USB(); u_compute<PM>(zc, zd, f1, bk0, bk1, wl, lane); USB();
            if ((lane & 15) == 0 && k < n) { bf16_t* zr_ = Zx + (size_t)UTOK(k) * 128 + 16 * (lane >> 4); *(u32x4*)zr_ = za; *(u32x4*)(zr_ + 8) = zb; *(u32x4*)(zr_ + 64) = zc; *(u32x4*)(zr_ + 72) = zd; }
        }
        asm volatile("s_waitcnt vmcnt(0) lgkmcnt(0)" ::: "memory");
    }
#undef UTOK
#undef USB
}

__device__ __forceinline__ float dppf(float v, int ctrl_sel) {
    const int s = __builtin_bit_cast(int, v);
    const int r = ctrl_sel == 0 ? __builtin_amdgcn_update_dpp(0, s, 0xB1, 0xF, 0xF, true) : ctrl_sel == 1 ? __builtin_amdgcn_update_dpp(0, s, 0x4E, 0xF, 0xF, true)
                : ctrl_sel == 2 ? __builtin_amdgcn_update_dpp(0, s, 0x141, 0xF, 0xF, true) : ctrl_sel == 3 ? __builtin_amdgcn_update_dpp(0, s, 0x140, 0xF, 0xF, true) : __builtin_amdgcn_update_dpp(0, s, 0x128, 0xF, 0xF, true);
    return __builtin_bit_cast(float, r);
}
constexpr float SA = 64.f;
__device__ __forceinline__ void act_phase(LAS unsigned char* lds, const bf16_t* __restrict__ Zp, const unsigned short* __restrict__ Pe_slot, const float* __restrict__ Pg, const float* __restrict__ ssq_h,
                                          unsigned short* __restrict__ PE2, unsigned char* __restrict__ PA2, int gw, int ngw) {
    const int lane = threadIdx.x & 63, wid = __builtin_amdgcn_readfirstlane(threadIdx.x >> 6);
    LAS unsigned short* lid = (LAS unsigned short*)(lds + wid * 512);
    LAS unsigned char* lw = lds + wid * 512 + 256;
    unsigned zw[8], ew; f32x2 gg; float sp;
#define ACT_LOAD(t_) do { const size_t o_ = (size_t)(t_) * 128 + 2 * lane; _Pragma("unroll") for (int xx = 0; xx < 8; ++xx) zw[xx] = *(const unsigned*)(Zp + (size_t)xx * T * 128 + o_); \
        ew = *(const unsigned*)(Pe_slot + o_); gg = *(const f32x2*)(Pg + o_); sp = ssq_h[(size_t)(t_) * 32 + (lane & 31)]; } while (0)
    if (gw < T) ACT_LOAD(gw);
    for (int tok = gw; tok < T; tok += ngw) {
        float z0 = 0.f, z1 = 0.f;
#pragma unroll
        for (int xx = 0; xx < 8; ++xx) { z0 += bf_lo(zw[xx]); z1 += bf_hi(zw[xx]); }
        const unsigned e2 = ew; const f32x2 g2 = gg;
        float s = sp;
        if (tok + ngw < T) ACT_LOAD(tok + ngw);
        s += dppf(s, 0); s += dppf(s, 1); s += dppf(s, 2); s += dppf(s, 3);
        const int si = __builtin_bit_cast(int, s);
        const float tot = __builtin_bit_cast(float, __builtin_amdgcn_readlane(si, 0)) + __builtin_bit_cast(float, __builtin_amdgcn_readlane(si, 16));
        const float zs = (1.0f / sqrtf(tot * (1.f / 1024.f) + EPS)) * (1.0f / (SU * SX));
        const float w0 = fminf(fmaxf(peer::gelu1(z0 * zs) * g2.x * SA, -440.f), 440.f), w1 = fminf(fmaxf(peer::gelu1(z1 * zs) * g2.y * SA, -440.f), 440.f);
        const unsigned w8 = (unsigned)__builtin_amdgcn_cvt_pk_fp8_f32(w0, w1, 0, false);
        const int sl0 = 2 * lane, d0 = (sl0 & 7) * 16 + (sl0 >> 3), d1 = ((sl0 + 1) & 7) * 16 + (sl0 >> 3);
        lid[d0] = (unsigned short)(e2 & 0xffffu); lid[d1] = (unsigned short)(e2 >> 16);
        lw[d0] = (unsigned char)(w8 & 0xffu); lw[d1] = (unsigned char)((w8 >> 8) & 0xffu);
        const u32x4 ov = *(const LAS u32x4*)(lds + wid * 512 + 16 * lane);
        if (lane < 16) *(u32x4*)(PE2 + (size_t)tok * 128 + 8 * lane) = ov;
        else if (lane < 24) *(u32x4*)(PA2 + (size_t)tok * 128 + 16 * (lane - 16)) = ov;
    }
#undef ACT_LOAD
}

struct VG { u32x4 v[8]; u32x2 w; };
template <int PM = 0> __device__ __forceinline__ void v_gather(VG& Gt, const u32x4& ew, const u32x2& ww, const unsigned char* __restrict__ vb  , unsigned loff  , unsigned emask) {
    Gt.w = ww;
#pragma unroll
    for (int i = 0; i < 8; ++i) {
        const unsigned word = (i >> 1) == 0 ? ew.x : ((i >> 1) == 1 ? ew.y : ((i >> 1) == 2 ? ew.z : ew.w));
        const unsigned e = ((i & 1) ? (word >> 16) : (word & 0xffffu)) & emask;
        if (PM == 1 && (i & 1)) Gt.v[i] = Gt.v[i - 1]; else
        Gt.v[i] = *(const u32x4*)(vb + (e * 128u + loff));
    }
}
struct VSel { unsigned lo[4], hi[4]; };
__device__ __forceinline__ void v_compute(f32x4& accL, f32x4& accH, const VG& Gt, const VSel& S) {
#pragma unroll
    for (int i = 0; i < 8; ++i) {
        const unsigned d = i < 4 ? Gt.w.x : Gt.w.y;
        const unsigned b0 = __builtin_amdgcn_perm(d, d, S.lo[i & 3]), b1 = __builtin_amdgcn_perm(d, d, S.hi[i & 3]);
        const long aL = (long)(((unsigned long long)Gt.v[i].y << 32) | Gt.v[i].x), aH = (long)(((unsigned long long)Gt.v[i].w << 32) | Gt.v[i].z);
        const long bb = (long)(((unsigned long long)b1 << 32) | b0);
        accL = __builtin_amdgcn_mfma_f32_16x16x32_fp8_fp8(aL, bb, accL, 0, 0, 0);
        accH = __builtin_amdgcn_mfma_f32_16x16x32_fp8_fp8(aH, bb, accH, 0, 0, 0);
    }
}
constexpr int V_REC = 512, V_CH = 16, V_WLDS = V_CH * V_REC + 1024;
template <int PM = 0> __device__ __forceinline__ void v_phase(LAS unsigned char* lds, const unsigned char* __restrict__ V8, const unsigned short* __restrict__ PE2, const unsigned char* __restrict__ PA2, bf16_t* __restrict__ Op, int x, int wg, int nwg, unsigned emask = 0xffffu) {
    const int lane = threadIdx.x & 63, wid = __builtin_amdgcn_readfirstlane(threadIdx.x >> 6), seg8 = lane >> 3, bp = lane & 7;
    LAS unsigned char* rb = lds + wid * V_WLDS;
    LAS float* tr = (LAS float*)(rb + V_CH * V_REC);
    const unsigned rb_u = (unsigned)__builtin_amdgcn_readfirstlane((int)(unsigned)(uintptr_t)rb);
    const unsigned char* vb = V8 + (size_t)x * ((size_t)16384 * 128); const unsigned loff = 16u * (lane & 7);
    bf16_t* Ox = Op + (size_t)x * T * 128;
    VSel S;
    { const unsigned none = 0x0c0c0c0cu, keep = none & ~(0xffu << (8 * (bp & 3)));
#pragma unroll
      for (int q = 0; q < 4; ++q) { const unsigned sq = keep | ((unsigned)q << (8 * (bp & 3))); S.lo[q] = bp < 4 ? sq : none; S.hi[q] = bp < 4 ? none : sq; } }
    const bool dvalid = ((lane >> 3) & 1) == (lane >> 5);
    LAS float* trw = tr + (lane >> 5) * 128 + 64 * ((lane >> 4) & 1) + bp;
    const int n = (T - wg + nwg - 1) / nwg;
    if (n <= 0) return;
    const int nch = (n + V_CH - 1) / V_CH;
#define VTOK(k) (wg + ((k) < n ? (k) : n - 1) * nwg)
    const int w32 = lane & 31, sub = lane >> 5;
    const unsigned char* rbase = w32 < 16 ? (const unsigned char*)PE2 + 16 * w32 : (w32 < 24 ? PA2 + 16 * (w32 - 16) : (const unsigned char*)PE2);
    const unsigned rstride = (w32 >= 16 && w32 < 24) ? 128u : 256u;
    const int roff = seg8 * 32, woff = 256 + seg8 * 16;
#pragma unroll 1
    for (int c = 0; c < nch; ++c) {
        if (PM != 2 || c == 0) {
#pragma unroll
        for (int i = 0; i < V_CH / 2; ++i)
            glds16(rbase + (size_t)VTOK(c * V_CH + 2 * i + sub) * rstride, rb_u + i * 1024);
        asm volatile("s_waitcnt vmcnt(0)" ::: "memory");
        }
        VG g0, g1;
        { const u32x4 ea = *(const LAS u32x4*)(rb + roff); const u32x2 wa = *(const LAS u32x2*)(rb + woff); v_gather<PM>(g0, ea, wa, vb, loff, emask); }
#pragma unroll 1
        for (int i = 0; i < V_CH; ++i) {
            const int k = c * V_CH + i, tok = VTOK(k);
            const LAS unsigned char* rec = rb + i * V_REC;
            const LAS unsigned char* nrec = (i + 1 < V_CH) ? rec + V_REC : rec;
            f32x4 accL = {0.f, 0.f, 0.f, 0.f}, accH = {0.f, 0.f, 0.f, 0.f};
            { const u32x4 ea = *(const LAS u32x4*)(rec + roff + 16); const u32x2 wa = *(const LAS u32x2*)(rec + woff + 8); v_gather<PM>(g1, ea, wa, vb, loff, emask); }
            __builtin_amdgcn_sched_barrier(0);
            v_compute(accL, accH, g0, S);
            { const u32x4 ea = *(const LAS u32x4*)(nrec + roff); const u32x2 wa = *(const LAS u32x2*)(nrec + woff); v_gather<PM>(g0, ea, wa, vb, loff, emask); }
            __builtin_amdgcn_sched_barrier(0);
            v_compute(accL, accH, g1, S);
            if (dvalid) {
#pragma unroll
                for (int r = 0; r < 4; ++r) { trw[16 * r] = accL[r]; trw[16 * r + 8] = accH[r]; }
            }
            const f32x4 oa = *(const LAS f32x4*)(tr + 4 * w32), ob = *(const LAS f32x4*)(tr + 128 + 4 * w32);
            if (lane < 32 && k < n) {
                constexpr float sc = 1.0f / (SA * SV);
                u32x2 w; w.x = pk_bf16((oa.x + ob.x) * sc, (oa.y + ob.y) * sc); w.y = pk_bf16((oa.z + ob.z) * sc, (oa.w + ob.w) * sc); *(u32x2*)(Ox + (size_t)tok * 128 + 4 * lane) = w;
            }
        }
        if (PM != 2) asm volatile("s_waitcnt vmcnt(0) lgkmcnt(0)" ::: "memory");
    }
#undef VTOK
}

__device__ __forceinline__ void final_phase(float* __restrict__ Out, const bf16_t* __restrict__ Hb, const bf16_t* __restrict__ Op, const float* __restrict__ g_final, int gw, int ngw) {
    const int lane = threadIdx.x & 63;
    const f32x4* gr = (const f32x4*)g_final + lane;
    const f32x4 g0 = gr[0], g1 = gr[64], g2 = gr[128], g3 = gr[192];
    const bf16_t* ob = Op + (size_t)(lane >> 5) * T * 128 + 4 * (lane & 31);
    for (int t0 = 4 * gw; t0 < T; t0 += 4 * ngw) {
        u32x2 hh[4][4], o[4][4];
#pragma unroll
        for (int r = 0; r < 4; ++r) {
            const int tok = t0 + r < T ? t0 + r : T - 1;
            const bf16_t* hr = Hb + (size_t)tok * DM + 4 * lane;
#pragma unroll
            for (int j = 0; j < 4; ++j) { hh[r][j] = *(const u32x2*)(hr + 256 * j); o[r][j] = *(const u32x2*)(ob + ((size_t)(2 * j) * T + tok) * 128); }
        }
#pragma unroll
        for (int r = 0; r < 4; ++r) {
            if (t0 + r >= T) break;
            f32x4 y[4];
            float s = 0.f;
#pragma unroll
            for (int j = 0; j < 4; ++j) {
                y[j].x = bf_lo(hh[r][j].x) + bf_lo(o[r][j].x); y[j].y = bf_hi(hh[r][j].x) + bf_hi(o[r][j].x); y[j].z = bf_lo(hh[r][j].y) + bf_lo(o[r][j].y); y[j].w = bf_hi(hh[r][j].y) + bf_hi(o[r][j].y);
                s += (y[j].x * y[j].x + y[j].y * y[j].y) + (y[j].z * y[j].z + y[j].w * y[j].w);
            }
            s += dppf(s, 0); s += dppf(s, 1); s += dppf(s, 2); s += dppf(s, 3);
            const int si = __builtin_bit_cast(int, s);
            const float tot = (__builtin_bit_cast(float, __builtin_amdgcn_readlane(si, 0)) + __builtin_bit_cast(float, __builtin_amdgcn_readlane(si, 16)))
                            + (__builtin_bit_cast(float, __builtin_amdgcn_readlane(si, 32)) + __builtin_bit_cast(float, __builtin_amdgcn_readlane(si, 48)));
            const float r2 = 1.0f / sqrtf(tot * (1.f / 1024.f) + EPS);
            f32x4* yr = (f32x4*)(Out + (size_t)(t0 + r) * DM) + lane;
            yr[0] = (f32x4){y[0].x * r2 * g0.x, y[0].y * r2 * g0.y, y[0].z * r2 * g0.z, y[0].w * r2 * g0.w};
            yr[64] = (f32x4){y[1].x * r2 * g1.x, y[1].y * r2 * g1.y, y[1].z * r2 * g1.z, y[1].w * r2 * g1.w};
            yr[128] = (f32x4){y[2].x * r2 * g2.x, y[2].y * r2 * g2.y, y[2].z * r2 * g2.z, y[2].w * r2 * g2.w};
            yr[192] = (f32x4){y[3].x * r2 * g3.x, y[3].y * r2 * g3.y, y[3].z * r2 * g3.z, y[3].w * r2 * g3.w};
        }
    }
}
}


#define XB_TMO      128
#define XB_XCNT(j)  (256  + 64 * (j))
#define XB_XSUB(j)  (1280 + 64 * (j))
#define XB_XGEN(j)  (2304 + 64 * (j))
#define XB_TOP      3328
#define XB_TOPGEN   3392
#define XCD_BAR_WORDS 3456
#define XB_SPIN_CAP (1u << 18)

__device__ __forceinline__ unsigned xb_ld(unsigned* p)              { return __hip_atomic_load(p, __ATOMIC_RELAXED, __HIP_MEMORY_SCOPE_AGENT); }
__device__ __forceinline__ unsigned xb_add(unsigned* p, unsigned v) { return __hip_atomic_fetch_add(p, v, __ATOMIC_RELAXED, __HIP_MEMORY_SCOPE_AGENT); }
__device__ __forceinline__ unsigned xb_xcc_id() { return (unsigned)__builtin_amdgcn_s_getreg((3 << 11) | 20) & 0xFu; }
#define XB_SPIN(cond, bar) do { unsigned _sp = 0; while (cond) { __builtin_amdgcn_s_sleep(1); \
    if ((++_sp & 255u) == 0u) { if (xb_ld(&(bar)[XB_TMO])) break; if (_sp > XB_SPIN_CAP) { atomicAdd(&(bar)[XB_TMO], 1u); break; } } } } while (0)

struct XcdBarrier {
    unsigned* bar; unsigned x;
    volatile LAS unsigned* st;
};

__device__ __forceinline__ XcdBarrier xcd_barrier_post(unsigned* bar, volatile LAS unsigned* st) {
    XcdBarrier b; b.bar = bar; b.x = xb_xcc_id(); b.st = st;
    if (threadIdx.x == 0) (void)xb_add(&bar[XB_XCNT(b.x)], 1u);
    return b;
}
__device__ __forceinline__ void xcd_barrier_complete(unsigned* bar, unsigned x, unsigned& nloc, unsigned& nx) {
    const unsigned G = gridDim.x * gridDim.y * gridDim.z;
    unsigned sum, cnt, mine, sp = 0u;
    for (;;) {
        sum = 0u; cnt = 0u; mine = 0u;
#pragma unroll
        for (unsigned j = 0; j < 16; ++j) { const unsigned c = xb_ld(&bar[XB_XCNT(j)]); sum += c; cnt += (c > 0u) ? 1u : 0u; mine = (j == x) ? c : mine; }
        if (sum == G) break;
        __builtin_amdgcn_s_sleep(1);
        if ((++sp & 255u) == 0u) { if (xb_ld(&bar[XB_TMO])) break; if (sp > XB_SPIN_CAP) { atomicAdd(&bar[XB_TMO], 1u); break; } }
    }
    nloc = mine > 0u ? mine : 1u; nx = cnt > 0u ? cnt : 1u;
}

__device__ __forceinline__ void xcd_barrier(const XcdBarrier& b) {
    asm volatile("s_waitcnt vmcnt(0)" ::: "memory");
    __syncthreads();
    if (threadIdx.x == 0) {
        unsigned* bar = b.bar;
        __builtin_amdgcn_s_waitcnt(0);
        unsigned nloc = b.st[0], nx = b.st[1];
        if (nloc == 0u) { xcd_barrier_complete(bar, b.x, nloc, nx); b.st[0] = nloc; b.st[1] = nx; }
        const unsigned old = xb_add(&bar[XB_XSUB(b.x)], 1u);
        const unsigned gen = old / nloc;
        if (old + 1u == (gen + 1u) * nloc) {
            __builtin_amdgcn_fence(__ATOMIC_RELEASE, "agent");
            asm volatile("s_waitcnt vmcnt(0)" ::: "memory");
            const unsigned og = xb_add(&bar[XB_TOP], 1u);
            const unsigned tg = og / nx;
            if (og + 1u == (tg + 1u) * nx) xb_add(&bar[XB_TOPGEN], 1u);
            else XB_SPIN(xb_ld(&bar[XB_TOPGEN]) == tg, bar);
            __builtin_amdgcn_fence(__ATOMIC_ACQUIRE, "agent");
            xb_add(&bar[XB_XGEN(b.x)], 1u);
            asm volatile("s_waitcnt vmcnt(0)" ::: "memory");
        } else {
            XB_SPIN(xb_ld(&bar[XB_XGEN(b.x)]) == gen, bar);
            __builtin_amdgcn_fence(__ATOMIC_ACQUIRE, "agent");
            asm volatile("s_waitcnt vmcnt(0)" ::: "memory");
        }
    }
    __syncthreads();
}

constexpr int NWAVES = 8;
constexpr int LDS_BYTES = 147456;
constexpr int MISC_OFF = 146432;

struct Args {
    const float *x, *g_mix, *w_in, *g_cq, *w_uq, *g_ckv, *w_ukv, *w_out, *g_ffn, *w_pq, *sub_keys, *u_emb, *v_emb, *g_final;
    const int* pos; float* out; unsigned char* ws; int ph_lo, ph_hi; unsigned probe_mask; int probe_shift;
};

__device__ __forceinline__ void p0_transpose_item(const float* __restrict__ W, int K, int N, const float* __restrict__ gk, bf16_t* __restrict__ WT, LAS float* scr, int item, int lane) {
    const int nblk = N / 32, kb = item / nblk, nb = item % nblk, k0 = 64 * kb, n0 = 32 * nb;
    float wv[32];
#pragma unroll
    for (int i = 0; i < 32; ++i) { const int kk = 2 * i + (lane >> 5); wv[i] = W[(size_t)(k0 + kk) * N + n0 + (lane & 31)]; if (gk) wv[i] *= gk[k0 + kk]; }
#pragma unroll
    for (int i = 0; i < 32; ++i) { const int kk = 2 * i + (lane >> 5); scr[kk * 33 + (lane & 31)] = wv[i]; }
    asm volatile("s_waitcnt lgkmcnt(0)" ::: "memory");
    const int c = lane & 7;
#pragma unroll
    for (int j = 0; j < 4; ++j) { const int n = (lane >> 3) + 8 * j; const LAS float* s = scr + (8 * c) * 33 + n;
        u32x4 o; o.x = pk_bf16(s[0 * 33], s[1 * 33]); o.y = pk_bf16(s[2 * 33], s[3 * 33]); o.z = pk_bf16(s[4 * 33], s[5 * 33]); o.w = pk_bf16(s[6 * 33], s[7 * 33]);
        *(u32x4*)(WT + (size_t)(n0 + n) * K + k0 + 8 * c) = o; }
    asm volatile("s_waitcnt lgkmcnt(0)" ::: "memory");
}
__device__ __forceinline__ bf16x8 cvt8(const float* p, float s) { const f32x4 a = *(const f32x4*)p, b = *(const f32x4*)(p + 4); u32x4 w; w.x = pk_bf16(a.x * s, a.y * s); w.y = pk_bf16(a.z * s, a.w * s); w.z = pk_bf16(b.x * s, b.y * s); w.w = pk_bf16(b.z * s, b.w * s); return __builtin_bit_cast(bf16x8, w); }
__device__ __forceinline__ void p0_wcomb_item(const float* __restrict__ keys, const float* __restrict__ w_pq, const float* __restrict__ g_ffn, bf16_t* __restrict__ Wc, int item, int lane) {
    const int hp = item >> 7, nblk = (item >> 5) & 3, kblk = item & 31, n0 = 32 * nblk, k0 = 32 * kblk, r32 = lane & 31, hi = lane >> 5;
    const float* ar = keys + ((size_t)hp * 128 + n0 + r32) * 128 + 8 * hi;
    const float* br = w_pq + (size_t)(k0 + r32) * 2048 + hp * 128 + 8 * hi;
    const float gk = g_ffn[k0 + r32];
    f32x16 d = {};
#pragma unroll
    for (int cs = 0; cs < 8; ++cs) d = __builtin_amdgcn_mfma_f32_32x32x16_bf16(cvt8(ar + 16 * cs, 1.f), cvt8(br + 16 * cs, 1.f), d, 0, 0, 0);
#pragma unroll
    for (int r = 0; r < 16; ++r) Wc[((size_t)hp * 128 + n0 + crow(r, hi)) * DM + k0 + r32] = (bf16_t)(pk_bf16(d[r] * gk, 0.f) & 0xffffu);
}
__device__ __forceinline__ void p0_prologue(const Args& a, LAS unsigned char* lds, int gw, int ngw, int lane, int wave) {
    unsigned char* ws = a.ws;
    LAS float* scr = (LAS float*)(lds + wave * 16384);
    bf16_t* Wt_in = (bf16_t*)(ws + WS_WIN); bf16_t* Wt_comb = (bf16_t*)(ws + WS_WCOMB); bf16_t* Wt_out = (bf16_t*)(ws + WS_WOUT); bf16_t* Wt_uq = (bf16_t*)(ws + WS_WUQ); bf16_t* Wt_ukv = (bf16_t*)(ws + WS_WUKV);
    constexpr int I_IN = (DM / 64) * (INW / 32), I_UQ = (256 / 64) * (768 / 32), I_UKV = (128 / 64) * (1024 / 32), I_OUT = (DM / 64) * (DM / 32), I_WC = 2048;
    constexpr int NITEMS = I_IN + I_UQ + I_UKV + I_OUT + I_WC;
    for (int it = gw; it < NITEMS; it += ngw) {
        int r = it;
        if (r < I_IN) { p0_transpose_item(a.w_in, DM, INW, nullptr, Wt_in, scr, r, lane); continue; } r -= I_IN;
        if (r < I_UQ) { p0_transpose_item(a.w_uq, 256, 768, a.g_cq, Wt_uq, scr, r, lane); continue; } r -= I_UQ;
        if (r < I_UKV) { p0_transpose_item(a.w_ukv, 128, 1024, a.g_ckv, Wt_ukv, scr, r, lane); continue; } r -= I_UKV;
        if (r < I_OUT) { p0_transpose_item(a.w_out, DM, DM, nullptr, Wt_out, scr, r, lane); continue; } r -= I_OUT;
        p0_wcomb_item(a.sub_keys, a.w_pq, a.g_ffn, Wt_comb, r, lane);
    }
    const int gt = gw * 64 + lane, ngt = ngw * 64;
    for (int i = gt; i < (2048 - INW) * DM / 8; i += ngt) *(u32x4*)(Wt_in + (size_t)INW * DM + (size_t)i * 8) = (u32x4){0u, 0u, 0u, 0u};
    { bf16_t* HN = (bf16_t*)(ws + WS_HN);
      const f32x4* gr = (const f32x4*)a.g_mix + lane;
      const f32x4 g0 = gr[0], g1 = gr[64], g2 = gr[128], g3 = gr[192];
      for (int m0 = 4 * gw; m0 < T; m0 += 4 * ngw) {
          f32x4 v[4][4];
#pragma unroll
          for (int r = 0; r < 4; ++r) { const f32x4* xr = (const f32x4*)(a.x + (size_t)(m0 + r) * DM) + lane; v[r][0] = xr[0]; v[r][1] = xr[64]; v[r][2] = xr[128]; v[r][3] = xr[192]; }
#pragma unroll
          for (int r = 0; r < 4; ++r) {
              float s = 0.f;
#pragma unroll
              for (int j = 0; j < 4; ++j) s += (v[r][j].x * v[r][j].x + v[r][j].y * v[r][j].y) + (v[r][j].z * v[r][j].z + v[r][j].w * v[r][j].w);
              const float rstd = 1.0f / sqrtf(wave_sum(s) * (1.f / DM) + EPS);
              u32x2* o8 = (u32x2*)(HN + (size_t)(m0 + r) * DM) + lane;
              u32x2 w;
              w.x = pk_bf16(v[r][0].x * rstd * g0.x, v[r][0].y * rstd * g0.y); w.y = pk_bf16(v[r][0].z * rstd * g0.z, v[r][0].w * rstd * g0.w); o8[0] = w;
              w.x = pk_bf16(v[r][1].x * rstd * g1.x, v[r][1].y * rstd * g1.y); w.y = pk_bf16(v[r][1].z * rstd * g1.z, v[r][1].w * rstd * g1.w); o8[64] = w;
              w.x = pk_bf16(v[r][2].x * rstd * g2.x, v[r][2].y * rstd * g2.y); w.y = pk_bf16(v[r][2].z * rstd * g2.z, v[r][2].w * rstd * g2.w); o8[128] = w;
              w.x = pk_bf16(v[r][3].x * rstd * g3.x, v[r][3].y * rstd * g3.y); w.y = pk_bf16(v[r][3].z * rstd * g3.z, v[r][3].w * rstd * g3.w); o8[192] = w;
          } } }
    { float* cosA = (float*)(ws + WS_COSA); float* sinA = (float*)(ws + WS_SINA); float* cosM = (float*)(ws + WS_COSM); float* sinM = (float*)(ws + WS_SINM);
      constexpr float INV16[16] = {1.0f, 0.44036659598350525f, 0.1939227432012558f, 0.08539710193872452f, 0.03760603070259094f, 0.016560440883040428f, 0.007292664609849453f, 0.0032114461064338684f,
                                   0.0014142135623842478f, 0.0006227724370546639f, 0.00027424818836152554f, 0.00012076973507646471f, 5.3182957344688475e-05f, 2.34199997066753e-05f, 1.0313385246263351e-05f, 4.541670477919979e-06f};
      for (int i = gt; i < T * 16; i += ngt) {
          const int tok = i >> 4, j = i & 15;
          const float ang = (float)a.pos[tok] * INV16[j];
          float sn, cs; sincosf(ang, &sn, &cs);
          cosM[tok * 16 + j] = cs; sinM[tok * 16 + j] = sn;
          if ((j & 1) == 0) { cosA[tok * 8 + (j >> 1)] = cs; sinA[tok * 8 + (j >> 1)] = sn; } } }
}

__global__ void __launch_bounds__(NWAVES * 64, 2) mk_fwd(Args a) {
    extern __shared__ __attribute__((aligned(16))) unsigned char lds_raw[];
    LAS unsigned char* lds = (LAS unsigned char*)lds_raw;
    volatile LAS unsigned* MISC = (volatile LAS unsigned*)(lds + MISC_OFF);
    const int tid = threadIdx.x, lane = tid & 63, wave = __builtin_amdgcn_readfirstlane(tid >> 6);
    const int G = gridDim.x, bx = blockIdx.x, vcu = (G % 8 == 0) ? (bx % 8) * (G / 8) + bx / 8 : bx;
    unsigned char* ws = a.ws;
    for (int u = tid; u < 64; u += NWAVES * 64) MISC[u] = 0u;
    __syncthreads();
    XcdBarrier bar = xcd_barrier_post((unsigned*)(ws + WS_CTL), MISC + 8);
    const int lo = a.ph_lo, hi = a.ph_hi;
#ifdef PROBE_LO
#define PMASK a.probe_mask
#else
#define PMASK 0xffffu
#endif
#define IN(k) (lo <= (k) && (k) < hi)
#ifdef PROBE_LO
#define RUN(k) (IN(k) && !(a.probe_shift & 16))
#else
#define RUN(k) IN(k)
#endif
#define SEAM(k) do { if (IN(k) && IN((k) + 1)) xcd_barrier(bar); } while (0)
    const int gw = vcu * NWAVES + wave, ngw = G * NWAVES;

    if (RUN(0)) { p0_prologue(a, lds, gw, ngw, lane, wave); }
    SEAM(0);
    if (RUN(1)) {
        pg8::Gemm g{(const bf16_t*)(ws + WS_HN), (const bf16_t*)(ws + WS_WIN), T, 2048, DM}; pg8::StaticOrder S; S.init(T, 2048, G, bx);
        pg8::EpiProj E{(bf16_t*)(ws + WS_QA), (bf16_t*)(ws + WS_KA), (bf16_t*)(ws + WS_VA), (bf16_t*)(ws + WS_CQ), (bf16_t*)(ws + WS_CKV), (bf16_t*)(ws + WS_KR),
                       (float*)(ws + WS_SSQQ), (float*)(ws + WS_SSQKV), (const float*)(ws + WS_COSA), (const float*)(ws + WS_SINA), (const float*)(ws + WS_COSM), (const float*)(ws + WS_SINM)};
        pg8::gemm_phase<pg8::EpiProj, pg8::StaticOrder, true, true>(lds, g, S, E);
    }
    SEAM(1);
    if (RUN(2)) {
        { int kk = 128; asm volatile("" : "+s"(kk));
          pg8::Gemm g{(const bf16_t*)(ws + WS_CKV), (const bf16_t*)(ws + WS_WUKV), T, 1024, kk}; pg8::StaticOrder S; S.init(T, 1024, G, bx);
          pg8::EpiKv E{(bf16_t*)(ws + WS_KN), (bf16_t*)(ws + WS_VM), (const float*)(ws + WS_SSQKV)};
          pg8::gemm_phase<pg8::EpiKv, pg8::StaticOrder, true, true>(lds, g, S, E); }
        __syncthreads();
        { int kk = 256; asm volatile("" : "+s"(kk));
          pg8::Gemm g{(const bf16_t*)(ws + WS_CQ), (const bf16_t*)(ws + WS_WUQ), T, 768, kk}; pg8::StaticOrder S; S.init(T, 768, G, bx);
          pg8::EpiQm E{(bf16_t*)(ws + WS_QM), (const float*)(ws + WS_SSQQ), (const float*)(ws + WS_COSM), (const float*)(ws + WS_SINM)};
          pg8::gemm_phase<pg8::EpiQm, pg8::StaticOrder, true, true>(lds, g, S, E); }
    }
    SEAM(2);
    if (RUN(3)) {
        if (!(a.probe_shift & 1)) for (int pr = vcu; pr < 256; pr += G) {
            const int bh = pr >> 4, s = pr & 15;
            att::mla_unit(lds, (const bf16_t*)(ws + WS_QM), (const bf16_t*)(ws + WS_KN), (const bf16_t*)(ws + WS_KR), (const bf16_t*)(ws + WS_VM), (bf16_t*)(ws + WS_MIXED), bh >> 3, bh & 7, 31 - s,
                          a.u_emb, a.v_emb, a.g_ffn, ws + WS_U8, ws + WS_V8, pr * 528);
            att::mla_unit(lds, (const bf16_t*)(ws + WS_QM), (const bf16_t*)(ws + WS_KN), (const bf16_t*)(ws + WS_KR), (const bf16_t*)(ws + WS_VM), (bf16_t*)(ws + WS_MIXED), bh >> 3, bh & 7, s,
                          a.u_emb, a.v_emb, a.g_ffn, ws + WS_U8, ws + WS_V8, pr * 528 + 16 * (32 - s));
        }
        if (!(a.probe_shift & 2)) for (int sg = vcu; sg < 256; sg += G)
            att::dil_segment(lds, (const bf16_t*)(ws + WS_QA), (const bf16_t*)(ws + WS_KA), (const bf16_t*)(ws + WS_VA), (bf16_t*)(ws + WS_MIXED), sg, wave, lane, a.probe_shift);
    }
    SEAM(3);
    if (RUN(4)) {
        pg8::Gemm g{(const bf16_t*)(ws + WS_MIXED), (const bf16_t*)(ws + WS_WOUT), T, DM, DM}; pg8::StaticOrder S; S.init(T, DM, G, bx);
        pg8::EpiOut E{a.x, (bf16_t*)(ws + WS_HB), ws + WS_HB8, (float*)(ws + WS_SSQH)};
        pg8::gemm_phase<pg8::EpiOut, pg8::StaticOrder, true, true>(lds, g, S, E);
    }
    SEAM(4);
    if (RUN(5)) {
        pg8::Gemm g{(const bf16_t*)(ws + WS_HB), (const bf16_t*)(ws + WS_WCOMB), T, 2048, DM}; pg8::StaticOrder S; S.init(T, 2048, G, bx);
        pg8::EpiSc E{(bf16_t*)(ws + WS_SC), (const float*)(ws + WS_SSQH)};
        pg8::gemm_phase<pg8::EpiSc, pg8::StaticOrder, true, true>(lds, g, S, E);
    }
    SEAM(5);
    if (RUN(6)) {
        peer2::topk_phase(lds, (const bf16_t*)(ws + WS_SC), (const float*)(ws + WS_SSQH), (unsigned short*)(ws + WS_PESLOT), (unsigned short*)(ws + WS_PEROW), (float*)(ws + WS_PG), (float*)(ws + WS_RSTDH), gw, ngw);
    }
    SEAM(6);
    const int sx = bx % 8, smem = (bx / 8) * NWAVES + wave, scnt = ((G - sx + 7) / 8) * NWAVES;
#ifdef PROBE_LO
    if (RUN(7) && (a.probe_shift & 8)) { peer2::u_phase<1>(lds, ws + WS_HB8, ws + WS_U8, (const unsigned short*)(ws + WS_PEROW), (bf16_t*)(ws + 160 * MiB), sx, smem, scnt, PMASK); } else
#endif
    if (RUN(7)) { peer2::u_phase(lds, ws + WS_HB8, ws + WS_U8, (const unsigned short*)(ws + WS_PEROW), (bf16_t*)(ws + WS_ZP), sx, smem, scnt, PMASK); }
    SEAM(7);
    if (RUN(8)) { peer2::act_phase(lds, (const bf16_t*)(ws + WS_ZP), (const unsigned short*)(ws + WS_PESLOT), (const float*)(ws + WS_PG), (const float*)(ws + WS_SSQH), (unsigned short*)(ws + WS_PE2), ws + WS_PA2, gw, ngw); }
    SEAM(8);
#ifdef PROBE_LO
    if (RUN(9) && (a.probe_shift & 128)) { peer2::v_phase<2>(lds, ws + WS_V8, (const unsigned short*)(ws + WS_PE2), ws + WS_PA2, (bf16_t*)(ws + 160 * MiB), sx, smem, scnt, PMASK); } else
    if (RUN(9) && (a.probe_shift & 4)) { peer2::v_phase<1>(lds, ws + WS_V8, (const unsigned short*)(ws + WS_PE2), ws + WS_PA2, (bf16_t*)(ws + WS_OP), sx, smem, scnt, PMASK); } else
#endif
    if (RUN(9)) { peer2::v_phase(lds, ws + WS_V8, (const unsigned short*)(ws + WS_PE2), ws + WS_PA2, (bf16_t*)(ws + WS_OP), sx, smem, scnt, PMASK); }
    SEAM(9);
    if (RUN(10)) { peer2::final_phase(a.out, (const bf16_t*)(ws + WS_HB), (const bf16_t*)(ws + WS_OP), a.g_final, gw, ngw); }
#undef IN
#undef RUN
#undef SEAM
}


#ifndef STAGE
#define STAGE 6
#endif
extern "C" void kernel_launch(void* const* d_in, const int* in_sizes, int n_in, void* d_out, int out_size, void* d_ws, size_t ws_size, hipStream_t stream) {
    static int grid = 0;
    if (grid == 0) {
        if (n_in != 15 || out_size != T * DM || ws_size < 256 * MiB) { fprintf(stderr, "kernel_launch: unexpected problem shape (n_in %d, out %d, ws %zu); nothing launched\n", n_in, out_size, ws_size); grid = -1; return; }
        int dev = 0, cus = 0, per_cu = 0;
        if (hipGetDevice(&dev) != hipSuccess || hipDeviceGetAttribute(&cus, hipDeviceAttributeMultiprocessorCount, dev) != hipSuccess) { grid = -1; return; }
        if (hipFuncSetAttribute((const void*)mk_fwd, hipFuncAttributeMaxDynamicSharedMemorySize, LDS_BYTES) != hipSuccess) { fprintf(stderr, "kernel_launch: hipFuncSetAttribute failed\n"); grid = -1; return; }
        if (hipOccupancyMaxActiveBlocksPerMultiprocessor(&per_cu, (const void*)mk_fwd, NWAVES * 64, LDS_BYTES) != hipSuccess || per_cu < 1) fprintf(stderr, "kernel_launch: note: occupancy query says %d workgroups per CU\n", per_cu);
        (void)hipGetLastError();
        grid = cus;
        if (grid < 8) { fprintf(stderr, "kernel_launch: %d CUs: the PEER slice phases need a grid of at least 8 workgroups; nothing launched\n", grid); grid = -1; return; }
    }
    if (grid < 0) return;
    unsigned char* ws = (unsigned char*)d_ws;
    (void)hipMemsetAsync(ws + WS_CTL, 0, CTL_ZERO_BYTES, stream);
    Args a{};
    a.x = (const float*)d_in[0]; a.pos = (const int*)d_in[1]; a.g_mix = (const float*)d_in[2]; a.w_in = (const float*)d_in[3]; a.g_cq = (const float*)d_in[4]; a.w_uq = (const float*)d_in[5];
    a.g_ckv = (const float*)d_in[6]; a.w_ukv = (const float*)d_in[7]; a.w_out = (const float*)d_in[8]; a.g_ffn = (const float*)d_in[9]; a.w_pq = (const float*)d_in[10]; a.sub_keys = (const float*)d_in[11];
    a.u_emb = (const float*)d_in[12]; a.v_emb = (const float*)d_in[13]; a.g_final = (const float*)d_in[14];
    a.out = (float*)d_out; a.ws = ws; a.ph_lo = 0; a.ph_hi = (STAGE >= 6) ? 11 : STAGE + 1; a.probe_mask = 0xffffu; a.probe_shift = 0;
#if defined(PROBE_LO) && PROBE_LO == 3
    { Args b1 = a; b1.ph_hi = 4; b1.probe_shift = PROBE_SHIFT; hipLaunchKernelGGL(mk_fwd, dim3(grid), dim3(NWAVES * 64), LDS_BYTES, stream, b1);
      (void)hipMemsetAsync(ws + WS_CTL, 0, CTL_ZERO_BYTES, stream); a.ph_lo = 3; }
#endif
    hipLaunchKernelGGL(mk_fwd, dim3(grid), dim3(NWAVES * 64), LDS_BYTES, stream, a);
#if defined(PROBE_LO) && PROBE_LO != 3
#if 0
#else
    { Args b2 = a; b2.ph_lo = PROBE_LO; b2.ph_hi = PROBE_HI; b2.probe_shift = PROBE_SHIFT; b2.probe_mask = PROBE_MASK; (void)hipMemsetAsync(ws + WS_CTL, 0, CTL_ZERO_BYTES, stream); hipLaunchKernelGGL(mk_fwd, dim3(grid), dim3(NWAVES * 64), LDS_BYTES, stream, b2); }
#endif
#endif
#if STAGE < 6
    float* out = (float*)d_out; float* mixed = out;
    const size_t MB = MiB;
#if STAGE == 2
    {
        float* q32 = (float*)(ws + 0 * MB); float* k32 = (float*)(ws + 32 * MB); float* v32 = (float*)(ws + 64 * MB);
        const long n = (long)T * 512;
        nv::k_cvt<<<(int)((n + 255) / 256), 256, 0, stream>>>((const bf16_t*)(ws + WS_QA), q32, n, 1.0f / LOG2E);
        nv::k_cvt<<<(int)((n + 255) / 256), 256, 0, stream>>>((const bf16_t*)(ws + WS_KA), k32, n, 1.0f);
        nv::k_cvt<<<(int)((n + 255) / 256), 256, 0, stream>>>((const bf16_t*)(ws + WS_VA), v32, n, 1.0f);
        nv::k_dilated<<<T * 8 / 4, 256, 0, stream>>>(q32, k32, v32, mixed);
        float* qm32 = (float*)(ws + 112 * MB);
        const long nq = (long)T * 768;
        nv::k_cvt<<<(int)((nq + 255) / 256), 256, 0, stream>>>((const bf16_t*)(ws + WS_QM), qm32, nq, 1.0f / LOG2E);
        float* Kt = (float*)(ws + 0 * MB); float* Vt = Kt + (size_t)NB * 8 * 96 * SEQ;
        nv::k_build_ktvt<<<(int)(((long)NB * 8 * 160 * SEQ + 255) / 256), 256, 0, stream>>>((const bf16_t*)(ws + WS_KN), (const bf16_t*)(ws + WS_VM), (const bf16_t*)(ws + WS_KR), Kt, Vt);
        nv::k_mla<<<NB * 8 * (SEQ / 4), 256, 0, stream>>>(qm32, Kt, Vt, mixed);
    }
#elif STAGE == 3
    { const long n = (long)T * DM; nv::k_cvt<<<(int)((n + 255) / 256), 256, 0, stream>>>((const bf16_t*)(ws + WS_MIXED), mixed, n, 1.0f); }
#endif
    float* hbuf = (float*)(ws + 192 * MB); float* rstd_h = (float*)(ws + 180 * MB);
#if STAGE <= 3
    nv::k_gemm<<<dim3(DM / 64, T / 64), 256, 0, stream>>>(mixed, DM, nullptr, nullptr, a.w_out, DM, hbuf, DM, T, DM, DM, a.x, DM);
#else
    (void)hipMemcpyAsync(hbuf, out, (size_t)T * DM * 4, hipMemcpyDeviceToDevice, stream);
#endif
    float* qp = (float*)(ws + 0 * MB);
    float* vals = (float*)(ws + 128 * MB); int* idxs = (int*)(ws + 145 * MB); int* expert = (int*)(ws + 162 * MB); float* gate = (float*)(ws + 171 * MB);
    nv::k_rstd<<<T / 4, 256, 0, stream>>>(hbuf, DM, DM, rstd_h, T);
    nv::k_gemm<<<dim3(2048 / 64, T / 64), 256, 0, stream>>>(hbuf, DM, rstd_h, a.g_ffn, a.w_pq, 2048, qp, 2048, T, 2048, DM, nullptr, 0);
    (void)hipFuncSetAttribute((const void*)nv::k_topk1, hipFuncAttributeMaxDynamicSharedMemorySize, 65536);
    nv::k_topk1<<<dim3(T / 256, 16), 256, 65536, stream>>>(qp, a.sub_keys, vals, idxs);
    nv::k_topk2<<<T * 8 / 256, 256, 0, stream>>>(vals, idxs, expert, gate);
    nv::k_peer_final<<<T / 4, 256, 0, stream>>>(hbuf, rstd_h, a.g_ffn, a.u_emb, a.v_emb, expert, gate, a.g_final, out);
#endif
}
```

```cpp
#include <hip/hip_runtime.h>
#include <hip/hip_bf16.h>
#include <math.h>
#include <stdio.h>
#include <stdint.h>

#define LAS __attribute__((address_space(3)))
#define GAS __attribute__((address_space(1)))
typedef unsigned short bf16_t;
typedef short bf16x8 __attribute__((ext_vector_type(8)));
typedef short s16x4 __attribute__((ext_vector_type(4)));
typedef float f32x2 __attribute__((ext_vector_type(2)));
typedef float f32x4 __attribute__((ext_vector_type(4)));
typedef float f32x16 __attribute__((ext_vector_type(16)));
typedef unsigned u32x2 __attribute__((ext_vector_type(2)));
typedef unsigned u32x4 __attribute__((ext_vector_type(4)));
typedef __bf16 bf16x2_t __attribute__((ext_vector_type(2)));
typedef _Float16 f16x2_t __attribute__((ext_vector_type(2)));
typedef int v8i __attribute__((ext_vector_type(8)));

constexpr int DM = 1024, NB = 2, SEQ = 8192, T = NB * SEQ;
constexpr int INW = 1952;
constexpr float EPS = 1e-6f;
constexpr float LOG2E = 1.4426950408889634f;
constexpr float QA_SCALE = 0.125f * LOG2E;
constexpr float QM_SCALE = 0.10206207261596577f * LOG2E;

constexpr size_t MiB = 1u << 20;
constexpr size_t WS_CTL = 0, CTL_ZERO_BYTES = 64 * 1024;
constexpr size_t WS_COSA = 1 * MiB, WS_SINA = WS_COSA + 512 * 1024, WS_COSM = 2 * MiB, WS_SINM = 3 * MiB;
constexpr size_t WS_WIN = 4 * MiB, WS_WCOMB = 8 * MiB, WS_WOUT = 12 * MiB, WS_WUQ = 14 * MiB, WS_WUKV = 14 * MiB + 512 * 1024;
constexpr size_t WS_SSQQ = 15 * MiB, WS_SSQKV = 15 * MiB + 512 * 1024;
constexpr size_t WS_U8 = 16 * MiB, WS_V8 = 32 * MiB;
constexpr size_t WS_HN = 80 * MiB, WS_MIXED = 80 * MiB;
constexpr size_t WS_QA = 112 * MiB, WS_KA = 128 * MiB, WS_VA = 144 * MiB;
constexpr size_t WS_CQ = 160 * MiB, WS_CKV = 168 * MiB, WS_KR = 172 * MiB;
constexpr size_t WS_QM = 176 * MiB, WS_KN = 200 * MiB, WS_VM = 216 * MiB;
constexpr size_t WS_SSQH = 232 * MiB;
constexpr size_t WS_HB = 112 * MiB, WS_SC = 144 * MiB;
constexpr size_t WS_HB8 = 208 * MiB;
constexpr size_t WS_ZP = 48 * MiB, WS_PEROW = 80 * MiB, WS_PESLOT = 84 * MiB, WS_PG = 88 * MiB, WS_SSQY = 96 * MiB, WS_RSTDH = 97 * MiB, WS_PE2 = 176 * MiB, WS_PA2 = 180 * MiB;
constexpr size_t WS_OP = 144 * MiB;
constexpr float SU = 256.f, SX = 16.f, SV = 64.f;
constexpr size_t WS_END = 234 * MiB;
static_assert(WS_KA == WS_QA + 16 * MiB && WS_VA == WS_KA + 16 * MiB && WS_VM == WS_KN + 16 * MiB, "epilogues address Ka/Va and Vm relative to Qa and Kn");

__device__ __forceinline__ unsigned pk_bf16(float lo, float hi) { f32x2 v = {lo, hi}; bf16x2_t b = __builtin_convertvector(v, bf16x2_t); return __builtin_bit_cast(unsigned, b); }
__device__ __forceinline__ unsigned pk_f16(float lo, float hi) { f32x2 v = {lo, hi}; f16x2_t b = __builtin_convertvector(v, f16x2_t); return __builtin_bit_cast(unsigned, b); }
__device__ __forceinline__ unsigned pk_fp8x4(float a, float b, float c, float d) { int w = __builtin_amdgcn_cvt_pk_fp8_f32(a, b, 0, false); w = __builtin_amdgcn_cvt_pk_fp8_f32(c, d, w, true); return (unsigned)w; }
__device__ __forceinline__ float bf_lo(unsigned w) { return __builtin_bit_cast(float, w << 16); }
__device__ __forceinline__ float bf_hi(unsigned w) { return __builtin_bit_cast(float, w & 0xffff0000u); }
__device__ __forceinline__ float wave_sum(float v) {
#pragma unroll
    for (int o = 1; o < 64; o <<= 1) v += __shfl_xor(v, o);
    return v;
}
__device__ __forceinline__ int crow(int r, int hi) { return (r & 3) + 8 * (r >> 2) + 4 * hi; }
__device__ __forceinline__ void glds16(const void* gsrc, unsigned lds_dst) { unsigned keep;
    asm volatile("s_mov_b32 %0, m0\n\ts_mov_b32 m0, %2\n\ts_nop 0\n\tglobal_load_lds_dwordx4 %1, off\n\ts_mov_b32 m0, %0" : "=&s"(keep) : "v"(gsrc), "s"(lds_dst) : "memory"); }

#define STAGE 6


namespace pg8 {
#define PG8_LAS __attribute__((address_space(3)))
typedef unsigned short bf16_t;
typedef short bf16x8 __attribute__((ext_vector_type(8)));
typedef float f32x4 __attribute__((ext_vector_type(4)));
typedef unsigned u32x4 __attribute__((ext_vector_type(4)));
constexpr int BM = 256, BK = 64, HALF = 128, HTB = HALF * BK * 2  , STAGE_BYTES = 8 * HTB, NXCD = 8, WGM = 8;

__host__ __device__ __forceinline__ int lds_byte(int r, int c) { const int st = (r >> 4) * 2 + (c >> 5), rr = r & 15, cc = c & 31, ob = rr * 64 + cc * 2; return st * 1024 + (ob ^ (((ob >> 9) & 1) << 5)); }
__host__ __device__ __forceinline__ void stage_rc(int b, int& R, int& C) { const int st = b / 1024, sb = b % 1024, swz = sb ^ (((sb >> 9) & 1) << 5); R = (st >> 1) * 16 + swz / 64; C = (st & 1) * 32 + (swz % 64) / 2; }
__host__ __device__ __forceinline__ int perm32(int rho) { const int n = rho >> 4, i = rho & 15; return 8 * (i >> 2) + 4 * n + (i & 3); }

struct Unit { int pm, pn; };
struct Gemm { const bf16_t* A; const bf16_t* Bt; int M, N, K; };

struct StaticOrder {
    int nM, nN, nwg, G, c;
    __host__ __device__ void init(int M, int N, int G_, int c_) { nM = M / BM; nN = N / BM; nwg = nM * nN; G = G_; c = c_; }
    __host__ __device__ bool next(int i, Unit& u) const {
        const long L = (long)i * G + c; if (L >= nwg) return false;
        int wgid = (int)L; { const int q = nwg / NXCD, r = nwg % NXCD, xcd = wgid % NXCD, off = wgid / NXCD; wgid = (xcd < r ? xcd * (q + 1) : r * (q + 1) + (xcd - r) * q) + off; }
        const int nig = WGM * nN, gid = wgid / nig, fm = gid * WGM, gsz = (nM - fm) < WGM ? (nM - fm) : WGM;
        u.pm = fm + ((wgid % nig) % gsz); u.pn = (wgid % nig) / gsz; return true;
    }
    __device__ __forceinline__ void a_ready(const Unit&) const {}
    __device__ __forceinline__ void done(const Unit&) const {}
};


__device__ __forceinline__ unsigned cvt_pk_bf16(float lo, float hi) { unsigned r; asm volatile("v_cvt_pk_bf16_f32 %0, %1, %2" : "=v"(r) : "v"(lo), "v"(hi)); return r; }
typedef float f32x2 __attribute__((ext_vector_type(2)));

__device__ __forceinline__ void load8(const float* p, float (&o)[8]);

template <class Epi, class Sched, bool ALIGN_EPI = false, bool SP2 = false>
__device__ __forceinline__ void gemm_phase(PG8_LAS unsigned char* lds, const Gemm g, const Sched& S, const Epi& E) {
    const int tid = threadIdx.x, wid = __builtin_amdgcn_readfirstlane(tid >> 6), lane = tid & 63, wr = wid >> 2, wc = wid & 3, fr = lane & 15, fq = lane >> 4;
    const int K = g.K, nt = K / BK;
    unsigned voffA[2], voffB[2];
#pragma unroll
    for (int i = 0; i < 2; ++i) { int R, C; stage_rc(tid * 16 + i * 8192, R, C); const int Rb = Epi::PERM ? ((R & ~31) + perm32(R & 31)) : R;
        voffA[i] = (unsigned)(R * K + C) * 2u; voffB[i] = (unsigned)(Rb * K + C) * 2u; }
    const size_t kstep = (size_t)(BK * 2);
    const size_t hstep = (size_t)HALF * K * 2;
    const size_t tstep = 2 * hstep;
    const unsigned ldsw = (unsigned)wid * 1024u;
    const int aoff = lds_byte(wr * 64 + fr, fq * 8), boff = lds_byte(wc * 32 + fr, fq * 8);
#define PG8_SA(b, h) (((b) * 2 + (h)) * HTB)
#define PG8_SB(b, h) ((4 + (b) * 2 + (h)) * HTB)
#define PG8_STAGE(bufoff, gbase, voff) do { _Pragma("unroll") for (int _i = 0; _i < 2; ++_i) \
        __builtin_amdgcn_global_load_lds((const unsigned*)((const char*)(gbase) + (voff)[_i]), (PG8_LAS unsigned*)(lds + (bufoff) + ldsw + _i * 8192), 16, 0, 0); } while (0)
#define PG8_LDA(dst, b, h) do { _Pragma("unroll") for (int m = 0; m < 4; ++m) _Pragma("unroll") for (int k = 0; k < 2; ++k) dst[m][k] = *(const PG8_LAS bf16x8*)(lds + PG8_SA(b, h) + aoff + m * 2048 + k * 1024); } while (0)
#define PG8_LDB(dst, b, h) do { _Pragma("unroll") for (int n = 0; n < 2; ++n) _Pragma("unroll") for (int k = 0; k < 2; ++k) dst[n][k] = *(const PG8_LAS bf16x8*)(lds + PG8_SB(b, h) + boff + n * 2048 + k * 1024); } while (0)
#define PG8_MMA(ai, bj, At, Bt) do { __builtin_amdgcn_s_setprio(1); _Pragma("unroll") for (int m = 0; m < 4; ++m) _Pragma("unroll") for (int n = 0; n < 2; ++n) _Pragma("unroll") for (int k = 0; k < 2; ++k) \
        acc[ai][bj][m][n] = __builtin_amdgcn_mfma_f32_16x16x32_bf16(Bt[n][k], At[m][k], acc[ai][bj][m][n], 0, 0, 0); __builtin_amdgcn_s_setprio(0); } while (0)
#define PG8_WAIT_V(n) asm volatile("s_waitcnt vmcnt(" #n ")" ::: "memory")
#define PG8_WAIT_L(n) asm volatile("s_waitcnt lgkmcnt(" #n ")" ::: "memory")
#define PG8_BAR __builtin_amdgcn_s_barrier()
#define PG8_SCHED __builtin_amdgcn_sched_barrier(0)
    Unit cur, nxt; int ui = 0;
    if (!S.next(0, cur)) return;
    f32x4 acc[2][2][4][2];
#pragma unroll
    for (int a = 0; a < 2; ++a)
#pragma unroll
        for (int b = 0; b < 2; ++b)
#pragma unroll
            for (int m = 0; m < 4; ++m)
#pragma unroll
                for (int n = 0; n < 2; ++n) acc[a][b][m][n] = (f32x4){0.f, 0.f, 0.f, 0.f};
    bf16x8 At[4][2], B0[2][2], B1[2][2];
    const char* cA = (const char*)g.A + (size_t)cur.pm * tstep; const char* cB = (const char*)g.Bt + (size_t)cur.pn * tstep;
    S.a_ready(cur);
    if constexpr (SP2) {
        PG8_STAGE(PG8_SB(0, 0), cB, voffB); PG8_STAGE(PG8_SB(0, 1), cB + hstep, voffB); PG8_STAGE(PG8_SA(0, 0), cA, voffA); PG8_STAGE(PG8_SA(0, 1), cA + hstep, voffA);
        if (wr == 1) PG8_BAR;
        PG8_WAIT_V(2); PG8_BAR;
        PG8_STAGE(PG8_SB(1, 0), cB + kstep, voffB); PG8_STAGE(PG8_SA(1, 0), cA + kstep, voffA); PG8_STAGE(PG8_SB(1, 1), cB + hstep + kstep, voffB);
        PG8_WAIT_V(6); PG8_BAR;
    } else {
        PG8_STAGE(PG8_SB(0, 0), cB, voffB); PG8_STAGE(PG8_SA(0, 0), cA, voffA); PG8_STAGE(PG8_SB(0, 1), cB + hstep, voffB); PG8_STAGE(PG8_SA(0, 1), cA + hstep, voffA);
        if (wr == 1) PG8_BAR;
        PG8_WAIT_V(4); PG8_BAR;
        PG8_STAGE(PG8_SB(1, 0), cB + kstep, voffB); PG8_STAGE(PG8_SA(1, 0), cA + kstep, voffA); PG8_STAGE(PG8_SB(1, 1), cB + hstep + kstep, voffB);
        PG8_WAIT_V(6); PG8_BAR;
    }
    for (;;) {
        const bool has_next = S.next(ui + 1, nxt);
        const char* nA = has_next ? (const char*)g.A + (size_t)nxt.pm * tstep : cA; const char* nB = has_next ? (const char*)g.Bt + (size_t)nxt.pn * tstep : cB;
        for (int t = 0; t < nt; t += 2) {
            const bool last = (t == nt - 2);
            const char* a1 = cA + (size_t)(t + 1) * kstep;
            const char* a2 = last ? nA : cA + (size_t)(t + 2) * kstep; const char* b2 = last ? nB : cB + (size_t)(t + 2) * kstep;
            const char* a3 = a2 + kstep; const char* b3 = b2 + kstep;
            if (last && has_next) S.a_ready(nxt);
            if constexpr (SP2) {
            PG8_LDB(B0, 0, 0); PG8_LDB(B1, 0, 1); PG8_SCHED; PG8_LDA(At, 0, 0); PG8_STAGE(PG8_SA(1, 1), a1 + hstep, voffA);
            PG8_WAIT_V(8); PG8_WAIT_L(0); PG8_BAR; PG8_MMA(0, 0, At, B0); PG8_MMA(0, 1, At, B1); PG8_BAR; PG8_SCHED;
            PG8_LDA(At, 0, 1); PG8_STAGE(PG8_SB(0, 0), b2, voffB); PG8_STAGE(PG8_SB(0, 1), b2 + hstep, voffB); PG8_STAGE(PG8_SA(0, 0), a2, voffA);
            PG8_WAIT_V(8); PG8_WAIT_L(0); PG8_BAR; PG8_MMA(1, 0, At, B0); PG8_MMA(1, 1, At, B1); PG8_BAR; PG8_SCHED;
            PG8_LDB(B0, 1, 0); PG8_LDB(B1, 1, 1); PG8_SCHED; PG8_LDA(At, 1, 0); PG8_STAGE(PG8_SA(0, 1), a2 + hstep, voffA);
            PG8_WAIT_V(8); PG8_WAIT_L(0); PG8_BAR; PG8_MMA(0, 0, At, B0); PG8_MMA(0, 1, At, B1); PG8_BAR; PG8_SCHED;
            PG8_LDA(At, 1, 1); PG8_STAGE(PG8_SB(1, 0), b3, voffB); PG8_STAGE(PG8_SB(1, 1), b3 + hstep, voffB); PG8_STAGE(PG8_SA(1, 0), a3, voffA);
            PG8_WAIT_V(8); PG8_WAIT_L(0); PG8_BAR; PG8_MMA(1, 0, At, B0); PG8_MMA(1, 1, At, B1); PG8_BAR; PG8_SCHED;
            } else {
            PG8_LDB(B0, 0, 0); PG8_SCHED; PG8_LDA(At, 0, 0); PG8_STAGE(PG8_SA(1, 1), a1 + hstep, voffA);
            PG8_WAIT_L(8); PG8_BAR; PG8_WAIT_L(0); PG8_MMA(0, 0, At, B0); PG8_BAR; PG8_SCHED;
            PG8_LDB(B1, 0, 1); PG8_STAGE(PG8_SB(0, 0), b2, voffB);
            PG8_BAR; PG8_WAIT_L(0); PG8_MMA(0, 1, At, B1); PG8_BAR;
            PG8_LDA(At, 0, 1); PG8_STAGE(PG8_SA(0, 0), a2, voffA);
            PG8_BAR; PG8_WAIT_L(0); PG8_MMA(1, 0, At, B0); PG8_BAR; PG8_SCHED;
            PG8_STAGE(PG8_SB(0, 1), b2 + hstep, voffB);
            PG8_WAIT_V(6); PG8_BAR; PG8_MMA(1, 1, At, B1); PG8_BAR;
            PG8_LDB(B0, 1, 0); PG8_SCHED; PG8_LDA(At, 1, 0); PG8_STAGE(PG8_SA(0, 1), a2 + hstep, voffA);
            PG8_WAIT_L(8); PG8_BAR; PG8_WAIT_L(0); PG8_MMA(0, 0, At, B0); PG8_BAR; PG8_SCHED;
            PG8_LDB(B1, 1, 1); PG8_STAGE(PG8_SB(1, 0), b3, voffB);
            PG8_BAR; PG8_WAIT_L(0); PG8_MMA(0, 1, At, B1); PG8_BAR;
            PG8_LDA(At, 1, 1); PG8_STAGE(PG8_SA(1, 0), a3, voffA);
            PG8_BAR; PG8_WAIT_L(0); PG8_MMA(1, 0, At, B0); PG8_BAR; PG8_SCHED;
            PG8_STAGE(PG8_SB(1, 1), b3 + hstep, voffB);
            PG8_WAIT_V(6); PG8_BAR; PG8_MMA(1, 1, At, B1); PG8_BAR;
            }
        }
        if constexpr (ALIGN_EPI) { if (wr == 0) PG8_BAR; }
        if constexpr (!Epi::AFTER_DRAIN) { E(acc, cur, wr, wc, fr, fq); S.done(cur); }
        if (!has_next) break;
#pragma unroll
        for (int a = 0; a < 2; ++a)
#pragma unroll
            for (int b = 0; b < 2; ++b)
#pragma unroll
                for (int m = 0; m < 4; ++m)
#pragma unroll
                    for (int n = 0; n < 2; ++n) acc[a][b][m][n] = (f32x4){0.f, 0.f, 0.f, 0.f};
        cur = nxt; cA = nA; cB = nB; ++ui;
        if constexpr (ALIGN_EPI) { if (wr == 1) PG8_BAR; }
    }
    PG8_WAIT_V(0);
    if constexpr (!ALIGN_EPI) { if (wr == 0) PG8_BAR; }
    PG8_BAR;
    if constexpr (Epi::AFTER_DRAIN) { E.fused(acc, cur, wr, wc, fr, fq, lds, wid, lane); S.done(cur); }
#undef PG8_SA
#undef PG8_SB
#undef PG8_STAGE
#undef PG8_LDA
#undef PG8_LDB
#undef PG8_MMA
#undef PG8_WAIT_V
#undef PG8_WAIT_L
#undef PG8_BAR
#undef PG8_SCHED
}
}

namespace pg8 {
#define EPI_V8(ai, bj, m) { acc[ai][bj][m][0][0], acc[ai][bj][m][0][1], acc[ai][bj][m][0][2], acc[ai][bj][m][0][3], acc[ai][bj][m][1][0], acc[ai][bj][m][1][1], acc[ai][bj][m][1][2], acc[ai][bj][m][1][3] }
__device__ __forceinline__ u32x4 pack8(const float (&v)[8], float s) { u32x4 w; w.x = pk_bf16(v[0] * s, v[1] * s); w.y = pk_bf16(v[2] * s, v[3] * s); w.z = pk_bf16(v[4] * s, v[5] * s); w.w = pk_bf16(v[6] * s, v[7] * s); return w; }
__device__ __forceinline__ float ssq8(const float (&v)[8]) { return ((v[0] * v[0] + v[1] * v[1]) + (v[2] * v[2] + v[3] * v[3])) + ((v[4] * v[4] + v[5] * v[5]) + (v[6] * v[6] + v[7] * v[7])); }
__device__ __forceinline__ void load8(const float* p, float (&o)[8]) { const f32x4 a = *(const f32x4*)p, b = *(const f32x4*)(p + 4); o[0] = a.x; o[1] = a.y; o[2] = a.z; o[3] = a.w; o[4] = b.x; o[5] = b.y; o[6] = b.z; o[7] = b.w; }

struct EpiProj {
    static constexpr bool PERM = true, AFTER_DRAIN = false;
    bf16_t *Qa, *Ka, *Va, *Cq, *Ckv, *Kr; float *ssq_q, *ssq_kv; const float *cosA, *sinA, *cosM, *sinM;
    __device__ __forceinline__ void operator()(const f32x4 (&acc)[2][2][4][2], const Unit& u, int wr, int wc, int fr, int fq) const {
        const int pn = u.pn, rowb = u.pm * BM + wr * 64 + fr;
        if (pn < 6) {
            const int kind = pn >> 1;
            bf16_t* dst = Qa + (size_t)kind * (size_t)(8u << 20);
            const float sc = kind == 0 ? QA_SCALE : 1.f;
            const bool ropew = (kind < 2) && ((wc & 1) == 0);
            float cq[2][8], sq[2][8];
            if (ropew) {
#pragma unroll
                for (int g = 0; g < 2; ++g) { const size_t r_ = (size_t)(rowb + g * 16) * 8; load8(cosA + r_, cq[g]); load8(sinA + r_, sq[g]); }
            }
#pragma unroll
            for (int ai = 0; ai < 2; ++ai)
#pragma unroll
                for (int m = 0; m < 4; ++m) {
                    const int row = rowb + ai * HALF + m * 16;
                    float cs[8], sn[8];
                    if (ropew) {
#pragma unroll
                        for (int i = 0; i < 8; ++i) { cs[i] = cq[m & 1][i]; sn[i] = sq[m & 1][i]; }
                        if (ai * 4 + m + 2 < 8) { const int g2 = ai * 4 + m + 2; const size_t r_ = (size_t)(rowb + (g2 >> 2) * HALF + (g2 & 3) * 16) * 8; load8(cosA + r_, cq[m & 1]); load8(sinA + r_, sq[m & 1]); }
                    }
#pragma unroll
                    for (int bj = 0; bj < 2; ++bj) {
                        float v[8] = EPI_V8(ai, bj, m);
                        if (ropew) {
#pragma unroll
                            for (int i = 0; i < 8; ++i) { const float pv = __shfl_xor(v[i], 16); if (fq == 0) v[i] = v[i] * cs[i] - pv * sn[i]; else if (fq == 1) v[i] = v[i] * cs[i] + pv * sn[i]; }
                        }
                        *(u32x4*)(dst + ((size_t)((row >> 13) * 8 + (pn & 1) * 4 + bj * 2 + (wc >> 1)) * SEQ + (row & (SEQ - 1))) * 64 + (wc & 1) * 32 + fq * 8) = pack8(v, sc);
                    }
                }
        } else if (pn == 6) {
#pragma unroll
            for (int ai = 0; ai < 2; ++ai)
#pragma unroll
                for (int m = 0; m < 4; ++m) {
                    const int row = rowb + ai * HALF + m * 16;
#pragma unroll
                    for (int bj = 0; bj < 2; ++bj) {
                        float v[8] = EPI_V8(ai, bj, m);
                        float s = ssq8(v); s += __shfl_xor(s, 16); s += __shfl_xor(s, 32);
                        if (fq == 0) ssq_q[(size_t)row * 8 + bj * 4 + wc] = s;
                        *(u32x4*)(Cq + (size_t)row * 256 + bj * HALF + wc * 32 + fq * 8) = pack8(v, 1.f);
                    }
                }
        } else {
#pragma unroll
            for (int ai = 0; ai < 2; ++ai)
#pragma unroll
                for (int m = 0; m < 4; ++m) {
                    const int row = rowb + ai * HALF + m * 16;
                    {
                        float v[8] = EPI_V8(ai, 0, m);
                        float s = ssq8(v); s += __shfl_xor(s, 16); s += __shfl_xor(s, 32);
                        if (fq == 0) ssq_kv[(size_t)row * 4 + wc] = s;
                        *(u32x4*)(Ckv + (size_t)row * 128 + wc * 32 + fq * 8) = pack8(v, 1.f);
                    }
                    if (wc == 0) {
                        float v[8] = EPI_V8(ai, 1, m);
                        float cs[8], sn[8];
                        load8(cosM + (size_t)row * 16 + 8 * (fq & 1), cs); load8(sinM + (size_t)row * 16 + 8 * (fq & 1), sn);
#pragma unroll
                        for (int i = 0; i < 8; ++i) { const float pv = __shfl_xor(v[i], 32); v[i] = (fq < 2) ? (v[i] * cs[i] - pv * sn[i]) : (v[i] * cs[i] + pv * sn[i]); }
                        *(u32x4*)(Kr + (size_t)row * 32 + fq * 8) = pack8(v, 1.f);
                    }
                }
        }
    }
};

struct EpiQm {
    static constexpr bool PERM = true, AFTER_DRAIN = false;
    bf16_t* Qm; const float* ssq_q; const float *cosM, *sinM;
    __device__ __forceinline__ void operator()(const f32x4 (&acc)[2][2][4][2], const Unit& u, int wr, int wc, int fr, int fq) const {
        const int pn = u.pn, rowb = u.pm * BM + wr * 64 + fr;
        f32x2 qa[8];
#pragma unroll
        for (int g = 0; g < 8; ++g) qa[g] = *(const f32x2*)(ssq_q + (size_t)(rowb + (g >> 2) * HALF + (g & 3) * 16) * 8 + 2 * fq);
        float cq[2][8], sq[2][8];
#pragma unroll
        for (int g = 0; g < 2; ++g) { const size_t r_ = (size_t)(rowb + g * 16) * 16 + 8 * (fq & 1); load8(cosM + r_, cq[g]); load8(sinM + r_, sq[g]); }
#pragma unroll
        for (int ai = 0; ai < 2; ++ai)
#pragma unroll
            for (int m = 0; m < 4; ++m) {
                const int row = rowb + ai * HALF + m * 16, g = ai * 4 + m;
                float ssum = qa[g].x + qa[g].y; ssum += __shfl_xor(ssum, 16); ssum += __shfl_xor(ssum, 32);
                const float rs = 1.0f / sqrtf(ssum * (1.f / 256.f) + EPS);
                float cs[8], sn[8];
#pragma unroll
                for (int i = 0; i < 8; ++i) { cs[i] = cq[m & 1][i]; sn[i] = sq[m & 1][i]; }
                if (g + 2 < 8) { const int g2 = g + 2; const size_t r_ = (size_t)(rowb + (g2 >> 2) * HALF + (g2 & 3) * 16) * 16 + 8 * (fq & 1); load8(cosM + r_, cq[m & 1]); load8(sinM + r_, sq[m & 1]); }
#pragma unroll
                for (int bj = 0; bj < 2; ++bj) {
                    const int g32 = pn * 8 + bj * 4 + wc;
                    const bool ropew = (g32 % 3) == 2;
                    float v[8] = EPI_V8(ai, bj, m);
#pragma unroll
                    for (int i = 0; i < 8; ++i) v[i] *= rs;
                    if (ropew) {
#pragma unroll
                        for (int i = 0; i < 8; ++i) { const float pv = __shfl_xor(v[i], 32); v[i] = (fq < 2) ? (v[i] * cs[i] - pv * sn[i]) : (v[i] * cs[i] + pv * sn[i]); }
                    }
                    *(u32x4*)(Qm + (size_t)row * 768 + pn * BM + bj * HALF + wc * 32 + fq * 8) = pack8(v, QM_SCALE);
                }
                asm volatile("" ::: "memory");
            }
    }
};

struct EpiKv {
    static constexpr bool PERM = true, AFTER_DRAIN = false;
    bf16_t *Kn, *Vm; const float* ssq_kv;
    __device__ __forceinline__ void operator()(const f32x4 (&acc)[2][2][4][2], const Unit& u, int wr, int wc, int fr, int fq) const {
        const int pn = u.pn, rowb = u.pm * BM + wr * 64 + fr;
        bf16_t* dst = Kn + (size_t)(wc >> 1) * (size_t)(8u << 20);
        const int within = (wc & 1) * 32 + fq * 8;
        f32x4 q4a[8];
#pragma unroll
        for (int g = 0; g < 8; ++g) q4a[g] = *(const f32x4*)(ssq_kv + (size_t)(rowb + (g >> 2) * HALF + (g & 3) * 16) * 4);
#pragma unroll
        for (int ai = 0; ai < 2; ++ai)
#pragma unroll
            for (int m = 0; m < 4; ++m) {
                const int row = rowb + ai * HALF + m * 16;
                const f32x4 q4 = q4a[ai * 4 + m];
                const float rs = 1.0f / sqrtf(((q4.x + q4.y) + (q4.z + q4.w)) * (1.f / 128.f) + EPS);
#pragma unroll
                for (int bj = 0; bj < 2; ++bj) {
                    float v[8] = EPI_V8(ai, bj, m);
                    *(u32x4*)(dst + ((size_t)((row >> 13) * 8 + pn * 2 + bj) * SEQ + (row & (SEQ - 1))) * 64 + within) = pack8(v, rs);
                }
            }
    }
};

struct EpiOut {
    static constexpr bool PERM = true, AFTER_DRAIN = false;
    const float* x; bf16_t* Hb; unsigned char* Hb8; float* ssq_h;
    __device__ __forceinline__ void operator()(const f32x4 (&acc)[2][2][4][2], const Unit& u, int wr, int wc, int fr, int fq) const {
        const int pn = u.pn, rowb = u.pm * BM + wr * 64 + fr;
        float xq[8][8];
#define XPIECE(t_) (x + (size_t)(rowb + ((t_) >> 3) * HALF + (((t_) >> 1) & 3) * 16) * DM + pn * BM + ((t_) & 1) * HALF + wc * 32 + fq * 8)
#pragma unroll
        for (int t = 0; t < 8; ++t) load8(XPIECE(t), xq[t]);
#pragma unroll
        for (int ai = 0; ai < 2; ++ai)
#pragma unroll
            for (int m = 0; m < 4; ++m) {
                const int row = rowb + ai * HALF + m * 16;
#pragma unroll
                for (int bj = 0; bj < 2; ++bj) {
                    const int col = pn * BM + bj * HALF + wc * 32 + fq * 8, t = (ai * 4 + m) * 2 + bj;
                    float v[8] = EPI_V8(ai, bj, m);
#pragma unroll
                    for (int i = 0; i < 8; ++i) v[i] += xq[t & 7][i];
                    if (t + 8 < 16) load8(XPIECE(t + 8), xq[t & 7]);
                    float s = ssq8(v); s += __shfl_xor(s, 16); s += __shfl_xor(s, 32);
                    if (fq == 0) ssq_h[(size_t)row * 32 + pn * 8 + bj * 4 + wc] = s;
                    *(u32x4*)(Hb + (size_t)row * DM + col) = pack8(v, 1.f);
                    { u32x2 w8; w8.x = pk_fp8x4(v[0] * SX, v[1] * SX, v[2] * SX, v[3] * SX); w8.y = pk_fp8x4(v[4] * SX, v[5] * SX, v[6] * SX, v[7] * SX); *(u32x2*)(Hb8 + (size_t)(col >> 7) * ((size_t)T * 128) + (size_t)row * 128 + (col & 127)) = w8; }
                }
            }
#undef XPIECE
    }
};

struct EpiSc {
    static constexpr bool PERM = true, AFTER_DRAIN = false;
    bf16_t* Sc; const float* ssq_h;
    __device__ __forceinline__ void operator()(const f32x4 (&acc)[2][2][4][2], const Unit& u, int wr, int wc, int fr, int fq) const {
        const int pn = u.pn, rowb = u.pm * BM + wr * 64 + fr;
        f32x4 q[8][2];
#pragma unroll
        for (int g = 0; g < 8; ++g) { const float* qp = ssq_h + (size_t)(rowb + (g >> 2) * HALF + (g & 3) * 16) * 32 + 8 * fq; q[g][0] = *(const f32x4*)qp; q[g][1] = *(const f32x4*)(qp + 4); }
#pragma unroll
        for (int ai = 0; ai < 2; ++ai)
#pragma unroll
            for (int m = 0; m < 4; ++m) {
                const int row = rowb + ai * HALF + m * 16, g = ai * 4 + m;
                float s = ((q[g][0].x + q[g][0].y) + (q[g][0].z + q[g][0].w)) + ((q[g][1].x + q[g][1].y) + (q[g][1].z + q[g][1].w));
                s += __shfl_xor(s, 16); s += __shfl_xor(s, 32);
                const float rs = 1.0f / sqrtf(s * (1.f / 1024.f) + EPS);
#pragma unroll
                for (int bj = 0; bj < 2; ++bj) {
                    float v[8] = EPI_V8(ai, bj, m);
                    u32x4 w; w.x = pk_f16(v[0] * rs, v[1] * rs); w.y = pk_f16(v[2] * rs, v[3] * rs); w.z = pk_f16(v[4] * rs, v[5] * rs); w.w = pk_f16(v[6] * rs, v[7] * rs);
                    *(u32x4*)(Sc + (size_t)row * 2048 + pn * BM + bj * HALF + wc * 32 + fq * 8) = w;
                }
            }
    }
};
#undef EPI_V8
}

namespace att {
constexpr float NEGM = -1.0e30f;
__device__ __forceinline__ s16x4 vtr(const LAS unsigned char* p) { typedef short v4i16_t __attribute__((ext_vector_type(4))); return __builtin_bit_cast(s16x4, __builtin_amdgcn_ds_read_tr16_b64_v4i16((LAS v4i16_t*)p)); }
__device__ __forceinline__ void swap32(unsigned& a, unsigned& b) { asm volatile("s_nop 1\n\tv_permlane32_swap_b32 %0, %1" : "+v"(a), "+v"(b)); }
__device__ __forceinline__ float swapmax(float v) { unsigned a = __builtin_bit_cast(unsigned, v), b = a; swap32(a, b); return fmaxf(__builtin_bit_cast(float, a), __builtin_bit_cast(float, b)); }
__device__ __forceinline__ float swapsum(float v) { unsigned a = __builtin_bit_cast(unsigned, v), b = a; swap32(a, b); return __builtin_bit_cast(float, a) + __builtin_bit_cast(float, b); }
__device__ __forceinline__ float max3f(float a, float b, float c) { float r; asm("v_max3_f32 %0, %1, %2, %3" : "=v"(r) : "v"(a), "v"(b), "v"(c)); return r; }
constexpr float THR = 8.0f;
__device__ __forceinline__ bf16x8 pack_p(const f32x16& p, int s) {
    u32x4 w; w.x = pk_bf16(p[8 * s + 0], p[8 * s + 1]); w.y = pk_bf16(p[8 * s + 2], p[8 * s + 3]); w.z = pk_bf16(p[8 * s + 4], p[8 * s + 5]); w.w = pk_bf16(p[8 * s + 6], p[8 * s + 7]);
    return __builtin_bit_cast(bf16x8, w);
}
__device__ __forceinline__ void pv_block(f32x16& o, const LAS unsigned char* vbase, const bf16x8& pb0, const bf16x8& pb1) {
    const s16x4 l0 = vtr(vbase), h0 = vtr(vbase + 8 * 64), l1 = vtr(vbase + 16 * 64), h1 = vtr(vbase + 24 * 64);
    const bf16x8 a0 = {l0[0], l0[1], l0[2], l0[3], h0[0], h0[1], h0[2], h0[3]}, a1 = {l1[0], l1[1], l1[2], l1[3], h1[0], h1[1], h1[2], h1[3]};
    o = __builtin_amdgcn_mfma_f32_32x32x16_bf16(a0, pb0, o, 0, 0, 0);
    o = __builtin_amdgcn_mfma_f32_32x32x16_bf16(a1, pb1, o, 0, 0, 0);
}
__device__ __forceinline__ void store_o(bf16_t* orow, const f32x16& o0, const f32x16& o1, float inv, int hi) {
#pragma unroll
    for (int g = 0; g < 4; ++g) {
        u32x2 a, b; a.x = pk_bf16(o0[4 * g] * inv, o0[4 * g + 1] * inv); a.y = pk_bf16(o0[4 * g + 2] * inv, o0[4 * g + 3] * inv);
        b.x = pk_bf16(o1[4 * g] * inv, o1[4 * g + 1] * inv); b.y = pk_bf16(o1[4 * g + 2] * inv, o1[4 * g + 3] * inv);
        *(u32x2*)(orow + 8 * g + 4 * hi) = a; *(u32x2*)(orow + 32 + 8 * g + 4 * hi) = b;
    }
}

constexpr int KROW = 208;
constexpr int TK = 128, KBYTES = TK * KROW, VBYTES = 2 * TK * 64, BUFB = KBYTES + VBYTES;
constexpr int MLA_LDS = 2 * BUFB;
__device__ __forceinline__ float rowmax64(const f32x16& s0, const f32x16& s1) {
    float mx = max3f(s0[0], s1[0], s0[1]);
#pragma unroll
    for (int r = 1; r < 15; r += 2) { mx = max3f(mx, s1[r], s0[r + 1]); mx = max3f(mx, s1[r + 1], s0[r + 2 < 16 ? r + 2 : 15]); }
    mx = max3f(mx, s1[15], s0[15]);
    return swapmax(mx);
}
__device__ __forceinline__ void scale16(f32x16& t, float a) {
    const f32x2 a2 = {a, a};
#pragma unroll
    for (int i = 0; i < 8; ++i) { f32x2 p = {t[2 * i], t[2 * i + 1]}; asm volatile("v_pk_mul_f32 %0, %0, %1" : "+v"(p) : "v"(a2)); t[2 * i] = p.x; t[2 * i + 1] = p.y; }
}
__device__ __forceinline__ void sub16(f32x16& t, float d) {
    const f32x2 d2 = {d, d};
#pragma unroll
    for (int i = 0; i < 8; ++i) { f32x2 p = {t[2 * i], t[2 * i + 1]}; asm volatile("v_pk_add_f32 %0, %0, %1 neg_lo:[0,1] neg_hi:[0,1]" : "+v"(p) : "v"(d2)); t[2 * i] = p.x; t[2 * i + 1] = p.y; }
}
__device__ __forceinline__ void rescale64(float mx, f32x16& s0, f32x16& s1, float& m, float& l, f32x16& o0, f32x16& o1) {
    if (__builtin_expect(__builtin_amdgcn_ballot_w64(mx > THR) != 0ull, 0)) {
        const float dl = fmaxf(mx, 0.f), alpha = __builtin_amdgcn_exp2f(-dl);
        m += dl; l *= alpha;
        sub16(s0, dl); sub16(s1, dl); scale16(o0, alpha); scale16(o1, alpha);
    }
}
__device__ __forceinline__ void exp64(f32x16& s0, f32x16& s1, float& l) {
    float rs = 0.f;
#pragma unroll
    for (int r = 0; r < 16; ++r) { s0[r] = __builtin_amdgcn_exp2f(s0[r]); s1[r] = __builtin_amdgcn_exp2f(s1[r]); rs += s0[r] + s1[r]; }
    l += rs;
}
__device__ __forceinline__ void sm64(f32x16& s0, f32x16& s1, float& m, float& l, f32x16& o0, f32x16& o1, f32x16& t0, f32x16& t1, bool adj_other) {
    float mx = max3f(s0[0], s1[0], s0[1]);
#pragma unroll
    for (int r = 1; r < 15; r += 2) { mx = max3f(mx, s1[r], s0[r + 1]); mx = max3f(mx, s1[r + 1], s0[r + 2 < 16 ? r + 2 : 15]); }
    mx = max3f(mx, s1[15], s0[15]);
    mx = swapmax(mx);
    if (__builtin_expect(__builtin_amdgcn_ballot_w64(mx > THR) != 0ull, 0)) {
        const float dl = fmaxf(mx, 0.f), alpha = __builtin_amdgcn_exp2f(-dl);
        m += dl; l *= alpha;
#pragma unroll
        for (int r = 0; r < 16; ++r) { s0[r] -= dl; s1[r] -= dl; o0[r] *= alpha; o1[r] *= alpha; }
        if (adj_other) {
#pragma unroll
            for (int r = 0; r < 16; ++r) { t0[r] -= dl; t1[r] -= dl; }
        }
    }
    float rs = 0.f;
#pragma unroll
    for (int r = 0; r < 16; ++r) { s0[r] = __builtin_amdgcn_exp2f(s0[r]); s1[r] = __builtin_amdgcn_exp2f(s1[r]); rs += s0[r] + s1[r]; }
    l += rs;
}
constexpr int MLA_G_OFF = 2 * (TK * 208 + 2 * TK * 64), MLA_PIECE_OFF = MLA_G_OFF + 4096;
__device__ __forceinline__ void mla_unit(LAS unsigned char* lds, const bf16_t* __restrict__ Qm, const bf16_t* __restrict__ Kn, const bf16_t* __restrict__ Kr, const bf16_t* __restrict__ Vm,
                                         bf16_t* __restrict__ Mixed, int b, int h, int qb,
                                         const float* __restrict__ u_emb, const float* __restrict__ v_emb, const float* __restrict__ g_ffn, unsigned char* __restrict__ U8, unsigned char* __restrict__ V8, int slot0) {
    const int tid = threadIdx.x, lane = tid & 63, wid = __builtin_amdgcn_readfirstlane(tid >> 6), r32 = lane & 31, hi = lane >> 5;
    const size_t tok0 = (size_t)b * SEQ;
    const int qpos = 256 * qb + 32 * wid + r32;
    bf16x8 qf[6];
    { const bf16_t* qrow = Qm + (tok0 + qpos) * 768 + h * 96 + 8 * hi;
#pragma unroll
      for (int ds = 0; ds < 6; ++ds) qf[ds] = *(const bf16x8*)(qrow + 16 * ds); }
    float m = 0.f, l = 0.f; f32x16 o0 = {}, o1 = {};
    const int nt = 2 * (qb + 1);
    const int wq0 = 256 * qb + 32 * wid, wqlast = wq0 + 31;
    const int srow = tid >> 3, sch = tid & 7, rrow = tid >> 2, rch = tid & 3;
    const bf16_t* gkn = Kn + ((size_t)(b * 8 + h) * SEQ + srow) * 64 + sch * 8;
    const bf16_t* gv = Vm + ((size_t)(b * 8 + h) * SEQ + srow) * 64 + sch * 8;
    const bf16_t* gkr = Kr + (tok0 + rrow) * 32 + rch * 8;
    const int wkn = srow * KROW + sch * 16, wkr = rrow * KROW + 128 + rch * 16, wv = KBYTES + (sch >> 2) * (TK * 64) + srow * 64 + (sch & 3) * 16;
    const int kfrag = r32 * KROW + hi * 16;
    const int i16 = lane & 15, vfrag = KBYTES + (4 * hi + (i16 >> 2)) * 64 + (16 * ((lane >> 4) & 1) + 4 * (i16 & 3)) * 2;
    u32x4 rk0, rk1, rv0, rv1, rr;
#define MLA_LOAD(t) do { const size_t adv_ = (size_t)(t) * TK; rk0 = *(const u32x4*)(gkn + adv_ * 64); rk1 = *(const u32x4*)(gkn + (adv_ + 64) * 64); \
        rv0 = *(const u32x4*)(gv + adv_ * 64); rv1 = *(const u32x4*)(gv + (adv_ + 64) * 64); rr = *(const u32x4*)(gkr + adv_ * 32); } while (0)
#define MLA_STORE(bp) do { LAS unsigned char* b_ = (bp); *(LAS u32x4*)(b_ + wkn) = rk0; *(LAS u32x4*)(b_ + wkn + 64 * KROW) = rk1; *(LAS u32x4*)(b_ + wv) = rv0; *(LAS u32x4*)(b_ + wv + 64 * 64) = rv1; *(LAS u32x4*)(b_ + wkr) = rr; } while (0)
    if (wid >= 4) __builtin_amdgcn_s_setprio(1);
    MLA_LOAD(0); MLA_STORE(lds);
    for (int u = tid; u < DM / 4; u += 512) *(LAS f32x4*)(lds + MLA_G_OFF + 16 * u) = *(const f32x4*)(g_ffn + 4 * u);
    LAS unsigned char* piece = lds + MLA_PIECE_OFF + wid * 1024;
    const unsigned piece_u = (unsigned)__builtin_amdgcn_readfirstlane((int)(unsigned)(uintptr_t)piece);
    __syncthreads();
    const int nfull = (wq0 + 1) >> 7;
    int kt = 0;
    for (; kt < nfull; ++kt) {
        const LAS unsigned char* buf = lds + (kt & 1) * BUFB;
        if (kt + 1 < nt) MLA_LOAD(kt + 1);
        const int pid = slot0 + 8 * kt + wid;
        if (pid < 131072) glds16(((pid >> 16) ? v_emb : u_emb) + (size_t)(pid & 65535) * 256 + 4 * lane, piece_u);
        {
            f32x16 a0, a1, b0, b1;
            { const float nm = -m; a0 = (f32x16){nm, nm, nm, nm, nm, nm, nm, nm, nm, nm, nm, nm, nm, nm, nm, nm}; a1 = a0; }
#pragma unroll
            for (int ds = 0; ds < 6; ++ds) {
                const bf16x8 k0 = *(const LAS bf16x8*)(buf + kfrag + ds * 32), k1 = *(const LAS bf16x8*)(buf + kfrag + 32 * KROW + ds * 32);
                a0 = __builtin_amdgcn_mfma_f32_32x32x16_bf16(k0, qf[ds], a0, 0, 0, 0);
                a1 = __builtin_amdgcn_mfma_f32_32x32x16_bf16(k1, qf[ds], a1, 0, 0, 0);
            }
            rescale64(rowmax64(a0, a1), a0, a1, m, l, o0, o1);
            { const float nm = -m; b0 = (f32x16){nm, nm, nm, nm, nm, nm, nm, nm, nm, nm, nm, nm, nm, nm, nm, nm}; b1 = b0; }
#pragma unroll
            for (int ds = 0; ds < 6; ++ds) {
                const bf16x8 k2 = *(const LAS bf16x8*)(buf + kfrag + 64 * KROW + ds * 32), k3 = *(const LAS bf16x8*)(buf + kfrag + 96 * KROW + ds * 32);
                b0 = __builtin_amdgcn_mfma_f32_32x32x16_bf16(k2, qf[ds], b0, 0, 0, 0);
                b1 = __builtin_amdgcn_mfma_f32_32x32x16_bf16(k3, qf[ds], b1, 0, 0, 0);
            }
            exp64(a0, a1, l);
            { const bf16x8 p00 = pack_p(a0, 0), p01 = pack_p(a0, 1), p10 = pack_p(a1, 0), p11 = pack_p(a1, 1);
              pv_block(o0, buf + vfrag, p00, p01); pv_block(o0, buf + vfrag + 2048, p10, p11);
              pv_block(o1, buf + vfrag + TK * 64, p00, p01); pv_block(o1, buf + vfrag + TK * 64 + 2048, p10, p11); }
            const float mxb = rowmax64(b0, b1);
            rescale64(mxb, b0, b1, m, l, o0, o1);
            exp64(b0, b1, l);
            { const bf16x8 p00 = pack_p(b0, 0), p01 = pack_p(b0, 1), p10 = pack_p(b1, 0), p11 = pack_p(b1, 1);
              pv_block(o0, buf + vfrag + 4096, p00, p01); pv_block(o0, buf + vfrag + 6144, p10, p11);
              pv_block(o1, buf + vfrag + TK * 64 + 4096, p00, p01); pv_block(o1, buf + vfrag + TK * 64 + 6144, p10, p11); }
        }
        if (kt + 1 < nt) MLA_STORE(lds + ((kt + 1) & 1) * BUFB);
        if (pid < 131072) {
            asm volatile("s_waitcnt vmcnt(0)" ::: "memory");
            const f32x4 xv = *(const LAS f32x4*)(piece + 16 * lane);
            const int idx = pid & 65535, col = (idx & 3) * 256 + 4 * lane;
            f32x4 sc = {SV, SV, SV, SV};
            if ((pid >> 16) == 0) { const f32x4 gv_ = *(const LAS f32x4*)(lds + MLA_G_OFF + 4 * col); sc = (f32x4){gv_.x * SU, gv_.y * SU, gv_.z * SU, gv_.w * SU}; }
            unsigned char* dst = ((pid >> 16) ? V8 : U8) + (size_t)(col >> 7) * ((size_t)16384 * 128) + (size_t)(idx >> 2) * 128 + (col & 127);
            *(unsigned*)dst = pk_fp8x4(xv.x * sc.x, xv.y * sc.y, xv.z * sc.z, xv.w * sc.w);
        }
        __syncthreads();
        }
    for (; kt < nt; ++kt) {
        const LAS unsigned char* buf = lds + (kt & 1) * BUFB;
        if (kt + 1 < nt) MLA_LOAD(kt + 1);
        const int pid = slot0 + 8 * kt + wid;
        if (pid < 131072) glds16(((pid >> 16) ? v_emb : u_emb) + (size_t)(pid & 65535) * 256 + 4 * lane, piece_u);
        if (TK * kt <= wqlast) {
            const bool needB = TK * kt + 64 <= wqlast;
            const float nm = -m; const f32x16 negm = {nm, nm, nm, nm, nm, nm, nm, nm, nm, nm, nm, nm, nm, nm, nm, nm};
            f32x16 a0 = negm, a1 = negm, b0 = negm, b1 = negm;
#pragma unroll
            for (int ds = 0; ds < 6; ++ds) {
                const bf16x8 k0 = *(const LAS bf16x8*)(buf + kfrag + ds * 32), k1 = *(const LAS bf16x8*)(buf + kfrag + 32 * KROW + ds * 32);
                a0 = __builtin_amdgcn_mfma_f32_32x32x16_bf16(k0, qf[ds], a0, 0, 0, 0);
                a1 = __builtin_amdgcn_mfma_f32_32x32x16_bf16(k1, qf[ds], a1, 0, 0, 0);
            }
            if (needB) {
#pragma unroll
                for (int ds = 0; ds < 6; ++ds) {
                    const bf16x8 k2 = *(const LAS bf16x8*)(buf + kfrag + 64 * KROW + ds * 32), k3 = *(const LAS bf16x8*)(buf + kfrag + 96 * KROW + ds * 32);
                    b0 = __builtin_amdgcn_mfma_f32_32x32x16_bf16(k2, qf[ds], b0, 0, 0, 0);
                    b1 = __builtin_amdgcn_mfma_f32_32x32x16_bf16(k3, qf[ds], b1, 0, 0, 0);
                }
            }
#pragma unroll
            for (int r = 0; r < 16; ++r) { const int kp = TK * kt + crow(r, hi); if (kp > qpos) a0[r] = NEGM; if (kp + 32 > qpos) a1[r] = NEGM; if (kp + 64 > qpos) b0[r] = NEGM; if (kp + 96 > qpos) b1[r] = NEGM; }
            sm64(a0, a1, m, l, o0, o1, b0, b1, needB);
            { const bf16x8 p00 = pack_p(a0, 0), p01 = pack_p(a0, 1), p10 = pack_p(a1, 0), p11 = pack_p(a1, 1);
              pv_block(o0, buf + vfrag, p00, p01); pv_block(o0, buf + vfrag + 2048, p10, p11);
              pv_block(o1, buf + vfrag + TK * 64, p00, p01); pv_block(o1, buf + vfrag + TK * 64 + 2048, p10, p11); }
            if (needB) {
                sm64(b0, b1, m, l, o0, o1, a0, a1, false);
                const bf16x8 p00 = pack_p(b0, 0), p01 = pack_p(b0, 1), p10 = pack_p(b1, 0), p11 = pack_p(b1, 1);
                pv_block(o0, buf + vfrag + 4096, p00, p01); pv_block(o0, buf + vfrag + 6144, p10, p11);
                pv_block(o1, buf + vfrag + TK * 64 + 4096, p00, p01); pv_block(o1, buf + vfrag + TK * 64 + 6144, p10, p11);
            }

        }
        if (kt + 1 < nt) MLA_STORE(lds + ((kt + 1) & 1) * BUFB);
        if (pid < 131072) {
            asm volatile("s_waitcnt vmcnt(0)" ::: "memory");
            const f32x4 xv = *(const LAS f32x4*)(piece + 16 * lane);
            const int idx = pid & 65535, col = (idx & 3) * 256 + 4 * lane;
            f32x4 sc = {SV, SV, SV, SV};
            if ((pid >> 16) == 0) { const f32x4 gv_ = *(const LAS f32x4*)(lds + MLA_G_OFF + 4 * col); sc = (f32x4){gv_.x * SU, gv_.y * SU, gv_.z * SU, gv_.w * SU}; }
            unsigned char* dst = ((pid >> 16) ? V8 : U8) + (size_t)(col >> 7) * ((size_t)16384 * 128) + (size_t)(idx >> 2) * 128 + (col & 127);
            *(unsigned*)dst = pk_fp8x4(xv.x * sc.x, xv.y * sc.y, xv.z * sc.z, xv.w * sc.w);
        }
        __syncthreads();
        }
#undef MLA_LOAD
#undef MLA_STORE
    __builtin_amdgcn_s_setprio(0);
    l = swapsum(l);
    store_o(Mixed + (tok0 + qpos) * DM + 512 + h * 64, o0, o1, 1.0f / l, hi);
}

constexpr int DIL_KR = 144, DIL_VR = 160, DIL_VOFF = 32 * DIL_KR, DIL_WLDS = 32 * DIL_KR + 32 * DIL_VR;
constexpr int DIL_SROW = 132, DIL_STATE_OFF = 8 * DIL_WLDS;
struct DilBlk { u32x4 k[4]; u32x4 v[4]; };
__device__ __forceinline__ void dil_load(DilBlk& B, const bf16_t* __restrict__ Ka, const bf16_t* __restrict__ Va, size_t hrow0  , int rd, int dl  , int imax, int idx0, int lane) {
#pragma unroll
    for (int i = 0; i < 4; ++i) {
        int ik = idx0 + 8 * i + (lane >> 3); ik = ik < 0 ? 0 : ik; ik = ik > imax ? imax : ik;
        const size_t off = (hrow0 + ((size_t)ik << dl) + rd) * 64 + 8 * (lane & 7);
        B.k[i] = *(const u32x4*)(Ka + off); B.v[i] = *(const u32x4*)(Va + off);
    }
}
__device__ __forceinline__ void pv_block_p(f32x16& o, const LAS unsigned char* vbase, const bf16x8& pb0, const bf16x8& pb1) {
    const s16x4 l0 = vtr(vbase), h0 = vtr(vbase + 8 * DIL_VR), l1 = vtr(vbase + 16 * DIL_VR), h1 = vtr(vbase + 24 * DIL_VR);
    const bf16x8 a0 = {l0[0], l0[1], l0[2], l0[3], h0[0], h0[1], h0[2], h0[3]}, a1 = {l1[0], l1[1], l1[2], l1[3], h1[0], h1[1], h1[2], h1[3]};
    o = __builtin_amdgcn_mfma_f32_32x32x16_bf16(a0, pb0, o, 0, 0, 0);
    o = __builtin_amdgcn_mfma_f32_32x32x16_bf16(a1, pb1, o, 0, 0, 0);
}
template <bool MASK>
__device__ __forceinline__ void dil_step(const DilBlk& B, LAS unsigned char* wl, const bf16x8 (&qf)[4], float& m, float& l, f32x16& o0, f32x16& o1, int A, int idx0, int lane) {
    const int r32 = lane & 31, hi = lane >> 5;
    {
        LAS unsigned char* kp = wl + (lane >> 3) * DIL_KR + (lane & 7) * 16;
        LAS unsigned char* vp = wl + DIL_VOFF + (lane >> 3) * DIL_VR + (lane & 7) * 16;
#pragma unroll
        for (int i = 0; i < 4; ++i) { *(LAS u32x4*)(kp + 8 * i * DIL_KR) = B.k[i]; *(LAS u32x4*)(vp + 8 * i * DIL_VR) = B.v[i]; }
    }
    const float nm = -m;
    f32x16 s = {nm, nm, nm, nm, nm, nm, nm, nm, nm, nm, nm, nm, nm, nm, nm, nm};
    { const LAS unsigned char* kfr = wl + r32 * DIL_KR + 16 * hi;
#pragma unroll
      for (int ds = 0; ds < 4; ++ds) s = __builtin_amdgcn_mfma_f32_32x32x16_bf16(*(const LAS bf16x8*)(kfr + 32 * ds), qf[ds], s, 0, 0, 0); }
    if (MASK) {
        const int qi = A + r32;
#pragma unroll
        for (int r = 0; r < 16; ++r) { const int ki = idx0 + crow(r, hi), dist = qi - ki; if (ki < 0 || dist < 0 || dist > 128) s[r] = NEGM; }
    }
    float mx = max3f(s[0], s[1], s[2]);
#pragma unroll
    for (int r = 3; r < 15; r += 2) mx = max3f(mx, s[r], s[r + 1]);
    mx = fmaxf(mx, s[15]);
    mx = swapmax(mx);
    if (__builtin_expect(__builtin_amdgcn_ballot_w64(mx > THR) != 0ull, 0)) {
        const float dl_ = fmaxf(mx, 0.f), alpha = __builtin_amdgcn_exp2f(-dl_);
        m += dl_; l *= alpha;
#pragma unroll
        for (int r = 0; r < 16; ++r) { s[r] -= dl_; o0[r] *= alpha; o1[r] *= alpha; }
    }
    float rs = 0.f;
#pragma unroll
    for (int r = 0; r < 16; ++r) { s[r] = __builtin_amdgcn_exp2f(s[r]); rs += s[r]; }
    l += rs;
    const bf16x8 p0 = pack_p(s, 0), p1 = pack_p(s, 1);
    const int i16 = lane & 15;
    const LAS unsigned char* vb = wl + DIL_VOFF + (4 * hi + (i16 >> 2)) * DIL_VR + (16 * ((lane >> 4) & 1) + 4 * (i16 & 3)) * 2;
    pv_block_p(o0, vb, p0, p1);
    pv_block_p(o1, vb + 64, p0, p1);
}
__device__ __forceinline__ void dil_unit(LAS unsigned char* wl, const bf16_t* __restrict__ Qa, const bf16_t* __restrict__ Ka, const bf16_t* __restrict__ Va, bf16_t* __restrict__ Mixed, LAS unsigned char* state,
                                         int b, int h, int p0, int dl, bool first, bool last, int lane, int pflags = 0) {
    const int r32 = lane & 31, hi = lane >> 5;
    const size_t tok0 = (size_t)b * SEQ, hrow0 = (size_t)(b * 8 + h) * SEQ;
    const int qpos = p0 + (r32 << dl);
    const int rd = p0 & ((1 << dl) - 1), A = p0 >> dl, imax = (SEQ - 1 - rd) >> dl;
    DilBlk b0, b1, b2;
#define DLOAD(B_, k_) dil_load(B_, Ka, Va, hrow0, rd, dl, imax, A - 128 + 32 * (k_), lane)
#define DSTEP(MK_, B_, k_) dil_step<MK_>(B_, wl, qf, m, l, o0, o1, A, A - 128 + 32 * (k_), lane)
    DLOAD(b0, 0); DLOAD(b1, 1);
    bf16x8 qf[4];
    { const bf16_t* qrow = Qa + (hrow0 + qpos) * 64 + 8 * hi;
#pragma unroll
      for (int ds = 0; ds < 4; ++ds) qf[ds] = *(const bf16x8*)(qrow + 16 * ds); }
    float m = 0.f, l = 0.f; f32x16 o0 = {}, o1 = {};
    LAS unsigned* st = (LAS unsigned*)(state + ((qpos & 511) * DIL_SROW));
    if (!first) {
        m = __builtin_bit_cast(float, st[32]); l = hi ? 0.f : 1.f;
#pragma unroll
        for (int g = 0; g < 4; ++g) {
            const unsigned a0 = st[4 * g + 2 * hi], a1 = st[4 * g + 2 * hi + 1], c0 = st[16 + 4 * g + 2 * hi], c1 = st[16 + 4 * g + 2 * hi + 1];
            o0[4 * g] = bf_lo(a0); o0[4 * g + 1] = bf_hi(a0); o0[4 * g + 2] = bf_lo(a1); o0[4 * g + 3] = bf_hi(a1);
            o1[4 * g] = bf_lo(c0); o1[4 * g + 1] = bf_hi(c0); o1[4 * g + 2] = bf_lo(c1); o1[4 * g + 3] = bf_hi(c1);
        }
    }
    const bool early = A - 96 < 0;
#ifdef PROBE_LO
    if (pflags & 32) { o0[0] += __builtin_bit_cast(float, b0.k[0].x ^ b1.k[0].x ^ b0.v[3].w ^ b1.v[3].w); l = 1.f; } else {
#endif
    DLOAD(b2, 2);
    DSTEP(true, b0, 0);
    DLOAD(b0, 3);
    if (early) DSTEP(true, b1, 1); else DSTEP(false, b1, 1);
    DLOAD(b1, 4);
    if (early) DSTEP(true, b2, 2); else DSTEP(false, b2, 2);
    if (early) DSTEP(true, b0, 3); else DSTEP(false, b0, 3);
    DSTEP(true, b1, 4);
#ifdef PROBE_LO
    }
#endif
#undef DLOAD
#undef DSTEP
    l = swapsum(l);
    const float inv = 1.0f / l;
    if (last) store_o(Mixed + (tok0 + qpos) * DM + h * 64, o0, o1, inv, hi);
    else {
#pragma unroll
        for (int g = 0; g < 4; ++g) {
            st[4 * g + 2 * hi] = pk_bf16(o0[4 * g] * inv, o0[4 * g + 1] * inv); st[4 * g + 2 * hi + 1] = pk_bf16(o0[4 * g + 2] * inv, o0[4 * g + 3] * inv);
            st[16 + 4 * g + 2 * hi] = pk_bf16(o1[4 * g] * inv, o1[4 * g + 1] * inv); st[16 + 4 * g + 2 * hi + 1] = pk_bf16(o1[4 * g + 2] * inv, o1[4 * g + 3] * inv);
        }
        if (hi == 0) st[32] = __builtin_bit_cast(unsigned, m + __builtin_amdgcn_logf(l));
    }
}
__device__ __forceinline__ void dil_segment(LAS unsigned char* lds, const bf16_t* __restrict__ Qa, const bf16_t* __restrict__ Ka, const bf16_t* __restrict__ Va, bf16_t* __restrict__ Mixed,
                                            int sg, int wave, int lane, int pflags = 0) {
    const int seg = sg & 15, h = (sg >> 4) & 7, b = sg >> 7, base = 512 * seg;
    LAS unsigned char* wl = lds + wave * DIL_WLDS;
#pragma unroll 1
    for (int pass = 0; pass < ((pflags & 64) ? 1 : 3); ++pass) {
        const int dl = 2 * pass;
#pragma unroll 1
        for (int j = wave; j < 16; j += 8) {
            const int rd = j & ((1 << dl) - 1), cj = j >> dl;
            dil_unit(wl, Qa, Ka, Va, Mixed, lds + DIL_STATE_OFF, b, h, base + rd + ((32 * cj) << dl), dl, pass == 0, pass == 2, lane, pflags);
        }
        if (pass < 2) __syncthreads();
    }
}
}

namespace peer {
__device__ __forceinline__ void ins16(unsigned (&L)[16], unsigned key) {
#pragma unroll
    for (int i = 0; i < 16; ++i) { const unsigned hi_ = L[i] > key ? L[i] : key; key = L[i] > key ? key : L[i]; L[i] = hi_; }
}
__device__ __forceinline__ void ce(unsigned& a, unsigned& b) { const unsigned hi_ = a > b ? a : b, lo_ = a > b ? b : a; a = hi_; b = lo_; }
__device__ __forceinline__ void sort8(unsigned (&v)[8]) {
    ce(v[0], v[1]); ce(v[2], v[3]); ce(v[4], v[5]); ce(v[6], v[7]); ce(v[0], v[2]); ce(v[1], v[3]); ce(v[4], v[6]); ce(v[5], v[7]); ce(v[1], v[2]); ce(v[5], v[6]);
    ce(v[0], v[4]); ce(v[3], v[7]); ce(v[1], v[5]); ce(v[2], v[6]); ce(v[1], v[4]); ce(v[3], v[6]); ce(v[2], v[4]); ce(v[3], v[5]); ce(v[3], v[4]);
}
__device__ __forceinline__ void bmerge16(unsigned (&v)[16]) {
#pragma unroll
    for (int k = 8; k >= 1; k >>= 1)
#pragma unroll
        for (int i = 0; i < 16; ++i) if ((i & k) == 0) ce(v[i], v[i + k]);
}
__device__ __forceinline__ float dec16(unsigned key) { const unsigned s = key >> 16; const unsigned b = (s & 0x8000u) ? (s & 0x7fffu) : (~s & 0xffffu); return (float)__builtin_bit_cast(_Float16, (unsigned short)b); }
__device__ __forceinline__ unsigned enc32(float f) { const unsigned u = __builtin_bit_cast(unsigned, f); return (u & 0x80000000u) ? ~u : (u | 0x80000000u); }
__device__ __forceinline__ float dec32(unsigned s) { const unsigned u = (s & 0x80000000u) ? (s & 0x7fffffffu) : ~s; return __builtin_bit_cast(float, u); }
__device__ __forceinline__ float gelu1(float v) {
    const float av = fabsf(v), t = __builtin_amdgcn_rcpf(av * 0.2316418882f + 1.0f);
    float q = t * 0.5307027145f + (-0.7265760135f); q = q * t + 0.7107068705f; q = q * t + (-0.142248368f); q = q * t + 0.127414796f; q = q * t;
    const float e = __builtin_amdgcn_exp2f((v * v) * (-0.72134752044f));
    const float mm = v * (q * e);
    return v < 0.f ? mm : v - mm;
}
struct CandTab { unsigned char i[52], j[52]; };
__host__ __device__ constexpr CandTab make_cands() {
    CandTab t{}; int n = 0;
    for (int i = 0; i < 16; ++i) for (int j = 0; j < 16; ++j) if ((i + 1) * (j + 1) <= 16) { t.i[n] = (unsigned char)i; t.j[n] = (unsigned char)j; ++n; }
    for (; n < 52; ++n) { t.i[n] = 15; t.j[n] = 15; }
    return t;
}

}

namespace peer2 {
__device__ __forceinline__ int ld_of(int j) { const int rho = 16 * ((j >> 2) & 3) + 4 * ((j >> 4) & 3) + (j & 3); return (j >> 6) * 64 + (rho & 7) * 8 + (rho >> 3); }

__device__ __forceinline__ void topk_phase(LAS unsigned char* lds, const bf16_t* __restrict__ Sc, const float* __restrict__ ssq_h, unsigned short* __restrict__ Pe_slot, unsigned short* __restrict__ Pe_ld,
                                           float* __restrict__ Pg, float* __restrict__ rstd_h, int gw, int ngw) {
    const int lane = threadIdx.x & 63, wid = __builtin_amdgcn_readfirstlane(threadIdx.x >> 6);
    LAS unsigned char* tile = lds + wid * 12288;
    LAS unsigned* lists = (LAS unsigned*)(tile + 8192);
    constexpr peer::CandTab CT = peer::make_cands();
    u32x4 nx[8];
#define TK_LOAD(g_, hh_) do { _Pragma("unroll") for (int i_ = 0; i_ < 8; ++i_) { const int s_ = 8 * i_ + (lane >> 3); \
        nx[i_] = *(const u32x4*)(Sc + (size_t)(4 * (g_) + (s_ >> 4)) * 2048 + (s_ & 15) * 128 + (hh_) * 64 + (lane & 7) * 8); } } while (0)
#define TK_WRITE() do { _Pragma("unroll") for (int i_ = 0; i_ < 8; ++i_) { const int s_ = 8 * i_ + (lane >> 3); *(LAS u32x4*)(tile + s_ * 128 + (((lane & 7) ^ (s_ & 7)) << 4)) = nx[i_]; } } while (0)
    if (gw < T / 4) TK_LOAD(gw, 0);
    for (int g = gw; g < T / 4; g += ngw) {
        const int t4 = lane >> 4, hp = lane & 15, tok = 4 * g + t4;
        unsigned L[16];
        {
            const LAS unsigned char* seg = tile + lane * 128;
#pragma unroll 1
            for (int gq = 0; gq < 8; ++gq) {
                if (gq == 0) { TK_WRITE(); TK_LOAD(g, 1); }
                if (gq == 4) { TK_WRITE(); if (g + ngw < T / 4) TK_LOAD(g + ngw, 0); }
                const int c0 = 2 * (gq & 3);
                const u32x4 w0 = *(const LAS u32x4*)(seg + ((c0 ^ (lane & 7)) << 4)), w1 = *(const LAS u32x4*)(seg + (((c0 + 1) ^ (lane & 7)) << 4));
                unsigned ka[8], kb[8];
#pragma unroll
                for (int e = 0; e < 8; ++e) {
                    const unsigned wa = (e >> 1) == 0 ? w0.x : ((e >> 1) == 1 ? w0.y : ((e >> 1) == 2 ? w0.z : w0.w)), wb = (e >> 1) == 0 ? w1.x : ((e >> 1) == 1 ? w1.y : ((e >> 1) == 2 ? w1.z : w1.w));
                    const unsigned ba = (e & 1) ? (wa >> 16) : (wa & 0xffffu), bb = (e & 1) ? (wb >> 16) : (wb & 0xffffu);
                    const unsigned sa = (ba & 0x8000u) ? (~ba & 0xffffu) : (ba | 0x8000u), sb = (bb & 0x8000u) ? (~bb & 0xffffu) : (bb | 0x8000u);
                    ka[e] = (sa << 16) | (unsigned)(127 - (16 * gq + e)); kb[e] = (sb << 16) | (unsigned)(127 - (16 * gq + 8 + e));
                }
                peer::sort8(ka); peer::sort8(kb);
                unsigned G[16];
#pragma unroll
                for (int i = 0; i < 8; ++i) { G[i] = ka[i]; G[8 + i] = kb[7 - i]; }
                peer::bmerge16(G);
                if (gq == 0) {
#pragma unroll
                    for (int i = 0; i < 16; ++i) L[i] = G[i];
                } else {
#pragma unroll
                    for (int i = 0; i < 16; ++i) L[i] = L[i] > G[15 - i] ? L[i] : G[15 - i];
                    peer::bmerge16(L);
                }
            }
        }
#pragma unroll
        for (int i = 0; i < 16; ++i) lists[lane * 16 + i] = L[i];
        const int p = hp & 1;
        float av[16], bv[16];
#pragma unroll
        for (int i = 0; i < 16; ++i) { const unsigned o = __shfl_xor(L[i], 1); av[i] = peer::dec16(p ? o : L[i]); bv[i] = peer::dec16(p ? L[i] : o); }
        unsigned M[16];
        {
            unsigned C[32];
#pragma unroll
            for (int k = 0; k < 25; ++k) {
                const int i0 = CT.i[2 * k], j0 = CT.j[2 * k], i1 = CT.i[2 * k + 1], j1 = CT.j[2 * k + 1];
                const float s0 = av[i0] + bv[j0], s1 = av[i1] + bv[j1];
                const float sm = p ? s1 : s0; const unsigned fl = p ? (unsigned)(i1 * 16 + j1) : (unsigned)(i0 * 16 + j0);
                C[k] = (peer::enc32(sm) & 0xffffff00u) | (255u - fl);
            }
#pragma unroll
            for (int k = 25; k < 32; ++k) C[k] = 0u;
            unsigned g0[8], g1[8], g2[8], g3[8];
#pragma unroll
            for (int i = 0; i < 8; ++i) { g0[i] = C[i]; g1[i] = C[8 + i]; g2[i] = C[16 + i]; g3[i] = C[24 + i]; }
            peer::sort8(g0); peer::sort8(g1); peer::sort8(g2); peer::sort8(g3);
            unsigned H[16];
#pragma unroll
            for (int i = 0; i < 8; ++i) { M[i] = g0[i]; M[8 + i] = g1[7 - i]; H[i] = g2[i]; H[8 + i] = g3[7 - i]; }
            peer::bmerge16(M); peer::bmerge16(H);
#pragma unroll
            for (int i = 0; i < 16; ++i) M[i] = M[i] > H[15 - i] ? M[i] : H[15 - i];
            peer::bmerge16(M);
        }
        unsigned R[16];
#pragma unroll
        for (int k = 0; k < 16; ++k) { const unsigned o = __shfl_xor(M[15 - k], 1); R[k] = M[k] > o ? M[k] : o; }
        float rv[16], mx = -INFINITY;
#pragma unroll
        for (int k = 0; k < 16; ++k) { rv[k] = peer::dec32(R[k] & 0xffffff00u); mx = fmaxf(mx, rv[k]); }
        float sum = 0.f;
#pragma unroll
        for (int k = 0; k < 16; ++k) { rv[k] = __builtin_amdgcn_exp2f((rv[k] - mx) * LOG2E); sum += rv[k]; }
        const float isum = 1.0f / sum;
        {
            const int h = hp >> 1;
            const LAS unsigned* la = lists + (lane & ~1) * 16; const LAS unsigned* lb = lists + (lane | 1) * 16;
#pragma unroll
            for (int k = 0; k < 8; ++k) {
                const unsigned fl = 255u - (R[k] & 0xffu);
                const unsigned i1 = 127u - (la[fl >> 4] & 0x7fu), i2 = 127u - (lb[fl & 15u] & 0x7fu);
                const int j = h * 16 + p * 8 + k, sl = j;
                const unsigned short e = (unsigned short)(i1 * 128u + i2);
                Pe_slot[(size_t)tok * 128 + sl] = e;
                Pe_ld[(size_t)tok * 128 + ld_of(j)] = e;
                Pg[(size_t)tok * 128 + sl] = rv[k] * isum;
            }
        }
        if (hp == 0) {
            float s = 0.f;
#pragma unroll
            for (int k = 0; k < 8; ++k) { const f32x4 q = *(const f32x4*)(ssq_h + (size_t)tok * 32 + 4 * k); s += (q.x + q.y) + (q.z + q.w); }
            rstd_h[tok] = 1.0f / sqrtf(s * (1.f / 1024.f) + EPS);
        }
    }
#undef TK_LOAD
#undef TK_WRITE
}

struct UG { u32x4 v[8]; };
struct UIDS { u32x4 e0, e1, b0, b1; };
__device__ __forceinline__ void u_ids(UIDS& I, const unsigned short* __restrict__ Pe_ld, const unsigned char* __restrict__ Hx, int tok, int lane) {
    const u32x4* ip = (const u32x4*)(Pe_ld + (size_t)tok * 128 + (lane >> 3) * 8);
    I.e0 = ip[0]; I.e1 = ip[8];
    const unsigned char* hrow = Hx + (size_t)tok * 128 + 32 * (lane >> 4);
    I.b0 = *(const u32x4*)hrow; I.b1 = *(const u32x4*)(hrow + 16);
}
__device__ __forceinline__ void u_gather(UG& F, const u32x4& w, const unsigned char* __restrict__ Ul  , unsigned emask, unsigned loff = 0u  ) {
#pragma unroll
    for (int i = 0; i < 8; ++i) {
        const unsigned word = (i >> 1) == 0 ? w.x : ((i >> 1) == 1 ? w.y : ((i >> 1) == 2 ? w.z : w.w));
        const unsigned e = ((i & 1) ? (word >> 16) : (word & 0xffffu)) & emask;
        F.v[i] = *(const u32x4*)(Ul + (e * 128u + loff));
    }
}
template <int PM = 0> __device__ __forceinline__ void u_compute(u32x4& z0, u32x4& z1, const UG& F, const u32x4& b0, const u32x4& b1, LAS unsigned char* hl  , int lane) {
    if (PM == 0) {
        LAS unsigned char* wp = hl + (lane >> 3) * 128 + (((lane & 7) ^ (lane >> 3)) << 4);
#pragma unroll
        for (int i = 0; i < 8; ++i) *(LAS u32x4*)(wp + i * 1024) = F.v[i];
    }
    const v8i bfr = {(int)b0.x, (int)b0.y, (int)b0.z, (int)b0.w, (int)b1.x, (int)b1.y, (int)b1.z, (int)b1.w};
    const int r16 = lane & 15, kb = lane >> 4;
    const LAS unsigned char* rp = hl + r16 * 128;
    const int p0 = ((2 * kb) ^ (r16 & 7)) << 4, p1 = ((2 * kb + 1) ^ (r16 & 7)) << 4;
    f32x4 acc[4];
#pragma unroll
    for (int g = 0; g < 4; ++g) {
        u32x4 a0, a1; if (PM == 0) { a0 = *(const LAS u32x4*)(rp + g * 2048 + p0); a1 = *(const LAS u32x4*)(rp + g * 2048 + p1); } else { a0 = F.v[2 * g]; a1 = F.v[2 * g + 1]; }
        const v8i afr = {(int)a0.x, (int)a0.y, (int)a0.z, (int)a0.w, (int)a1.x, (int)a1.y, (int)a1.z, (int)a1.w};
        acc[g] = __builtin_amdgcn_mfma_scale_f32_16x16x128_f8f6f4(afr, bfr, (f32x4){0.f, 0.f, 0.f, 0.f}, 0, 0, 0, 0, 0, 0);
    }
    z0.x = pk_bf16(acc[0][0], acc[0][1]); z0.y = pk_bf16(acc[0][2], acc[0][3]); z0.z = pk_bf16(acc[1][0], acc[1][1]); z0.w = pk_bf16(acc[1][2], acc[1][3]);
    z1.x = pk_bf16(acc[2][0], acc[2][1]); z1.y = pk_bf16(acc[2][2], acc[2][3]); z1.z = pk_bf16(acc[3][0], acc[3][1]); z1.w = pk_bf16(acc[3][2], acc[3][3]);
}
constexpr int U_REC = 512, U_CH = 16, U_STAGE = 8192, U_WLDS = U_STAGE + U_CH * U_REC;
template <int PM = 0> __device__ __forceinline__ void u_phase(LAS unsigned char* lds, const unsigned char* __restrict__ Hb8, const unsigned char* __restrict__ U8, const unsigned short* __restrict__ Pe_ld, bf16_t* __restrict__ Zp, int x, int wg, int nwg, unsigned emask = 0xffffu) {
    const int lane = threadIdx.x & 63, wid = __builtin_amdgcn_readfirstlane(threadIdx.x >> 6);
    LAS unsigned char* wl = lds + wid * U_WLDS;
    LAS unsigned char* rb = wl + U_STAGE;
    const unsigned rb_u = (unsigned)__builtin_amdgcn_readfirstlane((int)(unsigned)(uintptr_t)rb);
    const unsigned char* Hx = Hb8 + (size_t)x * ((size_t)T * 128);
    const unsigned char* Ul = U8 + (size_t)x * ((size_t)16384 * 128); const unsigned loff = 16u * (lane & 7);
    bf16_t* Zx = Zp + (size_t)x * T * 128;
    const int n = (T - wg + nwg - 1) / nwg;
    if (n <= 0) return;
    const int nch = (n + U_CH - 1) / U_CH;
#define UTOK(k) (wg + ((k) < n ? (k) : n - 1) * nwg)
#define USB() __builtin_amdgcn_sched_barrier(0)
    const int w32 = lane & 31, sub = lane >> 5;
    const unsigned char* rbase = w32 < 16 ? (const unsigned char*)Pe_ld + 16 * w32 : (w32 < 24 ? Hx + 16 * (w32 - 16) : (const unsigned char*)Pe_ld);
    const unsigned rstride = (w32 >= 16 && w32 < 24) ? 128u : 256u;
#pragma unroll 1
    for (int c = 0; c < nch; ++c) {
#pragma unroll
        for (int i = 0; i < U_CH / 2; ++i)
            glds16(rbase + (size_t)UTOK(c * U_CH + 2 * i + sub) * rstride, rb_u + i * 1024);
        asm volatile("s_waitcnt vmcnt(0)" ::: "memory");
        UG f0, f1;
        { const u32x4 e0 = *(const LAS u32x4*)(rb + (lane >> 3) * 16); u_gather(f0, e0, Ul, emask, loff); }
#pragma unroll 1
        for (int i = 0; i < U_CH; ++i) {
            const int k = c * U_CH + i;
            const LAS unsigned char* rec = rb + i * U_REC;
            const LAS unsigned char* nrec = (i + 1 < U_CH) ? rec + U_REC : rec;
            const u32x4 e1 = *(const LAS u32x4*)(rec + 128 + (lane >> 3) * 16), e0n = *(const LAS u32x4*)(nrec + (lane >> 3) * 16);
            const u32x4 bk0 = *(const LAS u32x4*)(rec + 256 + 32 * (lane >> 4)), bk1 = *(const LAS u32x4*)(rec + 256 + 32 * (lane >> 4) + 16);
            u32x4 za, zb, zc, zd;
            u_gather(f1, e1, Ul, emask, loff);
            USB(); u_compute<PM>(za, zb, f0, bk0, bk1, wl, lane); USB();
            u_gather(f0, e0n, Ul, emask, loff);
            USB(); u_compute<PM>(zc, zd, f1, bk0, bk1, wl, lane); USB();
            if ((lane & 15) == 0 && k < n) { bf16_t* zr_ = Zx + (size_t)UTOK(k) * 128 + 16 * (lane >> 4); *(u32x4*)zr_ = za; *(u32x4*)(zr_ + 8) = zb; *(u32x4*)(zr_ + 64) = zc; *(u32x4*)(zr_ + 72) = zd; }
        }
        asm volatile("s_waitcnt vmcnt(0) lgkmcnt(0)" ::: "memory");
    }
#undef UTOK
#undef USB
}

__device__ __forceinline__ float dppf(float v, int ctrl_sel) {
    const int s = __builtin_bit_cast(int, v);
    const int r = ctrl_sel == 0 ? __builtin_amdgcn_update_dpp(0, s, 0xB1, 0xF, 0xF, true) : ctrl_sel == 1 ? __builtin_amdgcn_update_dpp(0, s, 0x4E, 0xF, 0xF, true)
                : ctrl_sel == 2 ? __builtin_amdgcn_update_dpp(0, s, 0x141, 0xF, 0xF, true) : ctrl_sel == 3 ? __builtin_amdgcn_update_dpp(0, s, 0x140, 0xF, 0xF, true) : __builtin_amdgcn_update_dpp(0, s, 0x128, 0xF, 0xF, true);
    return __builtin_bit_cast(float, r);
}
constexpr float SA = 64.f;
__device__ __forceinline__ void act_phase(LAS unsigned char* lds, const bf16_t* __restrict__ Zp, const unsigned short* __restrict__ Pe_slot, const float* __restrict__ Pg, const float* __restrict__ ssq_h,
                                          unsigned short* __restrict__ PE2, unsigned char* __restrict__ PA2, int gw, int ngw) {
    const int lane = threadIdx.x & 63, wid = __builtin_amdgcn_readfirstlane(threadIdx.x >> 6);
    LAS unsigned short* lid = (LAS unsigned short*)(lds + wid * 512);
    LAS unsigned char* lw = lds + wid * 512 + 256;
    unsigned zw[8], ew; f32x2 gg; float sp;
#define ACT_LOAD(t_) do { const size_t o_ = (size_t)(t_) * 128 + 2 * lane; _Pragma("unroll") for (int xx = 0; xx < 8; ++xx) zw[xx] = *(const unsigned*)(Zp + (size_t)xx * T * 128 + o_); \
        ew = *(const unsigned*)(Pe_slot + o_); gg = *(const f32x2*)(Pg + o_); sp = ssq_h[(size_t)(t_) * 32 + (lane & 31)]; } while (0)
    if (gw < T) ACT_LOAD(gw);
    for (int tok = gw; tok < T; tok += ngw) {
        float z0 = 0.f, z1 = 0.f;
#pragma unroll
        for (int xx = 0; xx < 8; ++xx) { z0 += bf_lo(zw[xx]); z1 += bf_hi(zw[xx]); }
        const unsigned e2 = ew; const f32x2 g2 = gg;
        float s = sp;
        if (tok + ngw < T) ACT_LOAD(tok + ngw);
        s += dppf(s, 0); s += dppf(s, 1); s += dppf(s, 2); s += dppf(s, 3);
        const int si = __builtin_bit_cast(int, s);
        const float tot = __builtin_bit_cast(float, __builtin_amdgcn_readlane(si, 0)) + __builtin_bit_cast(float, __builtin_amdgcn_readlane(si, 16));
        const float zs = (1.0f / sqrtf(tot * (1.f / 1024.f) + EPS)) * (1.0f / (SU * SX));
        const float w0 = fminf(fmaxf(peer::gelu1(z0 * zs) * g2.x * SA, -440.f), 440.f), w1 = fminf(fmaxf(peer::gelu1(z1 * zs) * g2.y * SA, -440.f), 440.f);
        const unsigned w8 = (unsigned)__builtin_amdgcn_cvt_pk_fp8_f32(w0, w1, 0, false);
        const int sl0 = 2 * lane, d0 = (sl0 & 7) * 16 + (sl0 >> 3), d1 = ((sl0 + 1) & 7) * 16 + (sl0 >> 3);
        lid[d0] = (unsigned short)(e2 & 0xffffu); lid[d1] = (unsigned short)(e2 >> 16);
        lw[d0] = (unsigned char)(w8 & 0xffu); lw[d1] = (unsigned char)((w8 >> 8) & 0xffu);
        const u32x4 ov = *(const LAS u32x4*)(lds + wid * 512 + 16 * lane);
        if (lane < 16) *(u32x4*)(PE2 + (size_t)tok * 128 + 8 * lane) = ov;
        else if (lane < 24) *(u32x4*)(PA2 + (size_t)tok * 128 + 16 * (lane - 16)) = ov;
    }
#undef ACT_LOAD
}

struct VG { u32x4 v[8]; u32x2 w; };
template <int PM = 0> __device__ __forceinline__ void v_gather(VG& Gt, const u32x4& ew, const u32x2& ww, const unsigned char* __restrict__ vb  , unsigned loff  , unsigned emask) {
    Gt.w = ww;
#pragma unroll
    for (int i = 0; i < 8; ++i) {
        const unsigned word = (i >> 1) == 0 ? ew.x : ((i >> 1) == 1 ? ew.y : ((i >> 1) == 2 ? ew.z : ew.w));
        const unsigned e = ((i & 1) ? (word >> 16) : (word & 0xffffu)) & emask;
        if (PM == 1 && (i & 1)) Gt.v[i] = Gt.v[i - 1]; else
        Gt.v[i] = *(const u32x4*)(vb + (e * 128u + loff));
    }
}
struct VSel { unsigned lo[4], hi[4]; };
__device__ __forceinline__ void v_compute(f32x4& accL, f32x4& accH, const VG& Gt, const VSel& S) {
#pragma unroll
    for (int i = 0; i < 8; ++i) {
        const unsigned d = i < 4 ? Gt.w.x : Gt.w.y;
        const unsigned b0 = __builtin_amdgcn_perm(d, d, S.lo[i & 3]), b1 = __builtin_amdgcn_perm(d, d, S.hi[i & 3]);
        const long aL = (long)(((unsigned long long)Gt.v[i].y << 32) | Gt.v[i].x), aH = (long)(((unsigned long long)Gt.v[i].w << 32) | Gt.v[i].z);
        const long bb = (long)(((unsigned long long)b1 << 32) | b0);
        accL = __builtin_amdgcn_mfma_f32_16x16x32_fp8_fp8(aL, bb, accL, 0, 0, 0);
        accH = __builtin_amdgcn_mfma_f32_16x16x32_fp8_fp8(aH, bb, accH, 0, 0, 0);
    }
}
constexpr int V_REC = 512, V_CH = 16, V_WLDS = V_CH * V_REC + 1024;
template <int PM = 0> __device__ __forceinline__ void v_phase(LAS unsigned char* lds, const unsigned char* __restrict__ V8, const unsigned short* __restrict__ PE2, const unsigned char* __restrict__ PA2, bf16_t* __restrict__ Op, int x, int wg, int nwg, unsigned emask = 0xffffu) {
    const int lane = threadIdx.x & 63, wid = __builtin_amdgcn_readfirstlane(threadIdx.x >> 6), seg8 = lane >> 3, bp = lane & 7;
    LAS unsigned char* rb = lds + wid * V_WLDS;
    LAS float* tr = (LAS float*)(rb + V_CH * V_REC);
    const unsigned rb_u = (unsigned)__builtin_amdgcn_readfirstlane((int)(unsigned)(uintptr_t)rb);
    const unsigned char* vb = V8 + (size_t)x * ((size_t)16384 * 128); const unsigned loff = 16u * (lane & 7);
    bf16_t* Ox = Op + (size_t)x * T * 128;
    VSel S;
    { const unsigned none = 0x0c0c0c0cu, keep = none & ~(0xffu << (8 * (bp & 3)));
#pragma unroll
      for (int q = 0; q < 4; ++q) { const unsigned sq = keep | ((unsigned)q << (8 * (bp & 3))); S.lo[q] = bp < 4 ? sq : none; S.hi[q] = bp < 4 ? none : sq; } }
    const bool dvalid = ((lane >> 3) & 1) == (lane >> 5);
    LAS float* trw = tr + (lane >> 5) * 128 + 64 * ((lane >> 4) & 1) + bp;
    const int n = (T - wg + nwg - 1) / nwg;
    if (n <= 0) return;
    const int nch = (n + V_CH - 1) / V_CH;
#define VTOK(k) (wg + ((k) < n ? (k) : n - 1) * nwg)
    const int w32 = lane & 31, sub = lane >> 5;
    const unsigned char* rbase = w32 < 16 ? (const unsigned char*)PE2 + 16 * w32 : (w32 < 24 ? PA2 + 16 * (w32 - 16) : (const unsigned char*)PE2);
    const unsigned rstride = (w32 >= 16 && w32 < 24) ? 128u : 256u;
    const int roff = seg8 * 32, woff = 256 + seg8 * 16;
#pragma unroll 1
    for (int c = 0; c < nch; ++c) {
        if (PM != 2 || c == 0) {
#pragma unroll
        for (int i = 0; i < V_CH / 2; ++i)
            glds16(rbase + (size_t)VTOK(c * V_CH + 2 * i + sub) * rstride, rb_u + i * 1024);
        asm volatile("s_waitcnt vmcnt(0)" ::: "memory");
        }
        VG g0, g1;
        { const u32x4 ea = *(const LAS u32x4*)(rb + roff); const u32x2 wa = *(const LAS u32x2*)(rb + woff); v_gather<PM>(g0, ea, wa, vb, loff, emask); }
#pragma unroll 1
        for (int i = 0; i < V_CH; ++i) {
            const int k = c * V_CH + i, tok = VTOK(k);
            const LAS unsigned char* rec = rb + i * V_REC;
            const LAS unsigned char* nrec = (i + 1 < V_CH) ? rec + V_REC : rec;
            f32x4 accL = {0.f, 0.f, 0.f, 0.f}, accH = {0.f, 0.f, 0.f, 0.f};
            { const u32x4 ea = *(const LAS u32x4*)(rec + roff + 16); const u32x2 wa = *(const LAS u32x2*)(rec + woff + 8); v_gather<PM>(g1, ea, wa, vb, loff, emask); }
            __builtin_amdgcn_sched_barrier(0);
            v_compute(accL, accH, g0, S);
            { const u32x4 ea = *(const LAS u32x4*)(nrec + roff); const u32x2 wa = *(const LAS u32x2*)(nrec + woff); v_gather<PM>(g0, ea, wa, vb, loff, emask); }
            __builtin_amdgcn_sched_barrier(0);
            v_compute(accL, accH, g1, S);
            if (dvalid) {
#pragma unroll
                for (int r = 0; r < 4; ++r) { trw[16 * r] = accL[r]; trw[16 * r + 8] = accH[r]; }
            }
            const f32x4 oa = *(const LAS f32x4*)(tr + 4 * w32), ob = *(const LAS f32x4*)(tr + 128 + 4 * w32);
            if (lane < 32 && k < n) {
                constexpr float sc = 1.0f / (SA * SV);
                u32x2 w; w.x = pk_bf16((oa.x + ob.x) * sc, (oa.y + ob.y) * sc); w.y = pk_bf16((oa.z + ob.z) * sc, (oa.w + ob.w) * sc); *(u32x2*)(Ox + (size_t)tok * 128 + 4 * lane) = w;
            }
        }
        if (PM != 2) asm volatile("s_waitcnt vmcnt(0) lgkmcnt(0)" ::: "memory");
    }
#undef VTOK
}

__device__ __forceinline__ void final_phase(float* __restrict__ Out, const bf16_t* __restrict__ Hb, const bf16_t* __restrict__ Op, const float* __restrict__ g_final, int gw, int ngw) {
    const int lane = threadIdx.x & 63;
    const f32x4* gr = (const f32x4*)g_final + lane;
    const f32x4 g0 = gr[0], g1 = gr[64], g2 = gr[128], g3 = gr[192];
    const bf16_t* ob = Op + (size_t)(lane >> 5) * T * 128 + 4 * (lane & 31);
    for (int t0 = 4 * gw; t0 < T; t0 += 4 * ngw) {
        u32x2 hh[4][4], o[4][4];
#pragma unroll
        for (int r = 0; r < 4; ++r) {
            const int tok = t0 + r < T ? t0 + r : T - 1;
            const bf16_t* hr = Hb + (size_t)tok * DM + 4 * lane;
#pragma unroll
            for (int j = 0; j < 4; ++j) { hh[r][j] = *(const u32x2*)(hr + 256 * j); o[r][j] = *(const u32x2*)(ob + ((size_t)(2 * j) * T + tok) * 128); }
        }
#pragma unroll
        for (int r = 0; r < 4; ++r) {
            if (t0 + r >= T) break;
            f32x4 y[4];
            float s = 0.f;
#pragma unroll
            for (int j = 0; j < 4; ++j) {
                y[j].x = bf_lo(hh[r][j].x) + bf_lo(o[r][j].x); y[j].y = bf_hi(hh[r][j].x) + bf_hi(o[r][j].x); y[j].z = bf_lo(hh[r][j].y) + bf_lo(o[r][j].y); y[j].w = bf_hi(hh[r][j].y) + bf_hi(o[r][j].y);
                s += (y[j].x * y[j].x + y[j].y * y[j].y) + (y[j].z * y[j].z + y[j].w * y[j].w);
            }
            s += dppf(s, 0); s += dppf(s, 1); s += dppf(s, 2); s += dppf(s, 3);
            const int si = __builtin_bit_cast(int, s);
            const float tot = (__builtin_bit_cast(float, __builtin_amdgcn_readlane(si, 0)) + __builtin_bit_cast(float, __builtin_amdgcn_readlane(si, 16)))
                            + (__builtin_bit_cast(float, __builtin_amdgcn_readlane(si, 32)) + __builtin_bit_cast(float, __builtin_amdgcn_readlane(si, 48)));
            const float r2 = 1.0f / sqrtf(tot * (1.f / 1024.f) + EPS);
            f32x4* yr = (f32x4*)(Out + (size_t)(t0 + r) * DM) + lane;
            yr[0] = (f32x4){y[0].x * r2 * g0.x, y[0].y * r2 * g0.y, y[0].z * r2 * g0.z, y[0].w * r2 * g0.w};
            yr[64] = (f32x4){y[1].x * r2 * g1.x, y[1].y * r2 * g1.y, y[1].z * r2 * g1.z, y[1].w * r2 * g1.w};
            yr[128] = (f32x4){y[2].x * r2 * g2.x, y[2].y * r2 * g2.y, y[2].z * r2 * g2.z, y[2].w * r2 * g2.w};
            yr[192] = (f32x4){y[3].x * r2 * g3.x, y[3].y * r2 * g3.y, y[3].z * r2 * g3.z, y[3].w * r2 * g3.w};
        }
    }
}
}


#define XB_TMO      128
#define XB_XCNT(j)  (256  + 64 * (j))
#define XB_XSUB(j)  (1280 + 64 * (j))
#define XB_XGEN(j)  (2304 + 64 * (j))
#define XB_TOP      3328
#define XB_TOPGEN   3392
#define XCD_BAR_WORDS 3456
#define XB_SPIN_CAP (1u << 18)

__device__ __forceinline__ unsigned xb_ld(unsigned* p)              { return __hip_atomic_load(p, __ATOMIC_RELAXED, __HIP_MEMORY_SCOPE_AGENT); }
__device__ __forceinline__ unsigned xb_add(unsigned* p, unsigned v) { return __hip_atomic_fetch_add(p, v, __ATOMIC_RELAXED, __HIP_MEMORY_SCOPE_AGENT); }
__device__ __forceinline__ unsigned xb_xcc_id() { return (unsigned)__builtin_amdgcn_s_getreg((3 << 11) | 20) & 0xFu; }
#define XB_SPIN(cond, bar) do { unsigned _sp = 0; while (cond) { __builtin_amdgcn_s_sleep(1); \
    if ((++_sp & 255u) == 0u) { if (xb_ld(&(bar)[XB_TMO])) break; if (_sp > XB_SPIN_CAP) { atomicAdd(&(bar)[XB_TMO], 1u); break; } } } } while (0)

struct XcdBarrier {
    unsigned* bar; unsigned x;
    volatile LAS unsigned* st;
};

__device__ __forceinline__ XcdBarrier xcd_barrier_post(unsigned* bar, volatile LAS unsigned* st) {
    XcdBarrier b; b.bar = bar; b.x = xb_xcc_id(); b.st = st;
    if (threadIdx.x == 0) (void)xb_add(&bar[XB_XCNT(b.x)], 1u);
    return b;
}
__device__ __forceinline__ void xcd_barrier_complete(unsigned* bar, unsigned x, unsigned& nloc, unsigned& nx) {
    const unsigned G = gridDim.x * gridDim.y * gridDim.z;
    unsigned sum, cnt, mine, sp = 0u;
    for (;;) {
        sum = 0u; cnt = 0u; mine = 0u;
#pragma unroll
        for (unsigned j = 0; j < 16; ++j) { const unsigned c = xb_ld(&bar[XB_XCNT(j)]); sum += c; cnt += (c > 0u) ? 1u : 0u; mine = (j == x) ? c : mine; }
        if (sum == G) break;
        __builtin_amdgcn_s_sleep(1);
        if ((++sp & 255u) == 0u) { if (xb_ld(&bar[XB_TMO])) break; if (sp > XB_SPIN_CAP) { atomicAdd(&bar[XB_TMO], 1u); break; } }
    }
    nloc = mine > 0u ? mine : 1u; nx = cnt > 0u ? cnt : 1u;
}

__device__ __forceinline__ void xcd_barrier(const XcdBarrier& b) {
    asm volatile("s_waitcnt vmcnt(0)" ::: "memory");
    __syncthreads();
    if (threadIdx.x == 0) {
        unsigned* bar = b.bar;
        __builtin_amdgcn_s_waitcnt(0);
        unsigned nloc = b.st[0], nx = b.st[1];
        if (nloc == 0u) { xcd_barrier_complete(bar, b.x, nloc, nx); b.st[0] = nloc; b.st[1] = nx; }
        const unsigned old = xb_add(&bar[XB_XSUB(b.x)], 1u);
        const unsigned gen = old / nloc;
        if (old + 1u == (gen + 1u) * nloc) {
            __builtin_amdgcn_fence(__ATOMIC_RELEASE, "agent");
            asm volatile("s_waitcnt vmcnt(0)" ::: "memory");
            const unsigned og = xb_add(&bar[XB_TOP], 1u);
            const unsigned tg = og / nx;
            if (og + 1u == (tg + 1u) * nx) xb_add(&bar[XB_TOPGEN], 1u);
            else XB_SPIN(xb_ld(&bar[XB_TOPGEN]) == tg, bar);
            __builtin_amdgcn_fence(__ATOMIC_ACQUIRE, "agent");
            xb_add(&bar[XB_XGEN(b.x)], 1u);
            asm volatile("s_waitcnt vmcnt(0)" ::: "memory");
        } else {
            XB_SPIN(xb_ld(&bar[XB_XGEN(b.x)]) == gen, bar);
            __builtin_amdgcn_fence(__ATOMIC_ACQUIRE, "agent");
            asm volatile("s_waitcnt vmcnt(0)" ::: "memory");
        }
    }
    __syncthreads();
}

constexpr int NWAVES = 8;
constexpr int LDS_BYTES = 147456;
constexpr int MISC_OFF = 146432;

struct Args {
    const float *x, *g_mix, *w_in, *g_cq, *w_uq, *g_ckv, *w_ukv, *w_out, *g_ffn, *w_pq, *sub_keys, *u_emb, *v_emb, *g_final;
    const int* pos; float* out; unsigned char* ws; int ph_lo, ph_hi; unsigned probe_mask; int probe_shift;
};

__device__ __forceinline__ void p0_transpose_item(const float* __restrict__ W, int K, int N, const float* __restrict__ gk, bf16_t* __restrict__ WT, LAS float* scr, int item, int lane) {
    const int nblk = N / 32, kb = item / nblk, nb = item % nblk, k0 = 64 * kb, n0 = 32 * nb;
    float wv[32];
#pragma unroll
    for (int i = 0; i < 32; ++i) { const int kk = 2 * i + (lane >> 5); wv[i] = W[(size_t)(k0 + kk) * N + n0 + (lane & 31)]; if (gk) wv[i] *= gk[k0 + kk]; }
#pragma unroll
    for (int i = 0; i < 32; ++i) { const int kk = 2 * i + (lane >> 5); scr[kk * 33 + (lane & 31)] = wv[i]; }
    asm volatile("s_waitcnt lgkmcnt(0)" ::: "memory");
    const int c = lane & 7;
#pragma unroll
    for (int j = 0; j < 4; ++j) { const int n = (lane >> 3) + 8 * j; const LAS float* s = scr + (8 * c) * 33 + n;
        u32x4 o; o.x = pk_bf16(s[0 * 33], s[1 * 33]); o.y = pk_bf16(s[2 * 33], s[3 * 33]); o.z = pk_bf16(s[4 * 33], s[5 * 33]); o.w = pk_bf16(s[6 * 33], s[7 * 33]);
        *(u32x4*)(WT + (size_t)(n0 + n) * K + k0 + 8 * c) = o; }
    asm volatile("s_waitcnt lgkmcnt(0)" ::: "memory");
}
__device__ __forceinline__ bf16x8 cvt8(const float* p, float s) { const f32x4 a = *(const f32x4*)p, b = *(const f32x4*)(p + 4); u32x4 w; w.x = pk_bf16(a.x * s, a.y * s); w.y = pk_bf16(a.z * s, a.w * s); w.z = pk_bf16(b.x * s, b.y * s); w.w = pk_bf16(b.z * s, b.w * s); return __builtin_bit_cast(bf16x8, w); }
__device__ __forceinline__ void p0_wcomb_item(const float* __restrict__ keys, const float* __restrict__ w_pq, const float* __restrict__ g_ffn, bf16_t* __restrict__ Wc, int item, int lane) {
    const int hp = item >> 7, nblk = (item >> 5) & 3, kblk = item & 31, n0 = 32 * nblk, k0 = 32 * kblk, r32 = lane & 31, hi = lane >> 5;
    const float* ar = keys + ((size_t)hp * 128 + n0 + r32) * 128 + 8 * hi;
    const float* br = w_pq + (size_t)(k0 + r32) * 2048 + hp * 128 + 8 * hi;
    const float gk = g_ffn[k0 + r32];
    f32x16 d = {};
#pragma unroll
    for (int cs = 0; cs < 8; ++cs) d = __builtin_amdgcn_mfma_f32_32x32x16_bf16(cvt8(ar + 16 * cs, 1.f), cvt8(br + 16 * cs, 1.f), d, 0, 0, 0);
#pragma unroll
    for (int r = 0; r < 16; ++r) Wc[((size_t)hp * 128 + n0 + crow(r, hi)) * DM + k0 + r32] = (bf16_t)(pk_bf16(d[r] * gk, 0.f) & 0xffffu);
}
__device__ __forceinline__ void p0_prologue(const Args& a, LAS unsigned char* lds, int gw, int ngw, int lane, int wave) {
    unsigned char* ws = a.ws;
    LAS float* scr = (LAS float*)(lds + wave * 16384);
    bf16_t* Wt_in = (bf16_t*)(ws + WS_WIN); bf16_t* Wt_comb = (bf16_t*)(ws + WS_WCOMB); bf16_t* Wt_out = (bf16_t*)(ws + WS_WOUT); bf16_t* Wt_uq = (bf16_t*)(ws + WS_WUQ); bf16_t* Wt_ukv = (bf16_t*)(ws + WS_WUKV);
    constexpr int I_IN = (DM / 64) * (INW / 32), I_UQ = (256 / 64) * (768 / 32), I_UKV = (128 / 64) * (1024 / 32), I_OUT = (DM / 64) * (DM / 32), I_WC = 2048;
    constexpr int NITEMS = I_IN + I_UQ + I_UKV + I_OUT + I_WC;
    for (int it = gw; it < NITEMS; it += ngw) {
        int r = it;
        if (r < I_IN) { p0_transpose_item(a.w_in, DM, INW, nullptr, Wt_in, scr, r, lane); continue; } r -= I_IN;
        if (r < I_UQ) { p0_transpose_item(a.w_uq, 256, 768, a.g_cq, Wt_uq, scr, r, lane); continue; } r -= I_UQ;
        if (r < I_UKV) { p0_transpose_item(a.w_ukv, 128, 1024, a.g_ckv, Wt_ukv, scr, r, lane); continue; } r -= I_UKV;
        if (r < I_OUT) { p0_transpose_item(a.w_out, DM, DM, nullptr, Wt_out, scr, r, lane); continue; } r -= I_OUT;
        p0_wcomb_item(a.sub_keys, a.w_pq, a.g_ffn, Wt_comb, r, lane);
    }
    const int gt = gw * 64 + lane, ngt = ngw * 64;
    for (int i = gt; i < (2048 - INW) * DM / 8; i += ngt) *(u32x4*)(Wt_in + (size_t)INW * DM + (size_t)i * 8) = (u32x4){0u, 0u, 0u, 0u};
    { bf16_t* HN = (bf16_t*)(ws + WS_HN);
      const f32x4* gr = (const f32x4*)a.g_mix + lane;
      const f32x4 g0 = gr[0], g1 = gr[64], g2 = gr[128], g3 = gr[192];
      for (int m0 = 4 * gw; m0 < T; m0 += 4 * ngw) {
          f32x4 v[4][4];
#pragma unroll
          for (int r = 0; r < 4; ++r) { const f32x4* xr = (const f32x4*)(a.x + (size_t)(m0 + r) * DM) + lane; v[r][0] = xr[0]; v[r][1] = xr[64]; v[r][2] = xr[128]; v[r][3] = xr[192]; }
#pragma unroll
          for (int r = 0; r < 4; ++r) {
              float s = 0.f;
#pragma unroll
              for (int j = 0; j < 4; ++j) s += (v[r][j].x * v[r][j].x + v[r][j].y * v[r][j].y) + (v[r][j].z * v[r][j].z + v[r][j].w * v[r][j].w);
              const float rstd = 1.0f / sqrtf(wave_sum(s) * (1.f / DM) + EPS);
              u32x2* o8 = (u32x2*)(HN + (size_t)(m0 + r) * DM) + lane;
              u32x2 w;
              w.x = pk_bf16(v[r][0].x * rstd * g0.x, v[r][0].y * rstd * g0.y); w.y = pk_bf16(v[r][0].z * rstd * g0.z, v[r][0].w * rstd * g0.w); o8[0] = w;
              w.x = pk_bf16(v[r][1].x * rstd * g1.x, v[r][1].y * rstd * g1.y); w.y = pk_bf16(v[r][1].z * rstd * g1.z, v[r][1].w * rstd * g1.w); o8[64] = w;
              w.x = pk_bf16(v[r][2].x * rstd * g2.x, v[r][2].y * rstd * g2.y); w.y = pk_bf16(v[r][2].z * rstd * g2.z, v[r][2].w * rstd * g2.w); o8[128] = w;
              w.x = pk_bf16(v[r][3].x * rstd * g3.x, v[r][3].y * rstd * g3.y); w.y = pk_bf16(v[r][3].z * rstd * g3.z, v[r][3].w * rstd * g3.w); o8[192] = w;
          } } }
    { float* cosA = (float*)(ws + WS_COSA); float* sinA = (float*)(ws + WS_SINA); float* cosM = (float*)(ws + WS_COSM); float* sinM = (float*)(ws + WS_SINM);
      constexpr float INV16[16] = {1.0f, 0.44036659598350525f, 0.1939227432012558f, 0.08539710193872452f, 0.03760603070259094f, 0.016560440883040428f, 0.007292664609849453f, 0.0032114461064338684f,
                                   0.0014142135623842478f, 0.0006227724370546639f, 0.00027424818836152554f, 0.00012076973507646471f, 5.3182957344688475e-05f, 2.34199997066753e-05f, 1.0313385246263351e-05f, 4.541670477919979e-06f};
      for (int i = gt; i < T * 16; i += ngt) {
          const int tok = i >> 4, j = i & 15;
          const float ang = (float)a.pos[tok] * INV16[j];
          float sn, cs; sincosf(ang, &sn, &cs);
          cosM[tok * 16 + j] = cs; sinM[tok * 16 + j] = sn;
          if ((j & 1) == 0) { cosA[tok * 8 + (j >> 1)] = cs; sinA[tok * 8 + (j >> 1)] = sn; } } }
}

__global__ void __launch_bounds__(NWAVES * 64, 2) mk_fwd(Args a) {
    extern __shared__ __attribute__((aligned(16))) unsigned char lds_raw[];
    LAS unsigned char* lds = (LAS unsigned char*)lds_raw;
    volatile LAS unsigned* MISC = (volatile LAS unsigned*)(lds + MISC_OFF);
    const int tid = threadIdx.x, lane = tid & 63, wave = __builtin_amdgcn_readfirstlane(tid >> 6);
    const int G = gridDim.x, bx = blockIdx.x, vcu = (G % 8 == 0) ? (bx % 8) * (G / 8) + bx / 8 : bx;
    unsigned char* ws = a.ws;
    for (int u = tid; u < 64; u += NWAVES * 64) MISC[u] = 0u;
    __syncthreads();
    XcdBarrier bar = xcd_barrier_post((unsigned*)(ws + WS_CTL), MISC + 8);
    const int lo = a.ph_lo, hi = a.ph_hi;
#ifdef PROBE_LO
#define PMASK a.probe_mask
#else
#define PMASK 0xffffu
#endif
#define IN(k) (lo <= (k) && (k) < hi)
#ifdef PROBE_LO
#define RUN(k) (IN(k) && !(a.probe_shift & 16))
#else
#define RUN(k) IN(k)
#endif
#define SEAM(k) do { if (IN(k) && IN((k) + 1)) xcd_barrier(bar); } while (0)
    const int gw = vcu * NWAVES + wave, ngw = G * NWAVES;

    if (RUN(0)) { p0_prologue(a, lds, gw, ngw, lane, wave); }
    SEAM(0);
    if (RUN(1)) {
        pg8::Gemm g{(const bf16_t*)(ws + WS_HN), (const bf16_t*)(ws + WS_WIN), T, 2048, DM}; pg8::StaticOrder S; S.init(T, 2048, G, bx);
        pg8::EpiProj E{(bf16_t*)(ws + WS_QA), (bf16_t*)(ws + WS_KA), (bf16_t*)(ws + WS_VA), (bf16_t*)(ws + WS_CQ), (bf16_t*)(ws + WS_CKV), (bf16_t*)(ws + WS_KR),
                       (float*)(ws + WS_SSQQ), (float*)(ws + WS_SSQKV), (const float*)(ws + WS_COSA), (const float*)(ws + WS_SINA), (const float*)(ws + WS_COSM), (const float*)(ws + WS_SINM)};
        pg8::gemm_phase<pg8::EpiProj, pg8::StaticOrder, true, true>(lds, g, S, E);
    }
    SEAM(1);
    if (RUN(2)) {
        { int kk = 128; asm volatile("" : "+s"(kk));
          pg8::Gemm g{(const bf16_t*)(ws + WS_CKV), (const bf16_t*)(ws + WS_WUKV), T, 1024, kk}; pg8::StaticOrder S; S.init(T, 1024, G, bx);
          pg8::EpiKv E{(bf16_t*)(ws + WS_KN), (bf16_t*)(ws + WS_VM), (const float*)(ws + WS_SSQKV)};
          pg8::gemm_phase<pg8::EpiKv, pg8::StaticOrder, true, true>(lds, g, S, E); }
        __syncthreads();
        { int kk = 256; asm volatile("" : "+s"(kk));
          pg8::Gemm g{(const bf16_t*)(ws + WS_CQ), (const bf16_t*)(ws + WS_WUQ), T, 768, kk}; pg8::StaticOrder S; S.init(T, 768, G, bx);
          pg8::EpiQm E{(bf16_t*)(ws + WS_QM), (const float*)(ws + WS_SSQQ), (const float*)(ws + WS_COSM), (const float*)(ws + WS_SINM)};
          pg8::gemm_phase<pg8::EpiQm, pg8::StaticOrder, true, true>(lds, g, S, E); }
    }
    SEAM(2);
    if (RUN(3)) {
        if (!(a.probe_shift & 1)) for (int pr = vcu; pr < 256; pr += G) {
            const int bh = pr >> 4, s = pr & 15;
            att::mla_unit(lds, (const bf16_t*)(ws + WS_QM), (const bf16_t*)(ws + WS_KN), (const bf16_t*)(ws + WS_KR), (const bf16_t*)(ws + WS_VM), (bf16_t*)(ws + WS_MIXED), bh >> 3, bh & 7, 31 - s,
                          a.u_emb, a.v_emb, a.g_ffn, ws + WS_U8, ws + WS_V8, pr * 528);
            att::mla_unit(lds, (const bf16_t*)(ws + WS_QM), (const bf16_t*)(ws + WS_KN), (const bf16_t*)(ws + WS_KR), (const bf16_t*)(ws + WS_VM), (bf16_t*)(ws + WS_MIXED), bh >> 3, bh & 7, s,
                          a.u_emb, a.v_emb, a.g_ffn, ws + WS_U8, ws + WS_V8, pr * 528 + 16 * (32 - s));
        }
        if (!(a.probe_shift & 2)) for (int sg = vcu; sg < 256; sg += G)
            att::dil_segment(lds, (const bf16_t*)(ws + WS_QA), (const bf16_t*)(ws + WS_KA), (const bf16_t*)(ws + WS_VA), (bf16_t*)(ws + WS_MIXED), sg, wave, lane, a.probe_shift);
    }
    SEAM(3);
    if (RUN(4)) {
        pg8::Gemm g{(const bf16_t*)(ws + WS_MIXED), (const bf16_t*)(ws + WS_WOUT), T, DM, DM}; pg8::StaticOrder S; S.init(T, DM, G, bx);
        pg8::EpiOut E{a.x, (bf16_t*)(ws + WS_HB), ws + WS_HB8, (float*)(ws + WS_SSQH)};
        pg8::gemm_phase<pg8::EpiOut, pg8::StaticOrder, true, true>(lds, g, S, E);
    }
    SEAM(4);
    if (RUN(5)) {
        pg8::Gemm g{(const bf16_t*)(ws + WS_HB), (const bf16_t*)(ws + WS_WCOMB), T, 2048, DM}; pg8::StaticOrder S; S.init(T, 2048, G, bx);
        pg8::EpiSc E{(bf16_t*)(ws + WS_SC), (const float*)(ws + WS_SSQH)};
        pg8::gemm_phase<pg8::EpiSc, pg8::StaticOrder, true, true>(lds, g, S, E);
    }
    SEAM(5);
    if (RUN(6)) {
        peer2::topk_phase(lds, (const bf16_t*)(ws + WS_SC), (const float*)(ws + WS_SSQH), (unsigned short*)(ws + WS_PESLOT), (unsigned short*)(ws + WS_PEROW), (float*)(ws + WS_PG), (float*)(ws + WS_RSTDH), gw, ngw);
    }
    SEAM(6);
    const int sx = bx % 8, smem = (bx / 8) * NWAVES + wave, scnt = ((G - sx + 7) / 8) * NWAVES;
#ifdef PROBE_LO
    if (RUN(7) && (a.probe_shift & 8)) { peer2::u_phase<1>(lds, ws + WS_HB8, ws + WS_U8, (const unsigned short*)(ws + WS_PEROW), (bf16_t*)(ws + 160 * MiB), sx, smem, scnt, PMASK); } else
#endif
    if (RUN(7)) { peer2::u_phase(lds, ws + WS_HB8, ws + WS_U8, (const unsigned short*)(ws + WS_PEROW), (bf16_t*)(ws + WS_ZP), sx, smem, scnt, PMASK); }
    SEAM(7);
    if (RUN(8)) { peer2::act_phase(lds, (const bf16_t*)(ws + WS_ZP), (const unsigned short*)(ws + WS_PESLOT), (const float*)(ws + WS_PG), (const float*)(ws + WS_SSQH), (unsigned short*)(ws + WS_PE2), ws + WS_PA2, gw, ngw); }
    SEAM(8);
#ifdef PROBE_LO
    if (RUN(9) && (a.probe_shift & 128)) { peer2::v_phase<2>(lds, ws + WS_V8, (const unsigned short*)(ws + WS_PE2), ws + WS_PA2, (bf16_t*)(ws + 160 * MiB), sx, smem, scnt, PMASK); } else
    if (RUN(9) && (a.probe_shift & 4)) { peer2::v_phase<1>(lds, ws + WS_V8, (const unsigned short*)(ws + WS_PE2), ws + WS_PA2, (bf16_t*)(ws + WS_OP), sx, smem, scnt, PMASK); } else
#endif
    if (RUN(9)) { peer2::v_phase(lds, ws + WS_V8, (const unsigned short*)(ws + WS_PE2), ws + WS_PA2, (bf16_t*)(ws + WS_OP), sx, smem, scnt, PMASK); }
    SEAM(9);
    if (RUN(10)) { peer2::final_phase(a.out, (const bf16_t*)(ws + WS_HB), (const bf16_t*)(ws + WS_OP), a.g_final, gw, ngw); }
#undef IN
#undef RUN
#undef SEAM
}


#ifndef STAGE
#define STAGE 6
#endif
extern "C" void kernel_launch(void* const* d_in, const int* in_sizes, int n_in, void* d_out, int out_size, void* d_ws, size_t ws_size, hipStream_t stream) {
    static int grid = 0;
    if (grid == 0) {
        if (n_in != 15 || out_size != T * DM || ws_size < 256 * MiB) { fprintf(stderr, "kernel_launch: unexpected problem shape (n_in %d, out %d, ws %zu); nothing launched\n", n_in, out_size, ws_size); grid = -1; return; }
        int dev = 0, cus = 0, per_cu = 0;
        if (hipGetDevice(&dev) != hipSuccess || hipDeviceGetAttribute(&cus, hipDeviceAttributeMultiprocessorCount, dev) != hipSuccess) { grid = -1; return; }
        if (hipFuncSetAttribute((const void*)mk_fwd, hipFuncAttributeMaxDynamicSharedMemorySize, LDS_BYTES) != hipSuccess) { fprintf(stderr, "kernel_launch: hipFuncSetAttribute failed\n"); grid = -1; return; }
        if (hipOccupancyMaxActiveBlocksPerMultiprocessor(&per_cu, (const void*)mk_fwd, NWAVES * 64, LDS_BYTES) != hipSuccess || per_cu < 1) fprintf(stderr, "kernel_launch: note: occupancy query says %d workgroups per CU\n", per_cu);
        (void)hipGetLastError();
        grid = cus;
        if (grid < 8) { fprintf(stderr, "kernel_launch: %d CUs: the PEER slice phases need a grid of at least 8 workgroups; nothing launched\n", grid); grid = -1; return; }
    }
    if (grid < 0) return;
    unsigned char* ws = (unsigned char*)d_ws;
    (void)hipMemsetAsync(ws + WS_CTL, 0, CTL_ZERO_BYTES, stream);
    Args a{};
    a.x = (const float*)d_in[0]; a.pos = (const int*)d_in[1]; a.g_mix = (const float*)d_in[2]; a.w_in = (const float*)d_in[3]; a.g_cq = (const float*)d_in[4]; a.w_uq = (const float*)d_in[5];
    a.g_ckv = (const float*)d_in[6]; a.w_ukv = (const float*)d_in[7]; a.w_out = (const float*)d_in[8]; a.g_ffn = (const float*)d_in[9]; a.w_pq = (const float*)d_in[10]; a.sub_keys = (const float*)d_in[11];
    a.u_emb = (const float*)d_in[12]; a.v_emb = (const float*)d_in[13]; a.g_final = (const float*)d_in[14];
    a.out = (float*)d_out; a.ws = ws; a.ph_lo = 0; a.ph_hi = (STAGE >= 6) ? 11 : STAGE + 1; a.probe_mask = 0xffffu; a.probe_shift = 0;
#if defined(PROBE_LO) && PROBE_LO == 3
    { Args b1 = a; b1.ph_hi = 4; b1.probe_shift = PROBE_SHIFT; hipLaunchKernelGGL(mk_fwd, dim3(grid), dim3(NWAVES * 64), LDS_BYTES, stream, b1);
      (void)hipMemsetAsync(ws + WS_CTL, 0, CTL_ZERO_BYTES, stream); a.ph_lo = 3; }
#endif
    hipLaunchKernelGGL(mk_fwd, dim3(grid), dim3(NWAVES * 64), LDS_BYTES, stream, a);
#if defined(PROBE_LO) && PROBE_LO != 3
#if 0
#else
    { Args b2 = a; b2.ph_lo = PROBE_LO; b2.ph_hi = PROBE_HI; b2.probe_shift = PROBE_SHIFT; b2.probe_mask = PROBE_MASK; (void)hipMemsetAsync(ws + WS_CTL, 0, CTL_ZERO_BYTES, stream); hipLaunchKernelGGL(mk_fwd, dim3(grid), dim3(NWAVES * 64), LDS_BYTES, stream, b2); }
#endif
#endif
#if STAGE < 6
    float* out = (float*)d_out; float* mixed = out;
    const size_t MB = MiB;
#if STAGE == 2
    {
        float* q32 = (float*)(ws + 0 * MB); float* k32 = (float*)(ws + 32 * MB); float* v32 = (float*)(ws + 64 * MB);
        const long n = (long)T * 512;
        nv::k_cvt<<<(int)((n + 255) / 256), 256, 0, stream>>>((const bf16_t*)(ws + WS_QA), q32, n, 1.0f / LOG2E);
        nv::k_cvt<<<(int)((n + 255) / 256), 256, 0, stream>>>((const bf16_t*)(ws + WS_KA), k32, n, 1.0f);
        nv::k_cvt<<<(int)((n + 255) / 256), 256, 0, stream>>>((const bf16_t*)(ws + WS_VA), v32, n, 1.0f);
        nv::k_dilated<<<T * 8 / 4, 256, 0, stream>>>(q32, k32, v32, mixed);
        float* qm32 = (float*)(ws + 112 * MB);
        const long nq = (long)T * 768;
        nv::k_cvt<<<(int)((nq + 255) / 256), 256, 0, stream>>>((const bf16_t*)(ws + WS_QM), qm32, nq, 1.0f / LOG2E);
        float* Kt = (float*)(ws + 0 * MB); float* Vt = Kt + (size_t)NB * 8 * 96 * SEQ;
        nv::k_build_ktvt<<<(int)(((long)NB * 8 * 160 * SEQ + 255) / 256), 256, 0, stream>>>((const bf16_t*)(ws + WS_KN), (const bf16_t*)(ws + WS_VM), (const bf16_t*)(ws + WS_KR), Kt, Vt);
        nv::k_mla<<<NB * 8 * (SEQ / 4), 256, 0, stream>>>(qm32, Kt, Vt, mixed);
    }
#elif STAGE == 3
    { const long n = (long)T * DM; nv::k_cvt<<<(int)((n + 255) / 256), 256, 0, stream>>>((const bf16_t*)(ws + WS_MIXED), mixed, n, 1.0f); }
#endif
    float* hbuf = (float*)(ws + 192 * MB); float* rstd_h = (float*)(ws + 180 * MB);
#if STAGE <= 3
    nv::k_gemm<<<dim3(DM / 64, T / 64), 256, 0, stream>>>(mixed, DM, nullptr, nullptr, a.w_out, DM, hbuf, DM, T, DM, DM, a.x, DM);
#else
    (void)hipMemcpyAsync(hbuf, out, (size_t)T * DM * 4, hipMemcpyDeviceToDevice, stream);
#endif
    float* qp = (float*)(ws + 0 * MB);
    float* vals = (float*)(ws + 128 * MB); int* idxs = (int*)(ws + 145 * MB); int* expert = (int*)(ws + 162 * MB); float* gate = (float*)(ws + 171 * MB);
    nv::k_rstd<<<T / 4, 256, 0, stream>>>(hbuf, DM, DM, rstd_h, T);
    nv::k_gemm<<<dim3(2048 / 64, T / 64), 256, 0, stream>>>(hbuf, DM, rstd_h, a.g_ffn, a.w_pq, 2048, qp, 2048, T, 2048, DM, nullptr, 0);
    (void)hipFuncSetAttribute((const void*)nv::k_topk1, hipFuncAttributeMaxDynamicSharedMemorySize, 65536);
    nv::k_topk1<<<dim3(T / 256, 16), 256, 65536, stream>>>(qp, a.sub_keys, vals, idxs);
    nv::k_topk2<<<T * 8 / 256, 256, 0, stream>>>(vals, idxs, expert, gate);
    nv::k_peer_final<<<T / 4, 256, 0, stream>>>(hbuf, rstd_h, a.g_ffn, a.u_emb, a.v_emb, expert, gate, a.g_final, out);
#endif
}
```

```cpp
#include <hip/hip_runtime.h>
#include <hip/hip_bf16.h>
#include <math.h>
#include <stdio.h>
#include <stdint.h>

#define LAS __attribute__((address_space(3)))
#define GAS __attribute__((address_space(1)))
typedef unsigned short bf16_t;
typedef short bf16x8 __attribute__((ext_vector_type(8)));
typedef short s16x4 __attribute__((ext_vector_type(4)));
typedef float f32x2 __attribute__((ext_vector_type(2)));
typedef float f32x4 __attribute__((ext_vector_type(4)));
typedef float f32x16 __attribute__((ext_vector_type(16)));
typedef unsigned u32x2 __attribute__((ext_vector_type(2)));
typedef unsigned u32x4 __attribute__((ext_vector_type(4)));
typedef __bf16 bf16x2_t __attribute__((ext_vector_type(2)));
typedef _Float16 f16x2_t __attribute__((ext_vector_type(2)));
typedef int v8i __attribute__((ext_vector_type(8)));

constexpr int DM = 1024, NB = 2, SEQ = 8192, T = NB * SEQ;
constexpr int INW = 1952;
constexpr float EPS = 1e-6f;
constexpr float LOG2E = 1.4426950408889634f;
constexpr float QA_SCALE = 0.125f * LOG2E;
constexpr float QM_SCALE = 0.10206207261596577f * LOG2E;

constexpr size_t MiB = 1u << 20;
constexpr size_t WS_CTL = 0, CTL_ZERO_BYTES = 64 * 1024;
constexpr size_t WS_COSA = 1 * MiB, WS_SINA = WS_COSA + 512 * 1024, WS_COSM = 2 * MiB, WS_SINM = 3 * MiB;
constexpr size_t WS_WIN = 4 * MiB, WS_WCOMB = 8 * MiB, WS_WOUT = 12 * MiB, WS_WUQ = 14 * MiB, WS_WUKV = 14 * MiB + 512 * 1024;
constexpr size_t WS_SSQQ = 15 * MiB, WS_SSQKV = 15 * MiB + 512 * 1024;
constexpr size_t WS_U8 = 16 * MiB, WS_V8 = 32 * MiB;
constexpr size_t WS_HN = 80 * MiB, WS_MIXED = 80 * MiB;
constexpr size_t WS_QA = 112 * MiB, WS_KA = 128 * MiB, WS_VA = 144 * MiB;
constexpr size_t WS_CQ = 160 * MiB, WS_CKV = 168 * MiB, WS_KR = 172 * MiB;
constexpr size_t WS_QM = 176 * MiB, WS_KN = 200 * MiB, WS_VM = 216 * MiB;
constexpr size_t WS_SSQH = 232 * MiB;
constexpr size_t WS_HB = 112 * MiB, WS_SC = 144 * MiB;
constexpr size_t WS_HB8 = 208 * MiB;
constexpr size_t WS_ZP = 48 * MiB, WS_PEROW = 80 * MiB, WS_PESLOT = 84 * MiB, WS_PG = 88 * MiB, WS_SSQY = 96 * MiB, WS_RSTDH = 97 * MiB, WS_PE2 = 176 * MiB, WS_PA2 = 180 * MiB;
constexpr size_t WS_OP = 144 * MiB;
constexpr float SU = 256.f, SX = 16.f, SV = 64.f;
constexpr size_t WS_END = 234 * MiB;
static_assert(WS_KA == WS_QA + 16 * MiB && WS_VA == WS_KA + 16 * MiB && WS_VM == WS_KN + 16 * MiB, "epilogues address Ka/Va and Vm relative to Qa and Kn");

__device__ __forceinline__ unsigned pk_bf16(float lo, float hi) { f32x2 v = {lo, hi}; bf16x2_t b = __builtin_convertvector(v, bf16x2_t); return __builtin_bit_cast(unsigned, b); }
__device__ __forceinline__ unsigned pk_f16(float lo, float hi) { f32x2 v = {lo, hi}; f16x2_t b = __builtin_convertvector(v, f16x2_t); return __builtin_bit_cast(unsigned, b); }
__device__ __forceinline__ unsigned pk_fp8x4(float a, float b, float c, float d) { int w = __builtin_amdgcn_cvt_pk_fp8_f32(a, b, 0, false); w = __builtin_amdgcn_cvt_pk_fp8_f32(c, d, w, true); return (unsigned)w; }
__device__ __forceinline__ float bf_lo(unsigned w) { return __builtin_bit_cast(float, w << 16); }
__device__ __forceinline__ float bf_hi(unsigned w) { return __builtin_bit_cast(float, w & 0xffff0000u); }
__device__ __forceinline__ float wave_sum(float v) {
#pragma unroll
    for (int o = 1; o < 64; o <<= 1) v += __shfl_xor(v, o);
    return v;
}
__device__ __forceinline__ int crow(int r, int hi) { return (r & 3) + 8 * (r >> 2) + 4 * hi; }
__device__ __forceinline__ void glds16(const void* gsrc, unsigned lds_dst) { unsigned keep;
    asm volatile("s_mov_b32 %0, m0\n\ts_mov_b32 m0, %2\n\ts_nop 0\n\tglobal_load_lds_dwordx4 %1, off\n\ts_mov_b32 m0, %0" : "=&s"(keep) : "v"(gsrc), "s"(lds_dst) : "memory"); }

#define STAGE 6


namespace pg8 {
#define PG8_LAS __attribute__((address_space(3)))
typedef unsigned short bf16_t;
typedef short bf16x8 __attribute__((ext_vector_type(8)));
typedef float f32x4 __attribute__((ext_vector_type(4)));
typedef unsigned u32x4 __attribute__((ext_vector_type(4)));
constexpr int BM = 256, BK = 64, HALF = 128, HTB = HALF * BK * 2  , STAGE_BYTES = 8 * HTB, NXCD = 8, WGM = 8;

__host__ __device__ __forceinline__ int lds_byte(int r, int c) { const int st = (r >> 4) * 2 + (c >> 5), rr = r & 15, cc = c & 31, ob = rr * 64 + cc * 2; return st * 1024 + (ob ^ (((ob >> 9) & 1) << 5)); }
__host__ __device__ __forceinline__ void stage_rc(int b, int& R, int& C) { const int st = b / 1024, sb = b % 1024, swz = sb ^ (((sb >> 9) & 1) << 5); R = (st >> 1) * 16 + swz / 64; C = (st & 1) * 32 + (swz % 64) / 2; }
__host__ __device__ __forceinline__ int perm32(int rho) { const int n = rho >> 4, i = rho & 15; return 8 * (i >> 2) + 4 * n + (i & 3); }

struct Unit { int pm, pn; };
struct Gemm { const bf16_t* A; const bf16_t* Bt; int M, N, K; };

struct StaticOrder {
    int nM, nN, nwg, G, c;
    __host__ __device__ void init(int M, int N, int G_, int c_) { nM = M / BM; nN = N / BM; nwg = nM * nN; G = G_; c = c_; }
    __host__ __device__ bool next(int i, Unit& u) const {
        const long L = (long)i * G + c; if (L >= nwg) return false;
        int wgid = (int)L; { const int q = nwg / NXCD, r = nwg % NXCD, xcd = wgid % NXCD, off = wgid / NXCD; wgid = (xcd < r ? xcd * (q + 1) : r * (q + 1) + (xcd - r) * q) + off; }
        const int nig = WGM * nN, gid = wgid / nig, fm = gid * WGM, gsz = (nM - fm) < WGM ? (nM - fm) : WGM;
        u.pm = fm + ((wgid % nig) % gsz); u.pn = (wgid % nig) / gsz; return true;
    }
    __device__ __forceinline__ void a_ready(const Unit&) const {}
    __device__ __forceinline__ void done(const Unit&) const {}
};


__device__ __forceinline__ unsigned cvt_pk_bf16(float lo, float hi) { unsigned r; asm volatile("v_cvt_pk_bf16_f32 %0, %1, %2" : "=v"(r) : "v"(lo), "v"(hi)); return r; }
typedef float f32x2 __attribute__((ext_vector_type(2)));

__device__ __forceinline__ void load8(const float* p, float (&o)[8]);

template <class Epi, class Sched, bool ALIGN_EPI = false, bool SP2 = false>
__device__ __forceinline__ void gemm_phase(PG8_LAS unsigned char* lds, const Gemm g, const Sched& S, const Epi& E) {
    const int tid = threadIdx.x, wid = __builtin_amdgcn_readfirstlane(tid >> 6), lane = tid & 63, wr = wid >> 2, wc = wid & 3, fr = lane & 15, fq = lane >> 4;
    const int K = g.K, nt = K / BK;
    unsigned voffA[2], voffB[2];
#pragma unroll
    for (int i = 0; i < 2; ++i) { int R, C; stage_rc(tid * 16 + i * 8192, R, C); const int Rb = Epi::PERM ? ((R & ~31) + perm32(R & 31)) : R;
        voffA[i] = (unsigned)(R * K + C) * 2u; voffB[i] = (unsigned)(Rb * K + C) * 2u; }
    const size_t kstep = (size_t)(BK * 2);
    const size_t hstep = (size_t)HALF * K * 2;
    const size_t tstep = 2 * hstep;
    const unsigned ldsw = (unsigned)wid * 1024u;
    const int aoff = lds_byte(wr * 64 + fr, fq * 8), boff = lds_byte(wc * 32 + fr, fq * 8);
#define PG8_SA(b, h) (((b) * 2 + (h)) * HTB)
#define PG8_SB(b, h) ((4 + (b) * 2 + (h)) * HTB)
#define PG8_STAGE(bufoff, gbase, voff) do { _Pragma("unroll") for (int _i = 0; _i < 2; ++_i) \
        __builtin_amdgcn_global_load_lds((const unsigned*)((const char*)(gbase) + (voff)[_i]), (PG8_LAS unsigned*)(lds + (bufoff) + ldsw + _i * 8192), 16, 0, 0); } while (0)
#define PG8_LDA(dst, b, h) do { _Pragma("unroll") for (int m = 0; m < 4; ++m) _Pragma("unroll") for (int k = 0; k < 2; ++k) dst[m][k] = *(const PG8_LAS bf16x8*)(lds + PG8_SA(b, h) + aoff + m * 2048 + k * 1024); } while (0)
#define PG8_LDB(dst, b, h) do { _Pragma("unroll") for (int n = 0; n < 2; ++n) _Pragma("unroll") for (int k = 0; k < 2; ++k) dst[n][k] = *(const PG8_LAS bf16x8*)(lds + PG8_SB(b, h) + boff + n * 2048 + k * 1024); } while (0)
#define PG8_MMA(ai, bj, At, Bt) do { __builtin_amdgcn_s_setprio(1); _Pragma("unroll") for (int m = 0; m < 4; ++m) _Pragma("unroll") for (int n = 0; n < 2; ++n) _Pragma("unroll") for (int k = 0; k < 2; ++k) \
        acc[ai][bj][m][n] = __builtin_amdgcn_mfma_f32_16x16x32_bf16(Bt[n][k], At[m][k], acc[ai][bj][m][n], 0, 0, 0); __builtin_amdgcn_s_setprio(0); } while (0)
#define PG8_WAIT_V(n) asm volatile("s_waitcnt vmcnt(" #n ")" ::: "memory")
#define PG8_WAIT_L(n) asm volatile("s_waitcnt lgkmcnt(" #n ")" ::: "memory")
#define PG8_BAR __builtin_amdgcn_s_barrier()
#define PG8_SCHED __builtin_amdgcn_sched_barrier(0)
    Unit cur, nxt; int ui = 0;
    if (!S.next(0, cur)) return;
    f32x4 acc[2][2][4][2];
#pragma unroll
    for (int a = 0; a < 2; ++a)
#pragma unroll
        for (int b = 0; b < 2; ++b)
#pragma unroll
            for (int m = 0; m < 4; ++m)
#pragma unroll
                for (int n = 0; n < 2; ++n) acc[a][b][m][n] = (f32x4){0.f, 0.f, 0.f, 0.f};
    bf16x8 At[4][2], B0[2][2], B1[2][2];
    const char* cA = (const char*)g.A + (size_t)cur.pm * tstep; const char* cB = (const char*)g.Bt + (size_t)cur.pn * tstep;
    S.a_ready(cur);
    if constexpr (SP2) {
        PG8_STAGE(PG8_SB(0, 0), cB, voffB); PG8_STAGE(PG8_SB(0, 1), cB + hstep, voffB); PG8_STAGE(PG8_SA(0, 0), cA, voffA); PG8_STAGE(PG8_SA(0, 1), cA + hstep, voffA);
        if (wr == 1) PG8_BAR;
        PG8_WAIT_V(2); PG8_BAR;
        PG8_STAGE(PG8_SB(1, 0), cB + kstep, voffB); PG8_STAGE(PG8_SA(1, 0), cA + kstep, voffA); PG8_STAGE(PG8_SB(1, 1), cB + hstep + kstep, voffB);
        PG8_WAIT_V(6); PG8_BAR;
    } else {
        PG8_STAGE(PG8_SB(0, 0), cB, voffB); PG8_STAGE(PG8_SA(0, 0), cA, voffA); PG8_STAGE(PG8_SB(0, 1), cB + hstep, voffB); PG8_STAGE(PG8_SA(0, 1), cA + hstep, voffA);
        if (wr == 1) PG8_BAR;
        PG8_WAIT_V(4); PG8_BAR;
        PG8_STAGE(PG8_SB(1, 0), cB + kstep, voffB); PG8_STAGE(PG8_SA(1, 0), cA + kstep, voffA); PG8_STAGE(PG8_SB(1, 1), cB + hstep + kstep, voffB);
        PG8_WAIT_V(6); PG8_BAR;
    }
    for (;;) {
        const bool has_next = S.next(ui + 1, nxt);
        const char* nA = has_next ? (const char*)g.A + (size_t)nxt.pm * tstep : cA; const char* nB = has_next ? (const char*)g.Bt + (size_t)nxt.pn * tstep : cB;
        for (int t = 0; t < nt; t += 2) {
            const bool last = (t == nt - 2);
            const char* a1 = cA + (size_t)(t + 1) * kstep;
            const char* a2 = last ? nA : cA + (size_t)(t + 2) * kstep; const char* b2 = last ? nB : cB + (size_t)(t + 2) * kstep;
            const char* a3 = a2 + kstep; const char* b3 = b2 + kstep;
            if (last && has_next) S.a_ready(nxt);
            if constexpr (SP2) {
            PG8_LDB(B0, 0, 0); PG8_LDB(B1, 0, 1); PG8_SCHED; PG8_LDA(At, 0, 0); PG8_STAGE(PG8_SA(1, 1), a1 + hstep, voffA);
            PG8_WAIT_V(8); PG8_WAIT_L(0); PG8_BAR; PG8_MMA(0, 0, At, B0); PG8_MMA(0, 1, At, B1); PG8_BAR; PG8_SCHED;
            PG8_LDA(At, 0, 1); PG8_STAGE(PG8_SB(0, 0), b2, voffB); PG8_STAGE(PG8_SB(0, 1), b2 + hstep, voffB); PG8_STAGE(PG8_SA(0, 0), a2, voffA);
            PG8_WAIT_V(8); PG8_WAIT_L(0); PG8_BAR; PG8_MMA(1, 0, At, B0); PG8_MMA(1, 1, At, B1); PG8_BAR; PG8_SCHED;
            PG8_LDB(B0, 1, 0); PG8_LDB(B1, 1, 1); PG8_SCHED; PG8_LDA(At, 1, 0); PG8_STAGE(PG8_SA(0, 1), a2 + hstep, voffA);
            PG8_WAIT_V(8); PG8_WAIT_L(0); PG8_BAR; PG8_MMA(0, 0, At, B0); PG8_MMA(0, 1, At, B1); PG8_BAR; PG8_SCHED;
            PG8_LDA(At, 1, 1); PG8_STAGE(PG8_SB(1, 0), b3, voffB); PG8_STAGE(PG8_SB(1, 1), b3 + hstep, voffB); PG8_STAGE(PG8_SA(1, 0), a3, voffA);
            PG8_WAIT_V(8); PG8_WAIT_L(0); PG8_BAR; PG8_MMA(1, 0, At, B0); PG8_MMA(1, 1, At, B1); PG8_BAR; PG8_SCHED;
            } else {
            PG8_LDB(B0, 0, 0); PG8_SCHED; PG8_LDA(At, 0, 0); PG8_STAGE(PG8_SA(1, 1), a1 + hstep, voffA);
            PG8_WAIT_L(8); PG8_BAR; PG8_WAIT_L(0); PG8_MMA(0, 0, At, B0); PG8_BAR; PG8_SCHED;
            PG8_LDB(B1, 0, 1); PG8_STAGE(PG8_SB(0, 0), b2, voffB);
            PG8_BAR; PG8_WAIT_L(0); PG8_MMA(0, 1, At, B1); PG8_BAR;
            PG8_LDA(At, 0, 1); PG8_STAGE(PG8_SA(0, 0), a2, voffA);
            PG8_BAR; PG8_WAIT_L(0); PG8_MMA(1, 0, At, B0); PG8_BAR; PG8_SCHED;
            PG8_STAGE(PG8_SB(0, 1), b2 + hstep, voffB);
            PG8_WAIT_V(6); PG8_BAR; PG8_MMA(1, 1, At, B1); PG8_BAR;
            PG8_LDB(B0, 1, 0); PG8_SCHED; PG8_LDA(At, 1, 0); PG8_STAGE(PG8_SA(0, 1), a2 + hstep, voffA);
            PG8_WAIT_L(8); PG8_BAR; PG8_WAIT_L(0); PG8_MMA(0, 0, At, B0); PG8_BAR; PG8_SCHED;
            PG8_LDB(B1, 1, 1); PG8_STAGE(PG8_SB(1, 0), b3, voffB);
            PG8_BAR; PG8_WAIT_L(0); PG8_MMA(0, 1, At, B1); PG8_BAR;
            PG8_LDA(At, 1, 1); PG8_STAGE(PG8_SA(1, 0), a3, voffA);
            PG8_BAR; PG8_WAIT_L(0); PG8_MMA(1, 0, At, B0); PG8_BAR; PG8_SCHED;
            PG8_STAGE(PG8_SB(1, 1), b3 + hstep, voffB);
            PG8_WAIT_V(6); PG8_BAR; PG8_MMA(1, 1, At, B1); PG8_BAR;
            }
        }
        if constexpr (ALIGN_EPI) { if (wr == 0) PG8_BAR; }
        if constexpr (!Epi::AFTER_DRAIN) { E(acc, cur, wr, wc, fr, fq); S.done(cur); }
        if (!has_next) break;
#pragma unroll
        for (int a = 0; a < 2; ++a)
#pragma unroll
            for (int b = 0; b < 2; ++b)
#pragma unroll
                for (int m = 0; m < 4; ++m)
#pragma unroll
                    for (int n = 0; n < 2; ++n) acc[a][b][m][n] = (f32x4){0.f, 0.f, 0.f, 0.f};
        cur = nxt; cA = nA; cB = nB; ++ui;
        if constexpr (ALIGN_EPI) { if (wr == 1) PG8_BAR; }
    }
    PG8_WAIT_V(0);
    if constexpr (!ALIGN_EPI) { if (wr == 0) PG8_BAR; }
    PG8_BAR;
    if constexpr (Epi::AFTER_DRAIN) { E.fused(acc, cur, wr, wc, fr, fq, lds, wid, lane); S.done(cur); }
#undef PG8_SA
#undef PG8_SB
#undef PG8_STAGE
#undef PG8_LDA
#undef PG8_LDB
#undef PG8_MMA
#undef PG8_WAIT_V
#undef PG8_WAIT_L
#undef PG8_BAR
#undef PG8_SCHED
}
}

namespace pg8 {
#define EPI_V8(ai, bj, m) { acc[ai][bj][m][0][0], acc[ai][bj][m][0][1], acc[ai][bj][m][0][2], acc[ai][bj][m][0][3], acc[ai][bj][m][1][0], acc[ai][bj][m][1][1], acc[ai][bj][m][1][2], acc[ai][bj][m][1][3] }
__device__ __forceinline__ u32x4 pack8(const float (&v)[8], float s) { u32x4 w; w.x = pk_bf16(v[0] * s, v[1] * s); w.y = pk_bf16(v[2] * s, v[3] * s); w.z = pk_bf16(v[4] * s, v[5] * s); w.w = pk_bf16(v[6] * s, v[7] * s); return w; }
__device__ __forceinline__ float ssq8(const float (&v)[8]) { return ((v[0] * v[0] + v[1] * v[1]) + (v[2] * v[2] + v[3] * v[3])) + ((v[4] * v[4] + v[5] * v[5]) + (v[6] * v[6] + v[7] * v[7])); }
__device__ __forceinline__ void load8(const float* p, float (&o)[8]) { const f32x4 a = *(const f32x4*)p, b = *(const f32x4*)(p + 4); o[0] = a.x; o[1] = a.y; o[2] = a.z; o[3] = a.w; o[4] = b.x; o[5] = b.y; o[6] = b.z; o[7] = b.w; }

struct EpiProj {
    static constexpr bool PERM = true, AFTER_DRAIN = false;
    bf16_t *Qa, *Ka, *Va, *Cq, *Ckv, *Kr; float *ssq_q, *ssq_kv; const float *cosA, *sinA, *cosM, *sinM;
    __device__ __forceinline__ void operator()(const f32x4 (&acc)[2][2][4][2], const Unit& u, int wr, int wc, int fr, int fq) const {
        const int pn = u.pn, rowb = u.pm * BM + wr * 64 + fr;
        if (pn < 6) {
            const int kind = pn >> 1;
            bf16_t* dst = Qa + (size_t)kind * (size_t)(8u << 20);
            const float sc = kind == 0 ? QA_SCALE : 1.f;
            const bool ropew = (kind < 2) && ((wc & 1) == 0);
            float cq[2][8], sq[2][8];
            if (ropew) {
#pragma unroll
                for (int g = 0; g < 2; ++g) { const size_t r_ = (size_t)(rowb + g * 16) * 8; load8(cosA + r_, cq[g]); load8(sinA + r_, sq[g]); }
            }
#pragma unroll
            for (int ai = 0; ai < 2; ++ai)
#pragma unroll
                for (int m = 0; m < 4; ++m) {
                    const int row = rowb + ai * HALF + m * 16;
                    float cs[8], sn[8];
                    if (ropew) {
#pragma unroll
                        for (int i = 0; i < 8; ++i) { cs[i] = cq[m & 1][i]; sn[i] = sq[m & 1][i]; }
                        if (ai * 4 + m + 2 < 8) { const int g2 = ai * 4 + m + 2; const size_t r_ = (size_t)(rowb + (g2 >> 2) * HALF + (g2 & 3) * 16) * 8; load8(cosA + r_, cq[m & 1]); load8(sinA + r_, sq[m & 1]); }
                    }
#pragma unroll
                    for (int bj = 0; bj < 2; ++bj) {
                        float v[8] = EPI_V8(ai, bj, m);
                        if (ropew) {
#pragma unroll
                            for (int i = 0; i < 8; ++i) { const float pv = __shfl_xor(v[i], 16); if (fq == 0) v[i] = v[i] * cs[i] - pv * sn[i]; else if (fq == 1) v[i] = v[i] * cs[i] + pv * sn[i]; }
                        }
                        *(u32x4*)(dst + ((size_t)((row >> 13) * 8 + (pn & 1) * 4 + bj * 2 + (wc >> 1)) * SEQ + (row & (SEQ - 1))) * 64 + (wc & 1) * 32 + fq * 8) = pack8(v, sc);
                    }
                }
        } else if (pn == 6) {
#pragma unroll
            for (int ai = 0; ai < 2; ++ai)
#pragma unroll
                for (int m = 0; m < 4; ++m) {
                    const int row = rowb + ai * HALF + m * 16;
#pragma unroll
                    for (int bj = 0; bj < 2; ++bj) {
                        float v[8] = EPI_V8(ai, bj, m);
                        float s = ssq8(v); s += __shfl_xor(s, 16); s += __shfl_xor(s, 32);
                        if (fq == 0) ssq_q[(size_t)row * 8 + bj * 4 + wc] = s;
                        *(u32x4*)(Cq + (size_t)row * 256 + bj * HALF + wc * 32 + fq * 8) = pack8(v, 1.f);
                    }
                }
        } else {
#pragma unroll
            for (int ai = 0; ai < 2; ++ai)
#pragma unroll
                for (int m = 0; m < 4; ++m) {
                    const int row = rowb + ai * HALF + m * 16;
                    {
                        float v[8] = EPI_V8(ai, 0, m);
                        float s = ssq8(v); s += __shfl_xor(s, 16); s += __shfl_xor(s, 32);
                        if (fq == 0) ssq_kv[(size_t)row * 4 + wc] = s;
                        *(u32x4*)(Ckv + (size_t)row * 128 + wc * 32 + fq * 8) = pack8(v, 1.f);
                    }
                    if (wc == 0) {
                        float v[8] = EPI_V8(ai, 1, m);
                        float cs[8], sn[8];
                        load8(cosM + (size_t)row * 16 + 8 * (fq & 1), cs); load8(sinM + (size_t)row * 16 + 8 * (fq & 1), sn);
#pragma unroll
                        for (int i = 0; i < 8; ++i) { const float pv = __shfl_xor(v[i], 32); v[i] = (fq < 2) ? (v[i] * cs[i] - pv * sn[i]) : (v[i] * cs[i] + pv * sn[i]); }
                        *(u32x4*)(Kr + (size_t)row * 32 + fq * 8) = pack8(v, 1.f);
                    }
                }
        }
    }
};

struct EpiQm {
    static constexpr bool PERM = true, AFTER_DRAIN = false;
    bf16_t* Qm; const float* ssq_q; const float *cosM, *sinM;
    __device__ __forceinline__ void operator()(const f32x4 (&acc)[2][2][4][2], const Unit& u, int wr, int wc, int fr, int fq) const {
        const int pn = u.pn, rowb = u.pm * BM + wr * 64 + fr;
        f32x2 qa[8];
#pragma unroll
        for (int g = 0; g < 8; ++g) qa[g] = *(const f32x2*)(ssq_q + (size_t)(rowb + (g >> 2) * HALF + (g & 3) * 16) * 8 + 2 * fq);
        float cq[2][8], sq[2][8];
#pragma unroll
        for (int g = 0; g < 2; ++g) { const size_t r_ = (size_t)(rowb + g * 16) * 16 + 8 * (fq & 1); load8(cosM + r_, cq[g]); load8(sinM + r_, sq[g]); }
#pragma unroll
        for (int ai = 0; ai < 2; ++ai)
#pragma unroll
            for (int m = 0; m < 4; ++m) {
                const int row = rowb + ai * HALF + m * 16, g = ai * 4 + m;
                float ssum = qa[g].x + qa[g].y; ssum += __shfl_xor(ssum, 16); ssum += __shfl_xor(ssum, 32);
                const float rs = 1.0f / sqrtf(ssum * (1.f / 256.f) + EPS);
                float cs[8], sn[8];
#pragma unroll
                for (int i = 0; i < 8; ++i) { cs[i] = cq[m & 1][i]; sn[i] = sq[m & 1][i]; }
                if (g + 2 < 8) { const int g2 = g + 2; const size_t r_ = (size_t)(rowb + (g2 >> 2) * HALF + (g2 & 3) * 16) * 16 + 8 * (fq & 1); load8(cosM + r_, cq[m & 1]); load8(sinM + r_, sq[m & 1]); }
#pragma unroll
                for (int bj = 0; bj < 2; ++bj) {
                    const int g32 = pn * 8 + bj * 4 + wc;
                    const bool ropew = (g32 % 3) == 2;
                    float v[8] = EPI_V8(ai, bj, m);
#pragma unroll
                    for (int i = 0; i < 8; ++i) v[i] *= rs;
                    if (ropew) {
#pragma unroll
                        for (int i = 0; i < 8; ++i) { const float pv = __shfl_xor(v[i], 32); v[i] = (fq < 2) ? (v[i] * cs[i] - pv * sn[i]) : (v[i] * cs[i] + pv * sn[i]); }
                    }
                    *(u32x4*)(Qm + (size_t)row * 768 + pn * BM + bj * HALF + wc * 32 + fq * 8) = pack8(v, QM_SCALE);
                }
                asm volatile("" ::: "memory");
            }
    }
};

struct EpiKv {
    static constexpr bool PERM = true, AFTER_DRAIN = false;
    bf16_t *Kn, *Vm; const float* ssq_kv;
    __device__ __forceinline__ void operator()(const f32x4 (&acc)[2][2][4][2], const Unit& u, int wr, int wc, int fr, int fq) const {
        const int pn = u.pn, rowb = u.pm * BM + wr * 64 + fr;
        bf16_t* dst = Kn + (size_t)(wc >> 1) * (size_t)(8u << 20);
        const int within = (wc & 1) * 32 + fq * 8;
        f32x4 q4a[8];
#pragma unroll
        for (int g = 0; g < 8; ++g) q4a[g] = *(const f32x4*)(ssq_kv + (size_t)(rowb + (g >> 2) * HALF + (g & 3) * 16) * 4);
#pragma unroll
        for (int ai = 0; ai < 2; ++ai)
#pragma unroll
            for (int m = 0; m < 4; ++m) {
                const int row = rowb + ai * HALF + m * 16;
                const f32x4 q4 = q4a[ai * 4 + m];
                const float rs = 1.0f / sqrtf(((q4.x + q4.y) + (q4.z + q4.w)) * (1.f / 128.f) + EPS);
#pragma unroll
                for (int bj = 0; bj < 2; ++bj) {
                    float v[8] = EPI_V8(ai, bj, m);
                    *(u32x4*)(dst + ((size_t)((row >> 13) * 8 + pn * 2 + bj) * SEQ + (row & (SEQ - 1))) * 64 + within) = pack8(v, rs);
                }
            }
    }
};

struct EpiOut {
    static constexpr bool PERM = true, AFTER_DRAIN = false;
    const float* x; bf16_t* Hb; unsigned char* Hb8; float* ssq_h;
    __device__ __forceinline__ void operator()(const f32x4 (&acc)[2][2][4][2], const Unit& u, int wr, int wc, int fr, int fq) const {
        const int pn = u.pn, rowb = u.pm * BM + wr * 64 + fr;
        float xq[8][8];
#define XPIECE(t_) (x + (size_t)(rowb + ((t_) >> 3) * HALF + (((t_) >> 1) & 3) * 16) * DM + pn * BM + ((t_) & 1) * HALF + wc * 32 + fq * 8)
#pragma unroll
        for (int t = 0; t < 8; ++t) load8(XPIECE(t), xq[t]);
#pragma unroll
        for (int ai = 0; ai < 2; ++ai)
#pragma unroll
            for (int m = 0; m < 4; ++m) {
                const int row = rowb + ai * HALF + m * 16;
#pragma unroll
                for (int bj = 0; bj < 2; ++bj) {
                    const int col = pn * BM + bj * HALF + wc * 32 + fq * 8, t = (ai * 4 + m) * 2 + bj;
                    float v[8] = EPI_V8(ai, bj, m);
#pragma unroll
                    for (int i = 0; i < 8; ++i) v[i] += xq[t & 7][i];
                    if (t + 8 < 16) load8(XPIECE(t + 8), xq[t & 7]);
                    float s = ssq8(v); s += __shfl_xor(s, 16); s += __shfl_xor(s, 32);
                    if (fq == 0) ssq_h[(size_t)row * 32 + pn * 8 + bj * 4 + wc] = s;
                    *(u32x4*)(Hb + (size_t)row * DM + col) = pack8(v, 1.f);
                    { u32x2 w8; w8.x = pk_fp8x4(v[0] * SX, v[1] * SX, v[2] * SX, v[3] * SX); w8.y = pk_fp8x4(v[4] * SX, v[5] * SX, v[6] * SX, v[7] * SX); *(u32x2*)(Hb8 + (size_t)(col >> 7) * ((size_t)T * 128) + (size_t)row * 128 + (col & 127)) = w8; }
                }
            }
#undef XPIECE
    }
};

struct EpiSc {
    static constexpr bool PERM = true, AFTER_DRAIN = false;
    bf16_t* Sc; const float* ssq_h;
    __device__ __forceinline__ void operator()(const f32x4 (&acc)[2][2][4][2], const Unit& u, int wr, int wc, int fr, int fq) const {
        const int pn = u.pn, rowb = u.pm * BM + wr * 64 + fr;
        f32x4 q[8][2];
#pragma unroll
        for (int g = 0; g < 8; ++g) { const float* qp = ssq_h + (size_t)(rowb + (g >> 2) * HALF + (g & 3) * 16) * 32 + 8 * fq; q[g][0] = *(const f32x4*)qp; q[g][1] = *(const f32x4*)(qp + 4); }
#pragma unroll
        for (int ai = 0; ai < 2; ++ai)
#pragma unroll
            for (int m = 0; m < 4; ++m) {
                const int row = rowb + ai * HALF + m * 16, g = ai * 4 + m;
                float s = ((q[g][0].x + q[g][0].y) + (q[g][0].z + q[g][0].w)) + ((q[g][1].x + q[g][1].y) + (q[g][1].z + q[g][1].w));
                s += __shfl_xor(s, 16); s += __shfl_xor(s, 32);
                const float rs = 1.0f / sqrtf(s * (1.f / 1024.f) + EPS);
#pragma unroll
                for (int bj = 0; bj < 2; ++bj) {
                    float v[8] = EPI_V8(ai, bj, m);
                    u32x4 w; w.x = pk_f16(v[0] * rs, v[1] * rs); w.y = pk_f16(v[2] * rs, v[3] * rs); w.z = pk_f16(v[4] * rs, v[5] * rs); w.w = pk_f16(v[6] * rs, v[7] * rs);
                    *(u32x4*)(Sc + (size_t)row * 2048 + pn * BM + bj * HALF + wc * 32 + fq * 8) = w;
                }
            }
    }
};
#undef EPI_V8
}

namespace att {
constexpr float NEGM = -1.0e30f;
__device__ __forceinline__ s16x4 vtr(const LAS unsigned char* p) { typedef short v4i16_t __attribute__((ext_vector_type(4))); return __builtin_bit_cast(s16x4, __builtin_amdgcn_ds_read_tr16_b64_v4i16((LAS v4i16_t*)p)); }
__device__ __forceinline__ void swap32(unsigned& a, unsigned& b) { asm volatile("s_nop 1\n\tv_permlane32_swap_b32 %0, %1" : "+v"(a), "+v"(b)); }
__device__ __forceinline__ float swapmax(float v) { unsigned a = __builtin_bit_cast(unsigned, v), b = a; swap32(a, b); return fmaxf(__builtin_bit_cast(float, a), __builtin_bit_cast(float, b)); }
__device__ __forceinline__ float swapsum(float v) { unsigned a = __builtin_bit_cast(unsigned, v), b = a; swap32(a, b); return __builtin_bit_cast(float, a) + __builtin_bit_cast(float, b); }
__device__ __forceinline__ float max3f(float a, float b, float c) { return __builtin_fmaxf(__builtin_fmaxf(a, b), c); }
constexpr float THR = 8.0f;
__device__ __forceinline__ bf16x8 pack_p(const f32x16& p, int s) {
    u32x4 w; w.x = pk_bf16(p[8 * s + 0], p[8 * s + 1]); w.y = pk_bf16(p[8 * s + 2], p[8 * s + 3]); w.z = pk_bf16(p[8 * s + 4], p[8 * s + 5]); w.w = pk_bf16(p[8 * s + 6], p[8 * s + 7]);
    return __builtin_bit_cast(bf16x8, w);
}
__device__ __forceinline__ void pv_block(f32x16& o, const LAS unsigned char* vbase, const bf16x8& pb0, const bf16x8& pb1) {
    const s16x4 l0 = vtr(vbase), h0 = vtr(vbase + 8 * 64), l1 = vtr(vbase + 16 * 64), h1 = vtr(vbase + 24 * 64);
    const bf16x8 a0 = {l0[0], l0[1], l0[2], l0[3], h0[0], h0[1], h0[2], h0[3]}, a1 = {l1[0], l1[1], l1[2], l1[3], h1[0], h1[1], h1[2], h1[3]};
    o = __builtin_amdgcn_mfma_f32_32x32x16_bf16(a0, pb0, o, 0, 0, 0);
    o = __builtin_amdgcn_mfma_f32_32x32x16_bf16(a1, pb1, o, 0, 0, 0);
}
__device__ __forceinline__ void store_o(bf16_t* orow, const f32x16& o0, const f32x16& o1, float inv, int hi) {
#pragma unroll
    for (int g = 0; g < 4; ++g) {
        u32x2 a, b; a.x = pk_bf16(o0[4 * g] * inv, o0[4 * g + 1] * inv); a.y = pk_bf16(o0[4 * g + 2] * inv, o0[4 * g + 3] * inv);
        b.x = pk_bf16(o1[4 * g] * inv, o1[4 * g + 1] * inv); b.y = pk_bf16(o1[4 * g + 2] * inv, o1[4 * g + 3] * inv);
        *(u32x2*)(orow + 8 * g + 4 * hi) = a; *(u32x2*)(orow + 32 + 8 * g + 4 * hi) = b;
    }
}

constexpr int KROW = 208;
constexpr int TK = 128, KBYTES = TK * KROW, VBYTES = 2 * TK * 64, BUFB = KBYTES + VBYTES;
constexpr int MLA_LDS = 2 * BUFB;
__device__ __forceinline__ float rowmax64(const f32x16& s0, const f32x16& s1) {
    float mx = max3f(s0[0], s1[0], s0[1]);
#pragma unroll
    for (int r = 1; r < 15; r += 2) { mx = max3f(mx, s1[r], s0[r + 1]); mx = max3f(mx, s1[r + 1], s0[r + 2 < 16 ? r + 2 : 15]); }
    mx = max3f(mx, s1[15], s0[15]);
    return swapmax(mx);
}
__device__ __forceinline__ void scale16(f32x16& t, float a) {
    const f32x2 a2 = {a, a};
#pragma unroll
    for (int i = 0; i < 8; ++i) { f32x2 p = {t[2 * i], t[2 * i + 1]}; asm volatile("v_pk_mul_f32 %0, %0, %1" : "+v"(p) : "v"(a2)); t[2 * i] = p.x; t[2 * i + 1] = p.y; }
}
__device__ __forceinline__ void sub16(f32x16& t, float d) {
    const f32x2 d2 = {d, d};
#pragma unroll
    for (int i = 0; i < 8; ++i) { f32x2 p = {t[2 * i], t[2 * i + 1]}; asm volatile("v_pk_add_f32 %0, %0, %1 neg_lo:[0,1] neg_hi:[0,1]" : "+v"(p) : "v"(d2)); t[2 * i] = p.x; t[2 * i + 1] = p.y; }
}
__device__ __forceinline__ void rescale64(float mx, f32x16& s0, f32x16& s1, float& m, float& l, f32x16& o0, f32x16& o1) {
    if (__builtin_expect(__builtin_amdgcn_ballot_w64(mx > THR) != 0ull, 0)) {
        const float dl = fmaxf(mx, 0.f), alpha = __builtin_amdgcn_exp2f(-dl);
        m += dl; l *= alpha;
        sub16(s0, dl); sub16(s1, dl); scale16(o0, alpha); scale16(o1, alpha);
    }
}
__device__ __forceinline__ void exp64(f32x16& s0, f32x16& s1, float& l) {
    float rs = 0.f;
#pragma unroll
    for (int r = 0; r < 16; ++r) { s0[r] = __builtin_amdgcn_exp2f(s0[r]); s1[r] = __builtin_amdgcn_exp2f(s1[r]); rs += s0[r] + s1[r]; }
    l += rs;
}
__device__ __forceinline__ void sm64(f32x16& s0, f32x16& s1, float& m, float& l, f32x16& o0, f32x16& o1, f32x16& t0, f32x16& t1, bool adj_other) {
    float mx = max3f(s0[0], s1[0], s0[1]);
#pragma unroll
    for (int r = 1; r < 15; r += 2) { mx = max3f(mx, s1[r], s0[r + 1]); mx = max3f(mx, s1[r + 1], s0[r + 2 < 16 ? r + 2 : 15]); }
    mx = max3f(mx, s1[15], s0[15]);
    mx = swapmax(mx);
    if (__builtin_expect(__builtin_amdgcn_ballot_w64(mx > THR) != 0ull, 0)) {
        const float dl = fmaxf(mx, 0.f), alpha = __builtin_amdgcn_exp2f(-dl);
        m += dl; l *= alpha;
#pragma unroll
        for (int r = 0; r < 16; ++r) { s0[r] -= dl; s1[r] -= dl; o0[r] *= alpha; o1[r] *= alpha; }
        if (adj_other) {
#pragma unroll
            for (int r = 0; r < 16; ++r) { t0[r] -= dl; t1[r] -= dl; }
        }
    }
    float rs = 0.f;
#pragma unroll
    for (int r = 0; r < 16; ++r) { s0[r] = __builtin_amdgcn_exp2f(s0[r]); s1[r] = __builtin_amdgcn_exp2f(s1[r]); rs += s0[r] + s1[r]; }
    l += rs;
}
constexpr int MLA_G_OFF = 2 * (TK * 208 + 2 * TK * 64), MLA_PIECE_OFF = MLA_G_OFF + 4096;
__device__ __forceinline__ void mla_unit(LAS unsigned char* lds, const bf16_t* __restrict__ Qm, const bf16_t* __restrict__ Kn, const bf16_t* __restrict__ Kr, const bf16_t* __restrict__ Vm,
                                         bf16_t* __restrict__ Mixed, int b, int h, int qb,
                                         const float* __restrict__ u_emb, const float* __restrict__ v_emb, const float* __restrict__ g_ffn, unsigned char* __restrict__ U8, unsigned char* __restrict__ V8, int slot0) {
    const int tid = threadIdx.x, lane = tid & 63, wid = __builtin_amdgcn_readfirstlane(tid >> 6), r32 = lane & 31, hi = lane >> 5;
    const size_t tok0 = (size_t)b * SEQ;
    const int qpos = 256 * qb + 32 * wid + r32;
    bf16x8 qf[6];
    { const bf16_t* qrow = Qm + (tok0 + qpos) * 768 + h * 96 + 8 * hi;
#pragma unroll
      for (int ds = 0; ds < 6; ++ds) qf[ds] = *(const bf16x8*)(qrow + 16 * ds); }
    float m = 0.f, l = 0.f; f32x16 o0 = {}, o1 = {};
    const int nt = 2 * (qb + 1);
    const int wq0 = 256 * qb + 32 * wid, wqlast = wq0 + 31;
    const int srow = tid >> 3, sch = tid & 7, rrow = tid >> 2, rch = tid & 3;
    const bf16_t* gkn = Kn + ((size_t)(b * 8 + h) * SEQ + srow) * 64 + sch * 8;
    const bf16_t* gv = Vm + ((size_t)(b * 8 + h) * SEQ + srow) * 64 + sch * 8;
    const bf16_t* gkr = Kr + (tok0 + rrow) * 32 + rch * 8;
    const int wkn = srow * KROW + sch * 16, wkr = rrow * KROW + 128 + rch * 16, wv = KBYTES + (sch >> 2) * (TK * 64) + srow * 64 + (sch & 3) * 16;
    const int kfrag = r32 * KROW + hi * 16;
    const int i16 = lane & 15, vfrag = KBYTES + (4 * hi + (i16 >> 2)) * 64 + (16 * ((lane >> 4) & 1) + 4 * (i16 & 3)) * 2;
    u32x4 rk0, rk1, rv0, rv1, rr;
#define MLA_LOAD(t) do { const size_t adv_ = (size_t)(t) * TK; rk0 = *(const u32x4*)(gkn + adv_ * 64); rk1 = *(const u32x4*)(gkn + (adv_ + 64) * 64); \
        rv0 = *(const u32x4*)(gv + adv_ * 64); rv1 = *(const u32x4*)(gv + (adv_ + 64) * 64); rr = *(const u32x4*)(gkr + adv_ * 32); } while (0)
#define MLA_STORE(bp) do { LAS unsigned char* b_ = (bp); *(LAS u32x4*)(b_ + wkn) = rk0; *(LAS u32x4*)(b_ + wkn + 64 * KROW) = rk1; *(LAS u32x4*)(b_ + wv) = rv0; *(LAS u32x4*)(b_ + wv + 64 * 64) = rv1; *(LAS u32x4*)(b_ + wkr) = rr; } while (0)
    if (wid >= 4) __builtin_amdgcn_s_setprio(1);
    MLA_LOAD(0); MLA_STORE(lds);
    for (int u = tid; u < DM / 4; u += 512) *(LAS f32x4*)(lds + MLA_G_OFF + 16 * u) = *(const f32x4*)(g_ffn + 4 * u);
    LAS unsigned char* piece = lds + MLA_PIECE_OFF + wid * 1024;
    const unsigned piece_u = (unsigned)__builtin_amdgcn_readfirstlane((int)(unsigned)(uintptr_t)piece);
    __syncthreads();
    const int nfull = (wq0 + 1) >> 7;
    int kt = 0;
    for (; kt < nfull; ++kt) {
        const LAS unsigned char* buf = lds + (kt & 1) * BUFB;
        if (kt + 1 < nt) MLA_LOAD(kt + 1);
        const int pid = slot0 + 8 * kt + wid;
        if (pid < 131072) glds16(((pid >> 16) ? v_emb : u_emb) + (size_t)(pid & 65535) * 256 + 4 * lane, piece_u);
        {
            f32x16 a0, a1, b0, b1;
            { const float nm = -m; a0 = (f32x16){nm, nm, nm, nm, nm, nm, nm, nm, nm, nm, nm, nm, nm, nm, nm, nm}; a1 = a0; }
#pragma unroll
            for (int ds = 0; ds < 6; ++ds) {
                const bf16x8 k0 = *(const LAS bf16x8*)(buf + kfrag + ds * 32), k1 = *(const LAS bf16x8*)(buf + kfrag + 32 * KROW + ds * 32);
                a0 = __builtin_amdgcn_mfma_f32_32x32x16_bf16(k0, qf[ds], a0, 0, 0, 0);
                a1 = __builtin_amdgcn_mfma_f32_32x32x16_bf16(k1, qf[ds], a1, 0, 0, 0);
            }
            rescale64(rowmax64(a0, a1), a0, a1, m, l, o0, o1);
            { const float nm = -m; b0 = (f32x16){nm, nm, nm, nm, nm, nm, nm, nm, nm, nm, nm, nm, nm, nm, nm, nm}; b1 = b0; }
#pragma unroll
            for (int ds = 0; ds < 6; ++ds) {
                const bf16x8 k2 = *(const LAS bf16x8*)(buf + kfrag + 64 * KROW + ds * 32), k3 = *(const LAS bf16x8*)(buf + kfrag + 96 * KROW + ds * 32);
                b0 = __builtin_amdgcn_mfma_f32_32x32x16_bf16(k2, qf[ds], b0, 0, 0, 0);
                b1 = __builtin_amdgcn_mfma_f32_32x32x16_bf16(k3, qf[ds], b1, 0, 0, 0);
            }
            exp64(a0, a1, l);
            { const bf16x8 p00 = pack_p(a0, 0), p01 = pack_p(a0, 1), p10 = pack_p(a1, 0), p11 = pack_p(a1, 1);
              pv_block(o0, buf + vfrag, p00, p01); pv_block(o0, buf + vfrag + 2048, p10, p11);
              pv_block(o1, buf + vfrag + TK * 64, p00, p01); pv_block(o1, buf + vfrag + TK * 64 + 2048, p10, p11); }
            const float mxb = rowmax64(b0, b1);
            rescale64(mxb, b0, b1, m, l, o0, o1);
            exp64(b0, b1, l);
            { const bf16x8 p00 = pack_p(b0, 0), p01 = pack_p(b0, 1), p10 = pack_p(b1, 0), p11 = pack_p(b1, 1);
              pv_block(o0, buf + vfrag + 4096, p00, p01); pv_block(o0, buf + vfrag + 6144, p10, p11);
              pv_block(o1, buf + vfrag + TK * 64 + 4096, p00, p01); pv_block(o1, buf + vfrag + TK * 64 + 6144, p10, p11); }
        }
        if (kt + 1 < nt) MLA_STORE(lds + ((kt + 1) & 1) * BUFB);
        if (pid < 131072) {
            asm volatile("s_waitcnt vmcnt(0)" ::: "memory");
            const f32x4 xv = *(const LAS f32x4*)(piece + 16 * lane);
            const int idx = pid & 65535, col = (idx & 3) * 256 + 4 * lane;
            f32x4 sc = {SV, SV, SV, SV};
            if ((pid >> 16) == 0) { const f32x4 gv_ = *(const LAS f32x4*)(lds + MLA_G_OFF + 4 * col); sc = (f32x4){gv_.x * SU, gv_.y * SU, gv_.z * SU, gv_.w * SU}; }
            unsigned char* dst = ((pid >> 16) ? V8 : U8) + (size_t)(col >> 7) * ((size_t)16384 * 128) + (size_t)(idx >> 2) * 128 + (col & 127);
            *(unsigned*)dst = pk_fp8x4(xv.x * sc.x, xv.y * sc.y, xv.z * sc.z, xv.w * sc.w);
        }
        __syncthreads();
        }
    for (; kt < nt; ++kt) {
        const LAS unsigned char* buf = lds + (kt & 1) * BUFB;
        if (kt + 1 < nt) MLA_LOAD(kt + 1);
        const int pid = slot0 + 8 * kt + wid;
        if (pid < 131072) glds16(((pid >> 16) ? v_emb : u_emb) + (size_t)(pid & 65535) * 256 + 4 * lane, piece_u);
        if (TK * kt <= wqlast) {
            const bool needB = TK * kt + 64 <= wqlast;
            const float nm = -m; const f32x16 negm = {nm, nm, nm, nm, nm, nm, nm, nm, nm, nm, nm, nm, nm, nm, nm, nm};
            f32x16 a0 = negm, a1 = negm, b0 = negm, b1 = negm;
#pragma unroll
            for (int ds = 0; ds < 6; ++ds) {
                const bf16x8 k0 = *(const LAS bf16x8*)(buf + kfrag + ds * 32), k1 = *(const LAS bf16x8*)(buf + kfrag + 32 * KROW + ds * 32);
                a0 = __builtin_amdgcn_mfma_f32_32x32x16_bf16(k0, qf[ds], a0, 0, 0, 0);
                a1 = __builtin_amdgcn_mfma_f32_32x32x16_bf16(k1, qf[ds], a1, 0, 0, 0);
            }
            if (needB) {
#pragma unroll
                for (int ds = 0; ds < 6; ++ds) {
                    const bf16x8 k2 = *(const LAS bf16x8*)(buf + kfrag + 64 * KROW + ds * 32), k3 = *(const LAS bf16x8*)(buf + kfrag + 96 * KROW + ds * 32);
                    b0 = __builtin_amdgcn_mfma_f32_32x32x16_bf16(k2, qf[ds], b0, 0, 0, 0);
                    b1 = __builtin_amdgcn_mfma_f32_32x32x16_bf16(k3, qf[ds], b1, 0, 0, 0);
                }
            }
#pragma unroll
            for (int r = 0; r < 16; ++r) { const int kp = TK * kt + crow(r, hi); if (kp > qpos) a0[r] = NEGM; if (kp + 32 > qpos) a1[r] = NEGM; if (kp + 64 > qpos) b0[r] = NEGM; if (kp + 96 > qpos) b1[r] = NEGM; }
            sm64(a0, a1, m, l, o0, o1, b0, b1, needB);
            { const bf16x8 p00 = pack_p(a0, 0), p01 = pack_p(a0, 1), p10 = pack_p(a1, 0), p11 = pack_p(a1, 1);
              pv_block(o0, buf + vfrag, p00, p01); pv_block(o0, buf + vfrag + 2048, p10, p11);
              pv_block(o1, buf + vfrag + TK * 64, p00, p01); pv_block(o1, buf + vfrag + TK * 64 + 2048, p10, p11); }
            if (needB) {
                sm64(b0, b1, m, l, o0, o1, a0, a1, false);
                const bf16x8 p00 = pack_p(b0, 0), p01 = pack_p(b0, 1), p10 = pack_p(b1, 0), p11 = pack_p(b1, 1);
                pv_block(o0, buf + vfrag + 4096, p00, p01); pv_block(o0, buf + vfrag + 6144, p10, p11);
                pv_block(o1, buf + vfrag + TK * 64 + 4096, p00, p01); pv_block(o1, buf + vfrag + TK * 64 + 6144, p10, p11);
            }

        }
        if (kt + 1 < nt) MLA_STORE(lds + ((kt + 1) & 1) * BUFB);
        if (pid < 131072) {
            asm volatile("s_waitcnt vmcnt(0)" ::: "memory");
            const f32x4 xv = *(const LAS f32x4*)(piece + 16 * lane);
            const int idx = pid & 65535, col = (idx & 3) * 256 + 4 * lane;
            f32x4 sc = {SV, SV, SV, SV};
            if ((pid >> 16) == 0) { const f32x4 gv_ = *(const LAS f32x4*)(lds + MLA_G_OFF + 4 * col); sc = (f32x4){gv_.x * SU, gv_.y * SU, gv_.z * SU, gv_.w * SU}; }
            unsigned char* dst = ((pid >> 16) ? V8 : U8) + (size_t)(col >> 7) * ((size_t)16384 * 128) + (size_t)(idx >> 2) * 128 + (col & 127);
            *(unsigned*)dst = pk_fp8x4(xv.x * sc.x, xv.y * sc.y, xv.z * sc.z, xv.w * sc.w);
        }
        __syncthreads();
        }
#undef MLA_LOAD
#undef MLA_STORE
    __builtin_amdgcn_s_setprio(0);
    l = swapsum(l);
    store_o(Mixed + (tok0 + qpos) * DM + 512 + h * 64, o0, o1, 1.0f / l, hi);
}

constexpr int DIL_KR = 144, DIL_VR = 160, DIL_VOFF = 32 * DIL_KR, DIL_WLDS = 32 * DIL_KR + 32 * DIL_VR;
constexpr int DIL_SROW = 132, DIL_STATE_OFF = 8 * DIL_WLDS;
struct DilBlk { u32x4 k[4]; u32x4 v[4]; };
__device__ __forceinline__ void dil_load(DilBlk& B, const bf16_t* __restrict__ Ka, const bf16_t* __restrict__ Va, size_t hrow0  , int rd, int dl  , int imax, int idx0, int lane) {
#pragma unroll
    for (int i = 0; i < 4; ++i) {
        int ik = idx0 + 8 * i + (lane >> 3); ik = ik < 0 ? 0 : ik; ik = ik > imax ? imax : ik;
        const size_t off = (hrow0 + ((size_t)ik << dl) + rd) * 64 + 8 * (lane & 7);
        B.k[i] = *(const u32x4*)(Ka + off); B.v[i] = *(const u32x4*)(Va + off);
    }
}
__device__ __forceinline__ void pv_block_p(f32x16& o, const LAS unsigned char* vbase, const bf16x8& pb0, const bf16x8& pb1) {
    const s16x4 l0 = vtr(vbase), h0 = vtr(vbase + 8 * DIL_VR), l1 = vtr(vbase + 16 * DIL_VR), h1 = vtr(vbase + 24 * DIL_VR);
    const bf16x8 a0 = {l0[0], l0[1], l0[2], l0[3], h0[0], h0[1], h0[2], h0[3]}, a1 = {l1[0], l1[1], l1[2], l1[3], h1[0], h1[1], h1[2], h1[3]};
    o = __builtin_amdgcn_mfma_f32_32x32x16_bf16(a0, pb0, o, 0, 0, 0);
    o = __builtin_amdgcn_mfma_f32_32x32x16_bf16(a1, pb1, o, 0, 0, 0);
}
template <bool MASK>
__device__ __forceinline__ void dil_step(const DilBlk& B, LAS unsigned char* wl, const bf16x8 (&qf)[4], float& m, float& l, f32x16& o0, f32x16& o1, int A, int idx0, int lane) {
    const int r32 = lane & 31, hi = lane >> 5;
    {
        LAS unsigned char* kp = wl + (lane >> 3) * DIL_KR + (lane & 7) * 16;
        LAS unsigned char* vp = wl + DIL_VOFF + (lane >> 3) * DIL_VR + (lane & 7) * 16;
#pragma unroll
        for (int i = 0; i < 4; ++i) { *(LAS u32x4*)(kp + 8 * i * DIL_KR) = B.k[i]; *(LAS u32x4*)(vp + 8 * i * DIL_VR) = B.v[i]; }
    }
    const float nm = -m;
    f32x16 s = {nm, nm, nm, nm, nm, nm, nm, nm, nm, nm, nm, nm, nm, nm, nm, nm};
    { const LAS unsigned char* kfr = wl + r32 * DIL_KR + 16 * hi;
#pragma unroll
      for (int ds = 0; ds < 4; ++ds) s = __builtin_amdgcn_mfma_f32_32x32x16_bf16(*(const LAS bf16x8*)(kfr + 32 * ds), qf[ds], s, 0, 0, 0); }
    if (MASK) {
        const int qi = A + r32;
#pragma unroll
        for (int r = 0; r < 16; ++r) { const int ki = idx0 + crow(r, hi), dist = qi - ki; if (ki < 0 || dist < 0 || dist > 128) s[r] = NEGM; }
    }
    float mx = max3f(s[0], s[1], s[2]);
#pragma unroll
    for (int r = 3; r < 15; r += 2) mx = max3f(mx, s[r], s[r + 1]);
    mx = fmaxf(mx, s[15]);
    mx = swapmax(mx);
    if (__builtin_expect(__builtin_amdgcn_ballot_w64(mx > THR) != 0ull, 0)) {
        const float dl_ = fmaxf(mx, 0.f), alpha = __builtin_amdgcn_exp2f(-dl_);
        m += dl_; l *= alpha;
#pragma unroll
        for (int r = 0; r < 16; ++r) { s[r] -= dl_; o0[r] *= alpha; o1[r] *= alpha; }
    }
    float rs = 0.f;
#pragma unroll
    for (int r = 0; r < 16; ++r) { s[r] = __builtin_amdgcn_exp2f(s[r]); rs += s[r]; }
    l += rs;
    const bf16x8 p0 = pack_p(s, 0), p1 = pack_p(s, 1);
    const int i16 = lane & 15;
    const LAS unsigned char* vb = wl + DIL_VOFF + (4 * hi + (i16 >> 2)) * DIL_VR + (16 * ((lane >> 4) & 1) + 4 * (i16 & 3)) * 2;
    pv_block_p(o0, vb, p0, p1);
    pv_block_p(o1, vb + 64, p0, p1);
}
__device__ __forceinline__ void dil_unit(LAS unsigned char* wl, const bf16_t* __restrict__ Qa, const bf16_t* __restrict__ Ka, const bf16_t* __restrict__ Va, bf16_t* __restrict__ Mixed, LAS unsigned char* state,
                                         int b, int h, int p0, int dl, bool first, bool last, int lane, int pflags = 0) {
    const int r32 = lane & 31, hi = lane >> 5;
    const size_t tok0 = (size_t)b * SEQ, hrow0 = (size_t)(b * 8 + h) * SEQ;
    const int qpos = p0 + (r32 << dl);
    const int rd = p0 & ((1 << dl) - 1), A = p0 >> dl, imax = (SEQ - 1 - rd) >> dl;
    DilBlk b0, b1, b2;
#define DLOAD(B_, k_) dil_load(B_, Ka, Va, hrow0, rd, dl, imax, A - 128 + 32 * (k_), lane)
#define DSTEP(MK_, B_, k_) dil_step<MK_>(B_, wl, qf, m, l, o0, o1, A, A - 128 + 32 * (k_), lane)
    DLOAD(b0, 0); DLOAD(b1, 1);
    bf16x8 qf[4];
    { const bf16_t* qrow = Qa + (hrow0 + qpos) * 64 + 8 * hi;
#pragma unroll
      for (int ds = 0; ds < 4; ++ds) qf[ds] = *(const bf16x8*)(qrow + 16 * ds); }
    float m = 0.f, l = 0.f; f32x16 o0 = {}, o1 = {};
    LAS unsigned* st = (LAS unsigned*)(state + ((qpos & 511) * DIL_SROW));
    if (!first) {
        m = __builtin_bit_cast(float, st[32]); l = hi ? 0.f : 1.f;
#pragma unroll
        for (int g = 0; g < 4; ++g) {
            const unsigned a0 = st[4 * g + 2 * hi], a1 = st[4 * g + 2 * hi + 1], c0 = st[16 + 4 * g + 2 * hi], c1 = st[16 + 4 * g + 2 * hi + 1];
            o0[4 * g] = bf_lo(a0); o0[4 * g + 1] = bf_hi(a0); o0[4 * g + 2] = bf_lo(a1); o0[4 * g + 3] = bf_hi(a1);
            o1[4 * g] = bf_lo(c0); o1[4 * g + 1] = bf_hi(c0); o1[4 * g + 2] = bf_lo(c1); o1[4 * g + 3] = bf_hi(c1);
        }
    }
    const bool early = A - 96 < 0;
#ifdef PROBE_LO
    if (pflags & 32) { o0[0] += __builtin_bit_cast(float, b0.k[0].x ^ b1.k[0].x ^ b0.v[3].w ^ b1.v[3].w); l = 1.f; } else {
#endif
    DLOAD(b2, 2);
    DSTEP(true, b0, 0);
    DLOAD(b0, 3);
    if (early) DSTEP(true, b1, 1); else DSTEP(false, b1, 1);
    DLOAD(b1, 4);
    if (early) DSTEP(true, b2, 2); else DSTEP(false, b2, 2);
    if (early) DSTEP(true, b0, 3); else DSTEP(false, b0, 3);
    DSTEP(true, b1, 4);
#ifdef PROBE_LO
    }
#endif
#undef DLOAD
#undef DSTEP
    l = swapsum(l);
    const float inv = 1.0f / l;
    if (last) store_o(Mixed + (tok0 + qpos) * DM + h * 64, o0, o1, inv, hi);
    else {
#pragma unroll
        for (int g = 0; g < 4; ++g) {
            st[4 * g + 2 * hi] = pk_bf16(o0[4 * g] * inv, o0[4 * g + 1] * inv); st[4 * g + 2 * hi + 1] = pk_bf16(o0[4 * g + 2] * inv, o0[4 * g + 3] * inv);
            st[16 + 4 * g + 2 * hi] = pk_bf16(o1[4 * g] * inv, o1[4 * g + 1] * inv); st[16 + 4 * g + 2 * hi + 1] = pk_bf16(o1[4 * g + 2] * inv, o1[4 * g + 3] * inv);
        }
        if (hi == 0) st[32] = __builtin_bit_cast(unsigned, m + __builtin_amdgcn_logf(l));
    }
}
__device__ __forceinline__ void dil_segment(LAS unsigned char* lds, const bf16_t* __restrict__ Qa, const bf16_t* __restrict__ Ka, const bf16_t* __restrict__ Va, bf16_t* __restrict__ Mixed,
                                            int sg, int wave, int lane, int pflags = 0) {
    const int seg = sg & 15, h = (sg >> 4) & 7, b = sg >> 7, base = 512 * seg;
    LAS unsigned char* wl = lds + wave * DIL_WLDS;
#pragma unroll 1
    for (int pass = 0; pass < ((pflags & 64) ? 1 : 3); ++pass) {
        const int dl = 2 * pass;
#pragma unroll 1
        for (int j = wave; j < 16; j += 8) {
            const int rd = j & ((1 << dl) - 1), cj = j >> dl;
            dil_unit(wl, Qa, Ka, Va, Mixed, lds + DIL_STATE_OFF, b, h, base + rd + ((32 * cj) << dl), dl, pass == 0, pass == 2, lane, pflags);
        }
        if (pass < 2) __syncthreads();
    }
}
}

namespace peer {
__device__ __forceinline__ void ins16(unsigned (&L)[16], unsigned key) {
#pragma unroll
    for (int i = 0; i < 16; ++i) { const unsigned hi_ = L[i] > key ? L[i] : key; key = L[i] > key ? key : L[i]; L[i] = hi_; }
}
__device__ __forceinline__ void ce(unsigned& a, unsigned& b) { const unsigned hi_ = a > b ? a : b, lo_ = a > b ? b : a; a = hi_; b = lo_; }
__device__ __forceinline__ void sort8(unsigned (&v)[8]) {
    ce(v[0], v[1]); ce(v[2], v[3]); ce(v[4], v[5]); ce(v[6], v[7]); ce(v[0], v[2]); ce(v[1], v[3]); ce(v[4], v[6]); ce(v[5], v[7]); ce(v[1], v[2]); ce(v[5], v[6]);
    ce(v[0], v[4]); ce(v[3], v[7]); ce(v[1], v[5]); ce(v[2], v[6]); ce(v[1], v[4]); ce(v[3], v[6]); ce(v[2], v[4]); ce(v[3], v[5]); ce(v[3], v[4]);
}
__device__ __forceinline__ void bmerge16(unsigned (&v)[16]) {
#pragma unroll
    for (int k = 8; k >= 1; k >>= 1)
#pragma unroll
        for (int i = 0; i < 16; ++i) if ((i & k) == 0) ce(v[i], v[i + k]);
}
__device__ __forceinline__ float dec16(unsigned key) { const unsigned s = key >> 16; const unsigned b = (s & 0x8000u) ? (s & 0x7fffu) : (~s & 0xffffu); return (float)__builtin_bit_cast(_Float16, (unsigned short)b); }
__device__ __forceinline__ unsigned enc32(float f) { const unsigned u = __builtin_bit_cast(unsigned, f); return (u & 0x80000000u) ? ~u : (u | 0x80000000u); }
__device__ __forceinline__ float dec32(unsigned s) { const unsigned u = (s & 0x80000000u) ? (s & 0x7fffffffu) : ~s; return __builtin_bit_cast(float, u); }
__device__ __forceinline__ float gelu1(float v) {
    const float av = fabsf(v), t = __builtin_amdgcn_rcpf(av * 0.2316418882f + 1.0f);
    float q = t * 0.5307027145f + (-0.7265760135f); q = q * t + 0.7107068705f; q = q * t + (-0.142248368f); q = q * t + 0.127414796f; q = q * t;
    const float e = __builtin_amdgcn_exp2f((v * v) * (-0.72134752044f));
    const float mm = v * (q * e);
    return v < 0.f ? mm : v - mm;
}
struct CandTab { unsigned char i[52], j[52]; };
__host__ __device__ constexpr CandTab make_cands() {
    CandTab t{}; int n = 0;
    for (int i = 0; i < 16; ++i) for (int j = 0; j < 16; ++j) if ((i + 1) * (j + 1) <= 16) { t.i[n] = (unsigned char)i; t.j[n] = (unsigned char)j; ++n; }
    for (; n < 52; ++n) { t.i[n] = 15; t.j[n] = 15; }
    return t;
}

}

namespace peer2 {
__device__ __forceinline__ int ld_of(int j) { const int rho = 16 * ((j >> 2) & 3) + 4 * ((j >> 4) & 3) + (j & 3); return (j >> 6) * 64 + (rho & 7) * 8 + (rho >> 3); }

__device__ __forceinline__ void topk_phase(LAS unsigned char* lds, const bf16_t* __restrict__ Sc, const float* __restrict__ ssq_h, unsigned short* __restrict__ Pe_slot, unsigned short* __restrict__ Pe_ld,
                                           float* __restrict__ Pg, float* __restrict__ rstd_h, int gw, int ngw) {
    const int lane = threadIdx.x & 63, wid = __builtin_amdgcn_readfirstlane(threadIdx.x >> 6);
    LAS unsigned char* tile = lds + wid * 12288;
    LAS unsigned* lists = (LAS unsigned*)(tile + 8192);
    constexpr peer::CandTab CT = peer::make_cands();
    u32x4 nx[8];
#define TK_LOAD(g_, hh_) do { _Pragma("unroll") for (int i_ = 0; i_ < 8; ++i_) { const int s_ = 8 * i_ + (lane >> 3); \
        nx[i_] = *(const u32x4*)(Sc + (size_t)(4 * (g_) + (s_ >> 4)) * 2048 + (s_ & 15) * 128 + (hh_) * 64 + (lane & 7) * 8); } } while (0)
#define TK_WRITE() do { _Pragma("unroll") for (int i_ = 0; i_ < 8; ++i_) { const int s_ = 8 * i_ + (lane >> 3); *(LAS u32x4*)(tile + s_ * 128 + (((lane & 7) ^ (s_ & 7)) << 4)) = nx[i_]; } } while (0)
    if (gw < T / 4) TK_LOAD(gw, 0);
    for (int g = gw; g < T / 4; g += ngw) {
        const int t4 = lane >> 4, hp = lane & 15, tok = 4 * g + t4;
        unsigned L[16];
        {
            const LAS unsigned char* seg = tile + lane * 128;
#pragma unroll 1
            for (int gq = 0; gq < 8; ++gq) {
                if (gq == 0) { TK_WRITE(); TK_LOAD(g, 1); }
                if (gq == 4) { TK_WRITE(); if (g + ngw < T / 4) TK_LOAD(g + ngw, 0); }
                const int c0 = 2 * (gq & 3);
                const u32x4 w0 = *(const LAS u32x4*)(seg + ((c0 ^ (lane & 7)) << 4)), w1 = *(const LAS u32x4*)(seg + (((c0 + 1) ^ (lane & 7)) << 4));
                unsigned ka[8], kb[8];
#pragma unroll
                for (int e = 0; e < 8; ++e) {
                    const unsigned wa = (e >> 1) == 0 ? w0.x : ((e >> 1) == 1 ? w0.y : ((e >> 1) == 2 ? w0.z : w0.w)), wb = (e >> 1) == 0 ? w1.x : ((e >> 1) == 1 ? w1.y : ((e >> 1) == 2 ? w1.z : w1.w));
                    const unsigned ba = (e & 1) ? (wa >> 16) : (wa & 0xffffu), bb = (e & 1) ? (wb >> 16) : (wb & 0xffffu);
                    const unsigned sa = (ba & 0x8000u) ? (~ba & 0xffffu) : (ba | 0x8000u), sb = (bb & 0x8000u) ? (~bb & 0xffffu) : (bb | 0x8000u);
                    ka[e] = (sa << 16) | (unsigned)(127 - (16 * gq + e)); kb[e] = (sb << 16) | (unsigned)(127 - (16 * gq + 8 + e));
                }
                peer::sort8(ka); peer::sort8(kb);
                unsigned G[16];
#pragma unroll
                for (int i = 0; i < 8; ++i) { G[i] = ka[i]; G[8 + i] = kb[7 - i]; }
                peer::bmerge16(G);
                if (gq == 0) {
#pragma unroll
                    for (int i = 0; i < 16; ++i) L[i] = G[i];
                } else {
#pragma unroll
                    for (int i = 0; i < 16; ++i) L[i] = L[i] > G[15 - i] ? L[i] : G[15 - i];
                    peer::bmerge16(L);
                }
            }
        }
#pragma unroll
        for (int i = 0; i < 16; ++i) lists[lane * 16 + i] = L[i];
        const int p = hp & 1;
        float av[16], bv[16];
#pragma unroll
        for (int i = 0; i < 16; ++i) { const unsigned o = __shfl_xor(L[i], 1); av[i] = peer::dec16(p ? o : L[i]); bv[i] = peer::dec16(p ? L[i] : o); }
        unsigned M[16];
        {
            unsigned C[32];
#pragma unroll
            for (int k = 0; k < 25; ++k) {
                const int i0 = CT.i[2 * k], j0 = CT.j[2 * k], i1 = CT.i[2 * k + 1], j1 = CT.j[2 * k + 1];
                const float s0 = av[i0] + bv[j0], s1 = av[i1] + bv[j1];
                const float sm = p ? s1 : s0; const unsigned fl = p ? (unsigned)(i1 * 16 + j1) : (unsigned)(i0 * 16 + j0);
                C[k] = (peer::enc32(sm) & 0xffffff00u) | (255u - fl);
            }
#pragma unroll
            for (int k = 25; k < 32; ++k) C[k] = 0u;
            unsigned g0[8], g1[8], g2[8], g3[8];
#pragma unroll
            for (int i = 0; i < 8; ++i) { g0[i] = C[i]; g1[i] = C[8 + i]; g2[i] = C[16 + i]; g3[i] = C[24 + i]; }
            peer::sort8(g0); peer::sort8(g1); peer::sort8(g2); peer::sort8(g3);
            unsigned H[16];
#pragma unroll
            for (int i = 0; i < 8; ++i) { M[i] = g0[i]; M[8 + i] = g1[7 - i]; H[i] = g2[i]; H[8 + i] = g3[7 - i]; }
            peer::bmerge16(M); peer::bmerge16(H);
#pragma unroll
            for (int i = 0; i < 16; ++i) M[i] = M[i] > H[15 - i] ? M[i] : H[15 - i];
            peer::bmerge16(M);
        }
        unsigned R[16];
#pragma unroll
        for (int k = 0; k < 16; ++k) { const unsigned o = __shfl_xor(M[15 - k], 1); R[k] = M[k] > o ? M[k] : o; }
        float rv[16], mx = -INFINITY;
#pragma unroll
        for (int k = 0; k < 16; ++k) { rv[k] = peer::dec32(R[k] & 0xffffff00u); mx = fmaxf(mx, rv[k]); }
        float sum = 0.f;
#pragma unroll
        for (int k = 0; k < 16; ++k) { rv[k] = __builtin_amdgcn_exp2f((rv[k] - mx) * LOG2E); sum += rv[k]; }
        const float isum = 1.0f / sum;
        {
            const int h = hp >> 1;
            const LAS unsigned* la = lists + (lane & ~1) * 16; const LAS unsigned* lb = lists + (lane | 1) * 16;
#pragma unroll
            for (int k = 0; k < 8; ++k) {
                const unsigned fl = 255u - (R[k] & 0xffu);
                const unsigned i1 = 127u - (la[fl >> 4] & 0x7fu), i2 = 127u - (lb[fl & 15u] & 0x7fu);
                const int j = h * 16 + p * 8 + k, sl = j;
                const unsigned short e = (unsigned short)(i1 * 128u + i2);
                Pe_slot[(size_t)tok * 128 + sl] = e;
                Pe_ld[(size_t)tok * 128 + ld_of(j)] = e;
                Pg[(size_t)tok * 128 + sl] = rv[k] * isum;
            }
        }
        if (hp == 0) {
            float s = 0.f;
#pragma unroll
            for (int k = 0; k < 8; ++k) { const f32x4 q = *(const f32x4*)(ssq_h + (size_t)tok * 32 + 4 * k); s += (q.x + q.y) + (q.z + q.w); }
            rstd_h[tok] = 1.0f / sqrtf(s * (1.f / 1024.f) + EPS);
        }
    }
#undef TK_LOAD
#undef TK_WRITE
}

struct UG { u32x4 v[8]; };
struct UIDS { u32x4 e0, e1, b0, b1; };
__device__ __forceinline__ void u_ids(UIDS& I, const unsigned short* __restrict__ Pe_ld, const unsigned char* __restrict__ Hx, int tok, int lane) {
    const u32x4* ip = (const u32x4*)(Pe_ld + (size_t)tok * 128 + (lane >> 3) * 8);
    I.e0 = ip[0]; I.e1 = ip[8];
    const unsigned char* hrow = Hx + (size_t)tok * 128 + 32 * (lane >> 4);
    I.b0 = *(const u32x4*)hrow; I.b1 = *(const u32x4*)(hrow + 16);
}
__device__ __forceinline__ void u_gather(UG& F, const u32x4& w, const unsigned char* __restrict__ Ul  , unsigned emask, unsigned loff = 0u  ) {
#pragma unroll
    for (int i = 0; i < 8; ++i) {
        const unsigned word = (i >> 1) == 0 ? w.x : ((i >> 1) == 1 ? w.y : ((i >> 1) == 2 ? w.z : w.w));
        const unsigned e = ((i & 1) ? (word >> 16) : (word & 0xffffu)) & emask;
        F.v[i] = *(const u32x4*)(Ul + (e * 128u + loff));
    }
}
template <int PM = 0> __device__ __forceinline__ void u_compute(u32x4& z0, u32x4& z1, const UG& F, const u32x4& b0, const u32x4& b1, LAS unsigned char* hl  , int lane) {
    if (PM == 0) {
        LAS unsigned char* wp = hl + (lane >> 3) * 128 + (((lane & 7) ^ (lane >> 3)) << 4);
#pragma unroll
        for (int i = 0; i < 8; ++i) *(LAS u32x4*)(wp + i * 1024) = F.v[i];
    }
    const v8i bfr = {(int)b0.x, (int)b0.y, (int)b0.z, (int)b0.w, (int)b1.x, (int)b1.y, (int)b1.z, (int)b1.w};
    const int r16 = lane & 15, kb = lane >> 4;
    const LAS unsigned char* rp = hl + r16 * 128;
    const int p0 = ((2 * kb) ^ (r16 & 7)) << 4, p1 = ((2 * kb + 1) ^ (r16 & 7)) << 4;
    f32x4 acc[4];
#pragma unroll
    for (int g = 0; g < 4; ++g) {
        u32x4 a0, a1; if (PM == 0) { a0 = *(const LAS u32x4*)(rp + g * 2048 + p0); a1 = *(const LAS u32x4*)(rp + g * 2048 + p1); } else { a0 = F.v[2 * g]; a1 = F.v[2 * g + 1]; }
        const v8i afr = {(int)a0.x, (int)a0.y, (int)a0.z, (int)a0.w, (int)a1.x, (int)a1.y, (int)a1.z, (int)a1.w};
        acc[g] = __builtin_amdgcn_mfma_scale_f32_16x16x128_f8f6f4(afr, bfr, (f32x4){0.f, 0.f, 0.f, 0.f}, 0, 0, 0, 0, 0, 0);
    }
    z0.x = pk_bf16(acc[0][0], acc[0][1]); z0.y = pk_bf16(acc[0][2], acc[0][3]); z0.z = pk_bf16(acc[1][0], acc[1][1]); z0.w = pk_bf16(acc[1][2], acc[1][3]);
    z1.x = pk_bf16(acc[2][0], acc[2][1]); z1.y = pk_bf16(acc[2][2], acc[2][3]); z1.z = pk_bf16(acc[3][0], acc[3][1]); z1.w = pk_bf16(acc[3][2], acc[3][3]);
}
constexpr int U_REC = 512, U_CH = 16, U_STAGE = 8192, U_WLDS = U_STAGE + U_CH * U_REC;
template <int PM = 0> __device__ __forceinline__ void u_phase(LAS unsigned char* lds, const unsigned char* __restrict__ Hb8, const unsigned char* __restrict__ U8, const unsigned short* __restrict__ Pe_ld, bf16_t* __restrict__ Zp, int x, int wg, int nwg, unsigned emask = 0xffffu) {
    const int lane = threadIdx.x & 63, wid = __builtin_amdgcn_readfirstlane(threadIdx.x >> 6);
    LAS unsigned char* wl = lds + wid * U_WLDS;
    LAS unsigned char* rb = wl + U_STAGE;
    const unsigned rb_u = (unsigned)__builtin_amdgcn_readfirstlane((int)(unsigned)(uintptr_t)rb);
    const unsigned char* Hx = Hb8 + (size_t)x * ((size_t)T * 128);
    const unsigned char* Ul = U8 + (size_t)x * ((size_t)16384 * 128); const unsigned loff = 16u * (lane & 7);
    bf16_t* Zx = Zp + (size_t)x * T * 128;
    const int n = (T - wg + nwg - 1) / nwg;
    if (n <= 0) return;
    const int nch = (n + U_CH - 1) / U_CH;
#define UTOK(k) (wg + ((k) < n ? (k) : n - 1) * nwg)
#define USB() __builtin_amdgcn_sched_barrier(0)
    const int w32 = lane & 31, sub = lane >> 5;
    const unsigned char* rbase = w32 < 16 ? (const unsigned char*)Pe_ld + 16 * w32 : (w32 < 24 ? Hx + 16 * (w32 - 16) : (const unsigned char*)Pe_ld);
    const unsigned rstride = (w32 >= 16 && w32 < 24) ? 128u : 256u;
#pragma unroll 1
    for (int c = 0; c < nch; ++c) {
#pragma unroll
        for (int i = 0; i < U_CH / 2; ++i)
            glds16(rbase + (size_t)UTOK(c * U_CH + 2 * i + sub) * rstride, rb_u + i * 1024);
        asm volatile("s_waitcnt vmcnt(0)" ::: "memory");
        UG f0, f1;
        { const u32x4 e0 = *(const LAS u32x4*)(rb + (lane >> 3) * 16); u_gather(f0, e0, Ul, emask, loff); }
#pragma unroll 1
        for (int i = 0; i < U_CH; ++i) {
            const int k = c * U_CH + i;
            const LAS unsigned char* rec = rb + i * U_REC;
            const LAS unsigned char* nrec = (i + 1 < U_CH) ? rec + U_REC : rec;
            const u32x4 e1 = *(const LAS u32x4*)(rec + 128 + (lane >> 3) * 16), e0n = *(const LAS u32x4*)(nrec + (lane >> 3) * 16);
            const u32x4 bk0 = *(const LAS u32x4*)(rec + 256 + 32 * (lane >> 4)), bk1 = *(const LAS u32x4*)(rec + 256 + 32 * (lane >> 4) + 16);
            u32x4 za, zb, zc, zd;
            u_gather(f1, e1, Ul, emask, loff);
            USB(); u_compute<PM>(za, zb, f0, bk0, bk1, wl, lane); USB();
            u_gather(f0, e0n, Ul, emask, loff);
            USB(); u_compute<PM>(zc, zd, f1, bk0, bk1, wl, lane); USB();
            if ((lane & 15) == 0 && k < n) { bf16_t* zr_ = Zx + (size_t)UTOK(k) * 128 + 16 * (lane >> 4); *(u32x4*)zr_ = za; *(u32x4*)(zr_ + 8) = zb; *(u32x4*)(zr_ + 64) = zc; *(u32x4*)(zr_ + 72) = zd; }
        }
        asm volatile("s_waitcnt vmcnt(0) lgkmcnt(0)" ::: "memory");
    }
#undef UTOK
#undef USB
}

__device__ __forceinline__ float dppf(float v, int ctrl_sel) {
    const int s = __builtin_bit_cast(int, v);
    const int r = ctrl_sel == 0 ? __builtin_amdgcn_update_dpp(0, s, 0xB1, 0xF, 0xF, true) : ctrl_sel == 1 ? __builtin_amdgcn_update_dpp(0, s, 0x4E, 0xF, 0xF, true)
                : ctrl_sel == 2 ? __builtin_amdgcn_update_dpp(0, s, 0x141, 0xF, 0xF, true) : ctrl_sel == 3 ? __builtin_amdgcn_update_dpp(0, s, 0x140, 0xF, 0xF, true) : __builtin_amdgcn_update_dpp(0, s, 0x128, 0xF, 0xF, true);
    return __builtin_bit_cast(float, r);
}
constexpr float SA = 64.f;
__device__ __forceinline__ void act_phase(LAS unsigned char* lds, const bf16_t* __restrict__ Zp, const unsigned short* __restrict__ Pe_slot, const float* __restrict__ Pg, const float* __restrict__ ssq_h,
                                          unsigned short* __restrict__ PE2, unsigned char* __restrict__ PA2, int gw, int ngw) {
    const int lane = threadIdx.x & 63, wid = __builtin_amdgcn_readfirstlane(threadIdx.x >> 6);
    LAS unsigned short* lid = (LAS unsigned short*)(lds + wid * 512);
    LAS unsigned char* lw = lds + wid * 512 + 256;
    unsigned zw[8], ew; f32x2 gg; float sp;
#define ACT_LOAD(t_) do { const size_t o_ = (size_t)(t_) * 128 + 2 * lane; _Pragma("unroll") for (int xx = 0; xx < 8; ++xx) zw[xx] = *(const unsigned*)(Zp + (size_t)xx * T * 128 + o_); \
        ew = *(const unsigned*)(Pe_slot + o_); gg = *(const f32x2*)(Pg + o_); sp = ssq_h[(size_t)(t_) * 32 + (lane & 31)]; } while (0)
    if (gw < T) ACT_LOAD(gw);
    for (int tok = gw; tok < T; tok += ngw) {
        float z0 = 0.f, z1 = 0.f;
#pragma unroll
        for (int xx = 0; xx < 8; ++xx) { z0 += bf_lo(zw[xx]); z1 += bf_hi(zw[xx]); }
        const unsigned e2 = ew; const f32x2 g2 = gg;
        float s = sp;
        if (tok + ngw < T) ACT_LOAD(tok + ngw);
        s += dppf(s, 0); s += dppf(s, 1); s += dppf(s, 2); s += dppf(s, 3);
        const int si = __builtin_bit_cast(int, s);
        const float tot = __builtin_bit_cast(float, __builtin_amdgcn_readlane(si, 0)) + __builtin_bit_cast(float, __builtin_amdgcn_readlane(si, 16));
        const float zs = (1.0f / sqrtf(tot * (1.f / 1024.f) + EPS)) * (1.0f / (SU * SX));
        const float w0 = fminf(fmaxf(peer::gelu1(z0 * zs) * g2.x * SA, -440.f), 440.f), w1 = fminf(fmaxf(peer::gelu1(z1 * zs) * g2.y * SA, -440.f), 440.f);
        const unsigned w8 = (unsigned)__builtin_amdgcn_cvt_pk_fp8_f32(w0, w1, 0, false);
        const int sl0 = 2 * lane, d0 = (sl0 & 7) * 16 + (sl0 >> 3), d1 = ((sl0 + 1) & 7) * 16 + (sl0 >> 3);
        lid[d0] = (unsigned short)(e2 & 0xffffu); lid[d1] = (unsigned short)(e2 >> 16);
        lw[d0] = (unsigned char)(w8 & 0xffu); lw[d1] = (unsigned char)((w8 >> 8) & 0xffu);
        const u32x4 ov = *(const LAS u32x4*)(lds + wid * 512 + 16 * lane);
        if (lane < 16) *(u32x4*)(PE2 + (size_t)tok * 128 + 8 * lane) = ov;
        else if (lane < 24) *(u32x4*)(PA2 + (size_t)tok * 128 + 16 * (lane - 16)) = ov;
    }
#undef ACT_LOAD
}

struct VG { u32x4 v[8]; u32x2 w; };
template <int PM = 0> __device__ __forceinline__ void v_gather(VG& Gt, const u32x4& ew, const u32x2& ww, const unsigned char* __restrict__ vb  , unsigned loff  , unsigned emask) {
    Gt.w = ww;
#pragma unroll
    for (int i = 0; i < 8; ++i) {
        const unsigned word = (i >> 1) == 0 ? ew.x : ((i >> 1) == 1 ? ew.y : ((i >> 1) == 2 ? ew.z : ew.w));
        const unsigned e = ((i & 1) ? (word >> 16) : (word & 0xffffu)) & emask;
        if (PM == 1 && (i & 1)) Gt.v[i] = Gt.v[i - 1]; else
        Gt.v[i] = *(const u32x4*)(vb + (e * 128u + loff));
    }
}
struct VSel { unsigned lo[4], hi[4]; };
__device__ __forceinline__ void v_compute(f32x4& accL, f32x4& accH, const VG& Gt, const VSel& S) {
#pragma unroll
    for (int i = 0; i < 8; ++i) {
        const unsigned d = i < 4 ? Gt.w.x : Gt.w.y;
        const unsigned b0 = __builtin_amdgcn_perm(d, d, S.lo[i & 3]), b1 = __builtin_amdgcn_perm(d, d, S.hi[i & 3]);
        const long aL = (long)(((unsigned long long)Gt.v[i].y << 32) | Gt.v[i].x), aH = (long)(((unsigned long long)Gt.v[i].w << 32) | Gt.v[i].z);
        const long bb = (long)(((unsigned long long)b1 << 32) | b0);
        accL = __builtin_amdgcn_mfma_f32_16x16x32_fp8_fp8(aL, bb, accL, 0, 0, 0);
        accH = __builtin_amdgcn_mfma_f32_16x16x32_fp8_fp8(aH, bb, accH, 0, 0, 0);
    }
}
constexpr int V_REC = 512, V_CH = 16, V_WLDS = V_CH * V_REC + 1024;
template <int PM = 0> __device__ __forceinline__ void v_phase(LAS unsigned char* lds, const unsigned char* __restrict__ V8, const unsigned short* __restrict__ PE2, const unsigned char* __restrict__ PA2, bf16_t* __restrict__ Op, int x, int wg, int nwg, unsigned emask = 0xffffu) {
    const int lane = threadIdx.x & 63, wid = __builtin_amdgcn_readfirstlane(threadIdx.x >> 6), seg8 = lane >> 3, bp = lane & 7;
    LAS unsigned char* rb = lds + wid * V_WLDS;
    LAS float* tr = (LAS float*)(rb + V_CH * V_REC);
    const unsigned rb_u = (unsigned)__builtin_amdgcn_readfirstlane((int)(unsigned)(uintptr_t)rb);
    const unsigned char* vb = V8 + (size_t)x * ((size_t)16384 * 128); const unsigned loff = 16u * (lane & 7);
    bf16_t* Ox = Op + (size_t)x * T * 128;
    VSel S;
    { const unsigned none = 0x0c0c0c0cu, keep = none & ~(0xffu << (8 * (bp & 3)));
#pragma unroll
      for (int q = 0; q < 4; ++q) { const unsigned sq = keep | ((unsigned)q << (8 * (bp & 3))); S.lo[q] = bp < 4 ? sq : none; S.hi[q] = bp < 4 ? none : sq; } }
    const bool dvalid = ((lane >> 3) & 1) == (lane >> 5);
    LAS float* trw = tr + (lane >> 5) * 128 + 64 * ((lane >> 4) & 1) + bp;
    const int n = (T - wg + nwg - 1) / nwg;
    if (n <= 0) return;
    const int nch = (n + V_CH - 1) / V_CH;
#define VTOK(k) (wg + ((k) < n ? (k) : n - 1) * nwg)
    const int w32 = lane & 31, sub = lane >> 5;
    const unsigned char* rbase = w32 < 16 ? (const unsigned char*)PE2 + 16 * w32 : (w32 < 24 ? PA2 + 16 * (w32 - 16) : (const unsigned char*)PE2);
    const unsigned rstride = (w32 >= 16 && w32 < 24) ? 128u : 256u;
    const int roff = seg8 * 32, woff = 256 + seg8 * 16;
#pragma unroll 1
    for (int c = 0; c < nch; ++c) {
        if (PM != 2 || c == 0) {
#pragma unroll
        for (int i = 0; i < V_CH / 2; ++i)
            glds16(rbase + (size_t)VTOK(c * V_CH + 2 * i + sub) * rstride, rb_u + i * 1024);
        asm volatile("s_waitcnt vmcnt(0)" ::: "memory");
        }
        VG g0, g1;
        { const u32x4 ea = *(const LAS u32x4*)(rb + roff); const u32x2 wa = *(const LAS u32x2*)(rb + woff); v_gather<PM>(g0, ea, wa, vb, loff, emask); }
#pragma unroll 1
        for (int i = 0; i < V_CH; ++i) {
            const int k = c * V_CH + i, tok = VTOK(k);
            const LAS unsigned char* rec = rb + i * V_REC;
            const LAS unsigned char* nrec = (i + 1 < V_CH) ? rec + V_REC : rec;
            f32x4 accL = {0.f, 0.f, 0.f, 0.f}, accH = {0.f, 0.f, 0.f, 0.f};
            { const u32x4 ea = *(const LAS u32x4*)(rec + roff + 16); const u32x2 wa = *(const LAS u32x2*)(rec + woff + 8); v_gather<PM>(g1, ea, wa, vb, loff, emask); }
            __builtin_amdgcn_sched_barrier(0);
            v_compute(accL, accH, g0, S);
            { const u32x4 ea = *(const LAS u32x4*)(nrec + roff); const u32x2 wa = *(const LAS u32x2*)(nrec + woff); v_gather<PM>(g0, ea, wa, vb, loff, emask); }
            __builtin_amdgcn_sched_barrier(0);
            v_compute(accL, accH, g1, S);
            if (dvalid) {
#pragma unroll
                for (int r = 0; r < 4; ++r) { trw[16 * r] = accL[r]; trw[16 * r + 8] = accH[r]; }
            }
            const f32x4 oa = *(const LAS f32x4*)(tr + 4 * w32), ob = *(const LAS f32x4*)(tr + 128 + 4 * w32);
            if (lane < 32 && k < n) {
                constexpr float sc = 1.0f / (SA * SV);
                u32x2 w; w.x = pk_bf16((oa.x + ob.x) * sc, (oa.y + ob.y) * sc); w.y = pk_bf16((oa.z + ob.z) * sc, (oa.w + ob.w) * sc); *(u32x2*)(Ox + (size_t)tok * 128 + 4 * lane) = w;
            }
        }
        if (PM != 2) asm volatile("s_waitcnt vmcnt(0) lgkmcnt(0)" ::: "memory");
    }
#undef VTOK
}

__device__ __forceinline__ void final_phase(float* __restrict__ Out, const bf16_t* __restrict__ Hb, const bf16_t* __restrict__ Op, const float* __restrict__ g_final, int gw, int ngw) {
    const int lane = threadIdx.x & 63;
    const f32x4* gr = (const f32x4*)g_final + lane;
    const f32x4 g0 = gr[0], g1 = gr[64], g2 = gr[128], g3 = gr[192];
    const bf16_t* ob = Op + (size_t)(lane >> 5) * T * 128 + 4 * (lane & 31);
    for (int t0 = 4 * gw; t0 < T; t0 += 4 * ngw) {
        u32x2 hh[4][4], o[4][4];
#pragma unroll
        for (int r = 0; r < 4; ++r) {
            const int tok = t0 + r < T ? t0 + r : T - 1;
            const bf16_t* hr = Hb + (size_t)tok * DM + 4 * lane;
#pragma unroll
            for (int j = 0; j < 4; ++j) { hh[r][j] = *(const u32x2*)(hr + 256 * j); o[r][j] = *(const u32x2*)(ob + ((size_t)(2 * j) * T + tok) * 128); }
        }
#pragma unroll
        for (int r = 0; r < 4; ++r) {
            if (t0 + r >= T) break;
            f32x4 y[4];
            float s = 0.f;
#pragma unroll
            for (int j = 0; j < 4; ++j) {
                y[j].x = bf_lo(hh[r][j].x) + bf_lo(o[r][j].x); y[j].y = bf_hi(hh[r][j].x) + bf_hi(o[r][j].x); y[j].z = bf_lo(hh[r][j].y) + bf_lo(o[r][j].y); y[j].w = bf_hi(hh[r][j].y) + bf_hi(o[r][j].y);
                s += (y[j].x * y[j].x + y[j].y * y[j].y) + (y[j].z * y[j].z + y[j].w * y[j].w);
            }
            s += dppf(s, 0); s += dppf(s, 1); s += dppf(s, 2); s += dppf(s, 3);
            const int si = __builtin_bit_cast(int, s);
            const float tot = (__builtin_bit_cast(float, __builtin_amdgcn_readlane(si, 0)) + __builtin_bit_cast(float, __builtin_amdgcn_readlane(si, 16)))
                            + (__builtin_bit_cast(float, __builtin_amdgcn_readlane(si, 32)) + __builtin_bit_cast(float, __builtin_amdgcn_readlane(si, 48)));
            const float r2 = 1.0f / sqrtf(tot * (1.f / 1024.f) + EPS);
            f32x4* yr = (f32x4*)(Out + (size_t)(t0 + r) * DM) + lane;
            yr[0] = (f32x4){y[0].x * r2 * g0.x, y[0].y * r2 * g0.y, y[0].z * r2 * g0.z, y[0].w * r2 * g0.w};
            yr[64] = (f32x4){y[1].x * r2 * g1.x, y[1].y * r2 * g1.y, y[1].z * r2 * g1.z, y[1].w * r2 * g1.w};
            yr[128] = (f32x4){y[2].x * r2 * g2.x, y[2].y * r2 * g2.y, y[2].z * r2 * g2.z, y[2].w * r2 * g2.w};
            yr[192] = (f32x4){y[3].x * r2 * g3.x, y[3].y * r2 * g3.y, y[3].z * r2 * g3.z, y[3].w * r2 * g3.w};
        }
    }
}
}


#define XB_TMO      128
#define XB_XCNT(j)  (256  + 64 * (j))
#define XB_XSUB(j)  (1280 + 64 * (j))
#define XB_XGEN(j)  (2304 + 64 * (j))
#define XB_TOP      3328
#define XB_TOPGEN   3392
#define XCD_BAR_WORDS 3456
#define XB_SPIN_CAP (1u << 18)

__device__ __forceinline__ unsigned xb_ld(unsigned* p)              { return __hip_atomic_load(p, __ATOMIC_RELAXED, __HIP_MEMORY_SCOPE_AGENT); }
__device__ __forceinline__ unsigned xb_add(unsigned* p, unsigned v) { return __hip_atomic_fetch_add(p, v, __ATOMIC_RELAXED, __HIP_MEMORY_SCOPE_AGENT); }
__device__ __forceinline__ unsigned xb_xcc_id() { return (unsigned)__builtin_amdgcn_s_getreg((3 << 11) | 20) & 0xFu; }
#define XB_SPIN(cond, bar) do { unsigned _sp = 0; while (cond) { __builtin_amdgcn_s_sleep(1); \
    if ((++_sp & 255u) == 0u) { if (xb_ld(&(bar)[XB_TMO])) break; if (_sp > XB_SPIN_CAP) { atomicAdd(&(bar)[XB_TMO], 1u); break; } } } } while (0)

struct XcdBarrier {
    unsigned* bar; unsigned x;
    volatile LAS unsigned* st;
};

__device__ __forceinline__ XcdBarrier xcd_barrier_post(unsigned* bar, volatile LAS unsigned* st) {
    XcdBarrier b; b.bar = bar; b.x = xb_xcc_id(); b.st = st;
    if (threadIdx.x == 0) (void)xb_add(&bar[XB_XCNT(b.x)], 1u);
    return b;
}
__device__ __forceinline__ void xcd_barrier_complete(unsigned* bar, unsigned x, unsigned& nloc, unsigned& nx) {
    const unsigned G = gridDim.x * gridDim.y * gridDim.z;
    unsigned sum, cnt, mine, sp = 0u;
    for (;;) {
        sum = 0u; cnt = 0u; mine = 0u;
#pragma unroll
        for (unsigned j = 0; j < 16; ++j) { const unsigned c = xb_ld(&bar[XB_XCNT(j)]); sum += c; cnt += (c > 0u) ? 1u : 0u; mine = (j == x) ? c : mine; }
        if (sum == G) break;
        __builtin_amdgcn_s_sleep(1);
        if ((++sp & 255u) == 0u) { if (xb_ld(&bar[XB_TMO])) break; if (sp > XB_SPIN_CAP) { atomicAdd(&bar[XB_TMO], 1u); break; } }
    }
    nloc = mine > 0u ? mine : 1u; nx = cnt > 0u ? cnt : 1u;
}

__device__ __forceinline__ void xcd_barrier(const XcdBarrier& b) {
    asm volatile("s_waitcnt vmcnt(0)" ::: "memory");
    __syncthreads();
    if (threadIdx.x == 0) {
        unsigned* bar = b.bar;
        __builtin_amdgcn_s_waitcnt(0);
        unsigned nloc = b.st[0], nx = b.st[1];
        if (nloc == 0u) { xcd_barrier_complete(bar, b.x, nloc, nx); b.st[0] = nloc; b.st[1] = nx; }
        const unsigned old = xb_add(&bar[XB_XSUB(b.x)], 1u);
        const unsigned gen = old / nloc;
        if (old + 1u == (gen + 1u) * nloc) {
            __builtin_amdgcn_fence(__ATOMIC_RELEASE, "agent");
            asm volatile("s_waitcnt vmcnt(0)" ::: "memory");
            const unsigned og = xb_add(&bar[XB_TOP], 1u);
            const unsigned tg = og / nx;
            if (og + 1u == (tg + 1u) * nx) xb_add(&bar[XB_TOPGEN], 1u);
            else XB_SPIN(xb_ld(&bar[XB_TOPGEN]) == tg, bar);
            __builtin_amdgcn_fence(__ATOMIC_ACQUIRE, "agent");
            xb_add(&bar[XB_XGEN(b.x)], 1u);
            asm volatile("s_waitcnt vmcnt(0)" ::: "memory");
        } else {
            XB_SPIN(xb_ld(&bar[XB_XGEN(b.x)]) == gen, bar);
            __builtin_amdgcn_fence(__ATOMIC_ACQUIRE, "agent");
            asm volatile("s_waitcnt vmcnt(0)" ::: "memory");
        }
    }
    __syncthreads();
}

constexpr int NWAVES = 8;
constexpr int LDS_BYTES = 147456;
constexpr int MISC_OFF = 146432;

struct Args {
    const float *x, *g_mix, *w_in, *g_cq, *w_uq, *g_ckv, *w_ukv, *w_out, *g_ffn, *w_pq, *sub_keys, *u_emb, *v_emb, *g_final;
    const int* pos; float* out; unsigned char* ws; int ph_lo, ph_hi; unsigned probe_mask; int probe_shift;
};

__device__ __forceinline__ void p0_transpose_item(const float* __restrict__ W, int K, int N, const float* __restrict__ gk, bf16_t* __restrict__ WT, LAS float* scr, int item, int lane) {
    const int nblk = N / 32, kb = item / nblk, nb = item % nblk, k0 = 64 * kb, n0 = 32 * nb;
    float wv[32];
#pragma unroll
    for (int i = 0; i < 32; ++i) { const int kk = 2 * i + (lane >> 5); wv[i] = W[(size_t)(k0 + kk) * N + n0 + (lane & 31)]; if (gk) wv[i] *= gk[k0 + kk]; }
#pragma unroll
    for (int i = 0; i < 32; ++i) { const int kk = 2 * i + (lane >> 5); scr[kk * 33 + (lane & 31)] = wv[i]; }
    asm volatile("s_waitcnt lgkmcnt(0)" ::: "memory");
    const int c = lane & 7;
#pragma unroll
    for (int j = 0; j < 4; ++j) { const int n = (lane >> 3) + 8 * j; const LAS float* s = scr + (8 * c) * 33 + n;
        u32x4 o; o.x = pk_bf16(s[0 * 33], s[1 * 33]); o.y = pk_bf16(s[2 * 33], s[3 * 33]); o.z = pk_bf16(s[4 * 33], s[5 * 33]); o.w = pk_bf16(s[6 * 33], s[7 * 33]);
        *(u32x4*)(WT + (size_t)(n0 + n) * K + k0 + 8 * c) = o; }
    asm volatile("s_waitcnt lgkmcnt(0)" ::: "memory");
}
__device__ __forceinline__ bf16x8 cvt8(const float* p, float s) { const f32x4 a = *(const f32x4*)p, b = *(const f32x4*)(p + 4); u32x4 w; w.x = pk_bf16(a.x * s, a.y * s); w.y = pk_bf16(a.z * s, a.w * s); w.z = pk_bf16(b.x * s, b.y * s); w.w = pk_bf16(b.z * s, b.w * s); return __builtin_bit_cast(bf16x8, w); }
__device__ __forceinline__ void p0_wcomb_item(const float* __restrict__ keys, const float* __restrict__ w_pq, const float* __restrict__ g_ffn, bf16_t* __restrict__ Wc, int item, int lane) {
    const int hp = item >> 7, nblk = (item >> 5) & 3, kblk = item & 31, n0 = 32 * nblk, k0 = 32 * kblk, r32 = lane & 31, hi = lane >> 5;
    const float* ar = keys + ((size_t)hp * 128 + n0 + r32) * 128 + 8 * hi;
    const float* br = w_pq + (size_t)(k0 + r32) * 2048 + hp * 128 + 8 * hi;
    const float gk = g_ffn[k0 + r32];
    f32x16 d = {};
#pragma unroll
    for (int cs = 0; cs < 8; ++cs) d = __builtin_amdgcn_mfma_f32_32x32x16_bf16(cvt8(ar + 16 * cs, 1.f), cvt8(br + 16 * cs, 1.f), d, 0, 0, 0);
#pragma unroll
    for (int r = 0; r < 16; ++r) Wc[((size_t)hp * 128 + n0 + crow(r, hi)) * DM + k0 + r32] = (bf16_t)(pk_bf16(d[r] * gk, 0.f) & 0xffffu);
}
__device__ __forceinline__ void p0_prologue(const Args& a, LAS unsigned char* lds, int gw, int ngw, int lane, int wave) {
    unsigned char* ws = a.ws;
    LAS float* scr = (LAS float*)(lds + wave * 16384);
    bf16_t* Wt_in = (bf16_t*)(ws + WS_WIN); bf16_t* Wt_comb = (bf16_t*)(ws + WS_WCOMB); bf16_t* Wt_out = (bf16_t*)(ws + WS_WOUT); bf16_t* Wt_uq = (bf16_t*)(ws + WS_WUQ); bf16_t* Wt_ukv = (bf16_t*)(ws + WS_WUKV);
    constexpr int I_IN = (DM / 64) * (INW / 32), I_UQ = (256 / 64) * (768 / 32), I_UKV = (128 / 64) * (1024 / 32), I_OUT = (DM / 64) * (DM / 32), I_WC = 2048;
    constexpr int NITEMS = I_IN + I_UQ + I_UKV + I_OUT + I_WC;
    for (int it = gw; it < NITEMS; it += ngw) {
        int r = it;
        if (r < I_IN) { p0_transpose_item(a.w_in, DM, INW, nullptr, Wt_in, scr, r, lane); continue; } r -= I_IN;
        if (r < I_UQ) { p0_transpose_item(a.w_uq, 256, 768, a.g_cq, Wt_uq, scr, r, lane); continue; } r -= I_UQ;
        if (r < I_UKV) { p0_transpose_item(a.w_ukv, 128, 1024, a.g_ckv, Wt_ukv, scr, r, lane); continue; } r -= I_UKV;
        if (r < I_OUT) { p0_transpose_item(a.w_out, DM, DM, nullptr, Wt_out, scr, r, lane); continue; } r -= I_OUT;
        p0_wcomb_item(a.sub_keys, a.w_pq, a.g_ffn, Wt_comb, r, lane);
    }
    const int gt = gw * 64 + lane, ngt = ngw * 64;
    for (int i = gt; i < (2048 - INW) * DM / 8; i += ngt) *(u32x4*)(Wt_in + (size_t)INW * DM + (size_t)i * 8) = (u32x4){0u, 0u, 0u, 0u};
    { bf16_t* HN = (bf16_t*)(ws + WS_HN);
      const f32x4* gr = (const f32x4*)a.g_mix + lane;
      const f32x4 g0 = gr[0], g1 = gr[64], g2 = gr[128], g3 = gr[192];
      for (int m0 = 4 * gw; m0 < T; m0 += 4 * ngw) {
          f32x4 v[4][4];
#pragma unroll
          for (int r = 0; r < 4; ++r) { const f32x4* xr = (const f32x4*)(a.x + (size_t)(m0 + r) * DM) + lane; v[r][0] = xr[0]; v[r][1] = xr[64]; v[r][2] = xr[128]; v[r][3] = xr[192]; }
#pragma unroll
          for (int r = 0; r < 4; ++r) {
              float s = 0.f;
#pragma unroll
              for (int j = 0; j < 4; ++j) s += (v[r][j].x * v[r][j].x + v[r][j].y * v[r][j].y) + (v[r][j].z * v[r][j].z + v[r][j].w * v[r][j].w);
              const float rstd = 1.0f / sqrtf(wave_sum(s) * (1.f / DM) + EPS);
              u32x2* o8 = (u32x2*)(HN + (size_t)(m0 + r) * DM) + lane;
              u32x2 w;
              w.x = pk_bf16(v[r][0].x * rstd * g0.x, v[r][0].y * rstd * g0.y); w.y = pk_bf16(v[r][0].z * rstd * g0.z, v[r][0].w * rstd * g0.w); o8[0] = w;
              w.x = pk_bf16(v[r][1].x * rstd * g1.x, v[r][1].y * rstd * g1.y); w.y = pk_bf16(v[r][1].z * rstd * g1.z, v[r][1].w * rstd * g1.w); o8[64] = w;
              w.x = pk_bf16(v[r][2].x * rstd * g2.x, v[r][2].y * rstd * g2.y); w.y = pk_bf16(v[r][2].z * rstd * g2.z, v[r][2].w * rstd * g2.w); o8[128] = w;
              w.x = pk_bf16(v[r][3].x * rstd * g3.x, v[r][3].y * rstd * g3.y); w.y = pk_bf16(v[r][3].z * rstd * g3.z, v[r][3].w * rstd * g3.w); o8[192] = w;
          } } }
    { float* cosA = (float*)(ws + WS_COSA); float* sinA = (float*)(ws + WS_SINA); float* cosM = (float*)(ws + WS_COSM); float* sinM = (float*)(ws + WS_SINM);
      constexpr float INV16[16] = {1.0f, 0.44036659598350525f, 0.1939227432012558f, 0.08539710193872452f, 0.03760603070259094f, 0.016560440883040428f, 0.007292664609849453f, 0.0032114461064338684f,
                                   0.0014142135623842478f, 0.0006227724370546639f, 0.00027424818836152554f, 0.00012076973507646471f, 5.3182957344688475e-05f, 2.34199997066753e-05f, 1.0313385246263351e-05f, 4.541670477919979e-06f};
      for (int i = gt; i < T * 16; i += ngt) {
          const int tok = i >> 4, j = i & 15;
          const float ang = (float)a.pos[tok] * INV16[j];
          float sn, cs; sincosf(ang, &sn, &cs);
          cosM[tok * 16 + j] = cs; sinM[tok * 16 + j] = sn;
          if ((j & 1) == 0) { cosA[tok * 8 + (j >> 1)] = cs; sinA[tok * 8 + (j >> 1)] = sn; } } }
}

__global__ void __launch_bounds__(NWAVES * 64, 2) mk_fwd(Args a) {
    extern __shared__ __attribute__((aligned(16))) unsigned char lds_raw[];
    LAS unsigned char* lds = (LAS unsigned char*)lds_raw;
    volatile LAS unsigned* MISC = (volatile LAS unsigned*)(lds + MISC_OFF);
    const int tid = threadIdx.x, lane = tid & 63, wave = __builtin_amdgcn_readfirstlane(tid >> 6);
    const int G = gridDim.x, bx = blockIdx.x, vcu = (G % 8 == 0) ? (bx % 8) * (G / 8) + bx / 8 : bx;
    unsigned char* ws = a.ws;
    for (int u = tid; u < 64; u += NWAVES * 64) MISC[u] = 0u;
    __syncthreads();
    XcdBarrier bar = xcd_barrier_post((unsigned*)(ws + WS_CTL), MISC + 8);
    const int lo = a.ph_lo, hi = a.ph_hi;
#ifdef PROBE_LO
#define PMASK a.probe_mask
#else
#define PMASK 0xffffu
#endif
#define IN(k) (lo <= (k) && (k) < hi)
#ifdef PROBE_LO
#define RUN(k) (IN(k) && !(a.probe_shift & 16))
#else
#define RUN(k) IN(k)
#endif
#define SEAM(k) do { if (IN(k) && IN((k) + 1)) xcd_barrier(bar); } while (0)
    const int gw = vcu * NWAVES + wave, ngw = G * NWAVES;

    if (RUN(0)) { p0_prologue(a, lds, gw, ngw, lane, wave); }
    SEAM(0);
    if (RUN(1)) {
        pg8::Gemm g{(const bf16_t*)(ws + WS_HN), (const bf16_t*)(ws + WS_WIN), T, 2048, DM}; pg8::StaticOrder S; S.init(T, 2048, G, bx);
        pg8::EpiProj E{(bf16_t*)(ws + WS_QA), (bf16_t*)(ws + WS_KA), (bf16_t*)(ws + WS_VA), (bf16_t*)(ws + WS_CQ), (bf16_t*)(ws + WS_CKV), (bf16_t*)(ws + WS_KR),
                       (float*)(ws + WS_SSQQ), (float*)(ws + WS_SSQKV), (const float*)(ws + WS_COSA), (const float*)(ws + WS_SINA), (const float*)(ws + WS_COSM), (const float*)(ws + WS_SINM)};
        pg8::gemm_phase<pg8::EpiProj, pg8::StaticOrder, true, true>(lds, g, S, E);
    }
    SEAM(1);
    if (RUN(2)) {
        { int kk = 128; asm volatile("" : "+s"(kk));
          pg8::Gemm g{(const bf16_t*)(ws + WS_CKV), (const bf16_t*)(ws + WS_WUKV), T, 1024, kk}; pg8::StaticOrder S; S.init(T, 1024, G, bx);
          pg8::EpiKv E{(bf16_t*)(ws + WS_KN), (bf16_t*)(ws + WS_VM), (const float*)(ws + WS_SSQKV)};
          pg8::gemm_phase<pg8::EpiKv, pg8::StaticOrder, true, true>(lds, g, S, E); }
        __syncthreads();
        { int kk = 256; asm volatile("" : "+s"(kk));
          pg8::Gemm g{(const bf16_t*)(ws + WS_CQ), (const bf16_t*)(ws + WS_WUQ), T, 768, kk}; pg8::StaticOrder S; S.init(T, 768, G, bx);
          pg8::EpiQm E{(bf16_t*)(ws + WS_QM), (const float*)(ws + WS_SSQQ), (const float*)(ws + WS_COSM), (const float*)(ws + WS_SINM)};
          pg8::gemm_phase<pg8::EpiQm, pg8::StaticOrder, true, true>(lds, g, S, E); }
    }
    SEAM(2);
    if (RUN(3)) {
        if (!(a.probe_shift & 1)) for (int pr = vcu; pr < 256; pr += G) {
            const int bh = pr >> 4, s = pr & 15;
            att::mla_unit(lds, (const bf16_t*)(ws + WS_QM), (const bf16_t*)(ws + WS_KN), (const bf16_t*)(ws + WS_KR), (const bf16_t*)(ws + WS_VM), (bf16_t*)(ws + WS_MIXED), bh >> 3, bh & 7, 31 - s,
                          a.u_emb, a.v_emb, a.g_ffn, ws + WS_U8, ws + WS_V8, pr * 528);
            att::mla_unit(lds, (const bf16_t*)(ws + WS_QM), (const bf16_t*)(ws + WS_KN), (const bf16_t*)(ws + WS_KR), (const bf16_t*)(ws + WS_VM), (bf16_t*)(ws + WS_MIXED), bh >> 3, bh & 7, s,
                          a.u_emb, a.v_emb, a.g_ffn, ws + WS_U8, ws + WS_V8, pr * 528 + 16 * (32 - s));
        }
        if (!(a.probe_shift & 2)) for (int sg = vcu; sg < 256; sg += G)
            att::dil_segment(lds, (const bf16_t*)(ws + WS_QA), (const bf16_t*)(ws + WS_KA), (const bf16_t*)(ws + WS_VA), (bf16_t*)(ws + WS_MIXED), sg, wave, lane, a.probe_shift);
    }
    SEAM(3);
    if (RUN(4)) {
        pg8::Gemm g{(const bf16_t*)(ws + WS_MIXED), (const bf16_t*)(ws + WS_WOUT), T, DM, DM}; pg8::StaticOrder S; S.init(T, DM, G, bx);
        pg8::EpiOut E{a.x, (bf16_t*)(ws + WS_HB), ws + WS_HB8, (float*)(ws + WS_SSQH)};
        pg8::gemm_phase<pg8::EpiOut, pg8::StaticOrder, true, true>(lds, g, S, E);
    }
    SEAM(4);
    if (RUN(5)) {
        pg8::Gemm g{(const bf16_t*)(ws + WS_HB), (const bf16_t*)(ws + WS_WCOMB), T, 2048, DM}; pg8::StaticOrder S; S.init(T, 2048, G, bx);
        pg8::EpiSc E{(bf16_t*)(ws + WS_SC), (const float*)(ws + WS_SSQH)};
        pg8::gemm_phase<pg8::EpiSc, pg8::StaticOrder, true, true>(lds, g, S, E);
    }
    SEAM(5);
    if (RUN(6)) {
        peer2::topk_phase(lds, (const bf16_t*)(ws + WS_SC), (const float*)(ws + WS_SSQH), (unsigned short*)(ws + WS_PESLOT), (unsigned short*)(ws + WS_PEROW), (float*)(ws + WS_PG), (float*)(ws + WS_RSTDH), gw, ngw);
    }
    SEAM(6);
    const int sx = bx % 8, smem = (bx / 8) * NWAVES + wave, scnt = ((G - sx + 7) / 8) * NWAVES;
#ifdef PROBE_LO
    if (RUN(7) && (a.probe_shift & 8)) { peer2::u_phase<1>(lds, ws + WS_HB8, ws + WS_U8, (const unsigned short*)(ws + WS_PEROW), (bf16_t*)(ws + 160 * MiB), sx, smem, scnt, PMASK); } else
#endif
    if (RUN(7)) { peer2::u_phase(lds, ws + WS_HB8, ws + WS_U8, (const unsigned short*)(ws + WS_PEROW), (bf16_t*)(ws + WS_ZP), sx, smem, scnt, PMASK); }
    SEAM(7);
    if (RUN(8)) { peer2::act_phase(lds, (const bf16_t*)(ws + WS_ZP), (const unsigned short*)(ws + WS_PESLOT), (const float*)(ws + WS_PG), (const float*)(ws + WS_SSQH), (unsigned short*)(ws + WS_PE2), ws + WS_PA2, gw, ngw); }
    SEAM(8);
#ifdef PROBE_LO
    if (RUN(9) && (a.probe_shift & 128)) { peer2::v_phase<2>(lds, ws + WS_V8, (const unsigned short*)(ws + WS_PE2), ws + WS_PA2, (bf16_t*)(ws + 160 * MiB), sx, smem, scnt, PMASK); } else
    if (RUN(9) && (a.probe_shift & 4)) { peer2::v_phase<1>(lds, ws + WS_V8, (const unsigned short*)(ws + WS_PE2), ws + WS_PA2, (bf16_t*)(ws + WS_OP), sx, smem, scnt, PMASK); } else
#endif
    if (RUN(9)) { peer2::v_phase(lds, ws + WS_V8, (const unsigned short*)(ws + WS_PE2), ws + WS_PA2, (bf16_t*)(ws + WS_OP), sx, smem, scnt, PMASK); }
    SEAM(9);
    if (RUN(10)) { peer2::final_phase(a.out, (const bf16_t*)(ws + WS_HB), (const bf16_t*)(ws + WS_OP), a.g_final, gw, ngw); }
#undef IN
#undef RUN
#undef SEAM
}


#ifndef STAGE
#define STAGE 6
#endif
extern "C" void kernel_launch(void* const* d_in, const int* in_sizes, int n_in, void* d_out, int out_size, void* d_ws, size_t ws_size, hipStream_t stream) {
    static int grid = 0;
    if (grid == 0) {
        if (n_in != 15 || out_size != T * DM || ws_size < 256 * MiB) { fprintf(stderr, "kernel_launch: unexpected problem shape (n_in %d, out %d, ws %zu); nothing launched\n", n_in, out_size, ws_size); grid = -1; return; }
        int dev = 0, cus = 0, per_cu = 0;
        if (hipGetDevice(&dev) != hipSuccess || hipDeviceGetAttribute(&cus, hipDeviceAttributeMultiprocessorCount, dev) != hipSuccess) { grid = -1; return; }
        if (hipFuncSetAttribute((const void*)mk_fwd, hipFuncAttributeMaxDynamicSharedMemorySize, LDS_BYTES) != hipSuccess) { fprintf(stderr, "kernel_launch: hipFuncSetAttribute failed\n"); grid = -1; return; }
        if (hipOccupancyMaxActiveBlocksPerMultiprocessor(&per_cu, (const void*)mk_fwd, NWAVES * 64, LDS_BYTES) != hipSuccess || per_cu < 1) fprintf(stderr, "kernel_launch: note: occupancy query says %d workgroups per CU\n", per_cu);
        (void)hipGetLastError();
        grid = cus;
        if (grid < 8) { fprintf(stderr, "kernel_launch: %d CUs: the PEER slice phases need a grid of at least 8 workgroups; nothing launched\n", grid); grid = -1; return; }
    }
    if (grid < 0) return;
    unsigned char* ws = (unsigned char*)d_ws;
    (void)hipMemsetAsync(ws + WS_CTL, 0, CTL_ZERO_BYTES, stream);
    Args a{};
    a.x = (const float*)d_in[0]; a.pos = (const int*)d_in[1]; a.g_mix = (const float*)d_in[2]; a.w_in = (const float*)d_in[3]; a.g_cq = (const float*)d_in[4]; a.w_uq = (const float*)d_in[5];
    a.g_ckv = (const float*)d_in[6]; a.w_ukv = (const float*)d_in[7]; a.w_out = (const float*)d_in[8]; a.g_ffn = (const float*)d_in[9]; a.w_pq = (const float*)d_in[10]; a.sub_keys = (const float*)d_in[11];
    a.u_emb = (const float*)d_in[12]; a.v_emb = (const float*)d_in[13]; a.g_final = (const float*)d_in[14];
    a.out = (float*)d_out; a.ws = ws; a.ph_lo = 0; a.ph_hi = (STAGE >= 6) ? 11 : STAGE + 1; a.probe_mask = 0xffffu; a.probe_shift = 0;
#if defined(PROBE_LO) && PROBE_LO == 3
    { Args b1 = a; b1.ph_hi = 4; b1.probe_shift = PROBE_SHIFT; hipLaunchKernelGGL(mk_fwd, dim3(grid), dim3(NWAVES * 64), LDS_BYTES, stream, b1);
      (void)hipMemsetAsync(ws + WS_CTL, 0, CTL_ZERO_BYTES, stream); a.ph_lo = 3; }
#endif
    hipLaunchKernelGGL(mk_fwd, dim3(grid), dim3(NWAVES * 64), LDS_BYTES, stream, a);
#if defined(PROBE_LO) && PROBE_LO != 3
#if 0
#else
    { Args b2 = a; b2.ph_lo = PROBE_LO; b2.ph_hi = PROBE_HI; b2.probe_shift = PROBE_SHIFT; b2.probe_mask = PROBE_MASK; (void)hipMemsetAsync(ws + WS_CTL, 0, CTL_ZERO_BYTES, stream); hipLaunchKernelGGL(mk_fwd, dim3(grid), dim3(NWAVES * 64), LDS_BYTES, stream, b2); }
#endif
#endif
#if STAGE < 6
    float* out = (float*)d_out; float* mixed = out;
    const size_t MB = MiB;
#if STAGE == 2
    {
        float* q32 = (float*)(ws + 0 * MB); float* k32 = (float*)(ws + 32 * MB); float* v32 = (float*)(ws + 64 * MB);
        const long n = (long)T * 512;
        nv::k_cvt<<<(int)((n + 255) / 256), 256, 0, stream>>>((const bf16_t*)(ws + WS_QA), q32, n, 1.0f / LOG2E);
        nv::k_cvt<<<(int)((n + 255) / 256), 256, 0, stream>>>((const bf16_t*)(ws + WS_KA), k32, n, 1.0f);
        nv::k_cvt<<<(int)((n + 255) / 256), 256, 0, stream>>>((const bf16_t*)(ws + WS_VA), v32, n, 1.0f);
        nv::k_dilated<<<T * 8 / 4, 256, 0, stream>>>(q32, k32, v32, mixed);
        float* qm32 = (float*)(ws + 112 * MB);
        const long nq = (long)T * 768;
        nv::k_cvt<<<(int)((nq + 255) / 256), 256, 0, stream>>>((const bf16_t*)(ws + WS_QM), qm32, nq, 1.0f / LOG2E);
        float* Kt = (float*)(ws + 0 * MB); float* Vt = Kt + (size_t)NB * 8 * 96 * SEQ;
        nv::k_build_ktvt<<<(int)(((long)NB * 8 * 160 * SEQ + 255) / 256), 256, 0, stream>>>((const bf16_t*)(ws + WS_KN), (const bf16_t*)(ws + WS_VM), (const bf16_t*)(ws + WS_KR), Kt, Vt);
        nv::k_mla<<<NB * 8 * (SEQ / 4), 256, 0, stream>>>(qm32, Kt, Vt, mixed);
    }
#elif STAGE == 3
    { const long n = (long)T * DM; nv::k_cvt<<<(int)((n + 255) / 256), 256, 0, stream>>>((const bf16_t*)(ws + WS_MIXED), mixed, n, 1.0f); }
#endif
    float* hbuf = (float*)(ws + 192 * MB); float* rstd_h = (float*)(ws + 180 * MB);
#if STAGE <= 3
    nv::k_gemm<<<dim3(DM / 64, T / 64), 256, 0, stream>>>(mixed, DM, nullptr, nullptr, a.w_out, DM, hbuf, DM, T, DM, DM, a.x, DM);
#else
    (void)hipMemcpyAsync(hbuf, out, (size_t)T * DM * 4, hipMemcpyDeviceToDevice, stream);
#endif
    float* qp = (float*)(ws + 0 * MB);
    float* vals = (float*)(ws + 128 * MB); int* idxs = (int*)(ws + 145 * MB); int* expert = (int*)(ws + 162 * MB); float* gate = (float*)(ws + 171 * MB);
    nv::k_rstd<<<T / 4, 256, 0, stream>>>(hbuf, DM, DM, rstd_h, T);
    nv::k_gemm<<<dim3(2048 / 64, T / 64), 256, 0, stream>>>(hbuf, DM, rstd_h, a.g_ffn, a.w_pq, 2048, qp, 2048, T, 2048, DM, nullptr, 0);
    (void)hipFuncSetAttribute((const void*)nv::k_topk1, hipFuncAttributeMaxDynamicSharedMemorySize, 65536);
    nv::k_topk1<<<dim3(T / 256, 16), 256, 65536, stream>>>(qp, a.sub_keys, vals, idxs);
    nv::k_topk2<<<T * 8 / 256, 256, 0, stream>>>(vals, idxs, expert, gate);
    nv::k_peer_final<<<T / 4, 256, 0, stream>>>(hbuf, rstd_h, a.g_ffn, a.u_emb, a.v_emb, expert, gate, a.g_final, out);
#endif
}
```

```cpp
#include <hip/hip_runtime.h>
#include <hip/hip_bf16.h>
#include <math.h>
#include <stdio.h>
#include <stdint.h>

#define LAS __attribute__((address_space(3)))
#define GAS __attribute__((address_space(1)))
typedef unsigned short bf16_t;
typedef short bf16x8 __attribute__((ext_vector_type(8)));
typedef short s16x4 __attribute__((ext_vector_type(4)));
typedef float f32x2 __attribute__((ext_vector_type(2)));
typedef float f32x4 __attribute__((ext_vector_type(4)));
typedef float f32x16 __attribute__((ext_vector_type(16)));
typedef unsigned u32x2 __attribute__((ext_vector_type(2)));
typedef unsigned u32x4 __attribute__((ext_vector_type(4)));
typedef __bf16 bf16x2_t __attribute__((ext_vector_type(2)));
typedef _Float16 f16x2_t __attribute__((ext_vector_type(2)));
typedef int v8i __attribute__((ext_vector_type(8)));

constexpr int DM = 1024, NB = 2, SEQ = 8192, T = NB * SEQ;
constexpr int INW = 1952;
constexpr float EPS = 1e-6f;
constexpr float LOG2E = 1.4426950408889634f;
constexpr float QA_SCALE = 0.125f * LOG2E;
constexpr float QM_SCALE = 0.10206207261596577f * LOG2E;

constexpr size_t MiB = 1u << 20;
constexpr size_t WS_CTL = 0, CTL_ZERO_BYTES = 64 * 1024;
constexpr size_t WS_COSA = 1 * MiB, WS_SINA = WS_COSA + 512 * 1024, WS_COSM = 2 * MiB, WS_SINM = 3 * MiB;
constexpr size_t WS_WIN = 4 * MiB, WS_WCOMB = 8 * MiB, WS_WOUT = 12 * MiB, WS_WUQ = 14 * MiB, WS_WUKV = 14 * MiB + 512 * 1024;
constexpr size_t WS_SSQQ = 15 * MiB, WS_SSQKV = 15 * MiB + 512 * 1024;
constexpr size_t WS_U8 = 16 * MiB, WS_V8 = 32 * MiB;
constexpr size_t WS_HN = 80 * MiB, WS_MIXED = 80 * MiB;
constexpr size_t WS_QA = 112 * MiB, WS_KA = 128 * MiB, WS_VA = 144 * MiB;
constexpr size_t WS_CQ = 160 * MiB, WS_CKV = 168 * MiB, WS_KR = 172 * MiB;
constexpr size_t WS_QM = 176 * MiB, WS_KN = 200 * MiB, WS_VM = 216 * MiB;
constexpr size_t WS_SSQH = 232 * MiB;
constexpr size_t WS_HB = 112 * MiB, WS_SC = 144 * MiB;
constexpr size_t WS_HB8 = 208 * MiB;
constexpr size_t WS_ZP = 48 * MiB, WS_PEROW = 80 * MiB, WS_PESLOT = 84 * MiB, WS_PG = 88 * MiB, WS_SSQY = 96 * MiB, WS_RSTDH = 97 * MiB, WS_PE2 = 176 * MiB, WS_PA2 = 180 * MiB;
constexpr size_t WS_OP = 144 * MiB;
constexpr float SU = 256.f, SX = 16.f, SV = 64.f;
constexpr size_t WS_END = 234 * MiB;
static_assert(WS_KA == WS_QA + 16 * MiB && WS_VA == WS_KA + 16 * MiB && WS_VM == WS_KN + 16 * MiB, "epilogues address Ka/Va and Vm relative to Qa and Kn");

__device__ __forceinline__ unsigned pk_bf16(float lo, float hi) { f32x2 v = {lo, hi}; bf16x2_t b = __builtin_convertvector(v, bf16x2_t); return __builtin_bit_cast(unsigned, b); }
__device__ __forceinline__ unsigned pk_f16(float lo, float hi) { f32x2 v = {lo, hi}; f16x2_t b = __builtin_convertvector(v, f16x2_t); return __builtin_bit_cast(unsigned, b); }
__device__ __forceinline__ unsigned pk_fp8x4(float a, float b, float c, float d) { int w = __builtin_amdgcn_cvt_pk_fp8_f32(a, b, 0, false); w = __builtin_amdgcn_cvt_pk_fp8_f32(c, d, w, true); return (unsigned)w; }
__device__ __forceinline__ float bf_lo(unsigned w) { return __builtin_bit_cast(float, w << 16); }
__device__ __forceinline__ float bf_hi(unsigned w) { return __builtin_bit_cast(float, w & 0xffff0000u); }
__device__ __forceinline__ float wave_sum(float v) {
#pragma unroll
    for (int o = 1; o < 64; o <<= 1) v += __shfl_xor(v, o);
    return v;
}
__device__ __forceinline__ int crow(int r, int hi) { return (r & 3) + 8 * (r >> 2) + 4 * hi; }
__device__ __forceinline__ void glds16(const void* gsrc, unsigned lds_dst) { unsigned keep;
    asm volatile("s_mov_b32 %0, m0\n\ts_mov_b32 m0, %2\n\ts_nop 0\n\tglobal_load_lds_dwordx4 %1, off\n\ts_mov_b32 m0, %0" : "=&s"(keep) : "v"(gsrc), "s"(lds_dst) : "memory"); }

#define STAGE 6


namespace pg8 {
#define PG8_LAS __attribute__((address_space(3)))
typedef unsigned short bf16_t;
typedef short bf16x8 __attribute__((ext_vector_type(8)));
typedef float f32x4 __attribute__((ext_vector_type(4)));
typedef unsigned u32x4 __attribute__((ext_vector_type(4)));
constexpr int BM = 256, BK = 64, HALF = 128, HTB = HALF * BK * 2  , STAGE_BYTES = 8 * HTB, NXCD = 8, WGM = 8;

__host__ __device__ __forceinline__ int lds_byte(int r, int c) { const int st = (r >> 4) * 2 + (c >> 5), rr = r & 15, cc = c & 31, ob = rr * 64 + cc * 2; return st * 1024 + (ob ^ (((ob >> 9) & 1) << 5)); }
__host__ __device__ __forceinline__ void stage_rc(int b, int& R, int& C) { const int st = b / 1024, sb = b % 1024, swz = sb ^ (((sb >> 9) & 1) << 5); R = (st >> 1) * 16 + swz / 64; C = (st & 1) * 32 + (swz % 64) / 2; }
__host__ __device__ __forceinline__ int perm32(int rho) { const int n = rho >> 4, i = rho & 15; return 8 * (i >> 2) + 4 * n + (i & 3); }

struct Unit { int pm, pn; };
struct Gemm { const bf16_t* A; const bf16_t* Bt; int M, N, K; };

struct StaticOrder {
    int nM, nN, nwg, G, c;
    __host__ __device__ void init(int M, int N, int G_, int c_) { nM = M / BM; nN = N / BM; nwg = nM * nN; G = G_; c = c_; }
    __host__ __device__ bool next(int i, Unit& u) const {
        const long L = (long)i * G + c; if (L >= nwg) return false;
        int wgid = (int)L; { const int q = nwg / NXCD, r = nwg % NXCD, xcd = wgid % NXCD, off = wgid / NXCD; wgid = (xcd < r ? xcd * (q + 1) : r * (q + 1) + (xcd - r) * q) + off; }
        const int nig = WGM * nN, gid = wgid / nig, fm = gid * WGM, gsz = (nM - fm) < WGM ? (nM - fm) : WGM;
        u.pm = fm + ((wgid % nig) % gsz); u.pn = (wgid % nig) / gsz; return true;
    }
    __device__ __forceinline__ void a_ready(const Unit&) const {}
    __device__ __forceinline__ void done(const Unit&) const {}
};


__device__ __forceinline__ unsigned cvt_pk_bf16(float lo, float hi) { unsigned r; asm volatile("v_cvt_pk_bf16_f32 %0, %1, %2" : "=v"(r) : "v"(lo), "v"(hi)); return r; }
typedef float f32x2 __attribute__((ext_vector_type(2)));

__device__ __forceinline__ void load8(const float* p, float (&o)[8]);

template <class Epi, class Sched, bool ALIGN_EPI = false, bool SP2 = false>
__device__ __forceinline__ void gemm_phase(PG8_LAS unsigned char* lds, const Gemm g, const Sched& S, const Epi& E) {
    const int tid = threadIdx.x, wid = __builtin_amdgcn_readfirstlane(tid >> 6), lane = tid & 63, wr = wid >> 2, wc = wid & 3, fr = lane & 15, fq = lane >> 4;
    const int K = g.K, nt = K / BK;
    unsigned voffA[2], voffB[2];
#pragma unroll
    for (int i = 0; i < 2; ++i) { int R, C; stage_rc(tid * 16 + i * 8192, R, C); const int Rb = Epi::PERM ? ((R & ~31) + perm32(R & 31)) : R;
        voffA[i] = (unsigned)(R * K + C) * 2u; voffB[i] = (unsigned)(Rb * K + C) * 2u; }
    const size_t kstep = (size_t)(BK * 2);
    const size_t hstep = (size_t)HALF * K * 2;
    const size_t tstep = 2 * hstep;
    const unsigned ldsw = (unsigned)wid * 1024u;
    const int aoff = lds_byte(wr * 64 + fr, fq * 8), boff = lds_byte(wc * 32 + fr, fq * 8);
#define PG8_SA(b, h) (((b) * 2 + (h)) * HTB)
#define PG8_SB(b, h) ((4 + (b) * 2 + (h)) * HTB)
#define PG8_STAGE(bufoff, gbase, voff) do { _Pragma("unroll") for (int _i = 0; _i < 2; ++_i) \
        __builtin_amdgcn_global_load_lds((const unsigned*)((const char*)(gbase) + (voff)[_i]), (PG8_LAS unsigned*)(lds + (bufoff) + ldsw + _i * 8192), 16, 0, 0); } while (0)
#define PG8_LDA(dst, b, h) do { _Pragma("unroll") for (int m = 0; m < 4; ++m) _Pragma("unroll") for (int k = 0; k < 2; ++k) dst[m][k] = *(const PG8_LAS bf16x8*)(lds + PG8_SA(b, h) + aoff + m * 2048 + k * 1024); } while (0)
#define PG8_LDB(dst, b, h) do { _Pragma("unroll") for (int n = 0; n < 2; ++n) _Pragma("unroll") for (int k = 0; k < 2; ++k) dst[n][k] = *(const PG8_LAS bf16x8*)(lds + PG8_SB(b, h) + boff + n * 2048 + k * 1024); } while (0)
#define PG8_MMA(ai, bj, At, Bt) do { __builtin_amdgcn_s_setprio(1); _Pragma("unroll") for (int m = 0; m < 4; ++m) _Pragma("unroll") for (int n = 0; n < 2; ++n) _Pragma("unroll") for (int k = 0; k < 2; ++k) \
        acc[ai][bj][m][n] = __builtin_amdgcn_mfma_f32_16x16x32_bf16(Bt[n][k], At[m][k], acc[ai][bj][m][n], 0, 0, 0); __builtin_amdgcn_s_setprio(0); } while (0)
#define PG8_WAIT_V(n) asm volatile("s_waitcnt vmcnt(" #n ")" ::: "memory")
#define PG8_WAIT_L(n) asm volatile("s_waitcnt lgkmcnt(" #n ")" ::: "memory")
#define PG8_BAR __builtin_amdgcn_s_barrier()
#define PG8_SCHED __builtin_amdgcn_sched_barrier(0)
    Unit cur, nxt; int ui = 0;
    if (!S.next(0, cur)) return;
    f32x4 acc[2][2][4][2];
#pragma unroll
    for (int a = 0; a < 2; ++a)
#pragma unroll
        for (int b = 0; b < 2; ++b)
#pragma unroll
            for (int m = 0; m < 4; ++m)
#pragma unroll
                for (int n = 0; n < 2; ++n) acc[a][b][m][n] = (f32x4){0.f, 0.f, 0.f, 0.f};
    bf16x8 At[4][2], B0[2][2], B1[2][2];
    const char* cA = (const char*)g.A + (size_t)cur.pm * tstep; const char* cB = (const char*)g.Bt + (size_t)cur.pn * tstep;
    S.a_ready(cur);
    if constexpr (SP2) {
        PG8_STAGE(PG8_SB(0, 0), cB, voffB); PG8_STAGE(PG8_SB(0, 1), cB + hstep, voffB); PG8_STAGE(PG8_SA(0, 0), cA, voffA); PG8_STAGE(PG8_SA(0, 1), cA + hstep, voffA);
        if (wr == 1) PG8_BAR;
        PG8_WAIT_V(2); PG8_BAR;
        PG8_STAGE(PG8_SB(1, 0), cB + kstep, voffB); PG8_STAGE(PG8_SA(1, 0), cA + kstep, voffA); PG8_STAGE(PG8_SB(1, 1), cB + hstep + kstep, voffB);
        PG8_WAIT_V(6); PG8_BAR;
    } else {
        PG8_STAGE(PG8_SB(0, 0), cB, voffB); PG8_STAGE(PG8_SA(0, 0), cA, voffA); PG8_STAGE(PG8_SB(0, 1), cB + hstep, voffB); PG8_STAGE(PG8_SA(0, 1), cA + hstep, voffA);
        if (wr == 1) PG8_BAR;
        PG8_WAIT_V(4); PG8_BAR;
        PG8_STAGE(PG8_SB(1, 0), cB + kstep, voffB); PG8_STAGE(PG8_SA(1, 0), cA + kstep, voffA); PG8_STAGE(PG8_SB(1, 1), cB + hstep + kstep, voffB);
        PG8_WAIT_V(6); PG8_BAR;
    }
    for (;;) {
        const bool has_next = S.next(ui + 1, nxt);
        const char* nA = has_next ? (const char*)g.A + (size_t)nxt.pm * tstep : cA; const char* nB = has_next ? (const char*)g.Bt + (size_t)nxt.pn * tstep : cB;
        for (int t = 0; t < nt; t += 2) {
            const bool last = (t == nt - 2);
            const char* a1 = cA + (size_t)(t + 1) * kstep;
            const char* a2 = last ? nA : cA + (size_t)(t + 2) * kstep; const char* b2 = last ? nB : cB + (size_t)(t + 2) * kstep;
            const char* a3 = a2 + kstep; const char* b3 = b2 + kstep;
            if (last && has_next) S.a_ready(nxt);
            if constexpr (SP2) {
            PG8_LDB(B0, 0, 0); PG8_LDB(B1, 0, 1); PG8_SCHED; PG8_LDA(At, 0, 0); PG8_STAGE(PG8_SA(1, 1), a1 + hstep, voffA);
            PG8_WAIT_V(8); PG8_WAIT_L(0); PG8_BAR; PG8_MMA(0, 0, At, B0); PG8_MMA(0, 1, At, B1); PG8_BAR; PG8_SCHED;
            PG8_LDA(At, 0, 1); PG8_STAGE(PG8_SB(0, 0), b2, voffB); PG8_STAGE(PG8_SB(0, 1), b2 + hstep, voffB); PG8_STAGE(PG8_SA(0, 0), a2, voffA);
            PG8_WAIT_V(8); PG8_WAIT_L(0); PG8_BAR; PG8_MMA(1, 0, At, B0); PG8_MMA(1, 1, At, B1); PG8_BAR; PG8_SCHED;
            PG8_LDB(B0, 1, 0); PG8_LDB(B1, 1, 1); PG8_SCHED; PG8_LDA(At, 1, 0); PG8_STAGE(PG8_SA(0, 1), a2 + hstep, voffA);
            PG8_WAIT_V(8); PG8_WAIT_L(0); PG8_BAR; PG8_MMA(0, 0, At, B0); PG8_MMA(0, 1, At, B1); PG8_BAR; PG8_SCHED;
            PG8_LDA(At, 1, 1); PG8_STAGE(PG8_SB(1, 0), b3, voffB); PG8_STAGE(PG8_SB(1, 1), b3 + hstep, voffB); PG8_STAGE(PG8_SA(1, 0), a3, voffA);
            PG8_WAIT_V(8); PG8_WAIT_L(0); PG8_BAR; PG8_MMA(1, 0, At, B0); PG8_MMA(1, 1, At, B1); PG8_BAR; PG8_SCHED;
            } else {
            PG8_LDB(B0, 0, 0); PG8_SCHED; PG8_LDA(At, 0, 0); PG8_STAGE(PG8_SA(1, 1), a1 + hstep, voffA);
            PG8_WAIT_L(8); PG8_BAR; PG8_WAIT_L(0); PG8_MMA(0, 0, At, B0); PG8_BAR; PG8_SCHED;
            PG8_LDB(B1, 0, 1); PG8_STAGE(PG8_SB(0, 0), b2, voffB);
            PG8_BAR; PG8_WAIT_L(0); PG8_MMA(0, 1, At, B1); PG8_BAR;
            PG8_LDA(At, 0, 1); PG8_STAGE(PG8_SA(0, 0), a2, voffA);
            PG8_BAR; PG8_WAIT_L(0); PG8_MMA(1, 0, At, B0); PG8_BAR; PG8_SCHED;
            PG8_STAGE(PG8_SB(0, 1), b2 + hstep, voffB);
            PG8_WAIT_V(6); PG8_BAR; PG8_MMA(1, 1, At, B1); PG8_BAR;
            PG8_LDB(B0, 1, 0); PG8_SCHED; PG8_LDA(At, 1, 0); PG8_STAGE(PG8_SA(0, 1), a2 + hstep, voffA);
            PG8_WAIT_L(8); PG8_BAR; PG8_WAIT_L(0); PG8_MMA(0, 0, At, B0); PG8_BAR; PG8_SCHED;
            PG8_LDB(B1, 1, 1); PG8_STAGE(PG8_SB(1, 0), b3, voffB);
            PG8_BAR; PG8_WAIT_L(0); PG8_MMA(0, 1, At, B1); PG8_BAR;
            PG8_LDA(At, 1, 1); PG8_STAGE(PG8_SA(1, 0), a3, voffA);
            PG8_BAR; PG8_WAIT_L(0); PG8_MMA(1, 0, At, B0); PG8_BAR; PG8_SCHED;
            PG8_STAGE(PG8_SB(1, 1), b3 + hstep, voffB);
            PG8_WAIT_V(6); PG8_BAR; PG8_MMA(1, 1, At, B1); PG8_BAR;
            }
        }
        if constexpr (ALIGN_EPI) { if (wr == 0) PG8_BAR; }
        if constexpr (!Epi::AFTER_DRAIN) { E(acc, cur, wr, wc, fr, fq); S.done(cur); }
        if (!has_next) break;
#pragma unroll
        for (int a = 0; a < 2; ++a)
#pragma unroll
            for (int b = 0; b < 2; ++b)
#pragma unroll
                for (int m = 0; m < 4; ++m)
#pragma unroll
                    for (int n = 0; n < 2; ++n) acc[a][b][m][n] = (f32x4){0.f, 0.f, 0.f, 0.f};
        cur = nxt; cA = nA; cB = nB; ++ui;
        if constexpr (ALIGN_EPI) { if (wr == 1) PG8_BAR; }
    }
    PG8_WAIT_V(0);
    if constexpr (!ALIGN_EPI) { if (wr == 0) PG8_BAR; }
    PG8_BAR;
    if constexpr (Epi::AFTER_DRAIN) { E.fused(acc, cur, wr, wc, fr, fq, lds, wid, lane); S.done(cur); }
#undef PG8_SA
#undef PG8_SB
#undef PG8_STAGE
#undef PG8_LDA
#undef PG8_LDB
#undef PG8_MMA
#undef PG8_WAIT_V
#undef PG8_WAIT_L
#undef PG8_BAR
#undef PG8_SCHED
}
}

namespace pg8 {
#define EPI_V8(ai, bj, m) { acc[ai][bj][m][0][0], acc[ai][bj][m][0][1], acc[ai][bj][m][0][2], acc[ai][bj][m][0][3], acc[ai][bj][m][1][0], acc[ai][bj][m][1][1], acc[ai][bj][m][1][2], acc[ai][bj][m][1][3] }
__device__ __forceinline__ u32x4 pack8(const float (&v)[8], float s) { u32x4 w; w.x = pk_bf16(v[0] * s, v[1] * s); w.y = pk_bf16(v[2] * s, v[3] * s); w.z = pk_bf16(v[4] * s, v[5] * s); w.w = pk_bf16(v[6] * s, v[7] * s); return w; }
__device__ __forceinline__ float ssq8(const float (&v)[8]) { return ((v[0] * v[0] + v[1] * v[1]) + (v[2] * v[2] + v[3] * v[3])) + ((v[4] * v[4] + v[5] * v[5]) + (v[6] * v[6] + v[7] * v[7])); }
__device__ __forceinline__ void load8(const float* p, float (&o)[8]) { const f32x4 a = *(const f32x4*)p, b = *(const f32x4*)(p + 4); o[0] = a.x; o[1] = a.y; o[2] = a.z; o[3] = a.w; o[4] = b.x; o[5] = b.y; o[6] = b.z; o[7] = b.w; }

struct EpiProj {
    static constexpr bool PERM = true, AFTER_DRAIN = false;
    bf16_t *Qa, *Ka, *Va, *Cq, *Ckv, *Kr; float *ssq_q, *ssq_kv; const float *cosA, *sinA, *cosM, *sinM;
    __device__ __forceinline__ void operator()(const f32x4 (&acc)[2][2][4][2], const Unit& u, int wr, int wc, int fr, int fq) const {
        const int pn = u.pn, rowb = u.pm * BM + wr * 64 + fr;
        if (pn < 6) {
            const int kind = pn >> 1;
            bf16_t* dst = Qa + (size_t)kind * (size_t)(8u << 20);
            const float sc = kind == 0 ? QA_SCALE : 1.f;
            const bool ropew = (kind < 2) && ((wc & 1) == 0);
            float cq[2][8], sq[2][8];
            if (ropew) {
#pragma unroll
                for (int g = 0; g < 2; ++g) { const size_t r_ = (size_t)(rowb + g * 16) * 8; load8(cosA + r_, cq[g]); load8(sinA + r_, sq[g]); }
            }
#pragma unroll
            for (int ai = 0; ai < 2; ++ai)
#pragma unroll
                for (int m = 0; m < 4; ++m) {
                    const int row = rowb + ai * HALF + m * 16;
                    float cs[8], sn[8];
                    if (ropew) {
#pragma unroll
                        for (int i = 0; i < 8; ++i) { cs[i] = cq[m & 1][i]; sn[i] = sq[m & 1][i]; }
                        if (ai * 4 + m + 2 < 8) { const int g2 = ai * 4 + m + 2; const size_t r_ = (size_t)(rowb + (g2 >> 2) * HALF + (g2 & 3) * 16) * 8; load8(cosA + r_, cq[m & 1]); load8(sinA + r_, sq[m & 1]); }
                    }
#pragma unroll
                    for (int bj = 0; bj < 2; ++bj) {
                        float v[8] = EPI_V8(ai, bj, m);
                        if (ropew) {
#pragma unroll
                            for (int i = 0; i < 8; ++i) { const float pv = __shfl_xor(v[i], 16); if (fq == 0) v[i] = v[i] * cs[i] - pv * sn[i]; else if (fq == 1) v[i] = v[i] * cs[i] + pv * sn[i]; }
                        }
                        *(u32x4*)(dst + ((size_t)((row >> 13) * 8 + (pn & 1) * 4 + bj * 2 + (wc >> 1)) * SEQ + (row & (SEQ - 1))) * 64 + (wc & 1) * 32 + fq * 8) = pack8(v, sc);
                    }
                }
        } else if (pn == 6) {
#pragma unroll
            for (int ai = 0; ai < 2; ++ai)
#pragma unroll
                for (int m = 0; m < 4; ++m) {
                    const int row = rowb + ai * HALF + m * 16;
#pragma unroll
                    for (int bj = 0; bj < 2; ++bj) {
                        float v[8] = EPI_V8(ai, bj, m);
                        float s = ssq8(v); s += __shfl_xor(s, 16); s += __shfl_xor(s, 32);
                        if (fq == 0) ssq_q[(size_t)row * 8 + bj * 4 + wc] = s;
                        *(u32x4*)(Cq + (size_t)row * 256 + bj * HALF + wc * 32 + fq * 8) = pack8(v, 1.f);
                    }
                }
        } else {
#pragma unroll
            for (int ai = 0; ai < 2; ++ai)
#pragma unroll
                for (int m = 0; m < 4; ++m) {
                    const int row = rowb + ai * HALF + m * 16;
                    {
                        float v[8] = EPI_V8(ai, 0, m);
                        float s = ssq8(v); s += __shfl_xor(s, 16); s += __shfl_xor(s, 32);
                        if (fq == 0) ssq_kv[(size_t)row * 4 + wc] = s;
                        *(u32x4*)(Ckv + (size_t)row * 128 + wc * 32 + fq * 8) = pack8(v, 1.f);
                    }
                    if (wc == 0) {
                        float v[8] = EPI_V8(ai, 1, m);
                        float cs[8], sn[8];
                        load8(cosM + (size_t)row * 16 + 8 * (fq & 1), cs); load8(sinM + (size_t)row * 16 + 8 * (fq & 1), sn);
#pragma unroll
                        for (int i = 0; i < 8; ++i) { const float pv = __shfl_xor(v[i], 32); v[i] = (fq < 2) ? (v[i] * cs[i] - pv * sn[i]) : (v[i] * cs[i] + pv * sn[i]); }
                        *(u32x4*)(Kr + (size_t)row * 32 + fq * 8) = pack8(v, 1.f);
                    }
                }
        }
    }
};

struct EpiQm {
    static constexpr bool PERM = true, AFTER_DRAIN = false;
    bf16_t* Qm; const float* ssq_q; const float *cosM, *sinM;
    __device__ __forceinline__ void operator()(const f32x4 (&acc)[2][2][4][2], const Unit& u, int wr, int wc, int fr, int fq) const {
        const int pn = u.pn, rowb = u.pm * BM + wr * 64 + fr;
        f32x2 qa[8];
#pragma unroll
        for (int g = 0; g < 8; ++g) qa[g] = *(const f32x2*)(ssq_q + (size_t)(rowb + (g >> 2) * HALF + (g & 3) * 16) * 8 + 2 * fq);
        float cq[2][8], sq[2][8];
#pragma unroll
        for (int g = 0; g < 2; ++g) { const size_t r_ = (size_t)(rowb + g * 16) * 16 + 8 * (fq & 1); load8(cosM + r_, cq[g]); load8(sinM + r_, sq[g]); }
#pragma unroll
        for (int ai = 0; ai < 2; ++ai)
#pragma unroll
            for (int m = 0; m < 4; ++m) {
                const int row = rowb + ai * HALF + m * 16, g = ai * 4 + m;
                float ssum = qa[g].x + qa[g].y; ssum += __shfl_xor(ssum, 16); ssum += __shfl_xor(ssum, 32);
                const float rs = 1.0f / sqrtf(ssum * (1.f / 256.f) + EPS);
                float cs[8], sn[8];
#pragma unroll
                for (int i = 0; i < 8; ++i) { cs[i] = cq[m & 1][i]; sn[i] = sq[m & 1][i]; }
                if (g + 2 < 8) { const int g2 = g + 2; const size_t r_ = (size_t)(rowb + (g2 >> 2) * HALF + (g2 & 3) * 16) * 16 + 8 * (fq & 1); load8(cosM + r_, cq[m & 1]); load8(sinM + r_, sq[m & 1]); }
#pragma unroll
                for (int bj = 0; bj < 2; ++bj) {
                    const int g32 = pn * 8 + bj * 4 + wc;
                    const bool ropew = (g32 % 3) == 2;
                    float v[8] = EPI_V8(ai, bj, m);
#pragma unroll
                    for (int i = 0; i < 8; ++i) v[i] *= rs;
                    if (ropew) {
#pragma unroll
                        for (int i = 0; i < 8; ++i) { const float pv = __shfl_xor(v[i], 32); v[i] = (fq < 2) ? (v[i] * cs[i] - pv * sn[i]) : (v[i] * cs[i] + pv * sn[i]); }
                    }
                    *(u32x4*)(Qm + (size_t)row * 768 + pn * BM + bj * HALF + wc * 32 + fq * 8) = pack8(v, QM_SCALE);
                }
                asm volatile("" ::: "memory");
            }
    }
};

struct EpiKv {
    static constexpr bool PERM = true, AFTER_DRAIN = false;
    bf16_t *Kn, *Vm; const float* ssq_kv;
    __device__ __forceinline__ void operator()(const f32x4 (&acc)[2][2][4][2], const Unit& u, int wr, int wc, int fr, int fq) const {
        const int pn = u.pn, rowb = u.pm * BM + wr * 64 + fr;
        bf16_t* dst = Kn + (size_t)(wc >> 1) * (size_t)(8u << 20);
        const int within = (wc & 1) * 32 + fq * 8;
        f32x4 q4a[8];
#pragma unroll
        for (int g = 0; g < 8; ++g) q4a[g] = *(const f32x4*)(ssq_kv + (size_t)(rowb + (g >> 2) * HALF + (g & 3) * 16) * 4);
#pragma unroll
        for (int ai = 0; ai < 2; ++ai)
#pragma unroll
            for (int m = 0; m < 4; ++m) {
                const int row = rowb + ai * HALF + m * 16;
                const f32x4 q4 = q4a[ai * 4 + m];
                const float rs = 1.0f / sqrtf(((q4.x + q4.y) + (q4.z + q4.w)) * (1.f / 128.f) + EPS);
#pragma unroll
                for (int bj = 0; bj < 2; ++bj) {
                    float v[8] = EPI_V8(ai, bj, m);
                    *(u32x4*)(dst + ((size_t)((row >> 13) * 8 + pn * 2 + bj) * SEQ + (row & (SEQ - 1))) * 64 + within) = pack8(v, rs);
                }
            }
    }
};

struct EpiOut {
    static constexpr bool PERM = true, AFTER_DRAIN = false;
    const float* x; bf16_t* Hb; unsigned char* Hb8; float* ssq_h;
    __device__ __forceinline__ void operator()(const f32x4 (&acc)[2][2][4][2], const Unit& u, int wr, int wc, int fr, int fq) const {
        const int pn = u.pn, rowb = u.pm * BM + wr * 64 + fr;
        float xq[8][8];
#define XPIECE(t_) (x + (size_t)(rowb + ((t_) >> 3) * HALF + (((t_) >> 1) & 3) * 16) * DM + pn * BM + ((t_) & 1) * HALF + wc * 32 + fq * 8)
#pragma unroll
        for (int t = 0; t < 8; ++t) load8(XPIECE(t), xq[t]);
#pragma unroll
        for (int ai = 0; ai < 2; ++ai)
#pragma unroll
            for (int m = 0; m < 4; ++m) {
                const int row = rowb + ai * HALF + m * 16;
#pragma unroll
                for (int bj = 0; bj < 2; ++bj) {
                    const int col = pn * BM + bj * HALF + wc * 32 + fq * 8, t = (ai * 4 + m) * 2 + bj;
                    float v[8] = EPI_V8(ai, bj, m);
#pragma unroll
                    for (int i = 0; i < 8; ++i) v[i] += xq[t & 7][i];
                    if (t + 8 < 16) load8(XPIECE(t + 8), xq[t & 7]);
                    float s = ssq8(v); s += __shfl_xor(s, 16); s += __shfl_xor(s, 32);
                    if (fq == 0) ssq_h[(size_t)row * 32 + pn * 8 + bj * 4 + wc] = s;
                    *(u32x4*)(Hb + (size_t)row * DM + col) = pack8(v, 1.f);
                    { u32x2 w8; w8.x = pk_fp8x4(v[0] * SX, v[1] * SX, v[2] * SX, v[3] * SX); w8.y = pk_fp8x4(v[4] * SX, v[5] * SX, v[6] * SX, v[7] * SX); *(u32x2*)(Hb8 + (size_t)(col >> 7) * ((size_t)T * 128) + (size_t)row * 128 + (col & 127)) = w8; }
                }
            }
#undef XPIECE
    }
};

struct EpiSc {
    static constexpr bool PERM = true, AFTER_DRAIN = false;
    bf16_t* Sc; const float* ssq_h;
    __device__ __forceinline__ void operator()(const f32x4 (&acc)[2][2][4][2], const Unit& u, int wr, int wc, int fr, int fq) const {
        const int pn = u.pn, rowb = u.pm * BM + wr * 64 + fr;
        f32x4 q[8][2];
#pragma unroll
        for (int g = 0; g < 8; ++g) { const float* qp = ssq_h + (size_t)(rowb + (g >> 2) * HALF + (g & 3) * 16) * 32 + 8 * fq; q[g][0] = *(const f32x4*)qp; q[g][1] = *(const f32x4*)(qp + 4); }
#pragma unroll
        for (int ai = 0; ai < 2; ++ai)
#pragma unroll
            for (int m = 0; m < 4; ++m) {
                const int row = rowb + ai * HALF + m * 16, g = ai * 4 + m;
                float s = ((q[g][0].x + q[g][0].y) + (q[g][0].z + q[g][0].w)) + ((q[g][1].x + q[g][1].y) + (q[g][1].z + q[g][1].w));
                s += __shfl_xor(s, 16); s += __shfl_xor(s, 32);
                const float rs = 1.0f / sqrtf(s * (1.f / 1024.f) + EPS);
#pragma unroll
                for (int bj = 0; bj < 2; ++bj) {
                    float v[8] = EPI_V8(ai, bj, m);
                    u32x4 w; w.x = pk_f16(v[0] * rs, v[1] * rs); w.y = pk_f16(v[2] * rs, v[3] * rs); w.z = pk_f16(v[4] * rs, v[5] * rs); w.w = pk_f16(v[6] * rs, v[7] * rs);
                    *(u32x4*)(Sc + (size_t)row * 2048 + pn * BM + bj * HALF + wc * 32 + fq * 8) = w;
                }
            }
    }
};
#undef EPI_V8
}

namespace att {
constexpr float NEGM = -1.0e30f;
__device__ __forceinline__ s16x4 vtr(const LAS unsigned char* p) { typedef short v4i16_t __attribute__((ext_vector_type(4))); return __builtin_bit_cast(s16x4, __builtin_amdgcn_ds_read_tr16_b64_v4i16((LAS v4i16_t*)p)); }
__device__ __forceinline__ void swap32(unsigned& a, unsigned& b) { asm volatile("s_nop 1\n\tv_permlane32_swap_b32 %0, %1" : "+v"(a), "+v"(b)); }
__device__ __forceinline__ float swapmax(float v) { unsigned a = __builtin_bit_cast(unsigned, v), b = a; swap32(a, b); return fmaxf(__builtin_bit_cast(float, a), __builtin_bit_cast(float, b)); }
__device__ __forceinline__ float swapsum(float v) { unsigned a = __builtin_bit_cast(unsigned, v), b = a; swap32(a, b); return __builtin_bit_cast(float, a) + __builtin_bit_cast(float, b); }
__device__ __forceinline__ float max3f(float a, float b, float c) { return __builtin_fmaxf(__builtin_fmaxf(a, b), c); }
constexpr float THR = 8.0f;
__device__ __forceinline__ bf16x8 pack_p(const f32x16& p, int s) {
    u32x4 w; w.x = pk_bf16(p[8 * s + 0], p[8 * s + 1]); w.y = pk_bf16(p[8 * s + 2], p[8 * s + 3]); w.z = pk_bf16(p[8 * s + 4], p[8 * s + 5]); w.w = pk_bf16(p[8 * s + 6], p[8 * s + 7]);
    return __builtin_bit_cast(bf16x8, w);
}
__device__ __forceinline__ void pv_block(f32x16& o, const LAS unsigned char* vbase, const bf16x8& pb0, const bf16x8& pb1) {
    const s16x4 l0 = vtr(vbase), h0 = vtr(vbase + 8 * 64), l1 = vtr(vbase + 16 * 64), h1 = vtr(vbase + 24 * 64);
    const bf16x8 a0 = {l0[0], l0[1], l0[2], l0[3], h0[0], h0[1], h0[2], h0[3]}, a1 = {l1[0], l1[1], l1[2], l1[3], h1[0], h1[1], h1[2], h1[3]};
    o = __builtin_amdgcn_mfma_f32_32x32x16_bf16(a0, pb0, o, 0, 0, 0);
    o = __builtin_amdgcn_mfma_f32_32x32x16_bf16(a1, pb1, o, 0, 0, 0);
}
__device__ __forceinline__ void store_o(bf16_t* orow, const f32x16& o0, const f32x16& o1, float inv, int hi) {
#pragma unroll
    for (int g = 0; g < 4; ++g) {
        u32x2 a, b; a.x = pk_bf16(o0[4 * g] * inv, o0[4 * g + 1] * inv); a.y = pk_bf16(o0[4 * g + 2] * inv, o0[4 * g + 3] * inv);
        b.x = pk_bf16(o1[4 * g] * inv, o1[4 * g + 1] * inv); b.y = pk_bf16(o1[4 * g + 2] * inv, o1[4 * g + 3] * inv);
        *(u32x2*)(orow + 8 * g + 4 * hi) = a; *(u32x2*)(orow + 32 + 8 * g + 4 * hi) = b;
    }
}

constexpr int KROW = 208;
constexpr int TK = 128, KBYTES = TK * KROW, VBYTES = 2 * TK * 64, BUFB = KBYTES + VBYTES;
constexpr int MLA_LDS = 2 * BUFB;
__device__ __forceinline__ float rowmax64(const f32x16& s0, const f32x16& s1) {
    float mx = max3f(s0[0], s1[0], s0[1]);
#pragma unroll
    for (int r = 1; r < 15; r += 2) { mx = max3f(mx, s1[r], s0[r + 1]); mx = max3f(mx, s1[r + 1], s0[r + 2 < 16 ? r + 2 : 15]); }
    mx = max3f(mx, s1[15], s0[15]);
    return swapmax(mx);
}
__device__ __forceinline__ void scale16(f32x16& t, float a) {
    const f32x2 a2 = {a, a};
#pragma unroll
    for (int i = 0; i < 8; ++i) { f32x2 p = {t[2 * i], t[2 * i + 1]}; asm volatile("v_pk_mul_f32 %0, %0, %1" : "+v"(p) : "v"(a2)); t[2 * i] = p.x; t[2 * i + 1] = p.y; }
}
__device__ __forceinline__ void sub16(f32x16& t, float d) {
    const f32x2 d2 = {d, d};
#pragma unroll
    for (int i = 0; i < 8; ++i) { f32x2 p = {t[2 * i], t[2 * i + 1]}; asm volatile("v_pk_add_f32 %0, %0, %1 neg_lo:[0,1] neg_hi:[0,1]" : "+v"(p) : "v"(d2)); t[2 * i] = p.x; t[2 * i + 1] = p.y; }
}
__device__ __forceinline__ void rescale64(float mx, f32x16& s0, f32x16& s1, float& m, float& l, f32x16& o0, f32x16& o1) {
    if (__builtin_expect(__builtin_amdgcn_ballot_w64(mx > THR) != 0ull, 0)) {
        const float dl = fmaxf(mx, 0.f), alpha = __builtin_amdgcn_exp2f(-dl);
        m += dl; l *= alpha;
        sub16(s0, dl); sub16(s1, dl); scale16(o0, alpha); scale16(o1, alpha);
    }
}
__device__ __forceinline__ void exp64(f32x16& s0, f32x16& s1, float& l) {
    float rs = 0.f;
#pragma unroll
    for (int r = 0; r < 16; ++r) { s0[r] = __builtin_amdgcn_exp2f(s0[r]); s1[r] = __builtin_amdgcn_exp2f(s1[r]); rs += s0[r] + s1[r]; }
    l += rs;
}
__device__ __forceinline__ void sm64(f32x16& s0, f32x16& s1, float& m, float& l, f32x16& o0, f32x16& o1, f32x16& t0, f32x16& t1, bool adj_other) {
    float mx = max3f(s0[0], s1[0], s0[1]);
#pragma unroll
    for (int r = 1; r < 15; r += 2) { mx = max3f(mx, s1[r], s0[r + 1]); mx = max3f(mx, s1[r + 1], s0[r + 2 < 16 ? r + 2 : 15]); }
    mx = max3f(mx, s1[15], s0[15]);
    mx = swapmax(mx);
    if (__builtin_expect(__builtin_amdgcn_ballot_w64(mx > THR) != 0ull, 0)) {
        const float dl = fmaxf(mx, 0.f), alpha = __builtin_amdgcn_exp2f(-dl);
        m += dl; l *= alpha;
#pragma unroll
        for (int r = 0; r < 16; ++r) { s0[r] -= dl; s1[r] -= dl; o0[r] *= alpha; o1[r] *= alpha; }
        if (adj_other) {
#pragma unroll
            for (int r = 0; r < 16; ++r) { t0[r] -= dl; t1[r] -= dl; }
        }
    }
    float rs = 0.f;
#pragma unroll
    for (int r = 0; r < 16; ++r) { s0[r] = __builtin_amdgcn_exp2f(s0[r]); s1[r] = __builtin_amdgcn_exp2f(s1[r]); rs += s0[r] + s1[r]; }
    l += rs;
}
constexpr int MLA_G_OFF = 2 * (TK * 208 + 2 * TK * 64), MLA_PIECE_OFF = MLA_G_OFF + 4096;
__device__ __forceinline__ void mla_unit(LAS unsigned char* lds, const bf16_t* __restrict__ Qm, const bf16_t* __restrict__ Kn, const bf16_t* __restrict__ Kr, const bf16_t* __restrict__ Vm,
                                         bf16_t* __restrict__ Mixed, int b, int h, int qb,
                                         const float* __restrict__ u_emb, const float* __restrict__ v_emb, const float* __restrict__ g_ffn, unsigned char* __restrict__ U8, unsigned char* __restrict__ V8, int slot0) {
    const int tid = threadIdx.x, lane = tid & 63, wid = __builtin_amdgcn_readfirstlane(tid >> 6), r32 = lane & 31, hi = lane >> 5;
    const size_t tok0 = (size_t)b * SEQ;
    const int qpos = 256 * qb + 32 * wid + r32;
    bf16x8 qf[6];
    { const bf16_t* qrow = Qm + (tok0 + qpos) * 768 + h * 96 + 8 * hi;
#pragma unroll
      for (int ds = 0; ds < 6; ++ds) qf[ds] = *(const bf16x8*)(qrow + 16 * ds); }
    float m = 0.f, l = 0.f; f32x16 o0 = {}, o1 = {};
    const int nt = 2 * (qb + 1);
    const int wq0 = 256 * qb + 32 * wid, wqlast = wq0 + 31;
    const int srow = tid >> 3, sch = tid & 7, rrow = tid >> 2, rch = tid & 3;
    const bf16_t* gkn = Kn + ((size_t)(b * 8 + h) * SEQ + srow) * 64 + sch * 8;
    const bf16_t* gv = Vm + ((size_t)(b * 8 + h) * SEQ + srow) * 64 + sch * 8;
    const bf16_t* gkr = Kr + (tok0 + rrow) * 32 + rch * 8;
    const int wkn = srow * KROW + sch * 16, wkr = rrow * KROW + 128 + rch * 16, wv = KBYTES + (sch >> 2) * (TK * 64) + srow * 64 + (sch & 3) * 16;
    const int kfrag = r32 * KROW + hi * 16;
    const int i16 = lane & 15, vfrag = KBYTES + (4 * hi + (i16 >> 2)) * 64 + (16 * ((lane >> 4) & 1) + 4 * (i16 & 3)) * 2;
    u32x4 rk0, rk1, rv0, rv1, rr;
#define MLA_LOAD(t) do { const size_t adv_ = (size_t)(t) * TK; rk0 = *(const u32x4*)(gkn + adv_ * 64); rk1 = *(const u32x4*)(gkn + (adv_ + 64) * 64); \
        rv0 = *(const u32x4*)(gv + adv_ * 64); rv1 = *(const u32x4*)(gv + (adv_ + 64) * 64); rr = *(const u32x4*)(gkr + adv_ * 32); } while (0)
#define MLA_STORE(bp) do { LAS unsigned char* b_ = (bp); *(LAS u32x4*)(b_ + wkn) = rk0; *(LAS u32x4*)(b_ + wkn + 64 * KROW) = rk1; *(LAS u32x4*)(b_ + wv) = rv0; *(LAS u32x4*)(b_ + wv + 64 * 64) = rv1; *(LAS u32x4*)(b_ + wkr) = rr; } while (0)
    if (wid >= 4) __builtin_amdgcn_s_setprio(1);
    MLA_LOAD(0); MLA_STORE(lds);
    for (int u = tid; u < DM / 4; u += 512) *(LAS f32x4*)(lds + MLA_G_OFF + 16 * u) = *(const f32x4*)(g_ffn + 4 * u);
    LAS unsigned char* piece = lds + MLA_PIECE_OFF + wid * 1024;
    const unsigned piece_u = (unsigned)__builtin_amdgcn_readfirstlane((int)(unsigned)(uintptr_t)piece);
    __syncthreads();
    const int nfull = (wq0 + 1) >> 7;
    int kt = 0;
    for (; kt < nfull; ++kt) {
        const LAS unsigned char* buf = lds + (kt & 1) * BUFB;
        if (kt + 1 < nt) MLA_LOAD(kt + 1);
        const int pid = slot0 + 8 * kt + wid;
        if (pid < 131072) glds16(((pid >> 16) ? v_emb : u_emb) + (size_t)(pid & 65535) * 256 + 4 * lane, piece_u);
        {
            f32x16 a0, a1, b0, b1;
            { const float nm = -m; a0 = (f32x16){nm, nm, nm, nm, nm, nm, nm, nm, nm, nm, nm, nm, nm, nm, nm, nm}; a1 = a0; }
#pragma unroll
            for (int ds = 0; ds < 6; ++ds) {
                const bf16x8 k0 = *(const LAS bf16x8*)(buf + kfrag + ds * 32), k1 = *(const LAS bf16x8*)(buf + kfrag + 32 * KROW + ds * 32);
                a0 = __builtin_amdgcn_mfma_f32_32x32x16_bf16(k0, qf[ds], a0, 0, 0, 0);
                a1 = __builtin_amdgcn_mfma_f32_32x32x16_bf16(k1, qf[ds], a1, 0, 0, 0);
            }
            rescale64(rowmax64(a0, a1), a0, a1, m, l, o0, o1);
            { const float nm = -m; b0 = (f32x16){nm, nm, nm, nm, nm, nm, nm, nm, nm, nm, nm, nm, nm, nm, nm, nm}; b1 = b0; }
#pragma unroll
            for (int ds = 0; ds < 6; ++ds) {
                const bf16x8 k2 = *(const LAS bf16x8*)(buf + kfrag + 64 * KROW + ds * 32), k3 = *(const LAS bf16x8*)(buf + kfrag + 96 * KROW + ds * 32);
                b0 = __builtin_amdgcn_mfma_f32_32x32x16_bf16(k2, qf[ds], b0, 0, 0, 0);
                b1 = __builtin_amdgcn_mfma_f32_32x32x16_bf16(k3, qf[ds], b1, 0, 0, 0);
            }
            exp64(a0, a1, l);
            { const bf16x8 p00 = pack_p(a0, 0), p01 = pack_p(a0, 1), p10 = pack_p(a1, 0), p11 = pack_p(a1, 1);
              pv_block(o0, buf + vfrag, p00, p01); pv_block(o0, buf + vfrag + 2048, p10, p11);
              pv_block(o1, buf + vfrag + TK * 64, p00, p01); pv_block(o1, buf + vfrag + TK * 64 + 2048, p10, p11); }
            const float mxb = rowmax64(b0, b1);
            rescale64(mxb, b0, b1, m, l, o0, o1);
            exp64(b0, b1, l);
            { const bf16x8 p00 = pack_p(b0, 0), p01 = pack_p(b0, 1), p10 = pack_p(b1, 0), p11 = pack_p(b1, 1);
              pv_block(o0, buf + vfrag + 4096, p00, p01); pv_block(o0, buf + vfrag + 6144, p10, p11);
              pv_block(o1, buf + vfrag + TK * 64 + 4096, p00, p01); pv_block(o1, buf + vfrag + TK * 64 + 6144, p10, p11); }
        }
        if (kt + 1 < nt) MLA_STORE(lds + ((kt + 1) & 1) * BUFB);
        if (pid < 131072) {
            asm volatile("s_waitcnt vmcnt(0)" ::: "memory");
            const f32x4 xv = *(const LAS f32x4*)(piece + 16 * lane);
            const int idx = pid & 65535, col = (idx & 3) * 256 + 4 * lane;
            f32x4 sc = {SV, SV, SV, SV};
            if ((pid >> 16) == 0) { const f32x4 gv_ = *(const LAS f32x4*)(lds + MLA_G_OFF + 4 * col); sc = (f32x4){gv_.x * SU, gv_.y * SU, gv_.z * SU, gv_.w * SU}; }
            unsigned char* dst = ((pid >> 16) ? V8 : U8) + (size_t)(col >> 7) * ((size_t)16384 * 128) + (size_t)(idx >> 2) * 128 + (col & 127);
            *(unsigned*)dst = pk_fp8x4(xv.x * sc.x, xv.y * sc.y, xv.z * sc.z, xv.w * sc.w);
        }
        __syncthreads();
        }
    for (; kt < nt; ++kt) {
        const LAS unsigned char* buf = lds + (kt & 1) * BUFB;
        if (kt + 1 < nt) MLA_LOAD(kt + 1);
        const int pid = slot0 + 8 * kt + wid;
        if (pid < 131072) glds16(((pid >> 16) ? v_emb : u_emb) + (size_t)(pid & 65535) * 256 + 4 * lane, piece_u);
        if (TK * kt <= wqlast) {
            const bool needB = TK * kt + 64 <= wqlast;
            const float nm = -m; const f32x16 negm = {nm, nm, nm, nm, nm, nm, nm, nm, nm, nm, nm, nm, nm, nm, nm, nm};
            f32x16 a0 = negm, a1 = negm, b0 = negm, b1 = negm;
#pragma unroll
            for (int ds = 0; ds < 6; ++ds) {
                const bf16x8 k0 = *(const LAS bf16x8*)(buf + kfrag + ds * 32), k1 = *(const LAS bf16x8*)(buf + kfrag + 32 * KROW + ds * 32);
                a0 = __builtin_amdgcn_mfma_f32_32x32x16_bf16(k0, qf[ds], a0, 0, 0, 0);
                a1 = __builtin_amdgcn_mfma_f32_32x32x16_bf16(k1, qf[ds], a1, 0, 0, 0);
            }
            if (needB) {
#pragma unroll
                for (int ds = 0; ds < 6; ++ds) {
                    const bf16x8 k2 = *(const LAS bf16x8*)(buf + kfrag + 64 * KROW + ds * 32), k3 = *(const LAS bf16x8*)(buf + kfrag + 96 * KROW + ds * 32);
                    b0 = __builtin_amdgcn_mfma_f32_32x32x16_bf16(k2, qf[ds], b0, 0, 0, 0);
                    b1 = __builtin_amdgcn_mfma_f32_32x32x16_bf16(k3, qf[ds], b1, 0, 0, 0);
                }
            }
#pragma unroll
            for (int r = 0; r < 16; ++r) { const int kp = TK * kt + crow(r, hi); if (kp > qpos) a0[r] = NEGM; if (kp + 32 > qpos) a1[r] = NEGM; if (kp + 64 > qpos) b0[r] = NEGM; if (kp + 96 > qpos) b1[r] = NEGM; }
            sm64(a0, a1, m, l, o0, o1, b0, b1, needB);
            { const bf16x8 p00 = pack_p(a0, 0), p01 = pack_p(a0, 1), p10 = pack_p(a1, 0), p11 = pack_p(a1, 1);
              pv_block(o0, buf + vfrag, p00, p01); pv_block(o0, buf + vfrag + 2048, p10, p11);
              pv_block(o1, buf + vfrag + TK * 64, p00, p01); pv_block(o1, buf + vfrag + TK * 64 + 2048, p10, p11); }
            if (needB) {
                sm64(b0, b1, m, l, o0, o1, a0, a1, false);
                const bf16x8 p00 = pack_p(b0, 0), p01 = pack_p(b0, 1), p10 = pack_p(b1, 0), p11 = pack_p(b1, 1);
                pv_block(o0, buf + vfrag + 4096, p00, p01); pv_block(o0, buf + vfrag + 6144, p10, p11);
                pv_block(o1, buf + vfrag + TK * 64 + 4096, p00, p01); pv_block(o1, buf + vfrag + TK * 64 + 6144, p10, p11);
            }

        }
        if (kt + 1 < nt) MLA_STORE(lds + ((kt + 1) & 1) * BUFB);
        if (pid < 131072) {
            asm volatile("s_waitcnt vmcnt(0)" ::: "memory");
            const f32x4 xv = *(const LAS f32x4*)(piece + 16 * lane);
            const int idx = pid & 65535, col = (idx & 3) * 256 + 4 * lane;
            f32x4 sc = {SV, SV, SV, SV};
            if ((pid >> 16) == 0) { const f32x4 gv_ = *(const LAS f32x4*)(lds + MLA_G_OFF + 4 * col); sc = (f32x4){gv_.x * SU, gv_.y * SU, gv_.z * SU, gv_.w * SU}; }
            unsigned char* dst = ((pid >> 16) ? V8 : U8) + (size_t)(col >> 7) * ((size_t)16384 * 128) + (size_t)(idx >> 2) * 128 + (col & 127);
            *(unsigned*)dst = pk_fp8x4(xv.x * sc.x, xv.y * sc.y, xv.z * sc.z, xv.w * sc.w);
        }
        __syncthreads();
        }
#undef MLA_LOAD
#undef MLA_STORE
    __builtin_amdgcn_s_setprio(0);
    l = swapsum(l);
    store_o(Mixed + (tok0 + qpos) * DM + 512 + h * 64, o0, o1, 1.0f / l, hi);
}

constexpr int DIL_KR = 144, DIL_VR = 160, DIL_VOFF = 32 * DIL_KR, DIL_WLDS = 32 * DIL_KR + 32 * DIL_VR;
constexpr int DIL_SROW = 132, DIL_STATE_OFF = 8 * DIL_WLDS;
struct DilBlk { u32x4 k[4]; u32x4 v[4]; };
__device__ __forceinline__ void dil_load(DilBlk& B, const bf16_t* __restrict__ Ka, const bf16_t* __restrict__ Va, size_t hrow0  , int rd, int dl  , int imax, int idx0, int lane) {
#pragma unroll
    for (int i = 0; i < 4; ++i) {
        int ik = idx0 + 8 * i + (lane >> 3); ik = ik < 0 ? 0 : ik; ik = ik > imax ? imax : ik;
        const size_t off = (hrow0 + ((size_t)ik << dl) + rd) * 64 + 8 * (lane & 7);
        B.k[i] = *(const u32x4*)(Ka + off); B.v[i] = *(const u32x4*)(Va + off);
    }
}
__device__ __forceinline__ void pv_block_p(f32x16& o, const LAS unsigned char* vbase, const bf16x8& pb0, const bf16x8& pb1) {
    const s16x4 l0 = vtr(vbase), h0 = vtr(vbase + 8 * DIL_VR), l1 = vtr(vbase + 16 * DIL_VR), h1 = vtr(vbase + 24 * DIL_VR);
    const bf16x8 a0 = {l0[0], l0[1], l0[2], l0[3], h0[0], h0[1], h0[2], h0[3]}, a1 = {l1[0], l1[1], l1[2], l1[3], h1[0], h1[1], h1[2], h1[3]};
    o = __builtin_amdgcn_mfma_f32_32x32x16_bf16(a0, pb0, o, 0, 0, 0);
    o = __builtin_amdgcn_mfma_f32_32x32x16_bf16(a1, pb1, o, 0, 0, 0);
}
template <bool MASK>
__device__ __forceinline__ void dil_step(const DilBlk& B, LAS unsigned char* wl, const bf16x8 (&qf)[4], float& m, float& l, f32x16& o0, f32x16& o1, int A, int idx0, int lane) {
    const int r32 = lane & 31, hi = lane >> 5;
    {
        LAS unsigned char* kp = wl + (lane >> 3) * DIL_KR + (lane & 7) * 16;
        LAS unsigned char* vp = wl + DIL_VOFF + (lane >> 3) * DIL_VR + (lane & 7) * 16;
#pragma unroll
        for (int i = 0; i < 4; ++i) { *(LAS u32x4*)(kp + 8 * i * DIL_KR) = B.k[i]; *(LAS u32x4*)(vp + 8 * i * DIL_VR) = B.v[i]; }
    }
    const float nm = -m;
    f32x16 s = {nm, nm, nm, nm, nm, nm, nm, nm, nm, nm, nm, nm, nm, nm, nm, nm};
    { const LAS unsigned char* kfr = wl + r32 * DIL_KR + 16 * hi;
#pragma unroll
      for (int ds = 0; ds < 4; ++ds) s = __builtin_amdgcn_mfma_f32_32x32x16_bf16(*(const LAS bf16x8*)(kfr + 32 * ds), qf[ds], s, 0, 0, 0); }
    if (MASK) {
        const int qi = A + r32;
#pragma unroll
        for (int r = 0; r < 16; ++r) { const int ki = idx0 + crow(r, hi), dist = qi - ki; if (ki < 0 || dist < 0 || dist > 128) s[r] = NEGM; }
    }
    float mx = max3f(s[0], s[1], s[2]);
#pragma unroll
    for (int r = 3; r < 15; r += 2) mx = max3f(mx, s[r], s[r + 1]);
    mx = fmaxf(mx, s[15]);
    mx = swapmax(mx);
    if (__builtin_expect(__builtin_amdgcn_ballot_w64(mx > THR) != 0ull, 0)) {
        const float dl_ = fmaxf(mx, 0.f), alpha = __builtin_amdgcn_exp2f(-dl_);
        m += dl_; l *= alpha;
        sub16(s, dl_); scale16(o0, alpha); scale16(o1, alpha);
    }
    float rs = 0.f;
#pragma unroll
    for (int r = 0; r < 16; ++r) { s[r] = __builtin_amdgcn_exp2f(s[r]); rs += s[r]; }
    l += rs;
    const bf16x8 p0 = pack_p(s, 0), p1 = pack_p(s, 1);
    const int i16 = lane & 15;
    const LAS unsigned char* vb = wl + DIL_VOFF + (4 * hi + (i16 >> 2)) * DIL_VR + (16 * ((lane >> 4) & 1) + 4 * (i16 & 3)) * 2;
    pv_block_p(o0, vb, p0, p1);
    pv_block_p(o1, vb + 64, p0, p1);
}
__device__ __forceinline__ void dil_unit(LAS unsigned char* wl, const bf16_t* __restrict__ Qa, const bf16_t* __restrict__ Ka, const bf16_t* __restrict__ Va, bf16_t* __restrict__ Mixed, LAS unsigned char* state,
                                         int b, int h, int p0, int dl, bool first, bool last, int lane, int pflags = 0) {
    const int r32 = lane & 31, hi = lane >> 5;
    const size_t tok0 = (size_t)b * SEQ, hrow0 = (size_t)(b * 8 + h) * SEQ;
    const int qpos = p0 + (r32 << dl);
    const int rd = p0 & ((1 << dl) - 1), A = p0 >> dl, imax = (SEQ - 1 - rd) >> dl;
    DilBlk b0, b1, b2;
#define DLOAD(B_, k_) dil_load(B_, Ka, Va, hrow0, rd, dl, imax, A - 128 + 32 * (k_), lane)
#define DSTEP(MK_, B_, k_) dil_step<MK_>(B_, wl, qf, m, l, o0, o1, A, A - 128 + 32 * (k_), lane)
    DLOAD(b0, 0); DLOAD(b1, 1);
    bf16x8 qf[4];
    { const bf16_t* qrow = Qa + (hrow0 + qpos) * 64 + 8 * hi;
#pragma unroll
      for (int ds = 0; ds < 4; ++ds) qf[ds] = *(const bf16x8*)(qrow + 16 * ds); }
    float m = 0.f, l = 0.f; f32x16 o0 = {}, o1 = {};
    LAS unsigned* st = (LAS unsigned*)(state + ((qpos & 511) * DIL_SROW));
    if (!first) {
        m = __builtin_bit_cast(float, st[32]); l = hi ? 0.f : 1.f;
#pragma unroll
        for (int g = 0; g < 4; ++g) {
            const unsigned a0 = st[4 * g + 2 * hi], a1 = st[4 * g + 2 * hi + 1], c0 = st[16 + 4 * g + 2 * hi], c1 = st[16 + 4 * g + 2 * hi + 1];
            o0[4 * g] = bf_lo(a0); o0[4 * g + 1] = bf_hi(a0); o0[4 * g + 2] = bf_lo(a1); o0[4 * g + 3] = bf_hi(a1);
            o1[4 * g] = bf_lo(c0); o1[4 * g + 1] = bf_hi(c0); o1[4 * g + 2] = bf_lo(c1); o1[4 * g + 3] = bf_hi(c1);
        }
    }
    const bool early = A - 96 < 0;
#ifdef PROBE_LO
    if (pflags & 32) { o0[0] += __builtin_bit_cast(float, b0.k[0].x ^ b1.k[0].x ^ b0.v[3].w ^ b1.v[3].w); l = 1.f; } else {
#endif
    DLOAD(b2, 2);
    DSTEP(true, b0, 0);
    DLOAD(b0, 3);
    if (early) DSTEP(true, b1, 1); else DSTEP(false, b1, 1);
    DLOAD(b1, 4);
    if (early) DSTEP(true, b2, 2); else DSTEP(false, b2, 2);
    if (early) DSTEP(true, b0, 3); else DSTEP(false, b0, 3);
    DSTEP(true, b1, 4);
#ifdef PROBE_LO
    }
#endif
#undef DLOAD
#undef DSTEP
    l = swapsum(l);
    const float inv = 1.0f / l;
    if (last) store_o(Mixed + (tok0 + qpos) * DM + h * 64, o0, o1, inv, hi);
    else {
#pragma unroll
        for (int g = 0; g < 4; ++g) {
            st[4 * g + 2 * hi] = pk_bf16(o0[4 * g] * inv, o0[4 * g + 1] * inv); st[4 * g + 2 * hi + 1] = pk_bf16(o0[4 * g + 2] * inv, o0[4 * g + 3] * inv);
            st[16 + 4 * g + 2 * hi] = pk_bf16(o1[4 * g] * inv, o1[4 * g + 1] * inv); st[16 + 4 * g + 2 * hi + 1] = pk_bf16(o1[4 * g + 2] * inv, o1[4 * g + 3] * inv);
        }
        if (hi == 0) st[32] = __builtin_bit_cast(unsigned, m + __builtin_amdgcn_logf(l));
    }
}
__device__ __forceinline__ void dil_segment(LAS unsigned char* lds, const bf16_t* __restrict__ Qa, const bf16_t* __restrict__ Ka, const bf16_t* __restrict__ Va, bf16_t* __restrict__ Mixed,
                                            int sg, int wave, int lane, int pflags = 0) {
    const int seg = sg & 15, h = (sg >> 4) & 7, b = sg >> 7, base = 512 * seg;
    LAS unsigned char* wl = lds + wave * DIL_WLDS;
#pragma unroll 1
    for (int pass = 0; pass < ((pflags & 64) ? 1 : 3); ++pass) {
        const int dl = 2 * pass;
#pragma unroll 1
        for (int j = wave; j < 16; j += 8) {
            const int rd = j & ((1 << dl) - 1), cj = j >> dl;
            dil_unit(wl, Qa, Ka, Va, Mixed, lds + DIL_STATE_OFF, b, h, base + rd + ((32 * cj) << dl), dl, pass == 0, pass == 2, lane, pflags);
        }
        if (pass < 2) __syncthreads();
    }
}
}

namespace peer {
__device__ __forceinline__ void ins16(unsigned (&L)[16], unsigned key) {
#pragma unroll
    for (int i = 0; i < 16; ++i) { const unsigned hi_ = L[i] > key ? L[i] : key; key = L[i] > key ? key : L[i]; L[i] = hi_; }
}
__device__ __forceinline__ void ce(unsigned& a, unsigned& b) { const unsigned hi_ = a > b ? a : b, lo_ = a > b ? b : a; a = hi_; b = lo_; }
__device__ __forceinline__ void sort8(unsigned (&v)[8]) {
    ce(v[0], v[1]); ce(v[2], v[3]); ce(v[4], v[5]); ce(v[6], v[7]); ce(v[0], v[2]); ce(v[1], v[3]); ce(v[4], v[6]); ce(v[5], v[7]); ce(v[1], v[2]); ce(v[5], v[6]);
    ce(v[0], v[4]); ce(v[3], v[7]); ce(v[1], v[5]); ce(v[2], v[6]); ce(v[1], v[4]); ce(v[3], v[6]); ce(v[2], v[4]); ce(v[3], v[5]); ce(v[3], v[4]);
}
__device__ __forceinline__ void bmerge16(unsigned (&v)[16]) {
#pragma unroll
    for (int k = 8; k >= 1; k >>= 1)
#pragma unroll
        for (int i = 0; i < 16; ++i) if ((i & k) == 0) ce(v[i], v[i + k]);
}
__device__ __forceinline__ float dec16(unsigned key) { const unsigned s = key >> 16; const unsigned b = (s & 0x8000u) ? (s & 0x7fffu) : (~s & 0xffffu); return (float)__builtin_bit_cast(_Float16, (unsigned short)b); }
__device__ __forceinline__ unsigned enc32(float f) { const unsigned u = __builtin_bit_cast(unsigned, f); return (u & 0x80000000u) ? ~u : (u | 0x80000000u); }
__device__ __forceinline__ float dec32(unsigned s) { const unsigned u = (s & 0x80000000u) ? (s & 0x7fffffffu) : ~s; return __builtin_bit_cast(float, u); }
__device__ __forceinline__ float gelu1(float v) {
    const float av = fabsf(v), t = __builtin_amdgcn_rcpf(av * 0.2316418882f + 1.0f);
    float q = t * 0.5307027145f + (-0.7265760135f); q = q * t + 0.7107068705f; q = q * t + (-0.142248368f); q = q * t + 0.127414796f; q = q * t;
    const float e = __builtin_amdgcn_exp2f((v * v) * (-0.72134752044f));
    const float mm = v * (q * e);
    return v < 0.f ? mm : v - mm;
}
struct CandTab { unsigned char i[52], j[52]; };
__host__ __device__ constexpr CandTab make_cands() {
    CandTab t{}; int n = 0;
    for (int i = 0; i < 16; ++i) for (int j = 0; j < 16; ++j) if ((i + 1) * (j + 1) <= 16) { t.i[n] = (unsigned char)i; t.j[n] = (unsigned char)j; ++n; }
    for (; n < 52; ++n) { t.i[n] = 15; t.j[n] = 15; }
    return t;
}

}

namespace peer2 {
__device__ __forceinline__ int ld_of(int j) { const int rho = 16 * ((j >> 2) & 3) + 4 * ((j >> 4) & 3) + (j & 3); return (j >> 6) * 64 + (rho & 7) * 8 + (rho >> 3); }

__device__ __forceinline__ void topk_phase(LAS unsigned char* lds, const bf16_t* __restrict__ Sc, const float* __restrict__ ssq_h, unsigned short* __restrict__ Pe_slot, unsigned short* __restrict__ Pe_ld,
                                           float* __restrict__ Pg, float* __restrict__ rstd_h, int gw, int ngw) {
    const int lane = threadIdx.x & 63, wid = __builtin_amdgcn_readfirstlane(threadIdx.x >> 6);
    LAS unsigned char* tile = lds + wid * 12288;
    LAS unsigned* lists = (LAS unsigned*)(tile + 8192);
    constexpr peer::CandTab CT = peer::make_cands();
    u32x4 nx[8];
#define TK_LOAD(g_, hh_) do { _Pragma("unroll") for (int i_ = 0; i_ < 8; ++i_) { const int s_ = 8 * i_ + (lane >> 3); \
        nx[i_] = *(const u32x4*)(Sc + (size_t)(4 * (g_) + (s_ >> 4)) * 2048 + (s_ & 15) * 128 + (hh_) * 64 + (lane & 7) * 8); } } while (0)
#define TK_WRITE() do { _Pragma("unroll") for (int i_ = 0; i_ < 8; ++i_) { const int s_ = 8 * i_ + (lane >> 3); *(LAS u32x4*)(tile + s_ * 128 + (((lane & 7) ^ (s_ & 7)) << 4)) = nx[i_]; } } while (0)
    if (gw < T / 4) TK_LOAD(gw, 0);
    for (int g = gw; g < T / 4; g += ngw) {
        const int t4 = lane >> 4, hp = lane & 15, tok = 4 * g + t4;
        unsigned L[16];
        {
            const LAS unsigned char* seg = tile + lane * 128;
#pragma unroll 1
            for (int gq = 0; gq < 8; ++gq) {
                if (gq == 0) { TK_WRITE(); TK_LOAD(g, 1); }
                if (gq == 4) { TK_WRITE(); if (g + ngw < T / 4) TK_LOAD(g + ngw, 0); }
                const int c0 = 2 * (gq & 3);
                const u32x4 w0 = *(const LAS u32x4*)(seg + ((c0 ^ (lane & 7)) << 4)), w1 = *(const LAS u32x4*)(seg + (((c0 + 1) ^ (lane & 7)) << 4));
                unsigned ka[8], kb[8];
#pragma unroll
                for (int e2 = 0; e2 < 4; ++e2) {
                    const unsigned wa = e2 == 0 ? w0.x : (e2 == 1 ? w0.y : (e2 == 2 ? w0.z : w0.w)), wb = e2 == 0 ? w1.x : (e2 == 1 ? w1.y : (e2 == 2 ? w1.z : w1.w));
                    typedef short s16x2_t __attribute__((ext_vector_type(2)));
                    const unsigned ma = __builtin_bit_cast(unsigned, __builtin_bit_cast(s16x2_t, wa) >> (short)15) | 0x80008000u, mb = __builtin_bit_cast(unsigned, __builtin_bit_cast(s16x2_t, wb) >> (short)15) | 0x80008000u;
                    const unsigned sa = wa ^ ma, sb = wb ^ mb;
                    const unsigned i0 = (unsigned)(127 - (16 * gq + 2 * e2));
                    ka[2 * e2] = (sa << 16) | i0; ka[2 * e2 + 1] = (sa & 0xffff0000u) | (i0 - 1u);
                    kb[2 * e2] = (sb << 16) | (i0 - 8u); kb[2 * e2 + 1] = (sb & 0xffff0000u) | (i0 - 9u);
                }
                peer::sort8(ka); peer::sort8(kb);
                unsigned G[16];
#pragma unroll
                for (int i = 0; i < 8; ++i) { G[i] = ka[i]; G[8 + i] = kb[7 - i]; }
                peer::bmerge16(G);
                if (gq == 0) {
#pragma unroll
                    for (int i = 0; i < 16; ++i) L[i] = G[i];
                } else {
#pragma unroll
                    for (int i = 0; i < 16; ++i) L[i] = L[i] > G[15 - i] ? L[i] : G[15 - i];
                    peer::bmerge16(L);
                }
            }
        }
#pragma unroll
        for (int i = 0; i < 16; ++i) lists[lane * 16 + i] = L[i];
        const int p = hp & 1;
        float av[16], bv[16];
#pragma unroll
        for (int i = 0; i < 16; ++i) { const unsigned o = (unsigned)__builtin_amdgcn_update_dpp(0, (int)L[i], 0xB1, 0xF, 0xF, true); av[i] = peer::dec16(p ? o : L[i]); bv[i] = peer::dec16(p ? L[i] : o); }
        unsigned M[16];
        {
            unsigned C[32];
#pragma unroll
            for (int k = 0; k < 25; ++k) {
                const int i0 = CT.i[2 * k], j0 = CT.j[2 * k], i1 = CT.i[2 * k + 1], j1 = CT.j[2 * k + 1];
                const float s0 = av[i0] + bv[j0], s1 = av[i1] + bv[j1];
                const float sm = p ? s1 : s0; const unsigned fl = p ? (unsigned)(i1 * 16 + j1) : (unsigned)(i0 * 16 + j0);
                C[k] = (peer::enc32(sm) & 0xffffff00u) | (255u - fl);
            }
#pragma unroll
            for (int k = 25; k < 32; ++k) C[k] = 0u;
            unsigned g0[8], g1[8], g2[8], g3[8];
#pragma unroll
            for (int i = 0; i < 8; ++i) { g0[i] = C[i]; g1[i] = C[8 + i]; g2[i] = C[16 + i]; g3[i] = C[24 + i]; }
            peer::sort8(g0); peer::sort8(g1); peer::sort8(g2); peer::sort8(g3);
            unsigned H[16];
#pragma unroll
            for (int i = 0; i < 8; ++i) { M[i] = g0[i]; M[8 + i] = g1[7 - i]; H[i] = g2[i]; H[8 + i] = g3[7 - i]; }
            peer::bmerge16(M); peer::bmerge16(H);
#pragma unroll
            for (int i = 0; i < 16; ++i) M[i] = M[i] > H[15 - i] ? M[i] : H[15 - i];
            peer::bmerge16(M);
        }
        unsigned R[16];
#pragma unroll
        for (int k = 0; k < 16; ++k) { const unsigned o = (unsigned)__builtin_amdgcn_update_dpp(0, (int)M[15 - k], 0xB1, 0xF, 0xF, true); R[k] = M[k] > o ? M[k] : o; }
        float rv[16], mx = -INFINITY;
#pragma unroll
        for (int k = 0; k < 16; ++k) { rv[k] = peer::dec32(R[k] & 0xffffff00u); mx = fmaxf(mx, rv[k]); }
        float sum = 0.f;
#pragma unroll
        for (int k = 0; k < 16; ++k) { rv[k] = __builtin_amdgcn_exp2f((rv[k] - mx) * LOG2E); sum += rv[k]; }
        const float isum = 1.0f / sum;
        {
            const int h = hp >> 1;
            const LAS unsigned* la = lists + (lane & ~1) * 16; const LAS unsigned* lb = lists + (lane | 1) * 16;
#pragma unroll
            for (int k = 0; k < 8; ++k) {
                const unsigned fl = 255u - (R[k] & 0xffu);
                const unsigned i1 = 127u - (la[fl >> 4] & 0x7fu), i2 = 127u - (lb[fl & 15u] & 0x7fu);
                const int j = h * 16 + p * 8 + k, sl = j;
                const unsigned short e = (unsigned short)(i1 * 128u + i2);
                Pe_slot[(size_t)tok * 128 + sl] = e;
                Pe_ld[(size_t)tok * 128 + ld_of(j)] = e;
                Pg[(size_t)tok * 128 + sl] = rv[k] * isum;
            }
        }
        if (hp == 0) {
            float s = 0.f;
#pragma unroll
            for (int k = 0; k < 8; ++k) { const f32x4 q = *(const f32x4*)(ssq_h + (size_t)tok * 32 + 4 * k); s += (q.x + q.y) + (q.z + q.w); }
            rstd_h[tok] = 1.0f / sqrtf(s * (1.f / 1024.f) + EPS);
        }
    }
#undef TK_LOAD
#undef TK_WRITE
}

struct UG { u32x4 v[8]; };
struct UIDS { u32x4 e0, e1, b0, b1; };
__device__ __forceinline__ void u_ids(UIDS& I, const unsigned short* __restrict__ Pe_ld, const unsigned char* __restrict__ Hx, int tok, int lane) {
    const u32x4* ip = (const u32x4*)(Pe_ld + (size_t)tok * 128 + (lane >> 3) * 8);
    I.e0 = ip[0]; I.e1 = ip[8];
    const unsigned char* hrow = Hx + (size_t)tok * 128 + 32 * (lane >> 4);
    I.b0 = *(const u32x4*)hrow; I.b1 = *(const u32x4*)(hrow + 16);
}
__device__ __forceinline__ void u_gather(UG& F, const u32x4& w, const unsigned char* __restrict__ Ul  , unsigned emask, unsigned loff = 0u  ) {
#pragma unroll
    for (int i = 0; i < 8; ++i) {
        const unsigned word = (i >> 1) == 0 ? w.x : ((i >> 1) == 1 ? w.y : ((i >> 1) == 2 ? w.z : w.w));
        const unsigned e = ((i & 1) ? (word >> 16) : (word & 0xffffu)) & emask;
        F.v[i] = *(const u32x4*)(Ul + (e * 128u + loff));
    }
}
template <int PM = 0> __device__ __forceinline__ void u_compute(u32x4& z0, u32x4& z1, const UG& F, const u32x4& b0, const u32x4& b1, LAS unsigned char* hl  , int lane) {
    if (PM == 0) {
        LAS unsigned char* wp = hl + (lane >> 3) * 128 + (((lane & 7) ^ (lane >> 3)) << 4);
#pragma unroll
        for (int i = 0; i < 8; ++i) *(LAS u32x4*)(wp + i * 1024) = F.v[i];
    }
    const v8i bfr = {(int)b0.x, (int)b0.y, (int)b0.z, (int)b0.w, (int)b1.x, (int)b1.y, (int)b1.z, (int)b1.w};
    const int r16 = lane & 15, kb = lane >> 4;
    const LAS unsigned char* rp = hl + r16 * 128;
    const int p0 = ((2 * kb) ^ (r16 & 7)) << 4, p1 = ((2 * kb + 1) ^ (r16 & 7)) << 4;
    f32x4 acc[4];
#pragma unroll
    for (int g = 0; g < 4; ++g) {
        u32x4 a0, a1; if (PM == 0) { a0 = *(const LAS u32x4*)(rp + g * 2048 + p0); a1 = *(const LAS u32x4*)(rp + g * 2048 + p1); } else { a0 = F.v[2 * g]; a1 = F.v[2 * g + 1]; }
        const v8i afr = {(int)a0.x, (int)a0.y, (int)a0.z, (int)a0.w, (int)a1.x, (int)a1.y, (int)a1.z, (int)a1.w};
        acc[g] = __builtin_amdgcn_mfma_scale_f32_16x16x128_f8f6f4(afr, bfr, (f32x4){0.f, 0.f, 0.f, 0.f}, 0, 0, 0, 0, 0, 0);
    }
    z0.x = pk_bf16(acc[0][0], acc[0][1]); z0.y = pk_bf16(acc[0][2], acc[0][3]); z0.z = pk_bf16(acc[1][0], acc[1][1]); z0.w = pk_bf16(acc[1][2], acc[1][3]);
    z1.x = pk_bf16(acc[2][0], acc[2][1]); z1.y = pk_bf16(acc[2][2], acc[2][3]); z1.z = pk_bf16(acc[3][0], acc[3][1]); z1.w = pk_bf16(acc[3][2], acc[3][3]);
}
constexpr int U_REC = 512, U_CH = 16, U_STAGE = 8192, U_WLDS = U_STAGE + U_CH * U_REC;
template <int PM = 0> __device__ __forceinline__ void u_phase(LAS unsigned char* lds, const unsigned char* __restrict__ Hb8, const unsigned char* __restrict__ U8, const unsigned short* __restrict__ Pe_ld, bf16_t* __restrict__ Zp, int x, int wg, int nwg, unsigned emask = 0xffffu) {
    const int lane = threadIdx.x & 63, wid = __builtin_amdgcn_readfirstlane(threadIdx.x >> 6);
    LAS unsigned char* wl = lds + wid * U_WLDS;
    LAS unsigned char* rb = wl + U_STAGE;
    const unsigned rb_u = (unsigned)__builtin_amdgcn_readfirstlane((int)(unsigned)(uintptr_t)rb);
    const unsigned char* Hx = Hb8 + (size_t)x * ((size_t)T * 128);
    const unsigned char* Ul = U8 + (size_t)x * ((size_t)16384 * 128); const unsigned loff = 16u * (lane & 7);
    bf16_t* Zx = Zp + (size_t)x * T * 128;
    const int n = (T - wg + nwg - 1) / nwg;
    if (n <= 0) return;
    const int nch = (n + U_CH - 1) / U_CH;
#define UTOK(k) (wg + ((k) < n ? (k) : n - 1) * nwg)
#define USB() __builtin_amdgcn_sched_barrier(0)
    const int w32 = lane & 31, sub = lane >> 5;
    const unsigned char* rbase = w32 < 16 ? (const unsigned char*)Pe_ld + 16 * w32 : (w32 < 24 ? Hx + 16 * (w32 - 16) : (const unsigned char*)Pe_ld);
    const unsigned rstride = (w32 >= 16 && w32 < 24) ? 128u : 256u;
#pragma unroll 1
    for (int c = 0; c < nch; ++c) {
#pragma unroll
        for (int i = 0; i < U_CH / 2; ++i)
            glds16(rbase + (size_t)UTOK(c * U_CH + 2 * i + sub) * rstride, rb_u + i * 1024);
        asm volatile("s_waitcnt vmcnt(0)" ::: "memory");
        UG f0, f1;
        { const u32x4 e0 = *(const LAS u32x4*)(rb + (lane >> 3) * 16); u_gather(f0, e0, Ul, emask, loff); }
#pragma unroll 1
        for (int i = 0; i < U_CH; ++i) {
            const int k = c * U_CH + i;
            const LAS unsigned char* rec = rb + i * U_REC;
            const LAS unsigned char* nrec = (i + 1 < U_CH) ? rec + U_REC : rec;
            const u32x4 e1 = *(const LAS u32x4*)(rec + 128 + (lane >> 3) * 16), e0n = *(const LAS u32x4*)(nrec + (lane >> 3) * 16);
            const u32x4 bk0 = *(const LAS u32x4*)(rec + 256 + 32 * (lane >> 4)), bk1 = *(const LAS u32x4*)(rec + 256 + 32 * (lane >> 4) + 16);
            u32x4 za, zb, zc, zd;
            u_gather(f1, e1, Ul, emask, loff);
            USB(); u_compute<PM>(za, zb, f0, bk0, bk1, wl, lane); USB();
            u_gather(f0, e0n, Ul, emask, loff);
            USB(); u_compute<PM>(zc, zd, f1, bk0, bk1, wl, lane); USB();
            if ((lane & 15) == 0 && k < n) { bf16_t* zr_ = Zx + (size_t)UTOK(k) * 128 + 16 * (lane >> 4); *(u32x4*)zr_ = za; *(u32x4*)(zr_ + 8) = zb; *(u32x4*)(zr_ + 64) = zc; *(u32x4*)(zr_ + 72) = zd; }
        }
        asm volatile("s_waitcnt vmcnt(0) lgkmcnt(0)" ::: "memory");
    }
#undef UTOK
#undef USB
}

__device__ __forceinline__ float dppf(float v, int ctrl_sel) {
    const int s = __builtin_bit_cast(int, v);
    const int r = ctrl_sel == 0 ? __builtin_amdgcn_update_dpp(0, s, 0xB1, 0xF, 0xF, true) : ctrl_sel == 1 ? __builtin_amdgcn_update_dpp(0, s, 0x4E, 0xF, 0xF, true)
                : ctrl_sel == 2 ? __builtin_amdgcn_update_dpp(0, s, 0x141, 0xF, 0xF, true) : ctrl_sel == 3 ? __builtin_amdgcn_update_dpp(0, s, 0x140, 0xF, 0xF, true) : __builtin_amdgcn_update_dpp(0, s, 0x128, 0xF, 0xF, true);
    return __builtin_bit_cast(float, r);
}
constexpr float SA = 64.f;
__device__ __forceinline__ void act_phase(LAS unsigned char* lds, const bf16_t* __restrict__ Zp, const unsigned short* __restrict__ Pe_slot, const float* __restrict__ Pg, const float* __restrict__ ssq_h,
                                          unsigned short* __restrict__ PE2, unsigned char* __restrict__ PA2, int gw, int ngw) {
    const int lane = threadIdx.x & 63, wid = __builtin_amdgcn_readfirstlane(threadIdx.x >> 6);
    LAS unsigned short* lid = (LAS unsigned short*)(lds + wid * 512);
    LAS unsigned char* lw = lds + wid * 512 + 256;
    unsigned zw[8], ew; f32x2 gg; float sp;
#define ACT_LOAD(t_) do { const size_t o_ = (size_t)(t_) * 128 + 2 * lane; _Pragma("unroll") for (int xx = 0; xx < 8; ++xx) zw[xx] = *(const unsigned*)(Zp + (size_t)xx * T * 128 + o_); \
        ew = *(const unsigned*)(Pe_slot + o_); gg = *(const f32x2*)(Pg + o_); sp = ssq_h[(size_t)(t_) * 32 + (lane & 31)]; } while (0)
    if (gw < T) ACT_LOAD(gw);
    for (int tok = gw; tok < T; tok += ngw) {
        float z0 = 0.f, z1 = 0.f;
#pragma unroll
        for (int xx = 0; xx < 8; ++xx) { z0 += bf_lo(zw[xx]); z1 += bf_hi(zw[xx]); }
        const unsigned e2 = ew; const f32x2 g2 = gg;
        float s = sp;
        if (tok + ngw < T) ACT_LOAD(tok + ngw);
        s += dppf(s, 0); s += dppf(s, 1); s += dppf(s, 2); s += dppf(s, 3);
        const int si = __builtin_bit_cast(int, s);
        const float tot = __builtin_bit_cast(float, __builtin_amdgcn_readlane(si, 0)) + __builtin_bit_cast(float, __builtin_amdgcn_readlane(si, 16));
        const float zs = (1.0f / sqrtf(tot * (1.f / 1024.f) + EPS)) * (1.0f / (SU * SX));
        const float w0 = fminf(fmaxf(peer::gelu1(z0 * zs) * g2.x * SA, -440.f), 440.f), w1 = fminf(fmaxf(peer::gelu1(z1 * zs) * g2.y * SA, -440.f), 440.f);
        const unsigned w8 = (unsigned)__builtin_amdgcn_cvt_pk_fp8_f32(w0, w1, 0, false);
        const int sl0 = 2 * lane, d0 = (sl0 & 7) * 16 + (sl0 >> 3), d1 = ((sl0 + 1) & 7) * 16 + (sl0 >> 3);
        lid[d0] = (unsigned short)(e2 & 0xffffu); lid[d1] = (unsigned short)(e2 >> 16);
        lw[d0] = (unsigned char)(w8 & 0xffu); lw[d1] = (unsigned char)((w8 >> 8) & 0xffu);
        const u32x4 ov = *(const LAS u32x4*)(lds + wid * 512 + 16 * lane);
        if (lane < 16) *(u32x4*)(PE2 + (size_t)tok * 128 + 8 * lane) = ov;
        else if (lane < 24) *(u32x4*)(PA2 + (size_t)tok * 128 + 16 * (lane - 16)) = ov;
    }
#undef ACT_LOAD
}

struct VG { u32x4 v[8]; u32x2 w; };
template <int PM = 0> __device__ __forceinline__ void v_gather(VG& Gt, const u32x4& ew, const u32x2& ww, const unsigned char* __restrict__ vb  , unsigned loff  , unsigned emask) {
    Gt.w = ww;
#pragma unroll
    for (int i = 0; i < 8; ++i) {
        const unsigned word = (i >> 1) == 0 ? ew.x : ((i >> 1) == 1 ? ew.y : ((i >> 1) == 2 ? ew.z : ew.w));
        const unsigned e = ((i & 1) ? (word >> 16) : (word & 0xffffu)) & emask;
        if (PM == 1 && (i & 1)) Gt.v[i] = Gt.v[i - 1]; else
        Gt.v[i] = *(const u32x4*)(vb + (e * 128u + loff));
    }
}
struct VSel { unsigned lo[4], hi[4]; };
__device__ __forceinline__ void v_compute(f32x4& accL, f32x4& accH, const VG& Gt, const VSel& S) {
#pragma unroll
    for (int i = 0; i < 8; ++i) {
        const unsigned d = i < 4 ? Gt.w.x : Gt.w.y;
        const unsigned b0 = __builtin_amdgcn_perm(d, d, S.lo[i & 3]), b1 = __builtin_amdgcn_perm(d, d, S.hi[i & 3]);
        const long aL = (long)(((unsigned long long)Gt.v[i].y << 32) | Gt.v[i].x), aH = (long)(((unsigned long long)Gt.v[i].w << 32) | Gt.v[i].z);
        const long bb = (long)(((unsigned long long)b1 << 32) | b0);
        accL = __builtin_amdgcn_mfma_f32_16x16x32_fp8_fp8(aL, bb, accL, 0, 0, 0);
        accH = __builtin_amdgcn_mfma_f32_16x16x32_fp8_fp8(aH, bb, accH, 0, 0, 0);
    }
}
constexpr int V_REC = 512, V_CH = 16, V_WLDS = V_CH * V_REC + 1024;
template <int PM = 0> __device__ __forceinline__ void v_phase(LAS unsigned char* lds, const unsigned char* __restrict__ V8, const unsigned short* __restrict__ PE2, const unsigned char* __restrict__ PA2, bf16_t* __restrict__ Op, int x, int wg, int nwg, unsigned emask = 0xffffu) {
    const int lane = threadIdx.x & 63, wid = __builtin_amdgcn_readfirstlane(threadIdx.x >> 6), seg8 = lane >> 3, bp = lane & 7;
    LAS unsigned char* rb = lds + wid * V_WLDS;
    LAS float* tr = (LAS float*)(rb + V_CH * V_REC);
    const unsigned rb_u = (unsigned)__builtin_amdgcn_readfirstlane((int)(unsigned)(uintptr_t)rb);
    const unsigned char* vb = V8 + (size_t)x * ((size_t)16384 * 128); const unsigned loff = 16u * (lane & 7);
    bf16_t* Ox = Op + (size_t)x * T * 128;
    VSel S;
    { const unsigned none = 0x0c0c0c0cu, keep = none & ~(0xffu << (8 * (bp & 3)));
#pragma unroll
      for (int q = 0; q < 4; ++q) { const unsigned sq = keep | ((unsigned)q << (8 * (bp & 3))); S.lo[q] = bp < 4 ? sq : none; S.hi[q] = bp < 4 ? none : sq; } }
    const bool dvalid = ((lane >> 3) & 1) == (lane >> 5);
    LAS float* trw = tr + (lane >> 5) * 128 + 64 * ((lane >> 4) & 1) + bp;
    const int n = (T - wg + nwg - 1) / nwg;
    if (n <= 0) return;
    const int nch = (n + V_CH - 1) / V_CH;
#define VTOK(k) (wg + ((k) < n ? (k) : n - 1) * nwg)
    const int w32 = lane & 31, sub = lane >> 5;
    const unsigned char* rbase = w32 < 16 ? (const unsigned char*)PE2 + 16 * w32 : (w32 < 24 ? PA2 + 16 * (w32 - 16) : (const unsigned char*)PE2);
    const unsigned rstride = (w32 >= 16 && w32 < 24) ? 128u : 256u;
    const int roff = seg8 * 32, woff = 256 + seg8 * 16;
#pragma unroll 1
    for (int c = 0; c < nch; ++c) {
        if (PM != 2 || c == 0) {
#pragma unroll
        for (int i = 0; i < V_CH / 2; ++i)
            glds16(rbase + (size_t)VTOK(c * V_CH + 2 * i + sub) * rstride, rb_u + i * 1024);
        asm volatile("s_waitcnt vmcnt(0)" ::: "memory");
        }
        VG g0, g1;
        { const u32x4 ea = *(const LAS u32x4*)(rb + roff); const u32x2 wa = *(const LAS u32x2*)(rb + woff); v_gather<PM>(g0, ea, wa, vb, loff, emask); }
#pragma unroll 1
        for (int i = 0; i < V_CH; ++i) {
            const int k = c * V_CH + i, tok = VTOK(k);
            const LAS unsigned char* rec = rb + i * V_REC;
            const LAS unsigned char* nrec = (i + 1 < V_CH) ? rec + V_REC : rec;
            f32x4 accL = {0.f, 0.f, 0.f, 0.f}, accH = {0.f, 0.f, 0.f, 0.f};
            { const u32x4 ea = *(const LAS u32x4*)(rec + roff + 16); const u32x2 wa = *(const LAS u32x2*)(rec + woff + 8); v_gather<PM>(g1, ea, wa, vb, loff, emask); }
            __builtin_amdgcn_sched_barrier(0);
            v_compute(accL, accH, g0, S);
            { const u32x4 ea = *(const LAS u32x4*)(nrec + roff); const u32x2 wa = *(const LAS u32x2*)(nrec + woff); v_gather<PM>(g0, ea, wa, vb, loff, emask); }
            __builtin_amdgcn_sched_barrier(0);
            v_compute(accL, accH, g1, S);
            if (dvalid) {
#pragma unroll
                for (int r = 0; r < 4; ++r) { trw[16 * r] = accL[r]; trw[16 * r + 8] = accH[r]; }
            }
            const f32x4 oa = *(const LAS f32x4*)(tr + 4 * w32), ob = *(const LAS f32x4*)(tr + 128 + 4 * w32);
            if (lane < 32 && k < n) {
                constexpr float sc = 1.0f / (SA * SV);
                u32x2 w; w.x = pk_bf16((oa.x + ob.x) * sc, (oa.y + ob.y) * sc); w.y = pk_bf16((oa.z + ob.z) * sc, (oa.w + ob.w) * sc); *(u32x2*)(Ox + (size_t)tok * 128 + 4 * lane) = w;
            }
        }
        if (PM != 2) asm volatile("s_waitcnt vmcnt(0) lgkmcnt(0)" ::: "memory");
    }
#undef VTOK
}

__device__ __forceinline__ void final_phase(float* __restrict__ Out, const bf16_t* __restrict__ Hb, const bf16_t* __restrict__ Op, const float* __restrict__ g_final, int gw, int ngw) {
    const int lane = threadIdx.x & 63;
    const f32x4* gr = (const f32x4*)g_final + lane;
    const f32x4 g0 = gr[0], g1 = gr[64], g2 = gr[128], g3 = gr[192];
    const bf16_t* ob = Op + (size_t)(lane >> 5) * T * 128 + 4 * (lane & 31);
    for (int t0 = 4 * gw; t0 < T; t0 += 4 * ngw) {
        u32x2 hh[4][4], o[4][4];
#pragma unroll
        for (int r = 0; r < 4; ++r) {
            const int tok = t0 + r < T ? t0 + r : T - 1;
            const bf16_t* hr = Hb + (size_t)tok * DM + 4 * lane;
#pragma unroll
            for (int j = 0; j < 4; ++j) { hh[r][j] = *(const u32x2*)(hr + 256 * j); o[r][j] = *(const u32x2*)(ob + ((size_t)(2 * j) * T + tok) * 128); }
        }
#pragma unroll
        for (int r = 0; r < 4; ++r) {
            if (t0 + r >= T) break;
            f32x4 y[4];
            float s = 0.f;
#pragma unroll
            for (int j = 0; j < 4; ++j) {
                y[j].x = bf_lo(hh[r][j].x) + bf_lo(o[r][j].x); y[j].y = bf_hi(hh[r][j].x) + bf_hi(o[r][j].x); y[j].z = bf_lo(hh[r][j].y) + bf_lo(o[r][j].y); y[j].w = bf_hi(hh[r][j].y) + bf_hi(o[r][j].y);
                s += (y[j].x * y[j].x + y[j].y * y[j].y) + (y[j].z * y[j].z + y[j].w * y[j].w);
            }
            s += dppf(s, 0); s += dppf(s, 1); s += dppf(s, 2); s += dppf(s, 3);
            const int si = __builtin_bit_cast(int, s);
            const float tot = (__builtin_bit_cast(float, __builtin_amdgcn_readlane(si, 0)) + __builtin_bit_cast(float, __builtin_amdgcn_readlane(si, 16)))
                            + (__builtin_bit_cast(float, __builtin_amdgcn_readlane(si, 32)) + __builtin_bit_cast(float, __builtin_amdgcn_readlane(si, 48)));
            const float r2 = 1.0f / sqrtf(tot * (1.f / 1024.f) + EPS);
            f32x4* yr = (f32x4*)(Out + (size_t)(t0 + r) * DM) + lane;
            yr[0] = (f32x4){y[0].x * r2 * g0.x, y[0].y * r2 * g0.y, y[0].z * r2 * g0.z, y[0].w * r2 * g0.w};
            yr[64] = (f32x4){y[1].x * r2 * g1.x, y[1].y * r2 * g1.y, y[1].z * r2 * g1.z, y[1].w * r2 * g1.w};
            yr[128] = (f32x4){y[2].x * r2 * g2.x, y[2].y * r2 * g2.y, y[2].z * r2 * g2.z, y[2].w * r2 * g2.w};
            yr[192] = (f32x4){y[3].x * r2 * g3.x, y[3].y * r2 * g3.y, y[3].z * r2 * g3.z, y[3].w * r2 * g3.w};
        }
    }
}
}


#define XB_TMO      128
#define XB_XCNT(j)  (256  + 64 * (j))
#define XB_XSUB(j)  (1280 + 64 * (j))
#define XB_XGEN(j)  (2304 + 64 * (j))
#define XB_TOP      3328
#define XB_TOPGEN   3392
#define XCD_BAR_WORDS 3456
#define XB_SPIN_CAP (1u << 18)

__device__ __forceinline__ unsigned xb_ld(unsigned* p)              { return __hip_atomic_load(p, __ATOMIC_RELAXED, __HIP_MEMORY_SCOPE_AGENT); }
__device__ __forceinline__ unsigned xb_add(unsigned* p, unsigned v) { return __hip_atomic_fetch_add(p, v, __ATOMIC_RELAXED, __HIP_MEMORY_SCOPE_AGENT); }
__device__ __forceinline__ unsigned xb_xcc_id() { return (unsigned)__builtin_amdgcn_s_getreg((3 << 11) | 20) & 0xFu; }
#define XB_SPIN(cond, bar) do { unsigned _sp = 0; while (cond) { __builtin_amdgcn_s_sleep(1); \
    if ((++_sp & 255u) == 0u) { if (xb_ld(&(bar)[XB_TMO])) break; if (_sp > XB_SPIN_CAP) { atomicAdd(&(bar)[XB_TMO], 1u); break; } } } } while (0)

struct XcdBarrier {
    unsigned* bar; unsigned x;
    volatile LAS unsigned* st;
};

__device__ __forceinline__ XcdBarrier xcd_barrier_post(unsigned* bar, volatile LAS unsigned* st) {
    XcdBarrier b; b.bar = bar; b.x = xb_xcc_id(); b.st = st;
    if (threadIdx.x == 0) (void)xb_add(&bar[XB_XCNT(b.x)], 1u);
    return b;
}
__device__ __forceinline__ void xcd_barrier_complete(unsigned* bar, unsigned x, unsigned& nloc, unsigned& nx) {
    const unsigned G = gridDim.x * gridDim.y * gridDim.z;
    unsigned sum, cnt, mine, sp = 0u;
    for (;;) {
        sum = 0u; cnt = 0u; mine = 0u;
#pragma unroll
        for (unsigned j = 0; j < 16; ++j) { const unsigned c = xb_ld(&bar[XB_XCNT(j)]); sum += c; cnt += (c > 0u) ? 1u : 0u; mine = (j == x) ? c : mine; }
        if (sum == G) break;
        __builtin_amdgcn_s_sleep(1);
        if ((++sp & 255u) == 0u) { if (xb_ld(&bar[XB_TMO])) break; if (sp > XB_SPIN_CAP) { atomicAdd(&bar[XB_TMO], 1u); break; } }
    }
    nloc = mine > 0u ? mine : 1u; nx = cnt > 0u ? cnt : 1u;
}

__device__ __forceinline__ void xcd_barrier(const XcdBarrier& b) {
    asm volatile("s_waitcnt vmcnt(0)" ::: "memory");
    __syncthreads();
    if (threadIdx.x == 0) {
        unsigned* bar = b.bar;
        __builtin_amdgcn_s_waitcnt(0);
        unsigned nloc = b.st[0], nx = b.st[1];
        if (nloc == 0u) { xcd_barrier_complete(bar, b.x, nloc, nx); b.st[0] = nloc; b.st[1] = nx; }
        const unsigned old = xb_add(&bar[XB_XSUB(b.x)], 1u);
        const unsigned gen = old / nloc;
        if (old + 1u == (gen + 1u) * nloc) {
            __builtin_amdgcn_fence(__ATOMIC_RELEASE, "agent");
            asm volatile("s_waitcnt vmcnt(0)" ::: "memory");
            const unsigned og = xb_add(&bar[XB_TOP], 1u);
            const unsigned tg = og / nx;
            if (og + 1u == (tg + 1u) * nx) xb_add(&bar[XB_TOPGEN], 1u);
            else XB_SPIN(xb_ld(&bar[XB_TOPGEN]) == tg, bar);
            __builtin_amdgcn_fence(__ATOMIC_ACQUIRE, "agent");
            xb_add(&bar[XB_XGEN(b.x)], 1u);
            asm volatile("s_waitcnt vmcnt(0)" ::: "memory");
        } else {
            XB_SPIN(xb_ld(&bar[XB_XGEN(b.x)]) == gen, bar);
            __builtin_amdgcn_fence(__ATOMIC_ACQUIRE, "agent");
            asm volatile("s_waitcnt vmcnt(0)" ::: "memory");
        }
    }
    __syncthreads();
}

constexpr int NWAVES = 8;
constexpr int LDS_BYTES = 147456;
constexpr int MISC_OFF = 146432;

struct Args {
    const float *x, *g_mix, *w_in, *g_cq, *w_uq, *g_ckv, *w_ukv, *w_out, *g_ffn, *w_pq, *sub_keys, *u_emb, *v_emb, *g_final;
    const int* pos; float* out; unsigned char* ws; int ph_lo, ph_hi; unsigned probe_mask; int probe_shift;
};

__device__ __forceinline__ void p0_transpose_item(const float* __restrict__ W, int K, int N, const float* __restrict__ gk, bf16_t* __restrict__ WT, LAS float* scr, int item, int lane) {
    const int nblk = N / 32, kb = item / nblk, nb = item % nblk, k0 = 64 * kb, n0 = 32 * nb;
    float wv[32];
#pragma unroll
    for (int i = 0; i < 32; ++i) { const int kk = 2 * i + (lane >> 5); wv[i] = W[(size_t)(k0 + kk) * N + n0 + (lane & 31)]; if (gk) wv[i] *= gk[k0 + kk]; }
#pragma unroll
    for (int i = 0; i < 32; ++i) { const int kk = 2 * i + (lane >> 5); scr[kk * 33 + (lane & 31)] = wv[i]; }
    asm volatile("s_waitcnt lgkmcnt(0)" ::: "memory");
    const int c = lane & 7;
#pragma unroll
    for (int j = 0; j < 4; ++j) { const int n = (lane >> 3) + 8 * j; const LAS float* s = scr + (8 * c) * 33 + n;
        u32x4 o; o.x = pk_bf16(s[0 * 33], s[1 * 33]); o.y = pk_bf16(s[2 * 33], s[3 * 33]); o.z = pk_bf16(s[4 * 33], s[5 * 33]); o.w = pk_bf16(s[6 * 33], s[7 * 33]);
        *(u32x4*)(WT + (size_t)(n0 + n) * K + k0 + 8 * c) = o; }
    asm volatile("s_waitcnt lgkmcnt(0)" ::: "memory");
}
__device__ __forceinline__ bf16x8 cvt8(const float* p, float s) { const f32x4 a = *(const f32x4*)p, b = *(const f32x4*)(p + 4); u32x4 w; w.x = pk_bf16(a.x * s, a.y * s); w.y = pk_bf16(a.z * s, a.w * s); w.z = pk_bf16(b.x * s, b.y * s); w.w = pk_bf16(b.z * s, b.w * s); return __builtin_bit_cast(bf16x8, w); }
__device__ __forceinline__ void p0_wcomb_item(const float* __restrict__ keys, const float* __restrict__ w_pq, const float* __restrict__ g_ffn, bf16_t* __restrict__ Wc, int item, int lane) {
    const int hp = item >> 7, nblk = (item >> 5) & 3, kblk = item & 31, n0 = 32 * nblk, k0 = 32 * kblk, r32 = lane & 31, hi = lane >> 5;
    const float* ar = keys + ((size_t)hp * 128 + n0 + r32) * 128 + 8 * hi;
    const float* br = w_pq + (size_t)(k0 + r32) * 2048 + hp * 128 + 8 * hi;
    const float gk = g_ffn[k0 + r32];
    f32x16 d = {};
#pragma unroll
    for (int cs = 0; cs < 8; ++cs) d = __builtin_amdgcn_mfma_f32_32x32x16_bf16(cvt8(ar + 16 * cs, 1.f), cvt8(br + 16 * cs, 1.f), d, 0, 0, 0);
#pragma unroll
    for (int r = 0; r < 16; ++r) Wc[((size_t)hp * 128 + n0 + crow(r, hi)) * DM + k0 + r32] = (bf16_t)(pk_bf16(d[r] * gk, 0.f) & 0xffffu);
}
__device__ __forceinline__ void p0_prologue(const Args& a, LAS unsigned char* lds, int gw, int ngw, int lane, int wave) {
    unsigned char* ws = a.ws;
    LAS float* scr = (LAS float*)(lds + wave * 16384);
    bf16_t* Wt_in = (bf16_t*)(ws + WS_WIN); bf16_t* Wt_comb = (bf16_t*)(ws + WS_WCOMB); bf16_t* Wt_out = (bf16_t*)(ws + WS_WOUT); bf16_t* Wt_uq = (bf16_t*)(ws + WS_WUQ); bf16_t* Wt_ukv = (bf16_t*)(ws + WS_WUKV);
    constexpr int I_IN = (DM / 64) * (INW / 32), I_UQ = (256 / 64) * (768 / 32), I_UKV = (128 / 64) * (1024 / 32), I_OUT = (DM / 64) * (DM / 32), I_WC = 2048;
    constexpr int NITEMS = I_IN + I_UQ + I_UKV + I_OUT + I_WC;
    for (int it = gw; it < NITEMS; it += ngw) {
        int r = it;
        if (r < I_IN) { p0_transpose_item(a.w_in, DM, INW, nullptr, Wt_in, scr, r, lane); continue; } r -= I_IN;
        if (r < I_UQ) { p0_transpose_item(a.w_uq, 256, 768, a.g_cq, Wt_uq, scr, r, lane); continue; } r -= I_UQ;
        if (r < I_UKV) { p0_transpose_item(a.w_ukv, 128, 1024, a.g_ckv, Wt_ukv, scr, r, lane); continue; } r -= I_UKV;
        if (r < I_OUT) { p0_transpose_item(a.w_out, DM, DM, nullptr, Wt_out, scr, r, lane); continue; } r -= I_OUT;
        p0_wcomb_item(a.sub_keys, a.w_pq, a.g_ffn, Wt_comb, r, lane);
    }
    const int gt = gw * 64 + lane, ngt = ngw * 64;
    for (int i = gt; i < (2048 - INW) * DM / 8; i += ngt) *(u32x4*)(Wt_in + (size_t)INW * DM + (size_t)i * 8) = (u32x4){0u, 0u, 0u, 0u};
    { bf16_t* HN = (bf16_t*)(ws + WS_HN);
      const f32x4* gr = (const f32x4*)a.g_mix + lane;
      const f32x4 g0 = gr[0], g1 = gr[64], g2 = gr[128], g3 = gr[192];
      for (int m0 = 4 * gw; m0 < T; m0 += 4 * ngw) {
          f32x4 v[4][4];
#pragma unroll
          for (int r = 0; r < 4; ++r) { const f32x4* xr = (const f32x4*)(a.x + (size_t)(m0 + r) * DM) + lane; v[r][0] = xr[0]; v[r][1] = xr[64]; v[r][2] = xr[128]; v[r][3] = xr[192]; }
#pragma unroll
          for (int r = 0; r < 4; ++r) {
              float s = 0.f;
#pragma unroll
              for (int j = 0; j < 4; ++j) s += (v[r][j].x * v[r][j].x + v[r][j].y * v[r][j].y) + (v[r][j].z * v[r][j].z + v[r][j].w * v[r][j].w);
              const float rstd = 1.0f / sqrtf(wave_sum(s) * (1.f / DM) + EPS);
              u32x2* o8 = (u32x2*)(HN + (size_t)(m0 + r) * DM) + lane;
              u32x2 w;
              w.x = pk_bf16(v[r][0].x * rstd * g0.x, v[r][0].y * rstd * g0.y); w.y = pk_bf16(v[r][0].z * rstd * g0.z, v[r][0].w * rstd * g0.w); o8[0] = w;
              w.x = pk_bf16(v[r][1].x * rstd * g1.x, v[r][1].y * rstd * g1.y); w.y = pk_bf16(v[r][1].z * rstd * g1.z, v[r][1].w * rstd * g1.w); o8[64] = w;
              w.x = pk_bf16(v[r][2].x * rstd * g2.x, v[r][2].y * rstd * g2.y); w.y = pk_bf16(v[r][2].z * rstd * g2.z, v[r][2].w * rstd * g2.w); o8[128] = w;
              w.x = pk_bf16(v[r][3].x * rstd * g3.x, v[r][3].y * rstd * g3.y); w.y = pk_bf16(v[r][3].z * rstd * g3.z, v[r][3].w * rstd * g3.w); o8[192] = w;
          } } }
    { float* cosA = (float*)(ws + WS_COSA); float* sinA = (float*)(ws + WS_SINA); float* cosM = (float*)(ws + WS_COSM); float* sinM = (float*)(ws + WS_SINM);
      constexpr float INV16[16] = {1.0f, 0.44036659598350525f, 0.1939227432012558f, 0.08539710193872452f, 0.03760603070259094f, 0.016560440883040428f, 0.007292664609849453f, 0.0032114461064338684f,
                                   0.0014142135623842478f, 0.0006227724370546639f, 0.00027424818836152554f, 0.00012076973507646471f, 5.3182957344688475e-05f, 2.34199997066753e-05f, 1.0313385246263351e-05f, 4.541670477919979e-06f};
      for (int i = gt; i < T * 16; i += ngt) {
          const int tok = i >> 4, j = i & 15;
          const float ang = (float)a.pos[tok] * INV16[j];
          float sn, cs; sincosf(ang, &sn, &cs);
          cosM[tok * 16 + j] = cs; sinM[tok * 16 + j] = sn;
          if ((j & 1) == 0) { cosA[tok * 8 + (j >> 1)] = cs; sinA[tok * 8 + (j >> 1)] = sn; } } }
}

__global__ void __launch_bounds__(NWAVES * 64, 2) mk_fwd(Args a) {
    extern __shared__ __attribute__((aligned(16))) unsigned char lds_raw[];
    LAS unsigned char* lds = (LAS unsigned char*)lds_raw;
    volatile LAS unsigned* MISC = (volatile LAS unsigned*)(lds + MISC_OFF);
    const int tid = threadIdx.x, lane = tid & 63, wave = __builtin_amdgcn_readfirstlane(tid >> 6);
    const int G = gridDim.x, bx = blockIdx.x, vcu = (G % 8 == 0) ? (bx % 8) * (G / 8) + bx / 8 : bx;
    unsigned char* ws = a.ws;
    for (int u = tid; u < 64; u += NWAVES * 64) MISC[u] = 0u;
    __syncthreads();
    XcdBarrier bar = xcd_barrier_post((unsigned*)(ws + WS_CTL), MISC + 8);
    const int lo = a.ph_lo, hi = a.ph_hi;
#ifdef PROBE_LO
#define PMASK a.probe_mask
#else
#define PMASK 0xffffu
#endif
#define IN(k) (lo <= (k) && (k) < hi)
#ifdef PROBE_LO
#define RUN(k) (IN(k) && !(a.probe_shift & 16))
#else
#define RUN(k) IN(k)
#endif
#define SEAM(k) do { if (IN(k) && IN((k) + 1)) xcd_barrier(bar); } while (0)
    const int gw = vcu * NWAVES + wave, ngw = G * NWAVES;

    if (RUN(0)) { p0_prologue(a, lds, gw, ngw, lane, wave); }
    SEAM(0);
    if (RUN(1)) {
        pg8::Gemm g{(const bf16_t*)(ws + WS_HN), (const bf16_t*)(ws + WS_WIN), T, 2048, DM}; pg8::StaticOrder S; S.init(T, 2048, G, bx);
        pg8::EpiProj E{(bf16_t*)(ws + WS_QA), (bf16_t*)(ws + WS_KA), (bf16_t*)(ws + WS_VA), (bf16_t*)(ws + WS_CQ), (bf16_t*)(ws + WS_CKV), (bf16_t*)(ws + WS_KR),
                       (float*)(ws + WS_SSQQ), (float*)(ws + WS_SSQKV), (const float*)(ws + WS_COSA), (const float*)(ws + WS_SINA), (const float*)(ws + WS_COSM), (const float*)(ws + WS_SINM)};
        pg8::gemm_phase<pg8::EpiProj, pg8::StaticOrder, true, true>(lds, g, S, E);
    }
    SEAM(1);
    if (RUN(2)) {
        { int kk = 128; asm volatile("" : "+s"(kk));
          pg8::Gemm g{(const bf16_t*)(ws + WS_CKV), (const bf16_t*)(ws + WS_WUKV), T, 1024, kk}; pg8::StaticOrder S; S.init(T, 1024, G, bx);
          pg8::EpiKv E{(bf16_t*)(ws + WS_KN), (bf16_t*)(ws + WS_VM), (const float*)(ws + WS_SSQKV)};
          pg8::gemm_phase<pg8::EpiKv, pg8::StaticOrder, true, true>(lds, g, S, E); }
        __syncthreads();
        { int kk = 256; asm volatile("" : "+s"(kk));
          pg8::Gemm g{(const bf16_t*)(ws + WS_CQ), (const bf16_t*)(ws + WS_WUQ), T, 768, kk}; pg8::StaticOrder S; S.init(T, 768, G, bx);
          pg8::EpiQm E{(bf16_t*)(ws + WS_QM), (const float*)(ws + WS_SSQQ), (const float*)(ws + WS_COSM), (const float*)(ws + WS_SINM)};
          pg8::gemm_phase<pg8::EpiQm, pg8::StaticOrder, true, true>(lds, g, S, E); }
    }
    SEAM(2);
    if (RUN(3)) {
        if (!(a.probe_shift & 1)) for (int pr = vcu; pr < 256; pr += G) {
            const int bh = pr >> 4, s = pr & 15;
            att::mla_unit(lds, (const bf16_t*)(ws + WS_QM), (const bf16_t*)(ws + WS_KN), (const bf16_t*)(ws + WS_KR), (const bf16_t*)(ws + WS_VM), (bf16_t*)(ws + WS_MIXED), bh >> 3, bh & 7, 31 - s,
                          a.u_emb, a.v_emb, a.g_ffn, ws + WS_U8, ws + WS_V8, pr * 528);
            att::mla_unit(lds, (const bf16_t*)(ws + WS_QM), (const bf16_t*)(ws + WS_KN), (const bf16_t*)(ws + WS_KR), (const bf16_t*)(ws + WS_VM), (bf16_t*)(ws + WS_MIXED), bh >> 3, bh & 7, s,
                          a.u_emb, a.v_emb, a.g_ffn, ws + WS_U8, ws + WS_V8, pr * 528 + 16 * (32 - s));
        }
        if (!(a.probe_shift & 2)) for (int sg = vcu; sg < 256; sg += G)
            att::dil_segment(lds, (const bf16_t*)(ws + WS_QA), (const bf16_t*)(ws + WS_KA), (const bf16_t*)(ws + WS_VA), (bf16_t*)(ws + WS_MIXED), sg, wave, lane, a.probe_shift);
    }
    SEAM(3);
    if (RUN(4)) {
        pg8::Gemm g{(const bf16_t*)(ws + WS_MIXED), (const bf16_t*)(ws + WS_WOUT), T, DM, DM}; pg8::StaticOrder S; S.init(T, DM, G, bx);
        pg8::EpiOut E{a.x, (bf16_t*)(ws + WS_HB), ws + WS_HB8, (float*)(ws + WS_SSQH)};
        pg8::gemm_phase<pg8::EpiOut, pg8::StaticOrder, true, true>(lds, g, S, E);
    }
    SEAM(4);
    if (RUN(5)) {
        pg8::Gemm g{(const bf16_t*)(ws + WS_HB), (const bf16_t*)(ws + WS_WCOMB), T, 2048, DM}; pg8::StaticOrder S; S.init(T, 2048, G, bx);
        pg8::EpiSc E{(bf16_t*)(ws + WS_SC), (const float*)(ws + WS_SSQH)};
        pg8::gemm_phase<pg8::EpiSc, pg8::StaticOrder, true, true>(lds, g, S, E);
    }
    SEAM(5);
    if (RUN(6)) {
        peer2::topk_phase(lds, (const bf16_t*)(ws + WS_SC), (const float*)(ws + WS_SSQH), (unsigned short*)(ws + WS_PESLOT), (unsigned short*)(ws + WS_PEROW), (float*)(ws + WS_PG), (float*)(ws + WS_RSTDH), gw, ngw);
    }
    SEAM(6);
    const int sx = bx % 8, smem = (bx / 8) * NWAVES + wave, scnt = ((G - sx + 7) / 8) * NWAVES;
#ifdef PROBE_LO
    if (RUN(7) && (a.probe_shift & 8)) { peer2::u_phase<1>(lds, ws + WS_HB8, ws + WS_U8, (const unsigned short*)(ws + WS_PEROW), (bf16_t*)(ws + 160 * MiB), sx, smem, scnt, PMASK); } else
#endif
    if (RUN(7)) { peer2::u_phase(lds, ws + WS_HB8, ws + WS_U8, (const unsigned short*)(ws + WS_PEROW), (bf16_t*)(ws + WS_ZP), sx, smem, scnt, PMASK); }
    SEAM(7);
    if (RUN(8)) { peer2::act_phase(lds, (const bf16_t*)(ws + WS_ZP), (const unsigned short*)(ws + WS_PESLOT), (const float*)(ws + WS_PG), (const float*)(ws + WS_SSQH), (unsigned short*)(ws + WS_PE2), ws + WS_PA2, gw, ngw); }
    SEAM(8);
#ifdef PROBE_LO
    if (RUN(9) && (a.probe_shift & 128)) { peer2::v_phase<2>(lds, ws + WS_V8, (const unsigned short*)(ws + WS_PE2), ws + WS_PA2, (bf16_t*)(ws + 160 * MiB), sx, smem, scnt, PMASK); } else
    if (RUN(9) && (a.probe_shift & 4)) { peer2::v_phase<1>(lds, ws + WS_V8, (const unsigned short*)(ws + WS_PE2), ws + WS_PA2, (bf16_t*)(ws + WS_OP), sx, smem, scnt, PMASK); } else
#endif
    if (RUN(9)) { peer2::v_phase(lds, ws + WS_V8, (const unsigned short*)(ws + WS_PE2), ws + WS_PA2, (bf16_t*)(ws + WS_OP), sx, smem, scnt, PMASK); }
    SEAM(9);
    if (RUN(10)) { peer2::final_phase(a.out, (const bf16_t*)(ws + WS_HB), (const bf16_t*)(ws + WS_OP), a.g_final, gw, ngw); }
#undef IN
#undef RUN
#undef SEAM
}


#ifndef STAGE
#define STAGE 6
#endif
extern "C" void kernel_launch(void* const* d_in, const int* in_sizes, int n_in, void* d_out, int out_size, void* d_ws, size_t ws_size, hipStream_t stream) {
    static int grid = 0;
    if (grid == 0) {
        if (n_in != 15 || out_size != T * DM || ws_size < 256 * MiB) { fprintf(stderr, "kernel_launch: unexpected problem shape (n_in %d, out %d, ws %zu); nothing launched\n", n_in, out_size, ws_size); grid = -1; return; }
        int dev = 0, cus = 0, per_cu = 0;
        if (hipGetDevice(&dev) != hipSuccess || hipDeviceGetAttribute(&cus, hipDeviceAttributeMultiprocessorCount, dev) != hipSuccess) { grid = -1; return; }
        if (hipFuncSetAttribute((const void*)mk_fwd, hipFuncAttributeMaxDynamicSharedMemorySize, LDS_BYTES) != hipSuccess) { fprintf(stderr, "kernel_launch: hipFuncSetAttribute failed\n"); grid = -1; return; }
        if (hipOccupancyMaxActiveBlocksPerMultiprocessor(&per_cu, (const void*)mk_fwd, NWAVES * 64, LDS_BYTES) != hipSuccess || per_cu < 1) fprintf(stderr, "kernel_launch: note: occupancy query says %d workgroups per CU\n", per_cu);
        (void)hipGetLastError();
        grid = cus;
        if (grid < 8) { fprintf(stderr, "kernel_launch: %d CUs: the PEER slice phases need a grid of at least 8 workgroups; nothing launched\n", grid); grid = -1; return; }
    }
    if (grid < 0) return;
    unsigned char* ws = (unsigned char*)d_ws;
    (void)hipMemsetAsync(ws + WS_CTL, 0, CTL_ZERO_BYTES, stream);
    Args a{};
    a.x = (const float*)d_in[0]; a.pos = (const int*)d_in[1]; a.g_mix = (const float*)d_in[2]; a.w_in = (const float*)d_in[3]; a.g_cq = (const float*)d_in[4]; a.w_uq = (const float*)d_in[5];
    a.g_ckv = (const float*)d_in[6]; a.w_ukv = (const float*)d_in[7]; a.w_out = (const float*)d_in[8]; a.g_ffn = (const float*)d_in[9]; a.w_pq = (const float*)d_in[10]; a.sub_keys = (const float*)d_in[11];
    a.u_emb = (const float*)d_in[12]; a.v_emb = (const float*)d_in[13]; a.g_final = (const float*)d_in[14];
    a.out = (float*)d_out; a.ws = ws; a.ph_lo = 0; a.ph_hi = (STAGE >= 6) ? 11 : STAGE + 1; a.probe_mask = 0xffffu; a.probe_shift = 0;
#if defined(PROBE_LO) && PROBE_LO == 3
    { Args b1 = a; b1.ph_hi = 4; b1.probe_shift = PROBE_SHIFT; hipLaunchKernelGGL(mk_fwd, dim3(grid), dim3(NWAVES * 64), LDS_BYTES, stream, b1);
      (void)hipMemsetAsync(ws + WS_CTL, 0, CTL_ZERO_BYTES, stream); a.ph_lo = 3; }
#endif
    hipLaunchKernelGGL(mk_fwd, dim3(grid), dim3(NWAVES * 64), LDS_BYTES, stream, a);
#if defined(PROBE_LO) && PROBE_LO != 3
#if 0
#else
    { Args b2 = a; b2.ph_lo = PROBE_LO; b2.ph_hi = PROBE_HI; b2.probe_shift = PROBE_SHIFT; b2.probe_mask = PROBE_MASK; (void)hipMemsetAsync(ws + WS_CTL, 0, CTL_ZERO_BYTES, stream); hipLaunchKernelGGL(mk_fwd, dim3(grid), dim3(NWAVES * 64), LDS_BYTES, stream, b2); }
#endif
#endif
#if STAGE < 6
    float* out = (float*)d_out; float* mixed = out;
    const size_t MB = MiB;
#if STAGE == 2
    {
        float* q32 = (float*)(ws + 0 * MB); float* k32 = (float*)(ws + 32 * MB); float* v32 = (float*)(ws + 64 * MB);
        const long n = (long)T * 512;
        nv::k_cvt<<<(int)((n + 255) / 256), 256, 0, stream>>>((const bf16_t*)(ws + WS_QA), q32, n, 1.0f / LOG2E);
        nv::k_cvt<<<(int)((n + 255) / 256), 256, 0, stream>>>((const bf16_t*)(ws + WS_KA), k32, n, 1.0f);
        nv::k_cvt<<<(int)((n + 255) / 256), 256, 0, stream>>>((const bf16_t*)(ws + WS_VA), v32, n, 1.0f);
        nv::k_dilated<<<T * 8 / 4, 256, 0, stream>>>(q32, k32, v32, mixed);
        float* qm32 = (float*)(ws + 112 * MB);
        const long nq = (long)T * 768;
        nv::k_cvt<<<(int)((nq + 255) / 256), 256, 0, stream>>>((const bf16_t*)(ws + WS_QM), qm32, nq, 1.0f / LOG2E);
        float* Kt = (float*)(ws + 0 * MB); float* Vt = Kt + (size_t)NB * 8 * 96 * SEQ;
        nv::k_build_ktvt<<<(int)(((long)NB * 8 * 160 * SEQ + 255) / 256), 256, 0, stream>>>((const bf16_t*)(ws + WS_KN), (const bf16_t*)(ws + WS_VM), (const bf16_t*)(ws + WS_KR), Kt, Vt);
        nv::k_mla<<<NB * 8 * (SEQ / 4), 256, 0, stream>>>(qm32, Kt, Vt, mixed);
    }
#elif STAGE == 3
    { const long n = (long)T * DM; nv::k_cvt<<<(int)((n + 255) / 256), 256, 0, stream>>>((const bf16_t*)(ws + WS_MIXED), mixed, n, 1.0f); }
#endif
    float* hbuf = (float*)(ws + 192 * MB); float* rstd_h = (float*)(ws + 180 * MB);
#if STAGE <= 3
    nv::k_gemm<<<dim3(DM / 64, T / 64), 256, 0, stream>>>(mixed, DM, nullptr, nullptr, a.w_out, DM, hbuf, DM, T, DM, DM, a.x, DM);
#else
    (void)hipMemcpyAsync(hbuf, out, (size_t)T * DM * 4, hipMemcpyDeviceToDevice, stream);
#endif
    float* qp = (float*)(ws + 0 * MB);
    float* vals = (float*)(ws + 128 * MB); int* idxs = (int*)(ws + 145 * MB); int* expert = (int*)(ws + 162 * MB); float* gate = (float*)(ws + 171 * MB);
    nv::k_rstd<<<T / 4, 256, 0, stream>>>(hbuf, DM, DM, rstd_h, T);
    nv::k_gemm<<<dim3(2048 / 64, T / 64), 256, 0, stream>>>(hbuf, DM, rstd_h, a.g_ffn, a.w_pq, 2048, qp, 2048, T, 2048, DM, nullptr, 0);
    (void)hipFuncSetAttribute((const void*)nv::k_topk1, hipFuncAttributeMaxDynamicSharedMemorySize, 65536);
    nv::k_topk1<<<dim3(T / 256, 16), 256, 65536, stream>>>(qp, a.sub_keys, vals, idxs);
    nv::k_topk2<<<T * 8 / 256, 256, 0, stream>>>(vals, idxs, expert, gate);
    nv::k_peer_final<<<T / 4, 256, 0, stream>>>(hbuf, rstd_h, a.g_ffn, a.u_emb, a.v_emb, expert, gate, a.g_final, out);
#endif
}
```

```cpp
#include <hip/hip_runtime.h>
#include <hip/hip_bf16.h>
#include <math.h>
#include <stdio.h>
#include <stdint.h>

#define LAS __attribute__((address_space(3)))
#define GAS __attribute__((address_space(1)))
typedef unsigned short bf16_t;
typedef short bf16x8 __attribute__((ext_vector_type(8)));
typedef short s16x4 __attribute__((ext_vector_type(4)));
typedef float f32x2 __attribute__((ext_vector_type(2)));
typedef float f32x4 __attribute__((ext_vector_type(4)));
typedef float f32x16 __attribute__((ext_vector_type(16)));
typedef unsigned u32x2 __attribute__((ext_vector_type(2)));
typedef unsigned u32x4 __attribute__((ext_vector_type(4)));
typedef __bf16 bf16x2_t __attribute__((ext_vector_type(2)));
typedef _Float16 f16x2_t __attribute__((ext_vector_type(2)));
typedef int v8i __attribute__((ext_vector_type(8)));

constexpr int DM = 1024, NB = 2, SEQ = 8192, T = NB * SEQ;
constexpr int INW = 1952;
constexpr float EPS = 1e-6f;
constexpr float LOG2E = 1.4426950408889634f;
constexpr float QA_SCALE = 0.125f * LOG2E;
constexpr float QM_SCALE = 0.10206207261596577f * LOG2E;

constexpr size_t MiB = 1u << 20;
constexpr size_t WS_CTL = 0, CTL_ZERO_BYTES = 64 * 1024;
constexpr size_t WS_COSA = 1 * MiB, WS_SINA = WS_COSA + 512 * 1024, WS_COSM = 2 * MiB, WS_SINM = 3 * MiB;
constexpr size_t WS_WIN = 4 * MiB, WS_WCOMB = 8 * MiB, WS_WOUT = 12 * MiB, WS_WUQ = 14 * MiB, WS_WUKV = 14 * MiB + 512 * 1024;
constexpr size_t WS_SSQQ = 15 * MiB, WS_SSQKV = 15 * MiB + 512 * 1024;
constexpr size_t WS_U8 = 16 * MiB, WS_V8 = 32 * MiB;
constexpr size_t WS_HN = 80 * MiB, WS_MIXED = 80 * MiB;
constexpr size_t WS_QA = 112 * MiB, WS_KA = 128 * MiB, WS_VA = 144 * MiB;
constexpr size_t WS_CQ = 160 * MiB, WS_CKV = 168 * MiB, WS_KR = 172 * MiB;
constexpr size_t WS_QM = 176 * MiB, WS_KN = 200 * MiB, WS_VM = 216 * MiB;
constexpr size_t WS_SSQH = 232 * MiB;
constexpr size_t WS_HB = 112 * MiB, WS_SC = 144 * MiB;
constexpr size_t WS_HB8 = 208 * MiB;
constexpr size_t WS_ZP = 48 * MiB, WS_PEROW = 80 * MiB, WS_PESLOT = 84 * MiB, WS_PG = 88 * MiB, WS_SSQY = 96 * MiB, WS_RSTDH = 97 * MiB, WS_PE2 = 176 * MiB, WS_PA2 = 180 * MiB;
constexpr size_t WS_OP = 144 * MiB;
constexpr float SU = 256.f, SX = 16.f, SV = 64.f;
constexpr size_t WS_END = 234 * MiB;
static_assert(WS_KA == WS_QA + 16 * MiB && WS_VA == WS_KA + 16 * MiB && WS_VM == WS_KN + 16 * MiB, "epilogues address Ka/Va and Vm relative to Qa and Kn");

__device__ __forceinline__ unsigned pk_bf16(float lo, float hi) { f32x2 v = {lo, hi}; bf16x2_t b = __builtin_convertvector(v, bf16x2_t); return __builtin_bit_cast(unsigned, b); }
__device__ __forceinline__ unsigned pk_f16(float lo, float hi) { f32x2 v = {lo, hi}; f16x2_t b = __builtin_convertvector(v, f16x2_t); return __builtin_bit_cast(unsigned, b); }
__device__ __forceinline__ unsigned pk_fp8x4(float a, float b, float c, float d) { int w = __builtin_amdgcn_cvt_pk_fp8_f32(a, b, 0, false); w = __builtin_amdgcn_cvt_pk_fp8_f32(c, d, w, true); return (unsigned)w; }
__device__ __forceinline__ float bf_lo(unsigned w) { return __builtin_bit_cast(float, w << 16); }
__device__ __forceinline__ float bf_hi(unsigned w) { return __builtin_bit_cast(float, w & 0xffff0000u); }
__device__ __forceinline__ float wave_sum(float v) {
#pragma unroll
    for (int o = 1; o < 64; o <<= 1) v += __shfl_xor(v, o);
    return v;
}
__device__ __forceinline__ int crow(int r, int hi) { return (r & 3) + 8 * (r >> 2) + 4 * hi; }
__device__ __forceinline__ void glds16(const void* gsrc, unsigned lds_dst) { unsigned keep;
    asm volatile("s_mov_b32 %0, m0\n\ts_mov_b32 m0, %2\n\ts_nop 0\n\tglobal_load_lds_dwordx4 %1, off\n\ts_mov_b32 m0, %0" : "=&s"(keep) : "v"(gsrc), "s"(lds_dst) : "memory"); }

#define STAGE 6


namespace pg8 {
#define PG8_LAS __attribute__((address_space(3)))
typedef unsigned short bf16_t;
typedef short bf16x8 __attribute__((ext_vector_type(8)));
typedef float f32x4 __attribute__((ext_vector_type(4)));
typedef unsigned u32x4 __attribute__((ext_vector_type(4)));
constexpr int BM = 256, BK = 64, HALF = 128, HTB = HALF * BK * 2  , STAGE_BYTES = 8 * HTB, NXCD = 8, WGM = 8;

__host__ __device__ __forceinline__ int lds_byte(int r, int c) { const int st = (r >> 4) * 2 + (c >> 5), rr = r & 15, cc = c & 31, ob = rr * 64 + cc * 2; return st * 1024 + (ob ^ (((ob >> 9) & 1) << 5)); }
__host__ __device__ __forceinline__ void stage_rc(int b, int& R, int& C) { const int st = b / 1024, sb = b % 1024, swz = sb ^ (((sb >> 9) & 1) << 5); R = (st >> 1) * 16 + swz / 64; C = (st & 1) * 32 + (swz % 64) / 2; }
__host__ __device__ __forceinline__ int perm32(int rho) { const int n = rho >> 4, i = rho & 15; return 8 * (i >> 2) + 4 * n + (i & 3); }

struct Unit { int pm, pn; };
struct Gemm { const bf16_t* A; const bf16_t* Bt; int M, N, K; };

struct StaticOrder {
    int nM, nN, nwg, G, c;
    __host__ __device__ void init(int M, int N, int G_, int c_) { nM = M / BM; nN = N / BM; nwg = nM * nN; G = G_; c = c_; }
    __host__ __device__ bool next(int i, Unit& u) const {
        const long L = (long)i * G + c; if (L >= nwg) return false;
        int wgid = (int)L; { const int q = nwg / NXCD, r = nwg % NXCD, xcd = wgid % NXCD, off = wgid / NXCD; wgid = (xcd < r ? xcd * (q + 1) : r * (q + 1) + (xcd - r) * q) + off; }
        const int nig = WGM * nN, gid = wgid / nig, fm = gid * WGM, gsz = (nM - fm) < WGM ? (nM - fm) : WGM;
        u.pm = fm + ((wgid % nig) % gsz); u.pn = (wgid % nig) / gsz; return true;
    }
    __device__ __forceinline__ void a_ready(const Unit&) const {}
    __device__ __forceinline__ void done(const Unit&) const {}
};


__device__ __forceinline__ unsigned cvt_pk_bf16(float lo, float hi) { unsigned r; asm volatile("v_cvt_pk_bf16_f32 %0, %1, %2" : "=v"(r) : "v"(lo), "v"(hi)); return r; }
typedef float f32x2 __attribute__((ext_vector_type(2)));

__device__ __forceinline__ void load8(const float* p, float (&o)[8]);

template <class Epi, class Sched, bool ALIGN_EPI = false, bool SP2 = false>
__device__ __forceinline__ void gemm_phase(PG8_LAS unsigned char* lds, const Gemm g, const Sched& S, const Epi& E) {
    const int tid = threadIdx.x, wid = __builtin_amdgcn_readfirstlane(tid >> 6), lane = tid & 63, wr = wid >> 2, wc = wid & 3, fr = lane & 15, fq = lane >> 4;
    const int K = g.K, nt = K / BK;
    unsigned voffA[2], voffB[2];
#pragma unroll
    for (int i = 0; i < 2; ++i) { int R, C; stage_rc(tid * 16 + i * 8192, R, C); const int Rb = Epi::PERM ? ((R & ~31) + perm32(R & 31)) : R;
        voffA[i] = (unsigned)(R * K + C) * 2u; voffB[i] = (unsigned)(Rb * K + C) * 2u; }
    const size_t kstep = (size_t)(BK * 2);
    const size_t hstep = (size_t)HALF * K * 2;
    const size_t tstep = 2 * hstep;
    const unsigned ldsw = (unsigned)wid * 1024u;
    const int aoff = lds_byte(wr * 64 + fr, fq * 8), boff = lds_byte(wc * 32 + fr, fq * 8);
#define PG8_SA(b, h) (((b) * 2 + (h)) * HTB)
#define PG8_SB(b, h) ((4 + (b) * 2 + (h)) * HTB)
#define PG8_STAGE(bufoff, gbase, voff) do { _Pragma("unroll") for (int _i = 0; _i < 2; ++_i) \
        __builtin_amdgcn_global_load_lds((const unsigned*)((const char*)(gbase) + (voff)[_i]), (PG8_LAS unsigned*)(lds + (bufoff) + ldsw + _i * 8192), 16, 0, 0); } while (0)
#define PG8_LDA(dst, b, h) do { _Pragma("unroll") for (int m = 0; m < 4; ++m) _Pragma("unroll") for (int k = 0; k < 2; ++k) dst[m][k] = *(const PG8_LAS bf16x8*)(lds + PG8_SA(b, h) + aoff + m * 2048 + k * 1024); } while (0)
#define PG8_LDB(dst, b, h) do { _Pragma("unroll") for (int n = 0; n < 2; ++n) _Pragma("unroll") for (int k = 0; k < 2; ++k) dst[n][k] = *(const PG8_LAS bf16x8*)(lds + PG8_SB(b, h) + boff + n * 2048 + k * 1024); } while (0)
#define PG8_MMA(ai, bj, At, Bt) do { __builtin_amdgcn_s_setprio(1); _Pragma("unroll") for (int m = 0; m < 4; ++m) _Pragma("unroll") for (int n = 0; n < 2; ++n) _Pragma("unroll") for (int k = 0; k < 2; ++k) \
        acc[ai][bj][m][n] = __builtin_amdgcn_mfma_f32_16x16x32_bf16(Bt[n][k], At[m][k], acc[ai][bj][m][n], 0, 0, 0); __builtin_amdgcn_s_setprio(0); } while (0)
#define PG8_WAIT_V(n) asm volatile("s_waitcnt vmcnt(" #n ")" ::: "memory")
#define PG8_WAIT_L(n) asm volatile("s_waitcnt lgkmcnt(" #n ")" ::: "memory")
#define PG8_BAR __builtin_amdgcn_s_barrier()
#define PG8_SCHED __builtin_amdgcn_sched_barrier(0)
    Unit cur, nxt; int ui = 0;
    if (!S.next(0, cur)) return;
    f32x4 acc[2][2][4][2];
#pragma unroll
    for (int a = 0; a < 2; ++a)
#pragma unroll
        for (int b = 0; b < 2; ++b)
#pragma unroll
            for (int m = 0; m < 4; ++m)
#pragma unroll
                for (int n = 0; n < 2; ++n) acc[a][b][m][n] = (f32x4){0.f, 0.f, 0.f, 0.f};
    bf16x8 At[4][2], B0[2][2], B1[2][2];
    const char* cA = (const char*)g.A + (size_t)cur.pm * tstep; const char* cB = (const char*)g.Bt + (size_t)cur.pn * tstep;
    S.a_ready(cur);
    if constexpr (SP2) {
        PG8_STAGE(PG8_SB(0, 0), cB, voffB); PG8_STAGE(PG8_SB(0, 1), cB + hstep, voffB); PG8_STAGE(PG8_SA(0, 0), cA, voffA); PG8_STAGE(PG8_SA(0, 1), cA + hstep, voffA);
        if (wr == 1) PG8_BAR;
        PG8_WAIT_V(2); PG8_BAR;
        PG8_STAGE(PG8_SB(1, 0), cB + kstep, voffB); PG8_STAGE(PG8_SA(1, 0), cA + kstep, voffA); PG8_STAGE(PG8_SB(1, 1), cB + hstep + kstep, voffB);
        PG8_WAIT_V(6); PG8_BAR;
    } else {
        PG8_STAGE(PG8_SB(0, 0), cB, voffB); PG8_STAGE(PG8_SA(0, 0), cA, voffA); PG8_STAGE(PG8_SB(0, 1), cB + hstep, voffB); PG8_STAGE(PG8_SA(0, 1), cA + hstep, voffA);
        if (wr == 1) PG8_BAR;
        PG8_WAIT_V(4); PG8_BAR;
        PG8_STAGE(PG8_SB(1, 0), cB + kstep, voffB); PG8_STAGE(PG8_SA(1, 0), cA + kstep, voffA); PG8_STAGE(PG8_SB(1, 1), cB + hstep + kstep, voffB);
        PG8_WAIT_V(6); PG8_BAR;
    }
    for (;;) {
        const bool has_next = S.next(ui + 1, nxt);
        const char* nA = has_next ? (const char*)g.A + (size_t)nxt.pm * tstep : cA; const char* nB = has_next ? (const char*)g.Bt + (size_t)nxt.pn * tstep : cB;
        for (int t = 0; t < nt; t += 2) {
            const bool last = (t == nt - 2);
            const char* a1 = cA + (size_t)(t + 1) * kstep;
            const char* a2 = last ? nA : cA + (size_t)(t + 2) * kstep; const char* b2 = last ? nB : cB + (size_t)(t + 2) * kstep;
            const char* a3 = a2 + kstep; const char* b3 = b2 + kstep;
            if (last && has_next) S.a_ready(nxt);
            if constexpr (SP2) {
            PG8_LDB(B0, 0, 0); PG8_LDB(B1, 0, 1); PG8_SCHED; PG8_LDA(At, 0, 0); PG8_STAGE(PG8_SA(1, 1), a1 + hstep, voffA);
            PG8_WAIT_V(8); PG8_WAIT_L(0); PG8_BAR; PG8_MMA(0, 0, At, B0); PG8_MMA(0, 1, At, B1); PG8_BAR; PG8_SCHED;
            PG8_LDA(At, 0, 1); PG8_STAGE(PG8_SB(0, 0), b2, voffB); PG8_STAGE(PG8_SB(0, 1), b2 + hstep, voffB); PG8_STAGE(PG8_SA(0, 0), a2, voffA);
            PG8_WAIT_V(8); PG8_WAIT_L(0); PG8_BAR; PG8_MMA(1, 0, At, B0); PG8_MMA(1, 1, At, B1); PG8_BAR; PG8_SCHED;
            PG8_LDB(B0, 1, 0); PG8_LDB(B1, 1, 1); PG8_SCHED; PG8_LDA(At, 1, 0); PG8_STAGE(PG8_SA(0, 1), a2 + hstep, voffA);
            PG8_WAIT_V(8); PG8_WAIT_L(0); PG8_BAR; PG8_MMA(0, 0, At, B0); PG8_MMA(0, 1, At, B1); PG8_BAR; PG8_SCHED;
            PG8_LDA(At, 1, 1); PG8_STAGE(PG8_SB(1, 0), b3, voffB); PG8_STAGE(PG8_SB(1, 1), b3 + hstep, voffB); PG8_STAGE(PG8_SA(1, 0), a3, voffA);
            PG8_WAIT_V(8); PG8_WAIT_L(0); PG8_BAR; PG8_MMA(1, 0, At, B0); PG8_MMA(1, 1, At, B1); PG8_BAR; PG8_SCHED;
            } else {
            PG8_LDB(B0, 0, 0); PG8_SCHED; PG8_LDA(At, 0, 0); PG8_STAGE(PG8_SA(1, 1), a1 + hstep, voffA);
            PG8_WAIT_L(8); PG8_BAR; PG8_WAIT_L(0); PG8_MMA(0, 0, At, B0); PG8_BAR; PG8_SCHED;
            PG8_LDB(B1, 0, 1); PG8_STAGE(PG8_SB(0, 0), b2, voffB);
            PG8_BAR; PG8_WAIT_L(0); PG8_MMA(0, 1, At, B1); PG8_BAR;
            PG8_LDA(At, 0, 1); PG8_STAGE(PG8_SA(0, 0), a2, voffA);
            PG8_BAR; PG8_WAIT_L(0); PG8_MMA(1, 0, At, B0); PG8_BAR; PG8_SCHED;
            PG8_STAGE(PG8_SB(0, 1), b2 + hstep, voffB);
            PG8_WAIT_V(6); PG8_BAR; PG8_MMA(1, 1, At, B1); PG8_BAR;
            PG8_LDB(B0, 1, 0); PG8_SCHED; PG8_LDA(At, 1, 0); PG8_STAGE(PG8_SA(0, 1), a2 + hstep, voffA);
            PG8_WAIT_L(8); PG8_BAR; PG8_WAIT_L(0); PG8_MMA(0, 0, At, B0); PG8_BAR; PG8_SCHED;
            PG8_LDB(B1, 1, 1); PG8_STAGE(PG8_SB(1, 0), b3, voffB);
            PG8_BAR; PG8_WAIT_L(0); PG8_MMA(0, 1, At, B1); PG8_BAR;
            PG8_LDA(At, 1, 1); PG8_STAGE(PG8_SA(1, 0), a3, voffA);
            PG8_BAR; PG8_WAIT_L(0); PG8_MMA(1, 0, At, B0); PG8_BAR; PG8_SCHED;
            PG8_STAGE(PG8_SB(1, 1), b3 + hstep, voffB);
            PG8_WAIT_V(6); PG8_BAR; PG8_MMA(1, 1, At, B1); PG8_BAR;
            }
        }
        if constexpr (ALIGN_EPI) { if (wr == 0) PG8_BAR; }
        if constexpr (!Epi::AFTER_DRAIN) { E(acc, cur, wr, wc, fr, fq); S.done(cur); }
        if (!has_next) break;
#pragma unroll
        for (int a = 0; a < 2; ++a)
#pragma unroll
            for (int b = 0; b < 2; ++b)
#pragma unroll
                for (int m = 0; m < 4; ++m)
#pragma unroll
                    for (int n = 0; n < 2; ++n) acc[a][b][m][n] = (f32x4){0.f, 0.f, 0.f, 0.f};
        cur = nxt; cA = nA; cB = nB; ++ui;
        if constexpr (ALIGN_EPI) { if (wr == 1) PG8_BAR; }
    }
    PG8_WAIT_V(0);
    if constexpr (!ALIGN_EPI) { if (wr == 0) PG8_BAR; }
    PG8_BAR;
    if constexpr (Epi::AFTER_DRAIN) { E.fused(acc, cur, wr, wc, fr, fq, lds, wid, lane); S.done(cur); }
#undef PG8_SA
#undef PG8_SB
#undef PG8_STAGE
#undef PG8_LDA
#undef PG8_LDB
#undef PG8_MMA
#undef PG8_WAIT_V
#undef PG8_WAIT_L
#undef PG8_BAR
#undef PG8_SCHED
}
}

namespace pg8 {
#define EPI_V8(ai, bj, m) { acc[ai][bj][m][0][0], acc[ai][bj][m][0][1], acc[ai][bj][m][0][2], acc[ai][bj][m][0][3], acc[ai][bj][m][1][0], acc[ai][bj][m][1][1], acc[ai][bj][m][1][2], acc[ai][bj][m][1][3] }
__device__ __forceinline__ u32x4 pack8(const float (&v)[8], float s) { u32x4 w; w.x = pk_bf16(v[0] * s, v[1] * s); w.y = pk_bf16(v[2] * s, v[3] * s); w.z = pk_bf16(v[4] * s, v[5] * s); w.w = pk_bf16(v[6] * s, v[7] * s); return w; }
__device__ __forceinline__ float ssq8(const float (&v)[8]) { return ((v[0] * v[0] + v[1] * v[1]) + (v[2] * v[2] + v[3] * v[3])) + ((v[4] * v[4] + v[5] * v[5]) + (v[6] * v[6] + v[7] * v[7])); }
__device__ __forceinline__ void load8(const float* p, float (&o)[8]) { const f32x4 a = *(const f32x4*)p, b = *(const f32x4*)(p + 4); o[0] = a.x; o[1] = a.y; o[2] = a.z; o[3] = a.w; o[4] = b.x; o[5] = b.y; o[6] = b.z; o[7] = b.w; }

struct EpiProj {
    static constexpr bool PERM = true, AFTER_DRAIN = false;
    bf16_t *Qa, *Ka, *Va, *Cq, *Ckv, *Kr; float *ssq_q, *ssq_kv; const float *cosA, *sinA, *cosM, *sinM;
    __device__ __forceinline__ void operator()(const f32x4 (&acc)[2][2][4][2], const Unit& u, int wr, int wc, int fr, int fq) const {
        const int pn = u.pn, rowb = u.pm * BM + wr * 64 + fr;
        if (pn < 6) {
            const int kind = pn >> 1;
            bf16_t* dst = Qa + (size_t)kind * (size_t)(8u << 20);
            const float sc = kind == 0 ? QA_SCALE : 1.f;
            const bool ropew = (kind < 2) && ((wc & 1) == 0);
            float cq[2][8], sq[2][8];
            if (ropew) {
#pragma unroll
                for (int g = 0; g < 2; ++g) { const size_t r_ = (size_t)(rowb + g * 16) * 8; load8(cosA + r_, cq[g]); load8(sinA + r_, sq[g]); }
            }
#pragma unroll
            for (int ai = 0; ai < 2; ++ai)
#pragma unroll
                for (int m = 0; m < 4; ++m) {
                    const int row = rowb + ai * HALF + m * 16;
                    float cs[8], sn[8];
                    if (ropew) {
#pragma unroll
                        for (int i = 0; i < 8; ++i) { cs[i] = cq[m & 1][i]; sn[i] = sq[m & 1][i]; }
                        if (ai * 4 + m + 2 < 8) { const int g2 = ai * 4 + m + 2; const size_t r_ = (size_t)(rowb + (g2 >> 2) * HALF + (g2 & 3) * 16) * 8; load8(cosA + r_, cq[m & 1]); load8(sinA + r_, sq[m & 1]); }
                    }
#pragma unroll
                    for (int bj = 0; bj < 2; ++bj) {
                        float v[8] = EPI_V8(ai, bj, m);
                        if (ropew) {
#pragma unroll
                            for (int i = 0; i < 8; ++i) { const float pv = __shfl_xor(v[i], 16); if (fq == 0) v[i] = v[i] * cs[i] - pv * sn[i]; else if (fq == 1) v[i] = v[i] * cs[i] + pv * sn[i]; }
                        }
                        *(u32x4*)(dst + ((size_t)((row >> 13) * 8 + (pn & 1) * 4 + bj * 2 + (wc >> 1)) * SEQ + (row & (SEQ - 1))) * 64 + (wc & 1) * 32 + fq * 8) = pack8(v, sc);
                    }
                }
        } else if (pn == 6) {
#pragma unroll
            for (int ai = 0; ai < 2; ++ai)
#pragma unroll
                for (int m = 0; m < 4; ++m) {
                    const int row = rowb + ai * HALF + m * 16;
#pragma unroll
                    for (int bj = 0; bj < 2; ++bj) {
                        float v[8] = EPI_V8(ai, bj, m);
                        float s = ssq8(v); s += __shfl_xor(s, 16); s += __shfl_xor(s, 32);
                        if (fq == 0) ssq_q[(size_t)row * 8 + bj * 4 + wc] = s;
                        *(u32x4*)(Cq + (size_t)row * 256 + bj * HALF + wc * 32 + fq * 8) = pack8(v, 1.f);
                    }
                }
        } else {
#pragma unroll
            for (int ai = 0; ai < 2; ++ai)
#pragma unroll
                for (int m = 0; m < 4; ++m) {
                    const int row = rowb + ai * HALF + m * 16;
                    {
                        float v[8] = EPI_V8(ai, 0, m);
                        float s = ssq8(v); s += __shfl_xor(s, 16); s += __shfl_xor(s, 32);
                        if (fq == 0) ssq_kv[(size_t)row * 4 + wc] = s;
                        *(u32x4*)(Ckv + (size_t)row * 128 + wc * 32 + fq * 8) = pack8(v, 1.f);
                    }
                    if (wc == 0) {
                        float v[8] = EPI_V8(ai, 1, m);
                        float cs[8], sn[8];
                        load8(cosM + (size_t)row * 16 + 8 * (fq & 1), cs); load8(sinM + (size_t)row * 16 + 8 * (fq & 1), sn);
#pragma unroll
                        for (int i = 0; i < 8; ++i) { const float pv = __shfl_xor(v[i], 32); v[i] = (fq < 2) ? (v[i] * cs[i] - pv * sn[i]) : (v[i] * cs[i] + pv * sn[i]); }
                        *(u32x4*)(Kr + (size_t)row * 32 + fq * 8) = pack8(v, 1.f);
                    }
                }
        }
    }
};

struct EpiQm {
    static constexpr bool PERM = true, AFTER_DRAIN = false;
    bf16_t* Qm; const float* ssq_q; const float *cosM, *sinM;
    __device__ __forceinline__ void operator()(const f32x4 (&acc)[2][2][4][2], const Unit& u, int wr, int wc, int fr, int fq) const {
        const int pn = u.pn, rowb = u.pm * BM + wr * 64 + fr;
        f32x2 qa[8];
#pragma unroll
        for (int g = 0; g < 8; ++g) qa[g] = *(const f32x2*)(ssq_q + (size_t)(rowb + (g >> 2) * HALF + (g & 3) * 16) * 8 + 2 * fq);
        float cq[2][8], sq[2][8];
#pragma unroll
        for (int g = 0; g < 2; ++g) { const size_t r_ = (size_t)(rowb + g * 16) * 16 + 8 * (fq & 1); load8(cosM + r_, cq[g]); load8(sinM + r_, sq[g]); }
#pragma unroll
        for (int ai = 0; ai < 2; ++ai)
#pragma unroll
            for (int m = 0; m < 4; ++m) {
                const int row = rowb + ai * HALF + m * 16, g = ai * 4 + m;
                float ssum = qa[g].x + qa[g].y; ssum += __shfl_xor(ssum, 16); ssum += __shfl_xor(ssum, 32);
                const float rs = 1.0f / sqrtf(ssum * (1.f / 256.f) + EPS);
                float cs[8], sn[8];
#pragma unroll
                for (int i = 0; i < 8; ++i) { cs[i] = cq[m & 1][i]; sn[i] = sq[m & 1][i]; }
                if (g + 2 < 8) { const int g2 = g + 2; const size_t r_ = (size_t)(rowb + (g2 >> 2) * HALF + (g2 & 3) * 16) * 16 + 8 * (fq & 1); load8(cosM + r_, cq[m & 1]); load8(sinM + r_, sq[m & 1]); }
#pragma unroll
                for (int bj = 0; bj < 2; ++bj) {
                    const int g32 = pn * 8 + bj * 4 + wc;
                    const bool ropew = (g32 % 3) == 2;
                    float v[8] = EPI_V8(ai, bj, m);
#pragma unroll
                    for (int i = 0; i < 8; ++i) v[i] *= rs;
                    if (ropew) {
#pragma unroll
                        for (int i = 0; i < 8; ++i) { const float pv = __shfl_xor(v[i], 32); v[i] = (fq < 2) ? (v[i] * cs[i] - pv * sn[i]) : (v[i] * cs[i] + pv * sn[i]); }
                    }
                    *(u32x4*)(Qm + (size_t)row * 768 + pn * BM + bj * HALF + wc * 32 + fq * 8) = pack8(v, QM_SCALE);
                }
                asm volatile("" ::: "memory");
            }
    }
};

struct EpiKv {
    static constexpr bool PERM = true, AFTER_DRAIN = false;
    bf16_t *Kn, *Vm; const float* ssq_kv;
    __device__ __forceinline__ void operator()(const f32x4 (&acc)[2][2][4][2], const Unit& u, int wr, int wc, int fr, int fq) const {
        const int pn = u.pn, rowb = u.pm * BM + wr * 64 + fr;
        bf16_t* dst = Kn + (size_t)(wc >> 1) * (size_t)(8u << 20);
        const int within = (wc & 1) * 32 + fq * 8;
        f32x4 q4a[8];
#pragma unroll
        for (int g = 0; g < 8; ++g) q4a[g] = *(const f32x4*)(ssq_kv + (size_t)(rowb + (g >> 2) * HALF + (g & 3) * 16) * 4);
#pragma unroll
        for (int ai = 0; ai < 2; ++ai)
#pragma unroll
            for (int m = 0; m < 4; ++m) {
                const int row = rowb + ai * HALF + m * 16;
                const f32x4 q4 = q4a[ai * 4 + m];
                const float rs = 1.0f / sqrtf(((q4.x + q4.y) + (q4.z + q4.w)) * (1.f / 128.f) + EPS);
#pragma unroll
                for (int bj = 0; bj < 2; ++bj) {
                    float v[8] = EPI_V8(ai, bj, m);
                    *(u32x4*)(dst + ((size_t)((row >> 13) * 8 + pn * 2 + bj) * SEQ + (row & (SEQ - 1))) * 64 + within) = pack8(v, rs);
                }
            }
    }
};

struct EpiOut {
    static constexpr bool PERM = true, AFTER_DRAIN = false;
    const float* x; bf16_t* Hb; unsigned char* Hb8; float* ssq_h;
    __device__ __forceinline__ void operator()(const f32x4 (&acc)[2][2][4][2], const Unit& u, int wr, int wc, int fr, int fq) const {
        const int pn = u.pn, rowb = u.pm * BM + wr * 64 + fr;
        float xq[8][8];
#define XPIECE(t_) (x + (size_t)(rowb + ((t_) >> 3) * HALF + (((t_) >> 1) & 3) * 16) * DM + pn * BM + ((t_) & 1) * HALF + wc * 32 + fq * 8)
#pragma unroll
        for (int t = 0; t < 8; ++t) load8(XPIECE(t), xq[t]);
#pragma unroll
        for (int ai = 0; ai < 2; ++ai)
#pragma unroll
            for (int m = 0; m < 4; ++m) {
                const int row = rowb + ai * HALF + m * 16;
#pragma unroll
                for (int bj = 0; bj < 2; ++bj) {
                    const int col = pn * BM + bj * HALF + wc * 32 + fq * 8, t = (ai * 4 + m) * 2 + bj;
                    float v[8] = EPI_V8(ai, bj, m);
#pragma unroll
                    for (int i = 0; i < 8; ++i) v[i] += xq[t & 7][i];
                    if (t + 8 < 16) load8(XPIECE(t + 8), xq[t & 7]);
                    float s = ssq8(v); s += __shfl_xor(s, 16); s += __shfl_xor(s, 32);
                    if (fq == 0) ssq_h[(size_t)row * 32 + pn * 8 + bj * 4 + wc] = s;
                    *(u32x4*)(Hb + (size_t)row * DM + col) = pack8(v, 1.f);
                    { u32x2 w8; w8.x = pk_fp8x4(v[0] * SX, v[1] * SX, v[2] * SX, v[3] * SX); w8.y = pk_fp8x4(v[4] * SX, v[5] * SX, v[6] * SX, v[7] * SX); *(u32x2*)(Hb8 + (size_t)(col >> 7) * ((size_t)T * 128) + (size_t)row * 128 + (col & 127)) = w8; }
                }
            }
#undef XPIECE
    }
};

struct EpiSc {
    static constexpr bool PERM = true, AFTER_DRAIN = false;
    bf16_t* Sc; const float* ssq_h;
    __device__ __forceinline__ void operator()(const f32x4 (&acc)[2][2][4][2], const Unit& u, int wr, int wc, int fr, int fq) const {
        const int pn = u.pn, rowb = u.pm * BM + wr * 64 + fr;
        f32x4 q[8][2];
#pragma unroll
        for (int g = 0; g < 8; ++g) { const float* qp = ssq_h + (size_t)(rowb + (g >> 2) * HALF + (g & 3) * 16) * 32 + 8 * fq; q[g][0] = *(const f32x4*)qp; q[g][1] = *(const f32x4*)(qp + 4); }
#pragma unroll
        for (int ai = 0; ai < 2; ++ai)
#pragma unroll
            for (int m = 0; m < 4; ++m) {
                const int row = rowb + ai * HALF + m * 16, g = ai * 4 + m;
                float s = ((q[g][0].x + q[g][0].y) + (q[g][0].z + q[g][0].w)) + ((q[g][1].x + q[g][1].y) + (q[g][1].z + q[g][1].w));
                s += __shfl_xor(s, 16); s += __shfl_xor(s, 32);
                const float rs = 1.0f / sqrtf(s * (1.f / 1024.f) + EPS);
#pragma unroll
                for (int bj = 0; bj < 2; ++bj) {
                    float v[8] = EPI_V8(ai, bj, m);
                    u32x4 w; w.x = pk_f16(v[0] * rs, v[1] * rs); w.y = pk_f16(v[2] * rs, v[3] * rs); w.z = pk_f16(v[4] * rs, v[5] * rs); w.w = pk_f16(v[6] * rs, v[7] * rs);
                    *(u32x4*)(Sc + (size_t)row * 2048 + pn * BM + bj * HALF + wc * 32 + fq * 8) = w;
                }
            }
    }
};
#undef EPI_V8
}

namespace att {
constexpr float NEGM = -1.0e30f;
__device__ __forceinline__ s16x4 vtr(const LAS unsigned char* p) { typedef short v4i16_t __attribute__((ext_vector_type(4))); return __builtin_bit_cast(s16x4, __builtin_amdgcn_ds_read_tr16_b64_v4i16((LAS v4i16_t*)p)); }
__device__ __forceinline__ void swap32(unsigned& a, unsigned& b) { asm volatile("s_nop 1\n\tv_permlane32_swap_b32 %0, %1" : "+v"(a), "+v"(b)); }
__device__ __forceinline__ float swapmax(float v) { unsigned a = __builtin_bit_cast(unsigned, v), b = a; swap32(a, b); return fmaxf(__builtin_bit_cast(float, a), __builtin_bit_cast(float, b)); }
__device__ __forceinline__ float swapsum(float v) { unsigned a = __builtin_bit_cast(unsigned, v), b = a; swap32(a, b); return __builtin_bit_cast(float, a) + __builtin_bit_cast(float, b); }
__device__ __forceinline__ float max3f(float a, float b, float c) { return __builtin_fmaxf(__builtin_fmaxf(a, b), c); }
constexpr float THR = 8.0f;
__device__ __forceinline__ bf16x8 pack_p(const f32x16& p, int s) {
    u32x4 w; w.x = pk_bf16(p[8 * s + 0], p[8 * s + 1]); w.y = pk_bf16(p[8 * s + 2], p[8 * s + 3]); w.z = pk_bf16(p[8 * s + 4], p[8 * s + 5]); w.w = pk_bf16(p[8 * s + 6], p[8 * s + 7]);
    return __builtin_bit_cast(bf16x8, w);
}
__device__ __forceinline__ void pv_block(f32x16& o, const LAS unsigned char* vbase, const bf16x8& pb0, const bf16x8& pb1) {
    const s16x4 l0 = vtr(vbase), h0 = vtr(vbase + 8 * 64), l1 = vtr(vbase + 16 * 64), h1 = vtr(vbase + 24 * 64);
    const bf16x8 a0 = {l0[0], l0[1], l0[2], l0[3], h0[0], h0[1], h0[2], h0[3]}, a1 = {l1[0], l1[1], l1[2], l1[3], h1[0], h1[1], h1[2], h1[3]};
    o = __builtin_amdgcn_mfma_f32_32x32x16_bf16(a0, pb0, o, 0, 0, 0);
    o = __builtin_amdgcn_mfma_f32_32x32x16_bf16(a1, pb1, o, 0, 0, 0);
}
__device__ __forceinline__ void store_o(bf16_t* orow, const f32x16& o0, const f32x16& o1, float inv, int hi) {
#pragma unroll
    for (int g = 0; g < 4; ++g) {
        u32x2 a, b; a.x = pk_bf16(o0[4 * g] * inv, o0[4 * g + 1] * inv); a.y = pk_bf16(o0[4 * g + 2] * inv, o0[4 * g + 3] * inv);
        b.x = pk_bf16(o1[4 * g] * inv, o1[4 * g + 1] * inv); b.y = pk_bf16(o1[4 * g + 2] * inv, o1[4 * g + 3] * inv);
        *(u32x2*)(orow + 8 * g + 4 * hi) = a; *(u32x2*)(orow + 32 + 8 * g + 4 * hi) = b;
    }
}

constexpr int KROW = 208;
constexpr int TK = 128, KBYTES = TK * KROW, VBYTES = 2 * TK * 64, BUFB = KBYTES + VBYTES;
constexpr int MLA_LDS = 2 * BUFB;
__device__ __forceinline__ float rowmax64(const f32x16& s0, const f32x16& s1) {
    float mx = max3f(s0[0], s1[0], s0[1]);
#pragma unroll
    for (int r = 1; r < 15; r += 2) { mx = max3f(mx, s1[r], s0[r + 1]); mx = max3f(mx, s1[r + 1], s0[r + 2 < 16 ? r + 2 : 15]); }
    mx = max3f(mx, s1[15], s0[15]);
    return swapmax(mx);
}
__device__ __forceinline__ void scale16(f32x16& t, float a) {
    const f32x2 a2 = {a, a};
#pragma unroll
    for (int i = 0; i < 8; ++i) { f32x2 p = {t[2 * i], t[2 * i + 1]}; asm volatile("v_pk_mul_f32 %0, %0, %1" : "+v"(p) : "v"(a2)); t[2 * i] = p.x; t[2 * i + 1] = p.y; }
}
__device__ __forceinline__ void sub16(f32x16& t, float d) {
    const f32x2 d2 = {d, d};
#pragma unroll
    for (int i = 0; i < 8; ++i) { f32x2 p = {t[2 * i], t[2 * i + 1]}; asm volatile("v_pk_add_f32 %0, %0, %1 neg_lo:[0,1] neg_hi:[0,1]" : "+v"(p) : "v"(d2)); t[2 * i] = p.x; t[2 * i + 1] = p.y; }
}
__device__ __forceinline__ void rescale64(float mx, f32x16& s0, f32x16& s1, float& m, float& l, f32x16& o0, f32x16& o1) {
    if (__builtin_expect(__builtin_amdgcn_ballot_w64(mx > THR) != 0ull, 0)) {
        const float dl = fmaxf(mx, 0.f), alpha = __builtin_amdgcn_exp2f(-dl);
        m += dl; l *= alpha;
        sub16(s0, dl); sub16(s1, dl); scale16(o0, alpha); scale16(o1, alpha);
    }
}
__device__ __forceinline__ void exp64(f32x16& s0, f32x16& s1, float& l) {
    float rs = 0.f;
#pragma unroll
    for (int r = 0; r < 16; ++r) { s0[r] = __builtin_amdgcn_exp2f(s0[r]); s1[r] = __builtin_amdgcn_exp2f(s1[r]); rs += s0[r] + s1[r]; }
    l += rs;
}
__device__ __forceinline__ void sm64(f32x16& s0, f32x16& s1, float& m, float& l, f32x16& o0, f32x16& o1, f32x16& t0, f32x16& t1, bool adj_other) {
    float mx = max3f(s0[0], s1[0], s0[1]);
#pragma unroll
    for (int r = 1; r < 15; r += 2) { mx = max3f(mx, s1[r], s0[r + 1]); mx = max3f(mx, s1[r + 1], s0[r + 2 < 16 ? r + 2 : 15]); }
    mx = max3f(mx, s1[15], s0[15]);
    mx = swapmax(mx);
    if (__builtin_expect(__builtin_amdgcn_ballot_w64(mx > THR) != 0ull, 0)) {
        const float dl = fmaxf(mx, 0.f), alpha = __builtin_amdgcn_exp2f(-dl);
        m += dl; l *= alpha;
#pragma unroll
        for (int r = 0; r < 16; ++r) { s0[r] -= dl; s1[r] -= dl; o0[r] *= alpha; o1[r] *= alpha; }
        if (adj_other) {
#pragma unroll
            for (int r = 0; r < 16; ++r) { t0[r] -= dl; t1[r] -= dl; }
        }
    }
    float rs = 0.f;
#pragma unroll
    for (int r = 0; r < 16; ++r) { s0[r] = __builtin_amdgcn_exp2f(s0[r]); s1[r] = __builtin_amdgcn_exp2f(s1[r]); rs += s0[r] + s1[r]; }
    l += rs;
}
constexpr int MLA_G_OFF = 2 * (TK * 208 + 2 * TK * 64), MLA_PIECE_OFF = MLA_G_OFF + 4096;
__device__ __forceinline__ void mla_unit(LAS unsigned char* lds, const bf16_t* __restrict__ Qm, const bf16_t* __restrict__ Kn, const bf16_t* __restrict__ Kr, const bf16_t* __restrict__ Vm,
                                         bf16_t* __restrict__ Mixed, int b, int h, int qb,
                                         const float* __restrict__ u_emb, const float* __restrict__ v_emb, const float* __restrict__ g_ffn, unsigned char* __restrict__ U8, unsigned char* __restrict__ V8, int slot0) {
    const int tid = threadIdx.x, lane = tid & 63, wid = __builtin_amdgcn_readfirstlane(tid >> 6), r32 = lane & 31, hi = lane >> 5;
    const size_t tok0 = (size_t)b * SEQ;
    const int qpos = 256 * qb + 32 * wid + r32;
    bf16x8 qf[6];
    { const bf16_t* qrow = Qm + (tok0 + qpos) * 768 + h * 96 + 8 * hi;
#pragma unroll
      for (int ds = 0; ds < 6; ++ds) qf[ds] = *(const bf16x8*)(qrow + 16 * ds); }
    float m = 0.f, l = 0.f; f32x16 o0 = {}, o1 = {};
    const int nt = 2 * (qb + 1);
    const int wq0 = 256 * qb + 32 * wid, wqlast = wq0 + 31;
    const int srow = tid >> 3, sch = tid & 7, rrow = tid >> 2, rch = tid & 3;
    const bf16_t* gkn = Kn + ((size_t)(b * 8 + h) * SEQ + srow) * 64 + sch * 8;
    const bf16_t* gv = Vm + ((size_t)(b * 8 + h) * SEQ + srow) * 64 + sch * 8;
    const bf16_t* gkr = Kr + (tok0 + rrow) * 32 + rch * 8;
    const int wkn = srow * KROW + sch * 16, wkr = rrow * KROW + 128 + rch * 16, wv = KBYTES + (sch >> 2) * (TK * 64) + srow * 64 + (sch & 3) * 16;
    const int kfrag = r32 * KROW + hi * 16;
    const int i16 = lane & 15, vfrag = KBYTES + (4 * hi + (i16 >> 2)) * 64 + (16 * ((lane >> 4) & 1) + 4 * (i16 & 3)) * 2;
    u32x4 rk0, rk1, rv0, rv1, rr;
#define MLA_LOAD(t) do { const size_t adv_ = (size_t)(t) * TK; rk0 = *(const u32x4*)(gkn + adv_ * 64); rk1 = *(const u32x4*)(gkn + (adv_ + 64) * 64); \
        rv0 = *(const u32x4*)(gv + adv_ * 64); rv1 = *(const u32x4*)(gv + (adv_ + 64) * 64); rr = *(const u32x4*)(gkr + adv_ * 32); } while (0)
#define MLA_STORE(bp) do { LAS unsigned char* b_ = (bp); *(LAS u32x4*)(b_ + wkn) = rk0; *(LAS u32x4*)(b_ + wkn + 64 * KROW) = rk1; *(LAS u32x4*)(b_ + wv) = rv0; *(LAS u32x4*)(b_ + wv + 64 * 64) = rv1; *(LAS u32x4*)(b_ + wkr) = rr; } while (0)
    if (wid >= 4) __builtin_amdgcn_s_setprio(1);
    MLA_LOAD(0); MLA_STORE(lds);
    for (int u = tid; u < DM / 4; u += 512) *(LAS f32x4*)(lds + MLA_G_OFF + 16 * u) = *(const f32x4*)(g_ffn + 4 * u);
    LAS unsigned char* piece = lds + MLA_PIECE_OFF + wid * 1024;
    const unsigned piece_u = (unsigned)__builtin_amdgcn_readfirstlane((int)(unsigned)(uintptr_t)piece);
    __syncthreads();
    const int nfull = (wq0 + 1) >> 7;
    int kt = 0;
    for (; kt < nfull; ++kt) {
        const LAS unsigned char* buf = lds + (kt & 1) * BUFB;
        if (kt + 1 < nt) MLA_LOAD(kt + 1);
        const int pid = slot0 + 8 * kt + wid;
        if (pid < 131072) glds16(((pid >> 16) ? v_emb : u_emb) + (size_t)(pid & 65535) * 256 + 4 * lane, piece_u);
        {
            f32x16 a0, a1, b0, b1;
            { const float nm = -m; a0 = (f32x16){nm, nm, nm, nm, nm, nm, nm, nm, nm, nm, nm, nm, nm, nm, nm, nm}; a1 = a0; }
#pragma unroll
            for (int ds = 0; ds < 6; ++ds) {
                const bf16x8 k0 = *(const LAS bf16x8*)(buf + kfrag + ds * 32), k1 = *(const LAS bf16x8*)(buf + kfrag + 32 * KROW + ds * 32);
                a0 = __builtin_amdgcn_mfma_f32_32x32x16_bf16(k0, qf[ds], a0, 0, 0, 0);
                a1 = __builtin_amdgcn_mfma_f32_32x32x16_bf16(k1, qf[ds], a1, 0, 0, 0);
            }
            rescale64(rowmax64(a0, a1), a0, a1, m, l, o0, o1);
            { const float nm = -m; b0 = (f32x16){nm, nm, nm, nm, nm, nm, nm, nm, nm, nm, nm, nm, nm, nm, nm, nm}; b1 = b0; }
#pragma unroll
            for (int ds = 0; ds < 6; ++ds) {
                const bf16x8 k2 = *(const LAS bf16x8*)(buf + kfrag + 64 * KROW + ds * 32), k3 = *(const LAS bf16x8*)(buf + kfrag + 96 * KROW + ds * 32);
                b0 = __builtin_amdgcn_mfma_f32_32x32x16_bf16(k2, qf[ds], b0, 0, 0, 0);
                b1 = __builtin_amdgcn_mfma_f32_32x32x16_bf16(k3, qf[ds], b1, 0, 0, 0);
            }
            exp64(a0, a1, l);
            { const float mxb = rowmax64(b0, b1);
              if (__builtin_expect(__builtin_amdgcn_ballot_w64(mxb > THR) != 0ull, 0)) {
                  const float dl = fmaxf(mxb, 0.f), alpha = __builtin_amdgcn_exp2f(-dl);
                  m += dl; l *= alpha;
                  sub16(b0, dl); sub16(b1, dl); scale16(o0, alpha); scale16(o1, alpha); scale16(a0, alpha); scale16(a1, alpha);
              } }
            { const bf16x8 p00 = pack_p(a0, 0), p01 = pack_p(a0, 1), p10 = pack_p(a1, 0), p11 = pack_p(a1, 1);
              pv_block(o0, buf + vfrag, p00, p01); pv_block(o0, buf + vfrag + 2048, p10, p11);
              pv_block(o1, buf + vfrag + TK * 64, p00, p01); pv_block(o1, buf + vfrag + TK * 64 + 2048, p10, p11); }
            exp64(b0, b1, l);
            { const bf16x8 p00 = pack_p(b0, 0), p01 = pack_p(b0, 1), p10 = pack_p(b1, 0), p11 = pack_p(b1, 1);
              pv_block(o0, buf + vfrag + 4096, p00, p01); pv_block(o0, buf + vfrag + 6144, p10, p11);
              pv_block(o1, buf + vfrag + TK * 64 + 4096, p00, p01); pv_block(o1, buf + vfrag + TK * 64 + 6144, p10, p11); }
        }
        if (kt + 1 < nt) MLA_STORE(lds + ((kt + 1) & 1) * BUFB);
        if (pid < 131072) {
            asm volatile("s_waitcnt vmcnt(0)" ::: "memory");
            const f32x4 xv = *(const LAS f32x4*)(piece + 16 * lane);
            const int idx = pid & 65535, col = (idx & 3) * 256 + 4 * lane;
            f32x4 sc = {SV, SV, SV, SV};
            if ((pid >> 16) == 0) { const f32x4 gv_ = *(const LAS f32x4*)(lds + MLA_G_OFF + 4 * col); sc = (f32x4){gv_.x * SU, gv_.y * SU, gv_.z * SU, gv_.w * SU}; }
            unsigned char* dst = ((pid >> 16) ? V8 : U8) + (size_t)(col >> 7) * ((size_t)16384 * 128) + (size_t)(idx >> 2) * 128 + (col & 127);
            *(unsigned*)dst = pk_fp8x4(xv.x * sc.x, xv.y * sc.y, xv.z * sc.z, xv.w * sc.w);
        }
        __syncthreads();
        }
    for (; kt < nt; ++kt) {
        const LAS unsigned char* buf = lds + (kt & 1) * BUFB;
        if (kt + 1 < nt) MLA_LOAD(kt + 1);
        const int pid = slot0 + 8 * kt + wid;
        if (pid < 131072) glds16(((pid >> 16) ? v_emb : u_emb) + (size_t)(pid & 65535) * 256 + 4 * lane, piece_u);
        if (TK * kt <= wqlast) {
            const bool needB = TK * kt + 64 <= wqlast;
            const float nm = -m; const f32x16 negm = {nm, nm, nm, nm, nm, nm, nm, nm, nm, nm, nm, nm, nm, nm, nm, nm};
            f32x16 a0 = negm, a1 = negm, b0 = negm, b1 = negm;
#pragma unroll
            for (int ds = 0; ds < 6; ++ds) {
                const bf16x8 k0 = *(const LAS bf16x8*)(buf + kfrag + ds * 32), k1 = *(const LAS bf16x8*)(buf + kfrag + 32 * KROW + ds * 32);
                a0 = __builtin_amdgcn_mfma_f32_32x32x16_bf16(k0, qf[ds], a0, 0, 0, 0);
                a1 = __builtin_amdgcn_mfma_f32_32x32x16_bf16(k1, qf[ds], a1, 0, 0, 0);
            }
            if (needB) {
#pragma unroll
                for (int ds = 0; ds < 6; ++ds) {
                    const bf16x8 k2 = *(const LAS bf16x8*)(buf + kfrag + 64 * KROW + ds * 32), k3 = *(const LAS bf16x8*)(buf + kfrag + 96 * KROW + ds * 32);
                    b0 = __builtin_amdgcn_mfma_f32_32x32x16_bf16(k2, qf[ds], b0, 0, 0, 0);
                    b1 = __builtin_amdgcn_mfma_f32_32x32x16_bf16(k3, qf[ds], b1, 0, 0, 0);
                }
            }
#pragma unroll
            for (int r = 0; r < 16; ++r) { const int kp = TK * kt + crow(r, hi); if (kp > qpos) a0[r] = NEGM; if (kp + 32 > qpos) a1[r] = NEGM; if (kp + 64 > qpos) b0[r] = NEGM; if (kp + 96 > qpos) b1[r] = NEGM; }
            sm64(a0, a1, m, l, o0, o1, b0, b1, needB);
            { const bf16x8 p00 = pack_p(a0, 0), p01 = pack_p(a0, 1), p10 = pack_p(a1, 0), p11 = pack_p(a1, 1);
              pv_block(o0, buf + vfrag, p00, p01); pv_block(o0, buf + vfrag + 2048, p10, p11);
              pv_block(o1, buf + vfrag + TK * 64, p00, p01); pv_block(o1, buf + vfrag + TK * 64 + 2048, p10, p11); }
            if (needB) {
                sm64(b0, b1, m, l, o0, o1, a0, a1, false);
                const bf16x8 p00 = pack_p(b0, 0), p01 = pack_p(b0, 1), p10 = pack_p(b1, 0), p11 = pack_p(b1, 1);
                pv_block(o0, buf + vfrag + 4096, p00, p01); pv_block(o0, buf + vfrag + 6144, p10, p11);
                pv_block(o1, buf + vfrag + TK * 64 + 4096, p00, p01); pv_block(o1, buf + vfrag + TK * 64 + 6144, p10, p11);
            }

        }
        if (kt + 1 < nt) MLA_STORE(lds + ((kt + 1) & 1) * BUFB);
        if (pid < 131072) {
            asm volatile("s_waitcnt vmcnt(0)" ::: "memory");
            const f32x4 xv = *(const LAS f32x4*)(piece + 16 * lane);
            const int idx = pid & 65535, col = (idx & 3) * 256 + 4 * lane;
            f32x4 sc = {SV, SV, SV, SV};
            if ((pid >> 16) == 0) { const f32x4 gv_ = *(const LAS f32x4*)(lds + MLA_G_OFF + 4 * col); sc = (f32x4){gv_.x * SU, gv_.y * SU, gv_.z * SU, gv_.w * SU}; }
            unsigned char* dst = ((pid >> 16) ? V8 : U8) + (size_t)(col >> 7) * ((size_t)16384 * 128) + (size_t)(idx >> 2) * 128 + (col & 127);
            *(unsigned*)dst = pk_fp8x4(xv.x * sc.x, xv.y * sc.y, xv.z * sc.z, xv.w * sc.w);
        }
        __syncthreads();
        }
#undef MLA_LOAD
#undef MLA_STORE
    __builtin_amdgcn_s_setprio(0);
    l = swapsum(l);
    store_o(Mixed + (tok0 + qpos) * DM + 512 + h * 64, o0, o1, 1.0f / l, hi);
}

constexpr int DIL_KR = 144, DIL_VR = 160, DIL_VOFF = 32 * DIL_KR, DIL_WLDS = 32 * DIL_KR + 32 * DIL_VR;
constexpr int DIL_SROW = 132, DIL_STATE_OFF = 8 * DIL_WLDS;
struct DilBlk { u32x4 k[4]; u32x4 v[4]; };
__device__ __forceinline__ void dil_load(DilBlk& B, const bf16_t* __restrict__ Ka, const bf16_t* __restrict__ Va, size_t hrow0  , int rd, int dl  , int imax, int idx0, int lane) {
#pragma unroll
    for (int i = 0; i < 4; ++i) {
        int ik = idx0 + 8 * i + (lane >> 3); ik = ik < 0 ? 0 : ik; ik = ik > imax ? imax : ik;
        const size_t off = (hrow0 + ((size_t)ik << dl) + rd) * 64 + 8 * (lane & 7);
        B.k[i] = *(const u32x4*)(Ka + off); B.v[i] = *(const u32x4*)(Va + off);
    }
}
__device__ __forceinline__ void pv_block_p(f32x16& o, const LAS unsigned char* vbase, const bf16x8& pb0, const bf16x8& pb1) {
    const s16x4 l0 = vtr(vbase), h0 = vtr(vbase + 8 * DIL_VR), l1 = vtr(vbase + 16 * DIL_VR), h1 = vtr(vbase + 24 * DIL_VR);
    const bf16x8 a0 = {l0[0], l0[1], l0[2], l0[3], h0[0], h0[1], h0[2], h0[3]}, a1 = {l1[0], l1[1], l1[2], l1[3], h1[0], h1[1], h1[2], h1[3]};
    o = __builtin_amdgcn_mfma_f32_32x32x16_bf16(a0, pb0, o, 0, 0, 0);
    o = __builtin_amdgcn_mfma_f32_32x32x16_bf16(a1, pb1, o, 0, 0, 0);
}
template <bool MASK>
__device__ __forceinline__ void dil_step(const DilBlk& B, LAS unsigned char* wl, const bf16x8 (&qf)[4], float& m, float& l, f32x16& o0, f32x16& o1, int A, int idx0, int lane) {
    const int r32 = lane & 31, hi = lane >> 5;
    {
        LAS unsigned char* kp = wl + (lane >> 3) * DIL_KR + (lane & 7) * 16;
        LAS unsigned char* vp = wl + DIL_VOFF + (lane >> 3) * DIL_VR + (lane & 7) * 16;
#pragma unroll
        for (int i = 0; i < 4; ++i) { *(LAS u32x4*)(kp + 8 * i * DIL_KR) = B.k[i]; *(LAS u32x4*)(vp + 8 * i * DIL_VR) = B.v[i]; }
    }
    const float nm = -m;
    f32x16 s = {nm, nm, nm, nm, nm, nm, nm, nm, nm, nm, nm, nm, nm, nm, nm, nm};
    { const LAS unsigned char* kfr = wl + r32 * DIL_KR + 16 * hi;
#pragma unroll
      for (int ds = 0; ds < 4; ++ds) s = __builtin_amdgcn_mfma_f32_32x32x16_bf16(*(const LAS bf16x8*)(kfr + 32 * ds), qf[ds], s, 0, 0, 0); }
    if (MASK) {
        const int qi = A + r32;
#pragma unroll
        for (int r = 0; r < 16; ++r) { const int ki = idx0 + crow(r, hi), dist = qi - ki; if (ki < 0 || dist < 0 || dist > 128) s[r] = NEGM; }
    }
    float mx = max3f(s[0], s[1], s[2]);
#pragma unroll
    for (int r = 3; r < 15; r += 2) mx = max3f(mx, s[r], s[r + 1]);
    mx = fmaxf(mx, s[15]);
    mx = swapmax(mx);
    if (__builtin_expect(__builtin_amdgcn_ballot_w64(mx > THR) != 0ull, 0)) {
        const float dl_ = fmaxf(mx, 0.f), alpha = __builtin_amdgcn_exp2f(-dl_);
        m += dl_; l *= alpha;
        sub16(s, dl_); scale16(o0, alpha); scale16(o1, alpha);
    }
    float rs = 0.f;
#pragma unroll
    for (int r = 0; r < 16; ++r) { s[r] = __builtin_amdgcn_exp2f(s[r]); rs += s[r]; }
    l += rs;
    const bf16x8 p0 = pack_p(s, 0), p1 = pack_p(s, 1);
    const int i16 = lane & 15;
    const LAS unsigned char* vb = wl + DIL_VOFF + (4 * hi + (i16 >> 2)) * DIL_VR + (16 * ((lane >> 4) & 1) + 4 * (i16 & 3)) * 2;
    pv_block_p(o0, vb, p0, p1);
    pv_block_p(o1, vb + 64, p0, p1);
}
__device__ __forceinline__ void dil_unit(LAS unsigned char* wl, const bf16_t* __restrict__ Qa, const bf16_t* __restrict__ Ka, const bf16_t* __restrict__ Va, bf16_t* __restrict__ Mixed, LAS unsigned char* state,
                                         int b, int h, int p0, int dl, bool first, bool last, int lane, int pflags = 0) {
    const int r32 = lane & 31, hi = lane >> 5;
    const size_t tok0 = (size_t)b * SEQ, hrow0 = (size_t)(b * 8 + h) * SEQ;
    const int qpos = p0 + (r32 << dl);
    const int rd = p0 & ((1 << dl) - 1), A = p0 >> dl, imax = (SEQ - 1 - rd) >> dl;
    DilBlk b0, b1, b2;
#define DLOAD(B_, k_) dil_load(B_, Ka, Va, hrow0, rd, dl, imax, A - 128 + 32 * (k_), lane)
#define DSTEP(MK_, B_, k_) dil_step<MK_>(B_, wl, qf, m, l, o0, o1, A, A - 128 + 32 * (k_), lane)
    DLOAD(b0, 0); DLOAD(b1, 1);
    bf16x8 qf[4];
    { const bf16_t* qrow = Qa + (hrow0 + qpos) * 64 + 8 * hi;
#pragma unroll
      for (int ds = 0; ds < 4; ++ds) qf[ds] = *(const bf16x8*)(qrow + 16 * ds); }
    float m = 0.f, l = 0.f; f32x16 o0 = {}, o1 = {};
    LAS unsigned* st = (LAS unsigned*)(state + ((qpos & 511) * DIL_SROW));
    if (!first) {
        m = __builtin_bit_cast(float, st[32]); l = hi ? 0.f : 1.f;
#pragma unroll
        for (int g = 0; g < 4; ++g) {
            const unsigned a0 = st[4 * g + 2 * hi], a1 = st[4 * g + 2 * hi + 1], c0 = st[16 + 4 * g + 2 * hi], c1 = st[16 + 4 * g + 2 * hi + 1];
            o0[4 * g] = bf_lo(a0); o0[4 * g + 1] = bf_hi(a0); o0[4 * g + 2] = bf_lo(a1); o0[4 * g + 3] = bf_hi(a1);
            o1[4 * g] = bf_lo(c0); o1[4 * g + 1] = bf_hi(c0); o1[4 * g + 2] = bf_lo(c1); o1[4 * g + 3] = bf_hi(c1);
        }
    }
    const bool early = A - 96 < 0;
#ifdef PROBE_LO
    if (pflags & 32) { o0[0] += __builtin_bit_cast(float, b0.k[0].x ^ b1.k[0].x ^ b0.v[3].w ^ b1.v[3].w); l = 1.f; } else {
#endif
    DLOAD(b2, 2);
    DSTEP(true, b0, 0);
    DLOAD(b0, 3);
    if (early) DSTEP(true, b1, 1); else DSTEP(false, b1, 1);
    DLOAD(b1, 4);
    if (early) DSTEP(true, b2, 2); else DSTEP(false, b2, 2);
    if (early) DSTEP(true, b0, 3); else DSTEP(false, b0, 3);
    DSTEP(true, b1, 4);
#ifdef PROBE_LO
    }
#endif
#undef DLOAD
#undef DSTEP
    l = swapsum(l);
    const float inv = 1.0f / l;
    if (last) store_o(Mixed + (tok0 + qpos) * DM + h * 64, o0, o1, inv, hi);
    else {
#pragma unroll
        for (int g = 0; g < 4; ++g) {
            st[4 * g + 2 * hi] = pk_bf16(o0[4 * g] * inv, o0[4 * g + 1] * inv); st[4 * g + 2 * hi + 1] = pk_bf16(o0[4 * g + 2] * inv, o0[4 * g + 3] * inv);
            st[16 + 4 * g + 2 * hi] = pk_bf16(o1[4 * g] * inv, o1[4 * g + 1] * inv); st[16 + 4 * g + 2 * hi + 1] = pk_bf16(o1[4 * g + 2] * inv, o1[4 * g + 3] * inv);
        }
        if (hi == 0) st[32] = __builtin_bit_cast(unsigned, m + __builtin_amdgcn_logf(l));
    }
}
__device__ __forceinline__ void dil_segment(LAS unsigned char* lds, const bf16_t* __restrict__ Qa, const bf16_t* __restrict__ Ka, const bf16_t* __restrict__ Va, bf16_t* __restrict__ Mixed,
                                            int sg, int wave, int lane, int pflags = 0) {
    const int seg = sg & 15, h = (sg >> 4) & 7, b = sg >> 7, base = 512 * seg;
    LAS unsigned char* wl = lds + wave * DIL_WLDS;
#pragma unroll 1
    for (int pass = 0; pass < ((pflags & 64) ? 1 : 3); ++pass) {
        const int dl = 2 * pass;
#pragma unroll 1
        for (int j = wave; j < 16; j += 8) {
            const int rd = j & ((1 << dl) - 1), cj = j >> dl;
            dil_unit(wl, Qa, Ka, Va, Mixed, lds + DIL_STATE_OFF, b, h, base + rd + ((32 * cj) << dl), dl, pass == 0, pass == 2, lane, pflags);
        }
        if (pass < 2) __syncthreads();
    }
}
}

namespace peer {
__device__ __forceinline__ void ins16(unsigned (&L)[16], unsigned key) {
#pragma unroll
    for (int i = 0; i < 16; ++i) { const unsigned hi_ = L[i] > key ? L[i] : key; key = L[i] > key ? key : L[i]; L[i] = hi_; }
}
__device__ __forceinline__ void ce(unsigned& a, unsigned& b) { const unsigned hi_ = a > b ? a : b, lo_ = a > b ? b : a; a = hi_; b = lo_; }
__device__ __forceinline__ void sort8(unsigned (&v)[8]) {
    ce(v[0], v[1]); ce(v[2], v[3]); ce(v[4], v[5]); ce(v[6], v[7]); ce(v[0], v[2]); ce(v[1], v[3]); ce(v[4], v[6]); ce(v[5], v[7]); ce(v[1], v[2]); ce(v[5], v[6]);
    ce(v[0], v[4]); ce(v[3], v[7]); ce(v[1], v[5]); ce(v[2], v[6]); ce(v[1], v[4]); ce(v[3], v[6]); ce(v[2], v[4]); ce(v[3], v[5]); ce(v[3], v[4]);
}
__device__ __forceinline__ void bmerge16(unsigned (&v)[16]) {
#pragma unroll
    for (int k = 8; k >= 1; k >>= 1)
#pragma unroll
        for (int i = 0; i < 16; ++i) if ((i & k) == 0) ce(v[i], v[i + k]);
}
__device__ __forceinline__ float dec16(unsigned key) { const unsigned s = key >> 16; const unsigned b = (s & 0x8000u) ? (s & 0x7fffu) : (~s & 0xffffu); return (float)__builtin_bit_cast(_Float16, (unsigned short)b); }
__device__ __forceinline__ unsigned enc32(float f) { const unsigned u = __builtin_bit_cast(unsigned, f); return (u & 0x80000000u) ? ~u : (u | 0x80000000u); }
__device__ __forceinline__ float dec32(unsigned s) { const unsigned u = (s & 0x80000000u) ? (s & 0x7fffffffu) : ~s; return __builtin_bit_cast(float, u); }
__device__ __forceinline__ float gelu1(float v) {
    const float av = fabsf(v), t = __builtin_amdgcn_rcpf(av * 0.2316418882f + 1.0f);
    float q = t * 0.5307027145f + (-0.7265760135f); q = q * t + 0.7107068705f; q = q * t + (-0.142248368f); q = q * t + 0.127414796f; q = q * t;
    const float e = __builtin_amdgcn_exp2f((v * v) * (-0.72134752044f));
    const float mm = v * (q * e);
    return v < 0.f ? mm : v - mm;
}
struct CandTab { unsigned char i[52], j[52]; };
__host__ __device__ constexpr CandTab make_cands() {
    CandTab t{}; int n = 0;
    for (int i = 0; i < 16; ++i) for (int j = 0; j < 16; ++j) if ((i + 1) * (j + 1) <= 16) { t.i[n] = (unsigned char)i; t.j[n] = (unsigned char)j; ++n; }
    for (; n < 52; ++n) { t.i[n] = 15; t.j[n] = 15; }
    return t;
}

}

namespace peer2 {
__device__ __forceinline__ int ld_of(int j) { const int rho = 16 * ((j >> 2) & 3) + 4 * ((j >> 4) & 3) + (j & 3); return (j >> 6) * 64 + (rho & 7) * 8 + (rho >> 3); }

__device__ __forceinline__ void topk_phase(LAS unsigned char* lds, const bf16_t* __restrict__ Sc, const float* __restrict__ ssq_h, unsigned short* __restrict__ Pe_slot, unsigned short* __restrict__ Pe_ld,
                                           float* __restrict__ Pg, float* __restrict__ rstd_h, int gw, int ngw) {
    const int lane = threadIdx.x & 63, wid = __builtin_amdgcn_readfirstlane(threadIdx.x >> 6);
    LAS unsigned char* tile = lds + wid * 12288;
    LAS unsigned* lists = (LAS unsigned*)(tile + 8192);
    constexpr peer::CandTab CT = peer::make_cands();
    u32x4 nx[8];
#define TK_LOAD(g_, hh_) do { _Pragma("unroll") for (int i_ = 0; i_ < 8; ++i_) { const int s_ = 8 * i_ + (lane >> 3); \
        nx[i_] = *(const u32x4*)(Sc + (size_t)(4 * (g_) + (s_ >> 4)) * 2048 + (s_ & 15) * 128 + (hh_) * 64 + (lane & 7) * 8); } } while (0)
#define TK_WRITE() do { _Pragma("unroll") for (int i_ = 0; i_ < 8; ++i_) { const int s_ = 8 * i_ + (lane >> 3); *(LAS u32x4*)(tile + s_ * 128 + (((lane & 7) ^ (s_ & 7)) << 4)) = nx[i_]; } } while (0)
    if (gw < T / 4) TK_LOAD(gw, 0);
    for (int g = gw; g < T / 4; g += ngw) {
        const int t4 = lane >> 4, hp = lane & 15, tok = 4 * g + t4;
        unsigned L[16];
        {
            const LAS unsigned char* seg = tile + lane * 128;
#pragma unroll 1
            for (int gq = 0; gq < 8; ++gq) {
                if (gq == 0) { TK_WRITE(); TK_LOAD(g, 1); }
                if (gq == 4) { TK_WRITE(); if (g + ngw < T / 4) TK_LOAD(g + ngw, 0); }
                const int c0 = 2 * (gq & 3);
                const u32x4 w0 = *(const LAS u32x4*)(seg + ((c0 ^ (lane & 7)) << 4)), w1 = *(const LAS u32x4*)(seg + (((c0 + 1) ^ (lane & 7)) << 4));
                unsigned ka[8], kb[8];
#pragma unroll
                for (int e2 = 0; e2 < 4; ++e2) {
                    const unsigned wa = e2 == 0 ? w0.x : (e2 == 1 ? w0.y : (e2 == 2 ? w0.z : w0.w)), wb = e2 == 0 ? w1.x : (e2 == 1 ? w1.y : (e2 == 2 ? w1.z : w1.w));
                    typedef short s16x2_t __attribute__((ext_vector_type(2)));
                    const unsigned ma = __builtin_bit_cast(unsigned, __builtin_bit_cast(s16x2_t, wa) >> (short)15) | 0x80008000u, mb = __builtin_bit_cast(unsigned, __builtin_bit_cast(s16x2_t, wb) >> (short)15) | 0x80008000u;
                    const unsigned sa = wa ^ ma, sb = wb ^ mb;
                    const unsigned i0 = (unsigned)(127 - (16 * gq + 2 * e2));
                    ka[2 * e2] = (sa << 16) | i0; ka[2 * e2 + 1] = (sa & 0xffff0000u) | (i0 - 1u);
                    kb[2 * e2] = (sb << 16) | (i0 - 8u); kb[2 * e2 + 1] = (sb & 0xffff0000u) | (i0 - 9u);
                }
                peer::sort8(ka); peer::sort8(kb);
                unsigned G[16];
#pragma unroll
                for (int i = 0; i < 8; ++i) { G[i] = ka[i]; G[8 + i] = kb[7 - i]; }
                peer::bmerge16(G);
                if (gq == 0) {
#pragma unroll
                    for (int i = 0; i < 16; ++i) L[i] = G[i];
                } else {
#pragma unroll
                    for (int i = 0; i < 16; ++i) L[i] = L[i] > G[15 - i] ? L[i] : G[15 - i];
                    peer::bmerge16(L);
                }
            }
        }
#pragma unroll
        for (int i = 0; i < 16; ++i) lists[lane * 16 + i] = L[i];
        const int p = hp & 1;
        float av[16], bv[16];
#pragma unroll
        for (int i = 0; i < 16; ++i) { const unsigned o = (unsigned)__builtin_amdgcn_update_dpp(0, (int)L[i], 0xB1, 0xF, 0xF, true); av[i] = peer::dec16(p ? o : L[i]); bv[i] = peer::dec16(p ? L[i] : o); }
        unsigned M[16];
        {
            unsigned C[32];
#pragma unroll
            for (int k = 0; k < 25; ++k) {
                const int i0 = CT.i[2 * k], j0 = CT.j[2 * k], i1 = CT.i[2 * k + 1], j1 = CT.j[2 * k + 1];
                const float s0 = av[i0] + bv[j0], s1 = av[i1] + bv[j1];
                const float sm = p ? s1 : s0; const unsigned fl = p ? (unsigned)(i1 * 16 + j1) : (unsigned)(i0 * 16 + j0);
                C[k] = (peer::enc32(sm) & 0xffffff00u) | (255u - fl);
            }
#pragma unroll
            for (int k = 25; k < 32; ++k) C[k] = 0u;
            unsigned g0[8], g1[8], g2[8], g3[8];
#pragma unroll
            for (int i = 0; i < 8; ++i) { g0[i] = C[i]; g1[i] = C[8 + i]; g2[i] = C[16 + i]; g3[i] = C[24 + i]; }
            peer::sort8(g0); peer::sort8(g1); peer::sort8(g2); peer::sort8(g3);
            unsigned H[16];
#pragma unroll
            for (int i = 0; i < 8; ++i) { M[i] = g0[i]; M[8 + i] = g1[7 - i]; H[i] = g2[i]; H[8 + i] = g3[7 - i]; }
            peer::bmerge16(M); peer::bmerge16(H);
#pragma unroll
            for (int i = 0; i < 16; ++i) M[i] = M[i] > H[15 - i] ? M[i] : H[15 - i];
            peer::bmerge16(M);
        }
        unsigned R[16];
#pragma unroll
        for (int k = 0; k < 16; ++k) { const unsigned o = (unsigned)__builtin_amdgcn_update_dpp(0, (int)M[15 - k], 0xB1, 0xF, 0xF, true); R[k] = M[k] > o ? M[k] : o; }
        float rv[16], mx = -INFINITY;
#pragma unroll
        for (int k = 0; k < 16; ++k) { rv[k] = peer::dec32(R[k] & 0xffffff00u); mx = fmaxf(mx, rv[k]); }
        float sum = 0.f;
#pragma unroll
        for (int k = 0; k < 16; ++k) { rv[k] = __builtin_amdgcn_exp2f((rv[k] - mx) * LOG2E); sum += rv[k]; }
        const float isum = 1.0f / sum;
        {
            const int h = hp >> 1;
            const LAS unsigned* la = lists + (lane & ~1) * 16; const LAS unsigned* lb = lists + (lane | 1) * 16;
#pragma unroll
            for (int k = 0; k < 8; ++k) {
                const unsigned fl = 255u - (R[k] & 0xffu);
                const unsigned i1 = 127u - (la[fl >> 4] & 0x7fu), i2 = 127u - (lb[fl & 15u] & 0x7fu);
                const int j = h * 16 + p * 8 + k, sl = j;
                const unsigned short e = (unsigned short)(i1 * 128u + i2);
                Pe_slot[(size_t)tok * 128 + sl] = e;
                Pe_ld[(size_t)tok * 128 + ld_of(j)] = e;
                Pg[(size_t)tok * 128 + sl] = rv[k] * isum;
            }
        }
        if (hp == 0) {
            float s = 0.f;
#pragma unroll
            for (int k = 0; k < 8; ++k) { const f32x4 q = *(const f32x4*)(ssq_h + (size_t)tok * 32 + 4 * k); s += (q.x + q.y) + (q.z + q.w); }
            rstd_h[tok] = 1.0f / sqrtf(s * (1.f / 1024.f) + EPS);
        }
    }
#undef TK_LOAD
#undef TK_WRITE
}

struct UG { u32x4 v[8]; };
struct UIDS { u32x4 e0, e1, b0, b1; };
__device__ __forceinline__ void u_ids(UIDS& I, const unsigned short* __restrict__ Pe_ld, const unsigned char* __restrict__ Hx, int tok, int lane) {
    const u32x4* ip = (const u32x4*)(Pe_ld + (size_t)tok * 128 + (lane >> 3) * 8);
    I.e0 = ip[0]; I.e1 = ip[8];
    const unsigned char* hrow = Hx + (size_t)tok * 128 + 32 * (lane >> 4);
    I.b0 = *(const u32x4*)hrow; I.b1 = *(const u32x4*)(hrow + 16);
}
__device__ __forceinline__ void u_gather(UG& F, const u32x4& w, const unsigned char* __restrict__ Ul  , unsigned emask, unsigned loff = 0u  ) {
#pragma unroll
    for (int i = 0; i < 8; ++i) {
        const unsigned word = (i >> 1) == 0 ? w.x : ((i >> 1) == 1 ? w.y : ((i >> 1) == 2 ? w.z : w.w));
        const unsigned e = ((i & 1) ? (word >> 16) : (word & 0xffffu)) & emask;
        F.v[i] = *(const u32x4*)(Ul + (e * 128u + loff));
    }
}
template <int PM = 0> __device__ __forceinline__ void u_compute(u32x4& z0, u32x4& z1, const UG& F, const u32x4& b0, const u32x4& b1, LAS unsigned char* hl  , int lane) {
    if (PM == 0) {
        LAS unsigned char* wp = hl + (lane >> 3) * 128 + (((lane & 7) ^ (lane >> 3)) << 4);
#pragma unroll
        for (int i = 0; i < 8; ++i) *(LAS u32x4*)(wp + i * 1024) = F.v[i];
    }
    const v8i bfr = {(int)b0.x, (int)b0.y, (int)b0.z, (int)b0.w, (int)b1.x, (int)b1.y, (int)b1.z, (int)b1.w};
    const int r16 = lane & 15, kb = lane >> 4;
    const LAS unsigned char* rp = hl + r16 * 128;
    const int p0 = ((2 * kb) ^ (r16 & 7)) << 4, p1 = ((2 * kb + 1) ^ (r16 & 7)) << 4;
    f32x4 acc[4];
#pragma unroll
    for (int g = 0; g < 4; ++g) {
        u32x4 a0, a1; if (PM == 0) { a0 = *(const LAS u32x4*)(rp + g * 2048 + p0); a1 = *(const LAS u32x4*)(rp + g * 2048 + p1); } else { a0 = F.v[2 * g]; a1 = F.v[2 * g + 1]; }
        const v8i afr = {(int)a0.x, (int)a0.y, (int)a0.z, (int)a0.w, (int)a1.x, (int)a1.y, (int)a1.z, (int)a1.w};
        acc[g] = __builtin_amdgcn_mfma_scale_f32_16x16x128_f8f6f4(afr, bfr, (f32x4){0.f, 0.f, 0.f, 0.f}, 0, 0, 0, 0, 0, 0);
    }
    z0.x = pk_bf16(acc[0][0], acc[0][1]); z0.y = pk_bf16(acc[0][2], acc[0][3]); z0.z = pk_bf16(acc[1][0], acc[1][1]); z0.w = pk_bf16(acc[1][2], acc[1][3]);
    z1.x = pk_bf16(acc[2][0], acc[2][1]); z1.y = pk_bf16(acc[2][2], acc[2][3]); z1.z = pk_bf16(acc[3][0], acc[3][1]); z1.w = pk_bf16(acc[3][2], acc[3][3]);
}
constexpr int U_REC = 512, U_CH = 16, U_STAGE = 8192, U_WLDS = U_STAGE + U_CH * U_REC;
template <int PM = 0> __device__ __forceinline__ void u_phase(LAS unsigned char* lds, const unsigned char* __restrict__ Hb8, const unsigned char* __restrict__ U8, const unsigned short* __restrict__ Pe_ld, bf16_t* __restrict__ Zp, int x, int wg, int nwg, unsigned emask = 0xffffu) {
    const int lane = threadIdx.x & 63, wid = __builtin_amdgcn_readfirstlane(threadIdx.x >> 6);
    LAS unsigned char* wl = lds + wid * U_WLDS;
    LAS unsigned char* rb = wl + U_STAGE;
    const unsigned rb_u = (unsigned)__builtin_amdgcn_readfirstlane((int)(unsigned)(uintptr_t)rb);
    const unsigned char* Hx = Hb8 + (size_t)x * ((size_t)T * 128);
    const unsigned char* Ul = U8 + (size_t)x * ((size_t)16384 * 128); const unsigned loff = 16u * (lane & 7);
    bf16_t* Zx = Zp + (size_t)x * T * 128;
    const int n = (T - wg + nwg - 1) / nwg;
    if (n <= 0) return;
    const int nch = (n + U_CH - 1) / U_CH;
#define UTOK(k) (wg + ((k) < n ? (k) : n - 1) * nwg)
#define USB() __builtin_amdgcn_sched_barrier(0)
    const int w32 = lane & 31, sub = lane >> 5;
    const unsigned char* rbase = w32 < 16 ? (const unsigned char*)Pe_ld + 16 * w32 : (w32 < 24 ? Hx + 16 * (w32 - 16) : (const unsigned char*)Pe_ld);
    const unsigned rstride = (w32 >= 16 && w32 < 24) ? 128u : 256u;
#pragma unroll 1
    for (int c = 0; c < nch; ++c) {
#pragma unroll
        for (int i = 0; i < U_CH / 2; ++i)
            glds16(rbase + (size_t)UTOK(c * U_CH + 2 * i + sub) * rstride, rb_u + i * 1024);
        asm volatile("s_waitcnt vmcnt(0)" ::: "memory");
        UG f0, f1;
        { const u32x4 e0 = *(const LAS u32x4*)(rb + (lane >> 3) * 16); u_gather(f0, e0, Ul, emask, loff); }
#pragma unroll 1
        for (int i = 0; i < U_CH; ++i) {
            const int k = c * U_CH + i;
            const LAS unsigned char* rec = rb + i * U_REC;
            const LAS unsigned char* nrec = (i + 1 < U_CH) ? rec + U_REC : rec;
            const u32x4 e1 = *(const LAS u32x4*)(rec + 128 + (lane >> 3) * 16), e0n = *(const LAS u32x4*)(nrec + (lane >> 3) * 16);
            const u32x4 bk0 = *(const LAS u32x4*)(rec + 256 + 32 * (lane >> 4)), bk1 = *(const LAS u32x4*)(rec + 256 + 32 * (lane >> 4) + 16);
            u32x4 za, zb, zc, zd;
            u_gather(f1, e1, Ul, emask, loff);
            USB(); u_compute<PM>(za, zb, f0, bk0, bk1, wl, lane); USB();
            u_gather(f0, e0n, Ul, emask, loff);
            USB(); u_compute<PM>(zc, zd, f1, bk0, bk1, wl, lane); USB();
            if ((lane & 15) == 0 && k < n) { bf16_t* zr_ = Zx + (size_t)UTOK(k) * 128 + 16 * (lane >> 4); *(u32x4*)zr_ = za; *(u32x4*)(zr_ + 8) = zb; *(u32x4*)(zr_ + 64) = zc; *(u32x4*)(zr_ + 72) = zd; }
        }
        asm volatile("s_waitcnt vmcnt(0) lgkmcnt(0)" ::: "memory");
    }
#undef UTOK
#undef USB
}

__device__ __forceinline__ float dppf(float v, int ctrl_sel) {
    const int s = __builtin_bit_cast(int, v);
    const int r = ctrl_sel == 0 ? __builtin_amdgcn_update_dpp(0, s, 0xB1, 0xF, 0xF, true) : ctrl_sel == 1 ? __builtin_amdgcn_update_dpp(0, s, 0x4E, 0xF, 0xF, true)
                : ctrl_sel == 2 ? __builtin_amdgcn_update_dpp(0, s, 0x141, 0xF, 0xF, true) : ctrl_sel == 3 ? __builtin_amdgcn_update_dpp(0, s, 0x140, 0xF, 0xF, true) : __builtin_amdgcn_update_dpp(0, s, 0x128, 0xF, 0xF, true);
    return __builtin_bit_cast(float, r);
}
constexpr float SA = 64.f;
__device__ __forceinline__ void act_phase(LAS unsigned char* lds, const bf16_t* __restrict__ Zp, const unsigned short* __restrict__ Pe_slot, const float* __restrict__ Pg, const float* __restrict__ ssq_h,
                                          unsigned short* __restrict__ PE2, unsigned char* __restrict__ PA2, int gw, int ngw) {
    const int lane = threadIdx.x & 63, wid = __builtin_amdgcn_readfirstlane(threadIdx.x >> 6);
    LAS unsigned short* lid = (LAS unsigned short*)(lds + wid * 512);
    LAS unsigned char* lw = lds + wid * 512 + 256;
    unsigned zw[8], ew; f32x2 gg; float sp;
#define ACT_LOAD(t_) do { const size_t o_ = (size_t)(t_) * 128 + 2 * lane; _Pragma("unroll") for (int xx = 0; xx < 8; ++xx) zw[xx] = *(const unsigned*)(Zp + (size_t)xx * T * 128 + o_); \
        ew = *(const unsigned*)(Pe_slot + o_); gg = *(const f32x2*)(Pg + o_); sp = ssq_h[(size_t)(t_) * 32 + (lane & 31)]; } while (0)
    if (gw < T) ACT_LOAD(gw);
    for (int tok = gw; tok < T; tok += ngw) {
        float z0 = 0.f, z1 = 0.f;
#pragma unroll
        for (int xx = 0; xx < 8; ++xx) { z0 += bf_lo(zw[xx]); z1 += bf_hi(zw[xx]); }
        const unsigned e2 = ew; const f32x2 g2 = gg;
        float s = sp;
        if (tok + ngw < T) ACT_LOAD(tok + ngw);
        s += dppf(s, 0); s += dppf(s, 1); s += dppf(s, 2); s += dppf(s, 3);
        const int si = __builtin_bit_cast(int, s);
        const float tot = __builtin_bit_cast(float, __builtin_amdgcn_readlane(si, 0)) + __builtin_bit_cast(float, __builtin_amdgcn_readlane(si, 16));
        const float zs = (1.0f / sqrtf(tot * (1.f / 1024.f) + EPS)) * (1.0f / (SU * SX));
        const float w0 = fminf(fmaxf(peer::gelu1(z0 * zs) * g2.x * SA, -440.f), 440.f), w1 = fminf(fmaxf(peer::gelu1(z1 * zs) * g2.y * SA, -440.f), 440.f);
        const unsigned w8 = (unsigned)__builtin_amdgcn_cvt_pk_fp8_f32(w0, w1, 0, false);
        const int sl0 = 2 * lane, d0 = (sl0 & 7) * 16 + (sl0 >> 3), d1 = ((sl0 + 1) & 7) * 16 + (sl0 >> 3);
        lid[d0] = (unsigned short)(e2 & 0xffffu); lid[d1] = (unsigned short)(e2 >> 16);
        lw[d0] = (unsigned char)(w8 & 0xffu); lw[d1] = (unsigned char)((w8 >> 8) & 0xffu);
        const u32x4 ov = *(const LAS u32x4*)(lds + wid * 512 + 16 * lane);
        if (lane < 16) *(u32x4*)(PE2 + (size_t)tok * 128 + 8 * lane) = ov;
        else if (lane < 24) *(u32x4*)(PA2 + (size_t)tok * 128 + 16 * (lane - 16)) = ov;
    }
#undef ACT_LOAD
}

struct VG { u32x4 v[8]; u32x2 w; };
template <int PM = 0> __device__ __forceinline__ void v_gather(VG& Gt, const u32x4& ew, const u32x2& ww, const unsigned char* __restrict__ vb  , unsigned loff  , unsigned emask) {
    Gt.w = ww;
#pragma unroll
    for (int i = 0; i < 8; ++i) {
        const unsigned word = (i >> 1) == 0 ? ew.x : ((i >> 1) == 1 ? ew.y : ((i >> 1) == 2 ? ew.z : ew.w));
        const unsigned e = ((i & 1) ? (word >> 16) : (word & 0xffffu)) & emask;
        if (PM == 1 && (i & 1)) Gt.v[i] = Gt.v[i - 1]; else
        Gt.v[i] = *(const u32x4*)(vb + (e * 128u + loff));
    }
}
struct VSel { unsigned lo[4], hi[4]; };
__device__ __forceinline__ void v_compute(f32x4& accL, f32x4& accH, const VG& Gt, const VSel& S) {
#pragma unroll
    for (int i = 0; i < 8; ++i) {
        const unsigned d = i < 4 ? Gt.w.x : Gt.w.y;
        const unsigned b0 = __builtin_amdgcn_perm(d, d, S.lo[i & 3]), b1 = __builtin_amdgcn_perm(d, d, S.hi[i & 3]);
        const long aL = (long)(((unsigned long long)Gt.v[i].y << 32) | Gt.v[i].x), aH = (long)(((unsigned long long)Gt.v[i].w << 32) | Gt.v[i].z);
        const long bb = (long)(((unsigned long long)b1 << 32) | b0);
        accL = __builtin_amdgcn_mfma_f32_16x16x32_fp8_fp8(aL, bb, accL, 0, 0, 0);
        accH = __builtin_amdgcn_mfma_f32_16x16x32_fp8_fp8(aH, bb, accH, 0, 0, 0);
    }
}
constexpr int V_REC = 512, V_CH = 16, V_WLDS = V_CH * V_REC + 1024;
template <int PM = 0> __device__ __forceinline__ void v_phase(LAS unsigned char* lds, const unsigned char* __restrict__ V8, const unsigned short* __restrict__ PE2, const unsigned char* __restrict__ PA2, bf16_t* __restrict__ Op, int x, int wg, int nwg, unsigned emask = 0xffffu) {
    const int lane = threadIdx.x & 63, wid = __builtin_amdgcn_readfirstlane(threadIdx.x >> 6), seg8 = lane >> 3, bp = lane & 7;
    LAS unsigned char* rb = lds + wid * V_WLDS;
    LAS float* tr = (LAS float*)(rb + V_CH * V_REC);
    const unsigned rb_u = (unsigned)__builtin_amdgcn_readfirstlane((int)(unsigned)(uintptr_t)rb);
    const unsigned char* vb = V8 + (size_t)x * ((size_t)16384 * 128); const unsigned loff = 16u * (lane & 7);
    bf16_t* Ox = Op + (size_t)x * T * 128;
    VSel S;
    { const unsigned none = 0x0c0c0c0cu, keep = none & ~(0xffu << (8 * (bp & 3)));
#pragma unroll
      for (int q = 0; q < 4; ++q) { const unsigned sq = keep | ((unsigned)q << (8 * (bp & 3))); S.lo[q] = bp < 4 ? sq : none; S.hi[q] = bp < 4 ? none : sq; } }
    const bool dvalid = ((lane >> 3) & 1) == (lane >> 5);
    LAS float* trw = tr + (lane >> 5) * 128 + 64 * ((lane >> 4) & 1) + bp;
    const int n = (T - wg + nwg - 1) / nwg;
    if (n <= 0) return;
    const int nch = (n + V_CH - 1) / V_CH;
#define VTOK(k) (wg + ((k) < n ? (k) : n - 1) * nwg)
    const int w32 = lane & 31, sub = lane >> 5;
    const unsigned char* rbase = w32 < 16 ? (const unsigned char*)PE2 + 16 * w32 : (w32 < 24 ? PA2 + 16 * (w32 - 16) : (const unsigned char*)PE2);
    const unsigned rstride = (w32 >= 16 && w32 < 24) ? 128u : 256u;
    const int roff = seg8 * 32, woff = 256 + seg8 * 16;
#pragma unroll 1
    for (int c = 0; c < nch; ++c) {
        if (PM != 2 || c == 0) {
#pragma unroll
        for (int i = 0; i < V_CH / 2; ++i)
            glds16(rbase + (size_t)VTOK(c * V_CH + 2 * i + sub) * rstride, rb_u + i * 1024);
        asm volatile("s_waitcnt vmcnt(0)" ::: "memory");
        }
        VG g0, g1;
        { const u32x4 ea = *(const LAS u32x4*)(rb + roff); const u32x2 wa = *(const LAS u32x2*)(rb + woff); v_gather<PM>(g0, ea, wa, vb, loff, emask); }
#pragma unroll 1
        for (int i = 0; i < V_CH; ++i) {
            const int k = c * V_CH + i, tok = VTOK(k);
            const LAS unsigned char* rec = rb + i * V_REC;
            const LAS unsigned char* nrec = (i + 1 < V_CH) ? rec + V_REC : rec;
            f32x4 accL = {0.f, 0.f, 0.f, 0.f}, accH = {0.f, 0.f, 0.f, 0.f};
            { const u32x4 ea = *(const LAS u32x4*)(rec + roff + 16); const u32x2 wa = *(const LAS u32x2*)(rec + woff + 8); v_gather<PM>(g1, ea, wa, vb, loff, emask); }
            __builtin_amdgcn_sched_barrier(0);
            v_compute(accL, accH, g0, S);
            { const u32x4 ea = *(const LAS u32x4*)(nrec + roff); const u32x2 wa = *(const LAS u32x2*)(nrec + woff); v_gather<PM>(g0, ea, wa, vb, loff, emask); }
            __builtin_amdgcn_sched_barrier(0);
            v_compute(accL, accH, g1, S);
            if (dvalid) {
#pragma unroll
                for (int r = 0; r < 4; ++r) { trw[16 * r] = accL[r]; trw[16 * r + 8] = accH[r]; }
            }
            const f32x4 oa = *(const LAS f32x4*)(tr + 4 * w32), ob = *(const LAS f32x4*)(tr + 128 + 4 * w32);
            if (lane < 32 && k < n) {
                constexpr float sc = 1.0f / (SA * SV);
                u32x2 w; w.x = pk_bf16((oa.x + ob.x) * sc, (oa.y + ob.y) * sc); w.y = pk_bf16((oa.z + ob.z) * sc, (oa.w + ob.w) * sc); *(u32x2*)(Ox + (size_t)tok * 128 + 4 * lane) = w;
            }
        }
        if (PM != 2) asm volatile("s_waitcnt vmcnt(0) lgkmcnt(0)" ::: "memory");
    }
#undef VTOK
}

__device__ __forceinline__ void final_phase(float* __restrict__ Out, const bf16_t* __restrict__ Hb, const bf16_t* __restrict__ Op, const float* __restrict__ g_final, int gw, int ngw) {
    const int lane = threadIdx.x & 63;
    const f32x4* gr = (const f32x4*)g_final + lane;
    const f32x4 g0 = gr[0], g1 = gr[64], g2 = gr[128], g3 = gr[192];
    const bf16_t* ob = Op + (size_t)(lane >> 5) * T * 128 + 4 * (lane & 31);
    for (int t0 = 4 * gw; t0 < T; t0 += 4 * ngw) {
        u32x2 hh[4][4], o[4][4];
#pragma unroll
        for (int r = 0; r < 4; ++r) {
            const int tok = t0 + r < T ? t0 + r : T - 1;
            const bf16_t* hr = Hb + (size_t)tok * DM + 4 * lane;
#pragma unroll
            for (int j = 0; j < 4; ++j) { hh[r][j] = *(const u32x2*)(hr + 256 * j); o[r][j] = *(const u32x2*)(ob + ((size_t)(2 * j) * T + tok) * 128); }
        }
#pragma unroll
        for (int r = 0; r < 4; ++r) {
            if (t0 + r >= T) break;
            f32x4 y[4];
            float s = 0.f;
#pragma unroll
            for (int j = 0; j < 4; ++j) {
                y[j].x = bf_lo(hh[r][j].x) + bf_lo(o[r][j].x); y[j].y = bf_hi(hh[r][j].x) + bf_hi(o[r][j].x); y[j].z = bf_lo(hh[r][j].y) + bf_lo(o[r][j].y); y[j].w = bf_hi(hh[r][j].y) + bf_hi(o[r][j].y);
                s += (y[j].x * y[j].x + y[j].y * y[j].y) + (y[j].z * y[j].z + y[j].w * y[j].w);
            }
            s += dppf(s, 0); s += dppf(s, 1); s += dppf(s, 2); s += dppf(s, 3);
            const int si = __builtin_bit_cast(int, s);
            const float tot = (__builtin_bit_cast(float, __builtin_amdgcn_readlane(si, 0)) + __builtin_bit_cast(float, __builtin_amdgcn_readlane(si, 16)))
                            + (__builtin_bit_cast(float, __builtin_amdgcn_readlane(si, 32)) + __builtin_bit_cast(float, __builtin_amdgcn_readlane(si, 48)));
            const float r2 = 1.0f / sqrtf(tot * (1.f / 1024.f) + EPS);
            f32x4* yr = (f32x4*)(Out + (size_t)(t0 + r) * DM) + lane;
            yr[0] = (f32x4){y[0].x * r2 * g0.x, y[0].y * r2 * g0.y, y[0].z * r2 * g0.z, y[0].w * r2 * g0.w};
            yr[64] = (f32x4){y[1].x * r2 * g1.x, y[1].y * r2 * g1.y, y[1].z * r2 * g1.z, y[1].w * r2 * g1.w};
            yr[128] = (f32x4){y[2].x * r2 * g2.x, y[2].y * r2 * g2.y, y[2].z * r2 * g2.z, y[2].w * r2 * g2.w};
            yr[192] = (f32x4){y[3].x * r2 * g3.x, y[3].y * r2 * g3.y, y[3].z * r2 * g3.z, y[3].w * r2 * g3.w};
        }
    }
}
}


#define XB_TMO      128
#define XB_XCNT(j)  (256  + 64 * (j))
#define XB_XSUB(j)  (1280 + 64 * (j))
#define XB_XGEN(j)  (2304 + 64 * (j))
#define XB_TOP      3328
#define XB_TOPGEN   3392
#define XCD_BAR_WORDS 3456
#define XB_SPIN_CAP (1u << 18)

__device__ __forceinline__ unsigned xb_ld(unsigned* p)              { return __hip_atomic_load(p, __ATOMIC_RELAXED, __HIP_MEMORY_SCOPE_AGENT); }
__device__ __forceinline__ unsigned xb_add(unsigned* p, unsigned v) { return __hip_atomic_fetch_add(p, v, __ATOMIC_RELAXED, __HIP_MEMORY_SCOPE_AGENT); }
__device__ __forceinline__ unsigned xb_xcc_id() { return (unsigned)__builtin_amdgcn_s_getreg((3 << 11) | 20) & 0xFu; }
#define XB_SPIN(cond, bar) do { unsigned _sp = 0; while (cond) { __builtin_amdgcn_s_sleep(1); \
    if ((++_sp & 255u) == 0u) { if (xb_ld(&(bar)[XB_TMO])) break; if (_sp > XB_SPIN_CAP) { atomicAdd(&(bar)[XB_TMO], 1u); break; } } } } while (0)

struct XcdBarrier {
    unsigned* bar; unsigned x;
    volatile LAS unsigned* st;
};

__device__ __forceinline__ XcdBarrier xcd_barrier_post(unsigned* bar, volatile LAS unsigned* st) {
    XcdBarrier b; b.bar = bar; b.x = xb_xcc_id(); b.st = st;
    if (threadIdx.x == 0) (void)xb_add(&bar[XB_XCNT(b.x)], 1u);
    return b;
}
__device__ __forceinline__ void xcd_barrier_complete(unsigned* bar, unsigned x, unsigned& nloc, unsigned& nx) {
    const unsigned G = gridDim.x * gridDim.y * gridDim.z;
    unsigned sum, cnt, mine, sp = 0u;
    for (;;) {
        sum = 0u; cnt = 0u; mine = 0u;
#pragma unroll
        for (unsigned j = 0; j < 16; ++j) { const unsigned c = xb_ld(&bar[XB_XCNT(j)]); sum += c; cnt += (c > 0u) ? 1u : 0u; mine = (j == x) ? c : mine; }
        if (sum == G) break;
        __builtin_amdgcn_s_sleep(1);
        if ((++sp & 255u) == 0u) { if (xb_ld(&bar[XB_TMO])) break; if (sp > XB_SPIN_CAP) { atomicAdd(&bar[XB_TMO], 1u); break; } }
    }
    nloc = mine > 0u ? mine : 1u; nx = cnt > 0u ? cnt : 1u;
}

__device__ __forceinline__ void xcd_barrier(const XcdBarrier& b) {
    asm volatile("s_waitcnt vmcnt(0)" ::: "memory");
    __syncthreads();
    if (threadIdx.x == 0) {
        unsigned* bar = b.bar;
        __builtin_amdgcn_s_waitcnt(0);
        unsigned nloc = b.st[0], nx = b.st[1];
        if (nloc == 0u) { xcd_barrier_complete(bar, b.x, nloc, nx); b.st[0] = nloc; b.st[1] = nx; }
        const unsigned old = xb_add(&bar[XB_XSUB(b.x)], 1u);
        const unsigned gen = old / nloc;
        if (old + 1u == (gen + 1u) * nloc) {
            __builtin_amdgcn_fence(__ATOMIC_RELEASE, "agent");
            asm volatile("s_waitcnt vmcnt(0)" ::: "memory");
            const unsigned og = xb_add(&bar[XB_TOP], 1u);
            const unsigned tg = og / nx;
            if (og + 1u == (tg + 1u) * nx) xb_add(&bar[XB_TOPGEN], 1u);
            else XB_SPIN(xb_ld(&bar[XB_TOPGEN]) == tg, bar);
            __builtin_amdgcn_fence(__ATOMIC_ACQUIRE, "agent");
            xb_add(&bar[XB_XGEN(b.x)], 1u);
            asm volatile("s_waitcnt vmcnt(0)" ::: "memory");
        } else {
            XB_SPIN(xb_ld(&bar[XB_XGEN(b.x)]) == gen, bar);
            __builtin_amdgcn_fence(__ATOMIC_ACQUIRE, "agent");
            asm volatile("s_waitcnt vmcnt(0)" ::: "memory");
        }
    }
    __syncthreads();
}

constexpr int NWAVES = 8;
constexpr int LDS_BYTES = 147456;
constexpr int MISC_OFF = 146432;

struct Args {
    const float *x, *g_mix, *w_in, *g_cq, *w_uq, *g_ckv, *w_ukv, *w_out, *g_ffn, *w_pq, *sub_keys, *u_emb, *v_emb, *g_final;
    const int* pos; float* out; unsigned char* ws; int ph_lo, ph_hi; unsigned probe_mask; int probe_shift;
};

__device__ __forceinline__ void p0_transpose_item(const float* __restrict__ W, int K, int N, const float* __restrict__ gk, bf16_t* __restrict__ WT, LAS float* scr, int item, int lane) {
    const int nblk = N / 32, kb = item / nblk, nb = item % nblk, k0 = 64 * kb, n0 = 32 * nb;
    float wv[32];
#pragma unroll
    for (int i = 0; i < 32; ++i) { const int kk = 2 * i + (lane >> 5); wv[i] = W[(size_t)(k0 + kk) * N + n0 + (lane & 31)]; if (gk) wv[i] *= gk[k0 + kk]; }
#pragma unroll
    for (int i = 0; i < 32; ++i) { const int kk = 2 * i + (lane >> 5); scr[kk * 33 + (lane & 31)] = wv[i]; }
    asm volatile("s_waitcnt lgkmcnt(0)" ::: "memory");
    const int c = lane & 7;
#pragma unroll
    for (int j = 0; j < 4; ++j) { const int n = (lane >> 3) + 8 * j; const LAS float* s = scr + (8 * c) * 33 + n;
        u32x4 o; o.x = pk_bf16(s[0 * 33], s[1 * 33]); o.y = pk_bf16(s[2 * 33], s[3 * 33]); o.z = pk_bf16(s[4 * 33], s[5 * 33]); o.w = pk_bf16(s[6 * 33], s[7 * 33]);
        *(u32x4*)(WT + (size_t)(n0 + n) * K + k0 + 8 * c) = o; }
    asm volatile("s_waitcnt lgkmcnt(0)" ::: "memory");
}
__device__ __forceinline__ bf16x8 cvt8(const float* p, float s) { const f32x4 a = *(const f32x4*)p, b = *(const f32x4*)(p + 4); u32x4 w; w.x = pk_bf16(a.x * s, a.y * s); w.y = pk_bf16(a.z * s, a.w * s); w.z = pk_bf16(b.x * s, b.y * s); w.w = pk_bf16(b.z * s, b.w * s); return __builtin_bit_cast(bf16x8, w); }
__device__ __forceinline__ void p0_wcomb_item(const float* __restrict__ keys, const float* __restrict__ w_pq, const float* __restrict__ g_ffn, bf16_t* __restrict__ Wc, int item, int lane) {
    const int hp = item >> 7, nblk = (item >> 5) & 3, kblk = item & 31, n0 = 32 * nblk, k0 = 32 * kblk, r32 = lane & 31, hi = lane >> 5;
    const float* ar = keys + ((size_t)hp * 128 + n0 + r32) * 128 + 8 * hi;
    const float* br = w_pq + (size_t)(k0 + r32) * 2048 + hp * 128 + 8 * hi;
    const float gk = g_ffn[k0 + r32];
    f32x16 d = {};
#pragma unroll
    for (int cs = 0; cs < 8; ++cs) d = __builtin_amdgcn_mfma_f32_32x32x16_bf16(cvt8(ar + 16 * cs, 1.f), cvt8(br + 16 * cs, 1.f), d, 0, 0, 0);
#pragma unroll
    for (int r = 0; r < 16; ++r) Wc[((size_t)hp * 128 + n0 + crow(r, hi)) * DM + k0 + r32] = (bf16_t)(pk_bf16(d[r] * gk, 0.f) & 0xffffu);
}
__device__ __forceinline__ void p0_prologue(const Args& a, LAS unsigned char* lds, int gw, int ngw, int lane, int wave) {
    unsigned char* ws = a.ws;
    LAS float* scr = (LAS float*)(lds + wave * 16384);
    bf16_t* Wt_in = (bf16_t*)(ws + WS_WIN); bf16_t* Wt_comb = (bf16_t*)(ws + WS_WCOMB); bf16_t* Wt_out = (bf16_t*)(ws + WS_WOUT); bf16_t* Wt_uq = (bf16_t*)(ws + WS_WUQ); bf16_t* Wt_ukv = (bf16_t*)(ws + WS_WUKV);
    constexpr int I_IN = (DM / 64) * (INW / 32), I_UQ = (256 / 64) * (768 / 32), I_UKV = (128 / 64) * (1024 / 32), I_OUT = (DM / 64) * (DM / 32), I_WC = 2048;
    constexpr int NITEMS = I_IN + I_UQ + I_UKV + I_OUT + I_WC;
    for (int it = gw; it < NITEMS; it += ngw) {
        int r = it;
        if (r < I_IN) { p0_transpose_item(a.w_in, DM, INW, nullptr, Wt_in, scr, r, lane); continue; } r -= I_IN;
        if (r < I_UQ) { p0_transpose_item(a.w_uq, 256, 768, a.g_cq, Wt_uq, scr, r, lane); continue; } r -= I_UQ;
        if (r < I_UKV) { p0_transpose_item(a.w_ukv, 128, 1024, a.g_ckv, Wt_ukv, scr, r, lane); continue; } r -= I_UKV;
        if (r < I_OUT) { p0_transpose_item(a.w_out, DM, DM, nullptr, Wt_out, scr, r, lane); continue; } r -= I_OUT;
        p0_wcomb_item(a.sub_keys, a.w_pq, a.g_ffn, Wt_comb, r, lane);
    }
    const int gt = gw * 64 + lane, ngt = ngw * 64;
    for (int i = gt; i < (2048 - INW) * DM / 8; i += ngt) *(u32x4*)(Wt_in + (size_t)INW * DM + (size_t)i * 8) = (u32x4){0u, 0u, 0u, 0u};
    { bf16_t* HN = (bf16_t*)(ws + WS_HN);
      const f32x4* gr = (const f32x4*)a.g_mix + lane;
      const f32x4 g0 = gr[0], g1 = gr[64], g2 = gr[128], g3 = gr[192];
      for (int m0 = 4 * gw; m0 < T; m0 += 4 * ngw) {
          f32x4 v[4][4];
#pragma unroll
          for (int r = 0; r < 4; ++r) { const f32x4* xr = (const f32x4*)(a.x + (size_t)(m0 + r) * DM) + lane; v[r][0] = xr[0]; v[r][1] = xr[64]; v[r][2] = xr[128]; v[r][3] = xr[192]; }
#pragma unroll
          for (int r = 0; r < 4; ++r) {
              float s = 0.f;
#pragma unroll
              for (int j = 0; j < 4; ++j) s += (v[r][j].x * v[r][j].x + v[r][j].y * v[r][j].y) + (v[r][j].z * v[r][j].z + v[r][j].w * v[r][j].w);
              const float rstd = 1.0f / sqrtf(wave_sum(s) * (1.f / DM) + EPS);
              u32x2* o8 = (u32x2*)(HN + (size_t)(m0 + r) * DM) + lane;
              u32x2 w;
              w.x = pk_bf16(v[r][0].x * rstd * g0.x, v[r][0].y * rstd * g0.y); w.y = pk_bf16(v[r][0].z * rstd * g0.z, v[r][0].w * rstd * g0.w); o8[0] = w;
              w.x = pk_bf16(v[r][1].x * rstd * g1.x, v[r][1].y * rstd * g1.y); w.y = pk_bf16(v[r][1].z * rstd * g1.z, v[r][1].w * rstd * g1.w); o8[64] = w;
              w.x = pk_bf16(v[r][2].x * rstd * g2.x, v[r][2].y * rstd * g2.y); w.y = pk_bf16(v[r][2].z * rstd * g2.z, v[r][2].w * rstd * g2.w); o8[128] = w;
              w.x = pk_bf16(v[r][3].x * rstd * g3.x, v[r][3].y * rstd * g3.y); w.y = pk_bf16(v[r][3].z * rstd * g3.z, v[r][3].w * rstd * g3.w); o8[192] = w;
          } } }
    { float* cosA = (float*)(ws + WS_COSA); float* sinA = (float*)(ws + WS_SINA); float* cosM = (float*)(ws + WS_COSM); float* sinM = (float*)(ws + WS_SINM);
      constexpr float INV16[16] = {1.0f, 0.44036659598350525f, 0.1939227432012558f, 0.08539710193872452f, 0.03760603070259094f, 0.016560440883040428f, 0.007292664609849453f, 0.0032114461064338684f,
                                   0.0014142135623842478f, 0.0006227724370546639f, 0.00027424818836152554f, 0.00012076973507646471f, 5.3182957344688475e-05f, 2.34199997066753e-05f, 1.0313385246263351e-05f, 4.541670477919979e-06f};
      for (int i = gt; i < T * 16; i += ngt) {
          const int tok = i >> 4, j = i & 15;
          const float ang = (float)a.pos[tok] * INV16[j];
          float sn, cs; sincosf(ang, &sn, &cs);
          cosM[tok * 16 + j] = cs; sinM[tok * 16 + j] = sn;
          if ((j & 1) == 0) { cosA[tok * 8 + (j >> 1)] = cs; sinA[tok * 8 + (j >> 1)] = sn; } } }
}

__global__ void __launch_bounds__(NWAVES * 64, 2) mk_fwd(Args a) {
    extern __shared__ __attribute__((aligned(16))) unsigned char lds_raw[];
    LAS unsigned char* lds = (LAS unsigned char*)lds_raw;
    volatile LAS unsigned* MISC = (volatile LAS unsigned*)(lds + MISC_OFF);
    const int tid = threadIdx.x, lane = tid & 63, wave = __builtin_amdgcn_readfirstlane(tid >> 6);
    const int G = gridDim.x, bx = blockIdx.x, vcu = (G % 8 == 0) ? (bx % 8) * (G / 8) + bx / 8 : bx;
    unsigned char* ws = a.ws;
    for (int u = tid; u < 64; u += NWAVES * 64) MISC[u] = 0u;
    __syncthreads();
    XcdBarrier bar = xcd_barrier_post((unsigned*)(ws + WS_CTL), MISC + 8);
    const int lo = a.ph_lo, hi = a.ph_hi;
#ifdef PROBE_LO
#define PMASK a.probe_mask
#else
#define PMASK 0xffffu
#endif
#define IN(k) (lo <= (k) && (k) < hi)
#ifdef PROBE_LO
#define RUN(k) (IN(k) && !(a.probe_shift & 16))
#else
#define RUN(k) IN(k)
#endif
#define SEAM(k) do { if (IN(k) && IN((k) + 1)) xcd_barrier(bar); } while (0)
    const int gw = vcu * NWAVES + wave, ngw = G * NWAVES;

    if (RUN(0)) { p0_prologue(a, lds, gw, ngw, lane, wave); }
    SEAM(0);
    if (RUN(1)) {
        pg8::Gemm g{(const bf16_t*)(ws + WS_HN), (const bf16_t*)(ws + WS_WIN), T, 2048, DM}; pg8::StaticOrder S; S.init(T, 2048, G, bx);
        pg8::EpiProj E{(bf16_t*)(ws + WS_QA), (bf16_t*)(ws + WS_KA), (bf16_t*)(ws + WS_VA), (bf16_t*)(ws + WS_CQ), (bf16_t*)(ws + WS_CKV), (bf16_t*)(ws + WS_KR),
                       (float*)(ws + WS_SSQQ), (float*)(ws + WS_SSQKV), (const float*)(ws + WS_COSA), (const float*)(ws + WS_SINA), (const float*)(ws + WS_COSM), (const float*)(ws + WS_SINM)};
        pg8::gemm_phase<pg8::EpiProj, pg8::StaticOrder, true, true>(lds, g, S, E);
    }
    SEAM(1);
    if (RUN(2)) {
        { int kk = 128; asm volatile("" : "+s"(kk));
          pg8::Gemm g{(const bf16_t*)(ws + WS_CKV), (const bf16_t*)(ws + WS_WUKV), T, 1024, kk}; pg8::StaticOrder S; S.init(T, 1024, G, bx);
          pg8::EpiKv E{(bf16_t*)(ws + WS_KN), (bf16_t*)(ws + WS_VM), (const float*)(ws + WS_SSQKV)};
          pg8::gemm_phase<pg8::EpiKv, pg8::StaticOrder, true, true>(lds, g, S, E); }
        __syncthreads();
        { int kk = 256; asm volatile("" : "+s"(kk));
          pg8::Gemm g{(const bf16_t*)(ws + WS_CQ), (const bf16_t*)(ws + WS_WUQ), T, 768, kk}; pg8::StaticOrder S; S.init(T, 768, G, bx);
          pg8::EpiQm E{(bf16_t*)(ws + WS_QM), (const float*)(ws + WS_SSQQ), (const float*)(ws + WS_COSM), (const float*)(ws + WS_SINM)};
          pg8::gemm_phase<pg8::EpiQm, pg8::StaticOrder, true, true>(lds, g, S, E); }
    }
    SEAM(2);
    if (RUN(3)) {
        if (!(a.probe_shift & 1)) for (int pr = vcu; pr < 256; pr += G) {
            const int bh = pr >> 4, s = pr & 15;
            att::mla_unit(lds, (const bf16_t*)(ws + WS_QM), (const bf16_t*)(ws + WS_KN), (const bf16_t*)(ws + WS_KR), (const bf16_t*)(ws + WS_VM), (bf16_t*)(ws + WS_MIXED), bh >> 3, bh & 7, 31 - s,
                          a.u_emb, a.v_emb, a.g_ffn, ws + WS_U8, ws + WS_V8, pr * 528);
            att::mla_unit(lds, (const bf16_t*)(ws + WS_QM), (const bf16_t*)(ws + WS_KN), (const bf16_t*)(ws + WS_KR), (const bf16_t*)(ws + WS_VM), (bf16_t*)(ws + WS_MIXED), bh >> 3, bh & 7, s,
                          a.u_emb, a.v_emb, a.g_ffn, ws + WS_U8, ws + WS_V8, pr * 528 + 16 * (32 - s));
        }
        if (!(a.probe_shift & 2)) for (int sg = vcu; sg < 256; sg += G)
            att::dil_segment(lds, (const bf16_t*)(ws + WS_QA), (const bf16_t*)(ws + WS_KA), (const bf16_t*)(ws + WS_VA), (bf16_t*)(ws + WS_MIXED), sg, wave, lane, a.probe_shift);
    }
    SEAM(3);
    if (RUN(4)) {
        pg8::Gemm g{(const bf16_t*)(ws + WS_MIXED), (const bf16_t*)(ws + WS_WOUT), T, DM, DM}; pg8::StaticOrder S; S.init(T, DM, G, bx);
        pg8::EpiOut E{a.x, (bf16_t*)(ws + WS_HB), ws + WS_HB8, (float*)(ws + WS_SSQH)};
        pg8::gemm_phase<pg8::EpiOut, pg8::StaticOrder, true, true>(lds, g, S, E);
    }
    SEAM(4);
    if (RUN(5)) {
        pg8::Gemm g{(const bf16_t*)(ws + WS_HB), (const bf16_t*)(ws + WS_WCOMB), T, 2048, DM}; pg8::StaticOrder S; S.init(T, 2048, G, bx);
        pg8::EpiSc E{(bf16_t*)(ws + WS_SC), (const float*)(ws + WS_SSQH)};
        pg8::gemm_phase<pg8::EpiSc, pg8::StaticOrder, true, true>(lds, g, S, E);
    }
    SEAM(5);
    if (RUN(6)) {
        peer2::topk_phase(lds, (const bf16_t*)(ws + WS_SC), (const float*)(ws + WS_SSQH), (unsigned short*)(ws + WS_PESLOT), (unsigned short*)(ws + WS_PEROW), (float*)(ws + WS_PG), (float*)(ws + WS_RSTDH), gw, ngw);
    }
    SEAM(6);
    const int sx = bx % 8, smem = (bx / 8) * NWAVES + wave, scnt = ((G - sx + 7) / 8) * NWAVES;
#ifdef PROBE_LO
    if (RUN(7) && (a.probe_shift & 8)) { peer2::u_phase<1>(lds, ws + WS_HB8, ws + WS_U8, (const unsigned short*)(ws + WS_PEROW), (bf16_t*)(ws + 160 * MiB), sx, smem, scnt, PMASK); } else
#endif
    if (RUN(7)) { peer2::u_phase(lds, ws + WS_HB8, ws + WS_U8, (const unsigned short*)(ws + WS_PEROW), (bf16_t*)(ws + WS_ZP), sx, smem, scnt, PMASK); }
    SEAM(7);
    if (RUN(8)) { peer2::act_phase(lds, (const bf16_t*)(ws + WS_ZP), (const unsigned short*)(ws + WS_PESLOT), (const float*)(ws + WS_PG), (const float*)(ws + WS_SSQH), (unsigned short*)(ws + WS_PE2), ws + WS_PA2, gw, ngw); }
    SEAM(8);
#ifdef PROBE_LO
    if (RUN(9) && (a.probe_shift & 128)) { peer2::v_phase<2>(lds, ws + WS_V8, (const unsigned short*)(ws + WS_PE2), ws + WS_PA2, (bf16_t*)(ws + 160 * MiB), sx, smem, scnt, PMASK); } else
    if (RUN(9) && (a.probe_shift & 4)) { peer2::v_phase<1>(lds, ws + WS_V8, (const unsigned short*)(ws + WS_PE2), ws + WS_PA2, (bf16_t*)(ws + WS_OP), sx, smem, scnt, PMASK); } else
#endif
    if (RUN(9)) { peer2::v_phase(lds, ws + WS_V8, (const unsigned short*)(ws + WS_PE2), ws + WS_PA2, (bf16_t*)(ws + WS_OP), sx, smem, scnt, PMASK); }
    SEAM(9);
    if (RUN(10)) { peer2::final_phase(a.out, (const bf16_t*)(ws + WS_HB), (const bf16_t*)(ws + WS_OP), a.g_final, gw, ngw); }
#undef IN
#undef RUN
#undef SEAM
}


#ifndef STAGE
#define STAGE 6
#endif
extern "C" void kernel_launch(void* const* d_in, const int* in_sizes, int n_in, void* d_out, int out_size, void* d_ws, size_t ws_size, hipStream_t stream) {
    static int grid = 0;
    if (grid == 0) {
        if (n_in != 15 || out_size != T * DM || ws_size < 256 * MiB) { fprintf(stderr, "kernel_launch: unexpected problem shape (n_in %d, out %d, ws %zu); nothing launched\n", n_in, out_size, ws_size); grid = -1; return; }
        int dev = 0, cus = 0, per_cu = 0;
        if (hipGetDevice(&dev) != hipSuccess || hipDeviceGetAttribute(&cus, hipDeviceAttributeMultiprocessorCount, dev) != hipSuccess) { grid = -1; return; }
        if (hipFuncSetAttribute((const void*)mk_fwd, hipFuncAttributeMaxDynamicSharedMemorySize, LDS_BYTES) != hipSuccess) { fprintf(stderr, "kernel_launch: hipFuncSetAttribute failed\n"); grid = -1; return; }
        if (hipOccupancyMaxActiveBlocksPerMultiprocessor(&per_cu, (const void*)mk_fwd, NWAVES * 64, LDS_BYTES) != hipSuccess || per_cu < 1) fprintf(stderr, "kernel_launch: note: occupancy query says %d workgroups per CU\n", per_cu);
        (void)hipGetLastError();
        grid = cus;
        if (grid < 8) { fprintf(stderr, "kernel_launch: %d CUs: the PEER slice phases need a grid of at least 8 workgroups; nothing launched\n", grid); grid = -1; return; }
    }
    if (grid < 0) return;
    unsigned char* ws = (unsigned char*)d_ws;
    (void)hipMemsetAsync(ws + WS_CTL, 0, CTL_ZERO_BYTES, stream);
    Args a{};
    a.x = (const float*)d_in[0]; a.pos = (const int*)d_in[1]; a.g_mix = (const float*)d_in[2]; a.w_in = (const float*)d_in[3]; a.g_cq = (const float*)d_in[4]; a.w_uq = (const float*)d_in[5];
    a.g_ckv = (const float*)d_in[6]; a.w_ukv = (const float*)d_in[7]; a.w_out = (const float*)d_in[8]; a.g_ffn = (const float*)d_in[9]; a.w_pq = (const float*)d_in[10]; a.sub_keys = (const float*)d_in[11];
    a.u_emb = (const float*)d_in[12]; a.v_emb = (const float*)d_in[13]; a.g_final = (const float*)d_in[14];
    a.out = (float*)d_out; a.ws = ws; a.ph_lo = 0; a.ph_hi = (STAGE >= 6) ? 11 : STAGE + 1; a.probe_mask = 0xffffu; a.probe_shift = 0;
#if defined(PROBE_LO) && PROBE_LO == 3
    { Args b1 = a; b1.ph_hi = 4; b1.probe_shift = PROBE_SHIFT; hipLaunchKernelGGL(mk_fwd, dim3(grid), dim3(NWAVES * 64), LDS_BYTES, stream, b1);
      (void)hipMemsetAsync(ws + WS_CTL, 0, CTL_ZERO_BYTES, stream); a.ph_lo = 3; }
#endif
    hipLaunchKernelGGL(mk_fwd, dim3(grid), dim3(NWAVES * 64), LDS_BYTES, stream, a);
#if defined(PROBE_LO) && PROBE_LO != 3
#if 0
#else
    { Args b2 = a; b2.ph_lo = PROBE_LO; b2.ph_hi = PROBE_HI; b2.probe_shift = PROBE_SHIFT; b2.probe_mask = PROBE_MASK; (void)hipMemsetAsync(ws + WS_CTL, 0, CTL_ZERO_BYTES, stream); hipLaunchKernelGGL(mk_fwd, dim3(grid), dim3(NWAVES * 64), LDS_BYTES, stream, b2); }
#endif
#endif
#if STAGE < 6
    float* out = (float*)d_out; float* mixed = out;
    const size_t MB = MiB;
#if STAGE == 2
    {
        float* q32 = (float*)(ws + 0 * MB); float* k32 = (float*)(ws + 32 * MB); float* v32 = (float*)(ws + 64 * MB);
        const long n = (long)T * 512;
        nv::k_cvt<<<(int)((n + 255) / 256), 256, 0, stream>>>((const bf16_t*)(ws + WS_QA), q32, n, 1.0f / LOG2E);
        nv::k_cvt<<<(int)((n + 255) / 256), 256, 0, stream>>>((const bf16_t*)(ws + WS_KA), k32, n, 1.0f);
        nv::k_cvt<<<(int)((n + 255) / 256), 256, 0, stream>>>((const bf16_t*)(ws + WS_VA), v32, n, 1.0f);
        nv::k_dilated<<<T * 8 / 4, 256, 0, stream>>>(q32, k32, v32, mixed);
        float* qm32 = (float*)(ws + 112 * MB);
        const long nq = (long)T * 768;
        nv::k_cvt<<<(int)((nq + 255) / 256), 256, 0, stream>>>((const bf16_t*)(ws + WS_QM), qm32, nq, 1.0f / LOG2E);
        float* Kt = (float*)(ws + 0 * MB); float* Vt = Kt + (size_t)NB * 8 * 96 * SEQ;
        nv::k_build_ktvt<<<(int)(((long)NB * 8 * 160 * SEQ + 255) / 256), 256, 0, stream>>>((const bf16_t*)(ws + WS_KN), (const bf16_t*)(ws + WS_VM), (const bf16_t*)(ws + WS_KR), Kt, Vt);
        nv::k_mla<<<NB * 8 * (SEQ / 4), 256, 0, stream>>>(qm32, Kt, Vt, mixed);
    }
#elif STAGE == 3
    { const long n = (long)T * DM; nv::k_cvt<<<(int)((n + 255) / 256), 256, 0, stream>>>((const bf16_t*)(ws + WS_MIXED), mixed, n, 1.0f); }
#endif
    float* hbuf = (float*)(ws + 192 * MB); float* rstd_h = (float*)(ws + 180 * MB);
#if STAGE <= 3
    nv::k_gemm<<<dim3(DM / 64, T / 64), 256, 0, stream>>>(mixed, DM, nullptr, nullptr, a.w_out, DM, hbuf, DM, T, DM, DM, a.x, DM);
#else
    (void)hipMemcpyAsync(hbuf, out, (size_t)T * DM * 4, hipMemcpyDeviceToDevice, stream);
#endif
    float* qp = (float*)(ws + 0 * MB);
    float* vals = (float*)(ws + 128 * MB); int* idxs = (int*)(ws + 145 * MB); int* expert = (int*)(ws + 162 * MB); float* gate = (float*)(ws + 171 * MB);
    nv::k_rstd<<<T / 4, 256, 0, stream>>>(hbuf, DM, DM, rstd_h, T);
    nv::k_gemm<<<dim3(2048 / 64, T / 64), 256, 0, stream>>>(hbuf, DM, rstd_h, a.g_ffn, a.w_pq, 2048, qp, 2048, T, 2048, DM, nullptr, 0);
    (void)hipFuncSetAttribute((const void*)nv::k_topk1, hipFuncAttributeMaxDynamicSharedMemorySize, 65536);
    nv::k_topk1<<<dim3(T / 256, 16), 256, 65536, stream>>>(qp, a.sub_keys, vals, idxs);
    nv::k_topk2<<<T * 8 / 256, 256, 0, stream>>>(vals, idxs, expert, gate);
    nv::k_peer_final<<<T / 4, 256, 0, stream>>>(hbuf, rstd_h, a.g_ffn, a.u_emb, a.v_emb, expert, gate, a.g_final, out);
#endif
}
```

```cpp
#include <hip/hip_runtime.h>
#include <hip/hip_bf16.h>
#include <math.h>
#include <stdio.h>
#include <stdint.h>

#define LAS __attribute__((address_space(3)))
#define GAS __attribute__((address_space(1)))
typedef unsigned short bf16_t;
typedef short bf16x8 __attribute__((ext_vector_type(8)));
typedef short s16x4 __attribute__((ext_vector_type(4)));
typedef float f32x2 __attribute__((ext_vector_type(2)));
typedef float f32x4 __attribute__((ext_vector_type(4)));
typedef float f32x16 __attribute__((ext_vector_type(16)));
typedef unsigned u32x2 __attribute__((ext_vector_type(2)));
typedef unsigned u32x4 __attribute__((ext_vector_type(4)));
typedef __bf16 bf16x2_t __attribute__((ext_vector_type(2)));
typedef _Float16 f16x2_t __attribute__((ext_vector_type(2)));
typedef int v8i __attribute__((ext_vector_type(8)));

constexpr int DM = 1024, NB = 2, SEQ = 8192, T = NB * SEQ;
constexpr int INW = 1952;
constexpr float EPS = 1e-6f;
constexpr float LOG2E = 1.4426950408889634f;
constexpr float QA_SCALE = 0.125f * LOG2E;
constexpr float QM_SCALE = 0.10206207261596577f * LOG2E;

constexpr size_t MiB = 1u << 20;
constexpr size_t WS_CTL = 0, CTL_ZERO_BYTES = 64 * 1024;
constexpr size_t WS_COSA = 1 * MiB, WS_SINA = WS_COSA + 512 * 1024, WS_COSM = 2 * MiB, WS_SINM = 3 * MiB;
constexpr size_t WS_WIN = 4 * MiB, WS_WCOMB = 8 * MiB, WS_WOUT = 12 * MiB, WS_WUQ = 14 * MiB, WS_WUKV = 14 * MiB + 512 * 1024;
constexpr size_t WS_SSQQ = 15 * MiB, WS_SSQKV = 15 * MiB + 512 * 1024;
constexpr size_t WS_U8 = 16 * MiB, WS_V8 = 32 * MiB;
constexpr size_t WS_HN = 80 * MiB, WS_MIXED = 80 * MiB;
constexpr size_t WS_QA = 112 * MiB, WS_KA = 128 * MiB, WS_VA = 144 * MiB;
constexpr size_t WS_CQ = 160 * MiB, WS_CKV = 168 * MiB, WS_KR = 172 * MiB;
constexpr size_t WS_QM = 176 * MiB, WS_KN = 200 * MiB, WS_VM = 216 * MiB;
constexpr size_t WS_SSQH = 232 * MiB;
constexpr size_t WS_HB = 112 * MiB, WS_SC = 144 * MiB;
constexpr size_t WS_HB8 = 208 * MiB;
constexpr size_t WS_ZP = 48 * MiB, WS_PEROW = 80 * MiB, WS_PESLOT = 84 * MiB, WS_PG = 88 * MiB, WS_SSQY = 96 * MiB, WS_RSTDH = 97 * MiB, WS_PE2 = 176 * MiB, WS_PA2 = 180 * MiB;
constexpr size_t WS_OP = 144 * MiB;
constexpr float SU = 256.f, SX = 16.f, SV = 64.f;
constexpr size_t WS_END = 234 * MiB;
static_assert(WS_KA == WS_QA + 16 * MiB && WS_VA == WS_KA + 16 * MiB && WS_VM == WS_KN + 16 * MiB, "epilogues address Ka/Va and Vm relative to Qa and Kn");

__device__ __forceinline__ unsigned pk_bf16(float lo, float hi) { f32x2 v = {lo, hi}; bf16x2_t b = __builtin_convertvector(v, bf16x2_t); return __builtin_bit_cast(unsigned, b); }
__device__ __forceinline__ unsigned pk_f16(float lo, float hi) { f32x2 v = {lo, hi}; f16x2_t b = __builtin_convertvector(v, f16x2_t); return __builtin_bit_cast(unsigned, b); }
__device__ __forceinline__ unsigned pk_fp8x4(float a, float b, float c, float d) { int w = __builtin_amdgcn_cvt_pk_fp8_f32(a, b, 0, false); w = __builtin_amdgcn_cvt_pk_fp8_f32(c, d, w, true); return (unsigned)w; }
__device__ __forceinline__ float bf_lo(unsigned w) { return __builtin_bit_cast(float, w << 16); }
__device__ __forceinline__ float bf_hi(unsigned w) { return __builtin_bit_cast(float, w & 0xffff0000u); }
__device__ __forceinline__ float wave_sum(float v) {
#pragma unroll
    for (int o = 1; o < 64; o <<= 1) v += __shfl_xor(v, o);
    return v;
}
__device__ __forceinline__ int crow(int r, int hi) { return (r & 3) + 8 * (r >> 2) + 4 * hi; }
__device__ __forceinline__ void glds16(const void* gsrc, unsigned lds_dst) { unsigned keep;
    asm volatile("s_mov_b32 %0, m0\n\ts_mov_b32 m0, %2\n\ts_nop 0\n\tglobal_load_lds_dwordx4 %1, off\n\ts_mov_b32 m0, %0" : "=&s"(keep) : "v"(gsrc), "s"(lds_dst) : "memory"); }

#define STAGE 6


namespace pg8 {
#define PG8_LAS __attribute__((address_space(3)))
typedef unsigned short bf16_t;
typedef short bf16x8 __attribute__((ext_vector_type(8)));
typedef float f32x4 __attribute__((ext_vector_type(4)));
typedef unsigned u32x4 __attribute__((ext_vector_type(4)));
constexpr int BM = 256, BK = 64, HALF = 128, HTB = HALF * BK * 2  , STAGE_BYTES = 8 * HTB, NXCD = 8, WGM = 8;

__host__ __device__ __forceinline__ int lds_byte(int r, int c) { const int st = (r >> 4) * 2 + (c >> 5), rr = r & 15, cc = c & 31, ob = rr * 64 + cc * 2; return st * 1024 + (ob ^ (((ob >> 9) & 1) << 5)); }
__host__ __device__ __forceinline__ void stage_rc(int b, int& R, int& C) { const int st = b / 1024, sb = b % 1024, swz = sb ^ (((sb >> 9) & 1) << 5); R = (st >> 1) * 16 + swz / 64; C = (st & 1) * 32 + (swz % 64) / 2; }
__host__ __device__ __forceinline__ int perm32(int rho) { const int n = rho >> 4, i = rho & 15; return 8 * (i >> 2) + 4 * n + (i & 3); }

struct Unit { int pm, pn; };
struct Gemm { const bf16_t* A; const bf16_t* Bt; int M, N, K; };

struct StaticOrder {
    int nM, nN, nwg, G, c;
    __host__ __device__ void init(int M, int N, int G_, int c_) { nM = M / BM; nN = N / BM; nwg = nM * nN; G = G_; c = c_; }
    __host__ __device__ bool next(int i, Unit& u) const {
        const long L = (long)i * G + c; if (L >= nwg) return false;
        int wgid = (int)L; { const int q = nwg / NXCD, r = nwg % NXCD, xcd = wgid % NXCD, off = wgid / NXCD; wgid = (xcd < r ? xcd * (q + 1) : r * (q + 1) + (xcd - r) * q) + off; }
        const int nig = WGM * nN, gid = wgid / nig, fm = gid * WGM, gsz = (nM - fm) < WGM ? (nM - fm) : WGM;
        u.pm = fm + ((wgid % nig) % gsz); u.pn = (wgid % nig) / gsz; return true;
    }
    __device__ __forceinline__ void a_ready(const Unit&) const {}
    __device__ __forceinline__ void done(const Unit&) const {}
};


__device__ __forceinline__ unsigned cvt_pk_bf16(float lo, float hi) { unsigned r; asm volatile("v_cvt_pk_bf16_f32 %0, %1, %2" : "=v"(r) : "v"(lo), "v"(hi)); return r; }
typedef float f32x2 __attribute__((ext_vector_type(2)));

__device__ __forceinline__ void load8(const float* p, float (&o)[8]);

template <class Epi, class Sched, bool ALIGN_EPI = false, bool SP2 = false>
__device__ __forceinline__ void gemm_phase(PG8_LAS unsigned char* lds, const Gemm g, const Sched& S, const Epi& E) {
    const int tid = threadIdx.x, wid = __builtin_amdgcn_readfirstlane(tid >> 6), lane = tid & 63, wr = wid >> 2, wc = wid & 3, fr = lane & 15, fq = lane >> 4;
    const int K = g.K, nt = K / BK;
    unsigned voffA[2], voffB[2];
#pragma unroll
    for (int i = 0; i < 2; ++i) { int R, C; stage_rc(tid * 16 + i * 8192, R, C); const int Rb = Epi::PERM ? ((R & ~31) + perm32(R & 31)) : R;
        voffA[i] = (unsigned)(R * K + C) * 2u; voffB[i] = (unsigned)(Rb * K + C) * 2u; }
    const size_t kstep = (size_t)(BK * 2);
    const size_t hstep = (size_t)HALF * K * 2;
    const size_t tstep = 2 * hstep;
    const unsigned ldsw = (unsigned)wid * 1024u;
    const int aoff = lds_byte(wr * 64 + fr, fq * 8), boff = lds_byte(wc * 32 + fr, fq * 8);
#define PG8_SA(b, h) (((b) * 2 + (h)) * HTB)
#define PG8_SB(b, h) ((4 + (b) * 2 + (h)) * HTB)
#define PG8_STAGE(bufoff, gbase, voff) do { _Pragma("unroll") for (int _i = 0; _i < 2; ++_i) \
        __builtin_amdgcn_global_load_lds((const unsigned*)((const char*)(gbase) + (voff)[_i]), (PG8_LAS unsigned*)(lds + (bufoff) + ldsw + _i * 8192), 16, 0, 0); } while (0)
#define PG8_LDA(dst, b, h) do { _Pragma("unroll") for (int m = 0; m < 4; ++m) _Pragma("unroll") for (int k = 0; k < 2; ++k) dst[m][k] = *(const PG8_LAS bf16x8*)(lds + PG8_SA(b, h) + aoff + m * 2048 + k * 1024); } while (0)
#define PG8_LDB(dst, b, h) do { _Pragma("unroll") for (int n = 0; n < 2; ++n) _Pragma("unroll") for (int k = 0; k < 2; ++k) dst[n][k] = *(const PG8_LAS bf16x8*)(lds + PG8_SB(b, h) + boff + n * 2048 + k * 1024); } while (0)
#define PG8_MMA(ai, bj, At, Bt) do { __builtin_amdgcn_s_setprio(1); _Pragma("unroll") for (int m = 0; m < 4; ++m) _Pragma("unroll") for (int n = 0; n < 2; ++n) _Pragma("unroll") for (int k = 0; k < 2; ++k) \
        acc[ai][bj][m][n] = __builtin_amdgcn_mfma_f32_16x16x32_bf16(Bt[n][k], At[m][k], acc[ai][bj][m][n], 0, 0, 0); __builtin_amdgcn_s_setprio(0); } while (0)
#define PG8_WAIT_V(n) asm volatile("s_waitcnt vmcnt(" #n ")" ::: "memory")
#define PG8_WAIT_L(n) asm volatile("s_waitcnt lgkmcnt(" #n ")" ::: "memory")
#define PG8_BAR __builtin_amdgcn_s_barrier()
#define PG8_SCHED __builtin_amdgcn_sched_barrier(0)
    Unit cur, nxt; int ui = 0;
    if (!S.next(0, cur)) return;
    f32x4 acc[2][2][4][2];
#pragma unroll
    for (int a = 0; a < 2; ++a)
#pragma unroll
        for (int b = 0; b < 2; ++b)
#pragma unroll
            for (int m = 0; m < 4; ++m)
#pragma unroll
                for (int n = 0; n < 2; ++n) acc[a][b][m][n] = (f32x4){0.f, 0.f, 0.f, 0.f};
    bf16x8 At[4][2], B0[2][2], B1[2][2];
    const char* cA = (const char*)g.A + (size_t)cur.pm * tstep; const char* cB = (const char*)g.Bt + (size_t)cur.pn * tstep;
    S.a_ready(cur);
    if constexpr (SP2) {
        PG8_STAGE(PG8_SB(0, 0), cB, voffB); PG8_STAGE(PG8_SB(0, 1), cB + hstep, voffB); PG8_STAGE(PG8_SA(0, 0), cA, voffA); PG8_STAGE(PG8_SA(0, 1), cA + hstep, voffA);
        if (wr == 1) PG8_BAR;
        PG8_WAIT_V(2); PG8_BAR;
        PG8_STAGE(PG8_SB(1, 0), cB + kstep, voffB); PG8_STAGE(PG8_SA(1, 0), cA + kstep, voffA); PG8_STAGE(PG8_SB(1, 1), cB + hstep + kstep, voffB);
        PG8_WAIT_V(6); PG8_BAR;
    } else {
        PG8_STAGE(PG8_SB(0, 0), cB, voffB); PG8_STAGE(PG8_SA(0, 0), cA, voffA); PG8_STAGE(PG8_SB(0, 1), cB + hstep, voffB); PG8_STAGE(PG8_SA(0, 1), cA + hstep, voffA);
        if (wr == 1) PG8_BAR;
        PG8_WAIT_V(4); PG8_BAR;
        PG8_STAGE(PG8_SB(1, 0), cB + kstep, voffB); PG8_STAGE(PG8_SA(1, 0), cA + kstep, voffA); PG8_STAGE(PG8_SB(1, 1), cB + hstep + kstep, voffB);
        PG8_WAIT_V(6); PG8_BAR;
    }
    for (;;) {
        const bool has_next = S.next(ui + 1, nxt);
        const char* nA = has_next ? (const char*)g.A + (size_t)nxt.pm * tstep : cA; const char* nB = has_next ? (const char*)g.Bt + (size_t)nxt.pn * tstep : cB;
        for (int t = 0; t < nt; t += 2) {
            const bool last = (t == nt - 2);
            const char* a1 = cA + (size_t)(t + 1) * kstep;
            const char* a2 = last ? nA : cA + (size_t)(t + 2) * kstep; const char* b2 = last ? nB : cB + (size_t)(t + 2) * kstep;
            const char* a3 = a2 + kstep; const char* b3 = b2 + kstep;
            if (last && has_next) S.a_ready(nxt);
            if constexpr (SP2) {
            PG8_LDB(B0, 0, 0); PG8_LDB(B1, 0, 1); PG8_SCHED; PG8_LDA(At, 0, 0); PG8_STAGE(PG8_SA(1, 1), a1 + hstep, voffA);
            PG8_WAIT_V(8); PG8_WAIT_L(0); PG8_BAR; PG8_MMA(0, 0, At, B0); PG8_MMA(0, 1, At, B1); PG8_BAR; PG8_SCHED;
            PG8_LDA(At, 0, 1); PG8_STAGE(PG8_SB(0, 0), b2, voffB); PG8_STAGE(PG8_SB(0, 1), b2 + hstep, voffB); PG8_STAGE(PG8_SA(0, 0), a2, voffA);
            PG8_WAIT_V(8); PG8_WAIT_L(0); PG8_BAR; PG8_MMA(1, 0, At, B0); PG8_MMA(1, 1, At, B1); PG8_BAR; PG8_SCHED;
            PG8_LDB(B0, 1, 0); PG8_LDB(B1, 1, 1); PG8_SCHED; PG8_LDA(At, 1, 0); PG8_STAGE(PG8_SA(0, 1), a2 + hstep, voffA);
            PG8_WAIT_V(8); PG8_WAIT_L(0); PG8_BAR; PG8_MMA(0, 0, At, B0); PG8_MMA(0, 1, At, B1); PG8_BAR; PG8_SCHED;
            PG8_LDA(At, 1, 1); PG8_STAGE(PG8_SB(1, 0), b3, voffB); PG8_STAGE(PG8_SB(1, 1), b3 + hstep, voffB); PG8_STAGE(PG8_SA(1, 0), a3, voffA);
            PG8_WAIT_V(8); PG8_WAIT_L(0); PG8_BAR; PG8_MMA(1, 0, At, B0); PG8_MMA(1, 1, At, B1); PG8_BAR; PG8_SCHED;
            } else {
            PG8_LDB(B0, 0, 0); PG8_SCHED; PG8_LDA(At, 0, 0); PG8_STAGE(PG8_SA(1, 1), a1 + hstep, voffA);
            PG8_WAIT_L(8); PG8_BAR; PG8_WAIT_L(0); PG8_MMA(0, 0, At, B0); PG8_BAR; PG8_SCHED;
            PG8_LDB(B1, 0, 1); PG8_STAGE(PG8_SB(0, 0), b2, voffB);
            PG8_BAR; PG8_WAIT_L(0); PG8_MMA(0, 1, At, B1); PG8_BAR;
            PG8_LDA(At, 0, 1); PG8_STAGE(PG8_SA(0, 0), a2, voffA);
            PG8_BAR; PG8_WAIT_L(0); PG8_MMA(1, 0, At, B0); PG8_BAR; PG8_SCHED;
            PG8_STAGE(PG8_SB(0, 1), b2 + hstep, voffB);
            PG8_WAIT_V(6); PG8_BAR; PG8_MMA(1, 1, At, B1); PG8_BAR;
            PG8_LDB(B0, 1, 0); PG8_SCHED; PG8_LDA(At, 1, 0); PG8_STAGE(PG8_SA(0, 1), a2 + hstep, voffA);
            PG8_WAIT_L(8); PG8_BAR; PG8_WAIT_L(0); PG8_MMA(0, 0, At, B0); PG8_BAR; PG8_SCHED;
            PG8_LDB(B1, 1, 1); PG8_STAGE(PG8_SB(1, 0), b3, voffB);
            PG8_BAR; PG8_WAIT_L(0); PG8_MMA(0, 1, At, B1); PG8_BAR;
            PG8_LDA(At, 1, 1); PG8_STAGE(PG8_SA(1, 0), a3, voffA);
            PG8_BAR; PG8_WAIT_L(0); PG8_MMA(1, 0, At, B0); PG8_BAR; PG8_SCHED;
            PG8_STAGE(PG8_SB(1, 1), b3 + hstep, voffB);
            PG8_WAIT_V(6); PG8_BAR; PG8_MMA(1, 1, At, B1); PG8_BAR;
            }
        }
        if constexpr (ALIGN_EPI) { if (wr == 0) PG8_BAR; }
        if constexpr (!Epi::AFTER_DRAIN) { E(acc, cur, wr, wc, fr, fq); S.done(cur); }
        if (!has_next) break;
#pragma unroll
        for (int a = 0; a < 2; ++a)
#pragma unroll
            for (int b = 0; b < 2; ++b)
#pragma unroll
                for (int m = 0; m < 4; ++m)
#pragma unroll
                    for (int n = 0; n < 2; ++n) acc[a][b][m][n] = (f32x4){0.f, 0.f, 0.f, 0.f};
        cur = nxt; cA = nA; cB = nB; ++ui;
        if constexpr (ALIGN_EPI) { if (wr == 1) PG8_BAR; }
    }
    PG8_WAIT_V(0);
    if constexpr (!ALIGN_EPI) { if (wr == 0) PG8_BAR; }
    PG8_BAR;
    if constexpr (Epi::AFTER_DRAIN) { E.fused(acc, cur, wr, wc, fr, fq, lds, wid, lane); S.done(cur); }
#undef PG8_SA
#undef PG8_SB
#undef PG8_STAGE
#undef PG8_LDA
#undef PG8_LDB
#undef PG8_MMA
#undef PG8_WAIT_V
#undef PG8_WAIT_L
#undef PG8_BAR
#undef PG8_SCHED
}
}

namespace pg8 {
#define EPI_V8(ai, bj, m) { acc[ai][bj][m][0][0], acc[ai][bj][m][0][1], acc[ai][bj][m][0][2], acc[ai][bj][m][0][3], acc[ai][bj][m][1][0], acc[ai][bj][m][1][1], acc[ai][bj][m][1][2], acc[ai][bj][m][1][3] }
__device__ __forceinline__ u32x4 pack8(const float (&v)[8], float s) { u32x4 w; w.x = pk_bf16(v[0] * s, v[1] * s); w.y = pk_bf16(v[2] * s, v[3] * s); w.z = pk_bf16(v[4] * s, v[5] * s); w.w = pk_bf16(v[6] * s, v[7] * s); return w; }
__device__ __forceinline__ float ssq8(const float (&v)[8]) { return ((v[0] * v[0] + v[1] * v[1]) + (v[2] * v[2] + v[3] * v[3])) + ((v[4] * v[4] + v[5] * v[5]) + (v[6] * v[6] + v[7] * v[7])); }
__device__ __forceinline__ void load8(const float* p, float (&o)[8]) { const f32x4 a = *(const f32x4*)p, b = *(const f32x4*)(p + 4); o[0] = a.x; o[1] = a.y; o[2] = a.z; o[3] = a.w; o[4] = b.x; o[5] = b.y; o[6] = b.z; o[7] = b.w; }

struct EpiProj {
    static constexpr bool PERM = true, AFTER_DRAIN = false;
    bf16_t *Qa, *Ka, *Va, *Cq, *Ckv, *Kr; float *ssq_q, *ssq_kv; const float *cosA, *sinA, *cosM, *sinM;
    __device__ __forceinline__ void operator()(const f32x4 (&acc)[2][2][4][2], const Unit& u, int wr, int wc, int fr, int fq) const {
        const int pn = u.pn, rowb = u.pm * BM + wr * 64 + fr;
        if (pn < 6) {
            const int kind = pn >> 1;
            bf16_t* dst = Qa + (size_t)kind * (size_t)(8u << 20);
            const float sc = kind == 0 ? QA_SCALE : 1.f;
            const bool ropew = (kind < 2) && ((wc & 1) == 0);
            float cq[2][8], sq[2][8];
            if (ropew) {
#pragma unroll
                for (int g = 0; g < 2; ++g) { const size_t r_ = (size_t)(rowb + g * 16) * 8; load8(cosA + r_, cq[g]); load8(sinA + r_, sq[g]); }
            }
#pragma unroll
            for (int ai = 0; ai < 2; ++ai)
#pragma unroll
                for (int m = 0; m < 4; ++m) {
                    const int row = rowb + ai * HALF + m * 16;
                    float cs[8], sn[8];
                    if (ropew) {
#pragma unroll
                        for (int i = 0; i < 8; ++i) { cs[i] = cq[m & 1][i]; sn[i] = sq[m & 1][i]; }
                        if (ai * 4 + m + 2 < 8) { const int g2 = ai * 4 + m + 2; const size_t r_ = (size_t)(rowb + (g2 >> 2) * HALF + (g2 & 3) * 16) * 8; load8(cosA + r_, cq[m & 1]); load8(sinA + r_, sq[m & 1]); }
                    }
#pragma unroll
                    for (int bj = 0; bj < 2; ++bj) {
                        float v[8] = EPI_V8(ai, bj, m);
                        if (ropew) {
#pragma unroll
                            for (int i = 0; i < 8; ++i) { const float pv = __shfl_xor(v[i], 16); if (fq == 0) v[i] = v[i] * cs[i] - pv * sn[i]; else if (fq == 1) v[i] = v[i] * cs[i] + pv * sn[i]; }
                        }
                        *(u32x4*)(dst + ((size_t)((row >> 13) * 8 + (pn & 1) * 4 + bj * 2 + (wc >> 1)) * SEQ + (row & (SEQ - 1))) * 64 + (wc & 1) * 32 + fq * 8) = pack8(v, sc);
                    }
                }
        } else if (pn == 6) {
#pragma unroll
            for (int ai = 0; ai < 2; ++ai)
#pragma unroll
                for (int m = 0; m < 4; ++m) {
                    const int row = rowb + ai * HALF + m * 16;
#pragma unroll
                    for (int bj = 0; bj < 2; ++bj) {
                        float v[8] = EPI_V8(ai, bj, m);
                        float s = ssq8(v); s += __shfl_xor(s, 16); s += __shfl_xor(s, 32);
                        if (fq == 0) ssq_q[(size_t)row * 8 + bj * 4 + wc] = s;
                        *(u32x4*)(Cq + (size_t)row * 256 + bj * HALF + wc * 32 + fq * 8) = pack8(v, 1.f);
                    }
                }
        } else {
#pragma unroll
            for (int ai = 0; ai < 2; ++ai)
#pragma unroll
                for (int m = 0; m < 4; ++m) {
                    const int row = rowb + ai * HALF + m * 16;
                    {
                        float v[8] = EPI_V8(ai, 0, m);
                        float s = ssq8(v); s += __shfl_xor(s, 16); s += __shfl_xor(s, 32);
                        if (fq == 0) ssq_kv[(size_t)row * 4 + wc] = s;
                        *(u32x4*)(Ckv + (size_t)row * 128 + wc * 32 + fq * 8) = pack8(v, 1.f);
                    }
                    if (wc == 0) {
                        float v[8] = EPI_V8(ai, 1, m);
                        float cs[8], sn[8];
                        load8(cosM + (size_t)row * 16 + 8 * (fq & 1), cs); load8(sinM + (size_t)row * 16 + 8 * (fq & 1), sn);
#pragma unroll
                        for (int i = 0; i < 8; ++i) { const float pv = __shfl_xor(v[i], 32); v[i] = (fq < 2) ? (v[i] * cs[i] - pv * sn[i]) : (v[i] * cs[i] + pv * sn[i]); }
                        *(u32x4*)(Kr + (size_t)row * 32 + fq * 8) = pack8(v, 1.f);
                    }
                }
        }
    }
};

struct EpiQm {
    static constexpr bool PERM = true, AFTER_DRAIN = false;
    bf16_t* Qm; const float* ssq_q; const float *cosM, *sinM;
    __device__ __forceinline__ void operator()(const f32x4 (&acc)[2][2][4][2], const Unit& u, int wr, int wc, int fr, int fq) const {
        const int pn = u.pn, rowb = u.pm * BM + wr * 64 + fr;
        f32x2 qa[8];
#pragma unroll
        for (int g = 0; g < 8; ++g) qa[g] = *(const f32x2*)(ssq_q + (size_t)(rowb + (g >> 2) * HALF + (g & 3) * 16) * 8 + 2 * fq);
        float cq[2][8], sq[2][8];
#pragma unroll
        for (int g = 0; g < 2; ++g) { const size_t r_ = (size_t)(rowb + g * 16) * 16 + 8 * (fq & 1); load8(cosM + r_, cq[g]); load8(sinM + r_, sq[g]); }
#pragma unroll
        for (int ai = 0; ai < 2; ++ai)
#pragma unroll
            for (int m = 0; m < 4; ++m) {
                const int row = rowb + ai * HALF + m * 16, g = ai * 4 + m;
                float ssum = qa[g].x + qa[g].y; ssum += __shfl_xor(ssum, 16); ssum += __shfl_xor(ssum, 32);
                const float rs = 1.0f / sqrtf(ssum * (1.f / 256.f) + EPS);
                float cs[8], sn[8];
#pragma unroll
                for (int i = 0; i < 8; ++i) { cs[i] = cq[m & 1][i]; sn[i] = sq[m & 1][i]; }
                if (g + 2 < 8) { const int g2 = g + 2; const size_t r_ = (size_t)(rowb + (g2 >> 2) * HALF + (g2 & 3) * 16) * 16 + 8 * (fq & 1); load8(cosM + r_, cq[m & 1]); load8(sinM + r_, sq[m & 1]); }
#pragma unroll
                for (int bj = 0; bj < 2; ++bj) {
                    const int g32 = pn * 8 + bj * 4 + wc;
                    const bool ropew = (g32 % 3) == 2;
                    float v[8] = EPI_V8(ai, bj, m);
#pragma unroll
                    for (int i = 0; i < 8; ++i) v[i] *= rs;
                    if (ropew) {
#pragma unroll
                        for (int i = 0; i < 8; ++i) { const float pv = __shfl_xor(v[i], 32); v[i] = (fq < 2) ? (v[i] * cs[i] - pv * sn[i]) : (v[i] * cs[i] + pv * sn[i]); }
                    }
                    *(u32x4*)(Qm + (size_t)row * 768 + pn * BM + bj * HALF + wc * 32 + fq * 8) = pack8(v, QM_SCALE);
                }
                asm volatile("" ::: "memory");
            }
    }
};

struct EpiKv {
    static constexpr bool PERM = true, AFTER_DRAIN = false;
    bf16_t *Kn, *Vm; const float* ssq_kv;
    __device__ __forceinline__ void operator()(const f32x4 (&acc)[2][2][4][2], const Unit& u, int wr, int wc, int fr, int fq) const {
        const int pn = u.pn, rowb = u.pm * BM + wr * 64 + fr;
        bf16_t* dst = Kn + (size_t)(wc >> 1) * (size_t)(8u << 20);
        const int within = (wc & 1) * 32 + fq * 8;
        f32x4 q4a[8];
#pragma unroll
        for (int g = 0; g < 8; ++g) q4a[g] = *(const f32x4*)(ssq_kv + (size_t)(rowb + (g >> 2) * HALF + (g & 3) * 16) * 4);
#pragma unroll
        for (int ai = 0; ai < 2; ++ai)
#pragma unroll
            for (int m = 0; m < 4; ++m) {
                const int row = rowb + ai * HALF + m * 16;
                const f32x4 q4 = q4a[ai * 4 + m];
                const float rs = 1.0f / sqrtf(((q4.x + q4.y) + (q4.z + q4.w)) * (1.f / 128.f) + EPS);
#pragma unroll
                for (int bj = 0; bj < 2; ++bj) {
                    float v[8] = EPI_V8(ai, bj, m);
                    *(u32x4*)(dst + ((size_t)((row >> 13) * 8 + pn * 2 + bj) * SEQ + (row & (SEQ - 1))) * 64 + within) = pack8(v, rs);
                }
            }
    }
};

struct EpiOut {
    static constexpr bool PERM = true, AFTER_DRAIN = false;
    const float* x; bf16_t* Hb; unsigned char* Hb8; float* ssq_h;
    __device__ __forceinline__ void operator()(const f32x4 (&acc)[2][2][4][2], const Unit& u, int wr, int wc, int fr, int fq) const {
        const int pn = u.pn, rowb = u.pm * BM + wr * 64 + fr;
        float xq[8][8];
#define XPIECE(t_) (x + (size_t)(rowb + ((t_) >> 3) * HALF + (((t_) >> 1) & 3) * 16) * DM + pn * BM + ((t_) & 1) * HALF + wc * 32 + fq * 8)
#pragma unroll
        for (int t = 0; t < 8; ++t) load8(XPIECE(t), xq[t]);
#pragma unroll
        for (int ai = 0; ai < 2; ++ai)
#pragma unroll
            for (int m = 0; m < 4; ++m) {
                const int row = rowb + ai * HALF + m * 16;
#pragma unroll
                for (int bj = 0; bj < 2; ++bj) {
                    const int col = pn * BM + bj * HALF + wc * 32 + fq * 8, t = (ai * 4 + m) * 2 + bj;
                    float v[8] = EPI_V8(ai, bj, m);
#pragma unroll
                    for (int i = 0; i < 8; ++i) v[i] += xq[t & 7][i];
                    if (t + 8 < 16) load8(XPIECE(t + 8), xq[t & 7]);
                    float s = ssq8(v); s += __shfl_xor(s, 16); s += __shfl_xor(s, 32);
                    if (fq == 0) ssq_h[(size_t)row * 32 + pn * 8 + bj * 4 + wc] = s;
                    *(u32x4*)(Hb + (size_t)row * DM + col) = pack8(v, 1.f);
                    { u32x2 w8; w8.x = pk_fp8x4(v[0] * SX, v[1] * SX, v[2] * SX, v[3] * SX); w8.y = pk_fp8x4(v[4] * SX, v[5] * SX, v[6] * SX, v[7] * SX); *(u32x2*)(Hb8 + (size_t)(col >> 7) * ((size_t)T * 128) + (size_t)row * 128 + (col & 127)) = w8; }
                }
            }
#undef XPIECE
    }
};

struct EpiSc {
    static constexpr bool PERM = true, AFTER_DRAIN = false;
    bf16_t* Sc; const float* ssq_h;
    __device__ __forceinline__ void operator()(const f32x4 (&acc)[2][2][4][2], const Unit& u, int wr, int wc, int fr, int fq) const {
        const int pn = u.pn, rowb = u.pm * BM + wr * 64 + fr;
        f32x4 q[8][2];
#pragma unroll
        for (int g = 0; g < 8; ++g) { const float* qp = ssq_h + (size_t)(rowb + (g >> 2) * HALF + (g & 3) * 16) * 32 + 8 * fq; q[g][0] = *(const f32x4*)qp; q[g][1] = *(const f32x4*)(qp + 4); }
#pragma unroll
        for (int ai = 0; ai < 2; ++ai)
#pragma unroll
            for (int m = 0; m < 4; ++m) {
                const int row = rowb + ai * HALF + m * 16, g = ai * 4 + m;
                float s = ((q[g][0].x + q[g][0].y) + (q[g][0].z + q[g][0].w)) + ((q[g][1].x + q[g][1].y) + (q[g][1].z + q[g][1].w));
                s += __shfl_xor(s, 16); s += __shfl_xor(s, 32);
                const float rs = 1.0f / sqrtf(s * (1.f / 1024.f) + EPS);
#pragma unroll
                for (int bj = 0; bj < 2; ++bj) {
                    float v[8] = EPI_V8(ai, bj, m);
                    u32x4 w; w.x = pk_f16(v[0] * rs, v[1] * rs); w.y = pk_f16(v[2] * rs, v[3] * rs); w.z = pk_f16(v[4] * rs, v[5] * rs); w.w = pk_f16(v[6] * rs, v[7] * rs);
                    *(u32x4*)(Sc + (size_t)row * 2048 + pn * BM + bj * HALF + wc * 32 + fq * 8) = w;
                }
            }
    }
};
#undef EPI_V8
}

namespace att {
constexpr float NEGM = -1.0e30f;
__device__ __forceinline__ s16x4 vtr(const LAS unsigned char* p) { typedef short v4i16_t __attribute__((ext_vector_type(4))); return __builtin_bit_cast(s16x4, __builtin_amdgcn_ds_read_tr16_b64_v4i16((LAS v4i16_t*)p)); }
__device__ __forceinline__ void swap32(unsigned& a, unsigned& b) { asm volatile("s_nop 1\n\tv_permlane32_swap_b32 %0, %1" : "+v"(a), "+v"(b)); }
__device__ __forceinline__ float swapmax(float v) { unsigned a = __builtin_bit_cast(unsigned, v), b = a; swap32(a, b); return fmaxf(__builtin_bit_cast(float, a), __builtin_bit_cast(float, b)); }
__device__ __forceinline__ float swapsum(float v) { unsigned a = __builtin_bit_cast(unsigned, v), b = a; swap32(a, b); return __builtin_bit_cast(float, a) + __builtin_bit_cast(float, b); }
__device__ __forceinline__ float max3f(float a, float b, float c) { return __builtin_fmaxf(__builtin_fmaxf(a, b), c); }
constexpr float THR = 8.0f;
__device__ __forceinline__ bf16x8 pack_p(const f32x16& p, int s) {
    u32x4 w; w.x = pk_bf16(p[8 * s + 0], p[8 * s + 1]); w.y = pk_bf16(p[8 * s + 2], p[8 * s + 3]); w.z = pk_bf16(p[8 * s + 4], p[8 * s + 5]); w.w = pk_bf16(p[8 * s + 6], p[8 * s + 7]);
    return __builtin_bit_cast(bf16x8, w);
}
__device__ __forceinline__ void pv_block(f32x16& o, const LAS unsigned char* vbase, const bf16x8& pb0, const bf16x8& pb1) {
    const s16x4 l0 = vtr(vbase), h0 = vtr(vbase + 8 * 64), l1 = vtr(vbase + 16 * 64), h1 = vtr(vbase + 24 * 64);
    const bf16x8 a0 = {l0[0], l0[1], l0[2], l0[3], h0[0], h0[1], h0[2], h0[3]}, a1 = {l1[0], l1[1], l1[2], l1[3], h1[0], h1[1], h1[2], h1[3]};
    o = __builtin_amdgcn_mfma_f32_32x32x16_bf16(a0, pb0, o, 0, 0, 0);
    o = __builtin_amdgcn_mfma_f32_32x32x16_bf16(a1, pb1, o, 0, 0, 0);
}
__device__ __forceinline__ void store_o(bf16_t* orow, const f32x16& o0, const f32x16& o1, float inv, int hi) {
#pragma unroll
    for (int g = 0; g < 4; ++g) {
        u32x2 a, b; a.x = pk_bf16(o0[4 * g] * inv, o0[4 * g + 1] * inv); a.y = pk_bf16(o0[4 * g + 2] * inv, o0[4 * g + 3] * inv);
        b.x = pk_bf16(o1[4 * g] * inv, o1[4 * g + 1] * inv); b.y = pk_bf16(o1[4 * g + 2] * inv, o1[4 * g + 3] * inv);
        *(u32x2*)(orow + 8 * g + 4 * hi) = a; *(u32x2*)(orow + 32 + 8 * g + 4 * hi) = b;
    }
}

constexpr int KROW = 208;
constexpr int TK = 128, KBYTES = TK * KROW, VBYTES = 2 * TK * 64, BUFB = KBYTES + VBYTES;
constexpr int MLA_LDS = 2 * BUFB;
__device__ __forceinline__ float rowmax64(const f32x16& s0, const f32x16& s1) {
    float mx = max3f(s0[0], s1[0], s0[1]);
#pragma unroll
    for (int r = 1; r < 15; r += 2) { mx = max3f(mx, s1[r], s0[r + 1]); mx = max3f(mx, s1[r + 1], s0[r + 2 < 16 ? r + 2 : 15]); }
    mx = max3f(mx, s1[15], s0[15]);
    return swapmax(mx);
}
__device__ __forceinline__ void scale16(f32x16& t, float a) {
    const f32x2 a2 = {a, a};
#pragma unroll
    for (int i = 0; i < 8; ++i) { f32x2 p = {t[2 * i], t[2 * i + 1]}; asm volatile("v_pk_mul_f32 %0, %0, %1" : "+v"(p) : "v"(a2)); t[2 * i] = p.x; t[2 * i + 1] = p.y; }
}
__device__ __forceinline__ void sub16(f32x16& t, float d) {
    const f32x2 d2 = {d, d};
#pragma unroll
    for (int i = 0; i < 8; ++i) { f32x2 p = {t[2 * i], t[2 * i + 1]}; asm volatile("v_pk_add_f32 %0, %0, %1 neg_lo:[0,1] neg_hi:[0,1]" : "+v"(p) : "v"(d2)); t[2 * i] = p.x; t[2 * i + 1] = p.y; }
}
__device__ __forceinline__ void rescale64(float mx, f32x16& s0, f32x16& s1, float& m, float& l, f32x16& o0, f32x16& o1) {
    if (__builtin_expect(__builtin_amdgcn_ballot_w64(mx > THR) != 0ull, 0)) {
        const float dl = fmaxf(mx, 0.f), alpha = __builtin_amdgcn_exp2f(-dl);
        m += dl; l *= alpha;
        sub16(s0, dl); sub16(s1, dl); scale16(o0, alpha); scale16(o1, alpha);
    }
}
__device__ __forceinline__ void exp64(f32x16& s0, f32x16& s1, float& l) {
    float rs = 0.f;
#pragma unroll
    for (int r = 0; r < 16; ++r) { s0[r] = __builtin_amdgcn_exp2f(s0[r]); s1[r] = __builtin_amdgcn_exp2f(s1[r]); rs += s0[r] + s1[r]; }
    l += rs;
}
__device__ __forceinline__ void sm64(f32x16& s0, f32x16& s1, float& m, float& l, f32x16& o0, f32x16& o1, f32x16& t0, f32x16& t1, bool adj_other) {
    float mx = max3f(s0[0], s1[0], s0[1]);
#pragma unroll
    for (int r = 1; r < 15; r += 2) { mx = max3f(mx, s1[r], s0[r + 1]); mx = max3f(mx, s1[r + 1], s0[r + 2 < 16 ? r + 2 : 15]); }
    mx = max3f(mx, s1[15], s0[15]);
    mx = swapmax(mx);
    if (__builtin_expect(__builtin_amdgcn_ballot_w64(mx > THR) != 0ull, 0)) {
        const float dl = fmaxf(mx, 0.f), alpha = __builtin_amdgcn_exp2f(-dl);
        m += dl; l *= alpha;
#pragma unroll
        for (int r = 0; r < 16; ++r) { s0[r] -= dl; s1[r] -= dl; o0[r] *= alpha; o1[r] *= alpha; }
        if (adj_other) {
#pragma unroll
            for (int r = 0; r < 16; ++r) { t0[r] -= dl; t1[r] -= dl; }
        }
    }
    float rs = 0.f;
#pragma unroll
    for (int r = 0; r < 16; ++r) { s0[r] = __builtin_amdgcn_exp2f(s0[r]); s1[r] = __builtin_amdgcn_exp2f(s1[r]); rs += s0[r] + s1[r]; }
    l += rs;
}
constexpr int MLA_G_OFF = 2 * (TK * 208 + 2 * TK * 64), MLA_PIECE_OFF = MLA_G_OFF + 4096;
__device__ __forceinline__ void mla_unit(LAS unsigned char* lds, const bf16_t* __restrict__ Qm, const bf16_t* __restrict__ Kn, const bf16_t* __restrict__ Kr, const bf16_t* __restrict__ Vm,
                                         bf16_t* __restrict__ Mixed, int b, int h, int qb,
                                         const float* __restrict__ u_emb, const float* __restrict__ v_emb, const float* __restrict__ g_ffn, unsigned char* __restrict__ U8, unsigned char* __restrict__ V8, int slot0) {
    const int tid = threadIdx.x, lane = tid & 63, wid = __builtin_amdgcn_readfirstlane(tid >> 6), r32 = lane & 31, hi = lane >> 5;
    const size_t tok0 = (size_t)b * SEQ;
    const int qpos = 256 * qb + 32 * wid + r32;
    bf16x8 qf[6];
    { const bf16_t* qrow = Qm + (tok0 + qpos) * 768 + h * 96 + 8 * hi;
#pragma unroll
      for (int ds = 0; ds < 6; ++ds) qf[ds] = *(const bf16x8*)(qrow + 16 * ds); }
    float m = 0.f, l = 0.f; f32x16 o0 = {}, o1 = {};
    const int nt = 2 * (qb + 1);
    const int wq0 = 256 * qb + 32 * wid, wqlast = wq0 + 31;
    const int srow = tid >> 3, sch = tid & 7, rrow = tid >> 2, rch = tid & 3;
    const bf16_t* gkn = Kn + ((size_t)(b * 8 + h) * SEQ + srow) * 64 + sch * 8;
    const bf16_t* gv = Vm + ((size_t)(b * 8 + h) * SEQ + srow) * 64 + sch * 8;
    const bf16_t* gkr = Kr + (tok0 + rrow) * 32 + rch * 8;
    const int wkn = srow * KROW + sch * 16, wkr = rrow * KROW + 128 + rch * 16, wv = KBYTES + (sch >> 2) * (TK * 64) + srow * 64 + (sch & 3) * 16;
    const int kfrag = r32 * KROW + hi * 16;
    const int i16 = lane & 15, vfrag = KBYTES + (4 * hi + (i16 >> 2)) * 64 + (16 * ((lane >> 4) & 1) + 4 * (i16 & 3)) * 2;
    u32x4 rk0, rk1, rv0, rv1, rr;
#define MLA_LOAD(t) do { const size_t adv_ = (size_t)(t) * TK; rk0 = *(const u32x4*)(gkn + adv_ * 64); rk1 = *(const u32x4*)(gkn + (adv_ + 64) * 64); \
        rv0 = *(const u32x4*)(gv + adv_ * 64); rv1 = *(const u32x4*)(gv + (adv_ + 64) * 64); rr = *(const u32x4*)(gkr + adv_ * 32); } while (0)
#define MLA_STORE(bp) do { LAS unsigned char* b_ = (bp); *(LAS u32x4*)(b_ + wkn) = rk0; *(LAS u32x4*)(b_ + wkn + 64 * KROW) = rk1; *(LAS u32x4*)(b_ + wv) = rv0; *(LAS u32x4*)(b_ + wv + 64 * 64) = rv1; *(LAS u32x4*)(b_ + wkr) = rr; } while (0)
    if (wid >= 4) __builtin_amdgcn_s_setprio(1);
    MLA_LOAD(0); MLA_STORE(lds);
    for (int u = tid; u < DM / 4; u += 512) *(LAS f32x4*)(lds + MLA_G_OFF + 16 * u) = *(const f32x4*)(g_ffn + 4 * u);
    LAS unsigned char* piece = lds + MLA_PIECE_OFF + wid * 1024;
    const unsigned piece_u = (unsigned)__builtin_amdgcn_readfirstlane((int)(unsigned)(uintptr_t)piece);
    __syncthreads();
    const int nfull = (wq0 + 1) >> 7;
    int kt = 0;
    for (; kt < nfull; ++kt) {
        const LAS unsigned char* buf = lds + (kt & 1) * BUFB;
        if (kt + 1 < nt) MLA_LOAD(kt + 1);
        const int pid = slot0 + 8 * kt + wid;
        if (pid < 131072) glds16(((pid >> 16) ? v_emb : u_emb) + (size_t)(pid & 65535) * 256 + 4 * lane, piece_u);
        {
            f32x16 a0, a1, b0, b1;
            {
                const bf16x8 k0 = *(const LAS bf16x8*)(buf + kfrag), k1 = *(const LAS bf16x8*)(buf + kfrag + 32 * KROW);
                if (__builtin_amdgcn_ballot_w64(m != 0.f) == 0ull) {
                    const f32x16 z = {};
                    a0 = __builtin_amdgcn_mfma_f32_32x32x16_bf16(k0, qf[0], z, 0, 0, 0);
                    a1 = __builtin_amdgcn_mfma_f32_32x32x16_bf16(k1, qf[0], z, 0, 0, 0);
                } else {
                    const float nm = -m; const f32x16 nv = {nm, nm, nm, nm, nm, nm, nm, nm, nm, nm, nm, nm, nm, nm, nm, nm};
                    a0 = __builtin_amdgcn_mfma_f32_32x32x16_bf16(k0, qf[0], nv, 0, 0, 0);
                    a1 = __builtin_amdgcn_mfma_f32_32x32x16_bf16(k1, qf[0], nv, 0, 0, 0);
                }
            }
#pragma unroll
            for (int ds = 1; ds < 6; ++ds) {
                const bf16x8 k0 = *(const LAS bf16x8*)(buf + kfrag + ds * 32), k1 = *(const LAS bf16x8*)(buf + kfrag + 32 * KROW + ds * 32);
                a0 = __builtin_amdgcn_mfma_f32_32x32x16_bf16(k0, qf[ds], a0, 0, 0, 0);
                a1 = __builtin_amdgcn_mfma_f32_32x32x16_bf16(k1, qf[ds], a1, 0, 0, 0);
            }
            rescale64(rowmax64(a0, a1), a0, a1, m, l, o0, o1);
            {
                const bf16x8 k2 = *(const LAS bf16x8*)(buf + kfrag + 64 * KROW), k3 = *(const LAS bf16x8*)(buf + kfrag + 96 * KROW);
                if (__builtin_amdgcn_ballot_w64(m != 0.f) == 0ull) {
                    const f32x16 z = {};
                    b0 = __builtin_amdgcn_mfma_f32_32x32x16_bf16(k2, qf[0], z, 0, 0, 0);
                    b1 = __builtin_amdgcn_mfma_f32_32x32x16_bf16(k3, qf[0], z, 0, 0, 0);
                } else {
                    const float nm = -m; const f32x16 nv = {nm, nm, nm, nm, nm, nm, nm, nm, nm, nm, nm, nm, nm, nm, nm, nm};
                    b0 = __builtin_amdgcn_mfma_f32_32x32x16_bf16(k2, qf[0], nv, 0, 0, 0);
                    b1 = __builtin_amdgcn_mfma_f32_32x32x16_bf16(k3, qf[0], nv, 0, 0, 0);
                }
            }
#pragma unroll
            for (int ds = 1; ds < 6; ++ds) {
                const bf16x8 k2 = *(const LAS bf16x8*)(buf + kfrag + 64 * KROW + ds * 32), k3 = *(const LAS bf16x8*)(buf + kfrag + 96 * KROW + ds * 32);
                b0 = __builtin_amdgcn_mfma_f32_32x32x16_bf16(k2, qf[ds], b0, 0, 0, 0);
                b1 = __builtin_amdgcn_mfma_f32_32x32x16_bf16(k3, qf[ds], b1, 0, 0, 0);
            }
            exp64(a0, a1, l);
            { const float mxb = rowmax64(b0, b1);
              if (__builtin_expect(__builtin_amdgcn_ballot_w64(mxb > THR) != 0ull, 0)) {
                  const float dl = fmaxf(mxb, 0.f), alpha = __builtin_amdgcn_exp2f(-dl);
                  m += dl; l *= alpha;
                  sub16(b0, dl); sub16(b1, dl); scale16(o0, alpha); scale16(o1, alpha); scale16(a0, alpha); scale16(a1, alpha);
              } }
            { const bf16x8 p00 = pack_p(a0, 0), p01 = pack_p(a0, 1), p10 = pack_p(a1, 0), p11 = pack_p(a1, 1);
              pv_block(o0, buf + vfrag, p00, p01); pv_block(o0, buf + vfrag + 2048, p10, p11);
              pv_block(o1, buf + vfrag + TK * 64, p00, p01); pv_block(o1, buf + vfrag + TK * 64 + 2048, p10, p11); }
            exp64(b0, b1, l);
            { const bf16x8 p00 = pack_p(b0, 0), p01 = pack_p(b0, 1), p10 = pack_p(b1, 0), p11 = pack_p(b1, 1);
              pv_block(o0, buf + vfrag + 4096, p00, p01); pv_block(o0, buf + vfrag + 6144, p10, p11);
              pv_block(o1, buf + vfrag + TK * 64 + 4096, p00, p01); pv_block(o1, buf + vfrag + TK * 64 + 6144, p10, p11); }
        }
        if (kt + 1 < nt) MLA_STORE(lds + ((kt + 1) & 1) * BUFB);
        if (pid < 131072) {
            asm volatile("s_waitcnt vmcnt(0)" ::: "memory");
            const f32x4 xv = *(const LAS f32x4*)(piece + 16 * lane);
            const int idx = pid & 65535, col = (idx & 3) * 256 + 4 * lane;
            f32x4 sc = {SV, SV, SV, SV};
            if ((pid >> 16) == 0) { const f32x4 gv_ = *(const LAS f32x4*)(lds + MLA_G_OFF + 4 * col); sc = (f32x4){gv_.x * SU, gv_.y * SU, gv_.z * SU, gv_.w * SU}; }
            unsigned char* dst = ((pid >> 16) ? V8 : U8) + (size_t)(col >> 7) * ((size_t)16384 * 128) + (size_t)(idx >> 2) * 128 + (col & 127);
            *(unsigned*)dst = pk_fp8x4(xv.x * sc.x, xv.y * sc.y, xv.z * sc.z, xv.w * sc.w);
        }
        __syncthreads();
        }
    for (; kt < nt; ++kt) {
        const LAS unsigned char* buf = lds + (kt & 1) * BUFB;
        if (kt + 1 < nt) MLA_LOAD(kt + 1);
        const int pid = slot0 + 8 * kt + wid;
        if (pid < 131072) glds16(((pid >> 16) ? v_emb : u_emb) + (size_t)(pid & 65535) * 256 + 4 * lane, piece_u);
        if (TK * kt <= wqlast) {
            const bool needB = TK * kt + 64 <= wqlast;
            const float nm = -m; const f32x16 negm = {nm, nm, nm, nm, nm, nm, nm, nm, nm, nm, nm, nm, nm, nm, nm, nm};
            f32x16 a0 = negm, a1 = negm, b0 = negm, b1 = negm;
#pragma unroll
            for (int ds = 0; ds < 6; ++ds) {
                const bf16x8 k0 = *(const LAS bf16x8*)(buf + kfrag + ds * 32), k1 = *(const LAS bf16x8*)(buf + kfrag + 32 * KROW + ds * 32);
                a0 = __builtin_amdgcn_mfma_f32_32x32x16_bf16(k0, qf[ds], a0, 0, 0, 0);
                a1 = __builtin_amdgcn_mfma_f32_32x32x16_bf16(k1, qf[ds], a1, 0, 0, 0);
            }
            if (needB) {
#pragma unroll
                for (int ds = 0; ds < 6; ++ds) {
                    const bf16x8 k2 = *(const LAS bf16x8*)(buf + kfrag + 64 * KROW + ds * 32), k3 = *(const LAS bf16x8*)(buf + kfrag + 96 * KROW + ds * 32);
                    b0 = __builtin_amdgcn_mfma_f32_32x32x16_bf16(k2, qf[ds], b0, 0, 0, 0);
                    b1 = __builtin_amdgcn_mfma_f32_32x32x16_bf16(k3, qf[ds], b1, 0, 0, 0);
                }
            }
#pragma unroll
            for (int r = 0; r < 16; ++r) { const int kp = TK * kt + crow(r, hi); if (kp > qpos) a0[r] = NEGM; if (kp + 32 > qpos) a1[r] = NEGM; if (kp + 64 > qpos) b0[r] = NEGM; if (kp + 96 > qpos) b1[r] = NEGM; }
            sm64(a0, a1, m, l, o0, o1, b0, b1, needB);
            { const bf16x8 p00 = pack_p(a0, 0), p01 = pack_p(a0, 1), p10 = pack_p(a1, 0), p11 = pack_p(a1, 1);
              pv_block(o0, buf + vfrag, p00, p01); pv_block(o0, buf + vfrag + 2048, p10, p11);
              pv_block(o1, buf + vfrag + TK * 64, p00, p01); pv_block(o1, buf + vfrag + TK * 64 + 2048, p10, p11); }
            if (needB) {
                sm64(b0, b1, m, l, o0, o1, a0, a1, false);
                const bf16x8 p00 = pack_p(b0, 0), p01 = pack_p(b0, 1), p10 = pack_p(b1, 0), p11 = pack_p(b1, 1);
                pv_block(o0, buf + vfrag + 4096, p00, p01); pv_block(o0, buf + vfrag + 6144, p10, p11);
                pv_block(o1, buf + vfrag + TK * 64 + 4096, p00, p01); pv_block(o1, buf + vfrag + TK * 64 + 6144, p10, p11);
            }

        }
        if (kt + 1 < nt) MLA_STORE(lds + ((kt + 1) & 1) * BUFB);
        if (pid < 131072) {
            asm volatile("s_waitcnt vmcnt(0)" ::: "memory");
            const f32x4 xv = *(const LAS f32x4*)(piece + 16 * lane);
            const int idx = pid & 65535, col = (idx & 3) * 256 + 4 * lane;
            f32x4 sc = {SV, SV, SV, SV};
            if ((pid >> 16) == 0) { const f32x4 gv_ = *(const LAS f32x4*)(lds + MLA_G_OFF + 4 * col); sc = (f32x4){gv_.x * SU, gv_.y * SU, gv_.z * SU, gv_.w * SU}; }
            unsigned char* dst = ((pid >> 16) ? V8 : U8) + (size_t)(col >> 7) * ((size_t)16384 * 128) + (size_t)(idx >> 2) * 128 + (col & 127);
            *(unsigned*)dst = pk_fp8x4(xv.x * sc.x, xv.y * sc.y, xv.z * sc.z, xv.w * sc.w);
        }
        __syncthreads();
        }
#undef MLA_LOAD
#undef MLA_STORE
    __builtin_amdgcn_s_setprio(0);
    l = swapsum(l);
    store_o(Mixed + (tok0 + qpos) * DM + 512 + h * 64, o0, o1, 1.0f / l, hi);
}

constexpr int DIL_KR = 144, DIL_VR = 160, DIL_VOFF = 32 * DIL_KR, DIL_WLDS = 32 * DIL_KR + 32 * DIL_VR;
constexpr int DIL_SROW = 132, DIL_STATE_OFF = 8 * DIL_WLDS;
struct DilBlk { u32x4 k[4]; u32x4 v[4]; };
__device__ __forceinline__ void dil_load(DilBlk& B, const bf16_t* __restrict__ Ka, const bf16_t* __restrict__ Va, size_t hrow0  , int rd, int dl  , int imax, int idx0, int lane) {
#pragma unroll
    for (int i = 0; i < 4; ++i) {
        int ik = idx0 + 8 * i + (lane >> 3); ik = ik < 0 ? 0 : ik; ik = ik > imax ? imax : ik;
        const size_t off = (hrow0 + ((size_t)ik << dl) + rd) * 64 + 8 * (lane & 7);
        B.k[i] = *(const u32x4*)(Ka + off); B.v[i] = *(const u32x4*)(Va + off);
    }
}
__device__ __forceinline__ void pv_block_p(f32x16& o, const LAS unsigned char* vbase, const bf16x8& pb0, const bf16x8& pb1) {
    const s16x4 l0 = vtr(vbase), h0 = vtr(vbase + 8 * DIL_VR), l1 = vtr(vbase + 16 * DIL_VR), h1 = vtr(vbase + 24 * DIL_VR);
    const bf16x8 a0 = {l0[0], l0[1], l0[2], l0[3], h0[0], h0[1], h0[2], h0[3]}, a1 = {l1[0], l1[1], l1[2], l1[3], h1[0], h1[1], h1[2], h1[3]};
    o = __builtin_amdgcn_mfma_f32_32x32x16_bf16(a0, pb0, o, 0, 0, 0);
    o = __builtin_amdgcn_mfma_f32_32x32x16_bf16(a1, pb1, o, 0, 0, 0);
}
template <bool MASK>
__device__ __forceinline__ void dil_step(const DilBlk& B, LAS unsigned char* wl, const bf16x8 (&qf)[4], float& m, float& l, f32x16& o0, f32x16& o1, int A, int idx0, int lane) {
    const int r32 = lane & 31, hi = lane >> 5;
    {
        LAS unsigned char* kp = wl + (lane >> 3) * DIL_KR + (lane & 7) * 16;
        LAS unsigned char* vp = wl + DIL_VOFF + (lane >> 3) * DIL_VR + (lane & 7) * 16;
#pragma unroll
        for (int i = 0; i < 4; ++i) { *(LAS u32x4*)(kp + 8 * i * DIL_KR) = B.k[i]; *(LAS u32x4*)(vp + 8 * i * DIL_VR) = B.v[i]; }
    }
    const float nm = -m;
    f32x16 s = {nm, nm, nm, nm, nm, nm, nm, nm, nm, nm, nm, nm, nm, nm, nm, nm};
    { const LAS unsigned char* kfr = wl + r32 * DIL_KR + 16 * hi;
#pragma unroll
      for (int ds = 0; ds < 4; ++ds) s = __builtin_amdgcn_mfma_f32_32x32x16_bf16(*(const LAS bf16x8*)(kfr + 32 * ds), qf[ds], s, 0, 0, 0); }
    if (MASK) {
        const int qi = A + r32;
#pragma unroll
        for (int r = 0; r < 16; ++r) { const int ki = idx0 + crow(r, hi), dist = qi - ki; if (ki < 0 || dist < 0 || dist > 128) s[r] = NEGM; }
    }
    float mx = max3f(s[0], s[1], s[2]);
#pragma unroll
    for (int r = 3; r < 15; r += 2) mx = max3f(mx, s[r], s[r + 1]);
    mx = fmaxf(mx, s[15]);
    mx = swapmax(mx);
    if (__builtin_expect(__builtin_amdgcn_ballot_w64(mx > THR) != 0ull, 0)) {
        const float dl_ = fmaxf(mx, 0.f), alpha = __builtin_amdgcn_exp2f(-dl_);
        m += dl_; l *= alpha;
        sub16(s, dl_); scale16(o0, alpha); scale16(o1, alpha);
    }
    float rs = 0.f;
#pragma unroll
    for (int r = 0; r < 16; ++r) { s[r] = __builtin_amdgcn_exp2f(s[r]); rs += s[r]; }
    l += rs;
    const bf16x8 p0 = pack_p(s, 0), p1 = pack_p(s, 1);
    const int i16 = lane & 15;
    const LAS unsigned char* vb = wl + DIL_VOFF + (4 * hi + (i16 >> 2)) * DIL_VR + (16 * ((lane >> 4) & 1) + 4 * (i16 & 3)) * 2;
    pv_block_p(o0, vb, p0, p1);
    pv_block_p(o1, vb + 64, p0, p1);
}
__device__ __forceinline__ void dil_unit(LAS unsigned char* wl, const bf16_t* __restrict__ Qa, const bf16_t* __restrict__ Ka, const bf16_t* __restrict__ Va, bf16_t* __restrict__ Mixed, LAS unsigned char* state,
                                         int b, int h, int p0, int dl, bool first, bool last, int lane, int pflags = 0) {
    const int r32 = lane & 31, hi = lane >> 5;
    const size_t tok0 = (size_t)b * SEQ, hrow0 = (size_t)(b * 8 + h) * SEQ;
    const int qpos = p0 + (r32 << dl);
    const int rd = p0 & ((1 << dl) - 1), A = p0 >> dl, imax = (SEQ - 1 - rd) >> dl;
    DilBlk b0, b1, b2;
#define DLOAD(B_, k_) dil_load(B_, Ka, Va, hrow0, rd, dl, imax, A - 128 + 32 * (k_), lane)
#define DSTEP(MK_, B_, k_) dil_step<MK_>(B_, wl, qf, m, l, o0, o1, A, A - 128 + 32 * (k_), lane)
    DLOAD(b0, 0); DLOAD(b1, 1);
    bf16x8 qf[4];
    { const bf16_t* qrow = Qa + (hrow0 + qpos) * 64 + 8 * hi;
#pragma unroll
      for (int ds = 0; ds < 4; ++ds) qf[ds] = *(const bf16x8*)(qrow + 16 * ds); }
    float m = 0.f, l = 0.f; f32x16 o0 = {}, o1 = {};
    LAS unsigned* st = (LAS unsigned*)(state + ((qpos & 511) * DIL_SROW));
    if (!first) {
        m = __builtin_bit_cast(float, st[32]); l = hi ? 0.f : 1.f;
#pragma unroll
        for (int g = 0; g < 4; ++g) {
            const unsigned a0 = st[4 * g + 2 * hi], a1 = st[4 * g + 2 * hi + 1], c0 = st[16 + 4 * g + 2 * hi], c1 = st[16 + 4 * g + 2 * hi + 1];
            o0[4 * g] = bf_lo(a0); o0[4 * g + 1] = bf_hi(a0); o0[4 * g + 2] = bf_lo(a1); o0[4 * g + 3] = bf_hi(a1);
            o1[4 * g] = bf_lo(c0); o1[4 * g + 1] = bf_hi(c0); o1[4 * g + 2] = bf_lo(c1); o1[4 * g + 3] = bf_hi(c1);
        }
    }
    const bool early = A - 96 < 0;
#ifdef PROBE_LO
    if (pflags & 32) { o0[0] += __builtin_bit_cast(float, b0.k[0].x ^ b1.k[0].x ^ b0.v[3].w ^ b1.v[3].w); l = 1.f; } else {
#endif
    DLOAD(b2, 2);
    DSTEP(true, b0, 0);
    DLOAD(b0, 3);
    if (early) DSTEP(true, b1, 1); else DSTEP(false, b1, 1);
    DLOAD(b1, 4);
    if (early) DSTEP(true, b2, 2); else DSTEP(false, b2, 2);
    if (early) DSTEP(true, b0, 3); else DSTEP(false, b0, 3);
    DSTEP(true, b1, 4);
#ifdef PROBE_LO
    }
#endif
#undef DLOAD
#undef DSTEP
    l = swapsum(l);
    const float inv = 1.0f / l;
    if (last) store_o(Mixed + (tok0 + qpos) * DM + h * 64, o0, o1, inv, hi);
    else {
#pragma unroll
        for (int g = 0; g < 4; ++g) {
            st[4 * g + 2 * hi] = pk_bf16(o0[4 * g] * inv, o0[4 * g + 1] * inv); st[4 * g + 2 * hi + 1] = pk_bf16(o0[4 * g + 2] * inv, o0[4 * g + 3] * inv);
            st[16 + 4 * g + 2 * hi] = pk_bf16(o1[4 * g] * inv, o1[4 * g + 1] * inv); st[16 + 4 * g + 2 * hi + 1] = pk_bf16(o1[4 * g + 2] * inv, o1[4 * g + 3] * inv);
        }
        if (hi == 0) st[32] = __builtin_bit_cast(unsigned, m + __builtin_amdgcn_logf(l));
    }
}
__device__ __forceinline__ void dil_segment(LAS unsigned char* lds, const bf16_t* __restrict__ Qa, const bf16_t* __restrict__ Ka, const bf16_t* __restrict__ Va, bf16_t* __restrict__ Mixed,
                                            int sg, int wave, int lane, int pflags = 0) {
    const int seg = sg & 15, h = (sg >> 4) & 7, b = sg >> 7, base = 512 * seg;
    LAS unsigned char* wl = lds + wave * DIL_WLDS;
#pragma unroll 1
    for (int pass = 0; pass < ((pflags & 64) ? 1 : 3); ++pass) {
        const int dl = 2 * pass;
#pragma unroll 1
        for (int j = wave; j < 16; j += 8) {
            const int rd = j & ((1 << dl) - 1), cj = j >> dl;
            dil_unit(wl, Qa, Ka, Va, Mixed, lds + DIL_STATE_OFF, b, h, base + rd + ((32 * cj) << dl), dl, pass == 0, pass == 2, lane, pflags);
        }
        if (pass < 2) __syncthreads();
    }
}
}

namespace peer {
__device__ __forceinline__ void ins16(unsigned (&L)[16], unsigned key) {
#pragma unroll
    for (int i = 0; i < 16; ++i) { const unsigned hi_ = L[i] > key ? L[i] : key; key = L[i] > key ? key : L[i]; L[i] = hi_; }
}
__device__ __forceinline__ void ce(unsigned& a, unsigned& b) { const unsigned hi_ = a > b ? a : b, lo_ = a > b ? b : a; a = hi_; b = lo_; }
__device__ __forceinline__ void sort8(unsigned (&v)[8]) {
    ce(v[0], v[1]); ce(v[2], v[3]); ce(v[4], v[5]); ce(v[6], v[7]); ce(v[0], v[2]); ce(v[1], v[3]); ce(v[4], v[6]); ce(v[5], v[7]); ce(v[1], v[2]); ce(v[5], v[6]);
    ce(v[0], v[4]); ce(v[3], v[7]); ce(v[1], v[5]); ce(v[2], v[6]); ce(v[1], v[4]); ce(v[3], v[6]); ce(v[2], v[4]); ce(v[3], v[5]); ce(v[3], v[4]);
}
__device__ __forceinline__ void bmerge16(unsigned (&v)[16]) {
#pragma unroll
    for (int k = 8; k >= 1; k >>= 1)
#pragma unroll
        for (int i = 0; i < 16; ++i) if ((i & k) == 0) ce(v[i], v[i + k]);
}
__device__ __forceinline__ float dec16(unsigned key) { const unsigned s = key >> 16; const unsigned b = (s & 0x8000u) ? (s & 0x7fffu) : (~s & 0xffffu); return (float)__builtin_bit_cast(_Float16, (unsigned short)b); }
__device__ __forceinline__ unsigned enc32(float f) { const unsigned u = __builtin_bit_cast(unsigned, f); return (u & 0x80000000u) ? ~u : (u | 0x80000000u); }
__device__ __forceinline__ float dec32(unsigned s) { const unsigned u = (s & 0x80000000u) ? (s & 0x7fffffffu) : ~s; return __builtin_bit_cast(float, u); }
__device__ __forceinline__ float gelu1(float v) {
    const float av = fabsf(v), t = __builtin_amdgcn_rcpf(av * 0.2316418882f + 1.0f);
    float q = t * 0.5307027145f + (-0.7265760135f); q = q * t + 0.7107068705f; q = q * t + (-0.142248368f); q = q * t + 0.127414796f; q = q * t;
    const float e = __builtin_amdgcn_exp2f((v * v) * (-0.72134752044f));
    const float mm = v * (q * e);
    return v < 0.f ? mm : v - mm;
}
struct CandTab { unsigned char i[52], j[52]; };
__host__ __device__ constexpr CandTab make_cands() {
    CandTab t{}; int n = 0;
    for (int i = 0; i < 16; ++i) for (int j = 0; j < 16; ++j) if ((i + 1) * (j + 1) <= 16) { t.i[n] = (unsigned char)i; t.j[n] = (unsigned char)j; ++n; }
    for (; n < 52; ++n) { t.i[n] = 15; t.j[n] = 15; }
    return t;
}

}

namespace peer2 {
__device__ __forceinline__ int ld_of(int j) { const int rho = 16 * ((j >> 2) & 3) + 4 * ((j >> 4) & 3) + (j & 3); return (j >> 6) * 64 + (rho & 7) * 8 + (rho >> 3); }

__device__ __forceinline__ void topk_phase(LAS unsigned char* lds, const bf16_t* __restrict__ Sc, const float* __restrict__ ssq_h, unsigned short* __restrict__ Pe_slot, unsigned short* __restrict__ Pe_ld,
                                           float* __restrict__ Pg, float* __restrict__ rstd_h, int gw, int ngw) {
    const int lane = threadIdx.x & 63, wid = __builtin_amdgcn_readfirstlane(threadIdx.x >> 6);
    LAS unsigned char* tile = lds + wid * 12288;
    LAS unsigned* lists = (LAS unsigned*)(tile + 8192);
    constexpr peer::CandTab CT = peer::make_cands();
    u32x4 nx[8];
#define TK_LOAD(g_, hh_) do { _Pragma("unroll") for (int i_ = 0; i_ < 8; ++i_) { const int s_ = 8 * i_ + (lane >> 3); \
        nx[i_] = *(const u32x4*)(Sc + (size_t)(4 * (g_) + (s_ >> 4)) * 2048 + (s_ & 15) * 128 + (hh_) * 64 + (lane & 7) * 8); } } while (0)
#define TK_WRITE() do { _Pragma("unroll") for (int i_ = 0; i_ < 8; ++i_) { const int s_ = 8 * i_ + (lane >> 3); *(LAS u32x4*)(tile + s_ * 128 + (((lane & 7) ^ (s_ & 7)) << 4)) = nx[i_]; } } while (0)
    if (gw < T / 4) TK_LOAD(gw, 0);
    for (int g = gw; g < T / 4; g += ngw) {
        const int t4 = lane >> 4, hp = lane & 15, tok = 4 * g + t4;
        unsigned L[16];
        {
            const LAS unsigned char* seg = tile + lane * 128;
#pragma unroll 1
            for (int gq = 0; gq < 8; ++gq) {
                if (gq == 0) { TK_WRITE(); TK_LOAD(g, 1); }
                if (gq == 4) { TK_WRITE(); if (g + ngw < T / 4) TK_LOAD(g + ngw, 0); }
                const int c0 = 2 * (gq & 3);
                const u32x4 w0 = *(const LAS u32x4*)(seg + ((c0 ^ (lane & 7)) << 4)), w1 = *(const LAS u32x4*)(seg + (((c0 + 1) ^ (lane & 7)) << 4));
                unsigned ka[8], kb[8];
#pragma unroll
                for (int e2 = 0; e2 < 4; ++e2) {
                    const unsigned wa = e2 == 0 ? w0.x : (e2 == 1 ? w0.y : (e2 == 2 ? w0.z : w0.w)), wb = e2 == 0 ? w1.x : (e2 == 1 ? w1.y : (e2 == 2 ? w1.z : w1.w));
                    typedef short s16x2_t __attribute__((ext_vector_type(2)));
                    const unsigned ma = __builtin_bit_cast(unsigned, __builtin_bit_cast(s16x2_t, wa) >> (short)15) | 0x80008000u, mb = __builtin_bit_cast(unsigned, __builtin_bit_cast(s16x2_t, wb) >> (short)15) | 0x80008000u;
                    const unsigned sa = wa ^ ma, sb = wb ^ mb;
                    const unsigned i0 = (unsigned)(127 - (16 * gq + 2 * e2));
                    ka[2 * e2] = (sa << 16) | i0; ka[2 * e2 + 1] = (sa & 0xffff0000u) | (i0 - 1u);
                    kb[2 * e2] = (sb << 16) | (i0 - 8u); kb[2 * e2 + 1] = (sb & 0xffff0000u) | (i0 - 9u);
                }
                peer::sort8(ka); peer::sort8(kb);
                unsigned G[16];
#pragma unroll
                for (int i = 0; i < 8; ++i) { G[i] = ka[i]; G[8 + i] = kb[7 - i]; }
                peer::bmerge16(G);
                if (gq == 0) {
#pragma unroll
                    for (int i = 0; i < 16; ++i) L[i] = G[i];
                } else {
#pragma unroll
                    for (int i = 0; i < 16; ++i) L[i] = L[i] > G[15 - i] ? L[i] : G[15 - i];
                    peer::bmerge16(L);
                }
            }
        }
#pragma unroll
        for (int i = 0; i < 16; ++i) lists[lane * 16 + i] = L[i];
        const int p = hp & 1;
        float av[16], bv[16];
#pragma unroll
        for (int i = 0; i < 16; ++i) { const unsigned o = (unsigned)__builtin_amdgcn_update_dpp(0, (int)L[i], 0xB1, 0xF, 0xF, true); av[i] = peer::dec16(p ? o : L[i]); bv[i] = peer::dec16(p ? L[i] : o); }
        unsigned M[16];
        {
            unsigned C[32];
#pragma unroll
            for (int k = 0; k < 25; ++k) {
                const int i0 = CT.i[2 * k], j0 = CT.j[2 * k], i1 = CT.i[2 * k + 1], j1 = CT.j[2 * k + 1];
                const float s0 = av[i0] + bv[j0], s1 = av[i1] + bv[j1];
                const float sm = p ? s1 : s0; const unsigned fl = p ? (unsigned)(i1 * 16 + j1) : (unsigned)(i0 * 16 + j0);
                C[k] = (peer::enc32(sm) & 0xffffff00u) | (255u - fl);
            }
#pragma unroll
            for (int k = 25; k < 32; ++k) C[k] = 0u;
            unsigned g0[8], g1[8], g2[8], g3[8];
#pragma unroll
            for (int i = 0; i < 8; ++i) { g0[i] = C[i]; g1[i] = C[8 + i]; g2[i] = C[16 + i]; g3[i] = C[24 + i]; }
            peer::sort8(g0); peer::sort8(g1); peer::sort8(g2); peer::sort8(g3);
            unsigned H[16];
#pragma unroll
            for (int i = 0; i < 8; ++i) { M[i] = g0[i]; M[8 + i] = g1[7 - i]; H[i] = g2[i]; H[8 + i] = g3[7 - i]; }
            peer::bmerge16(M); peer::bmerge16(H);
#pragma unroll
            for (int i = 0; i < 16; ++i) M[i] = M[i] > H[15 - i] ? M[i] : H[15 - i];
            peer::bmerge16(M);
        }
        unsigned R[16];
#pragma unroll
        for (int k = 0; k < 16; ++k) { const unsigned o = (unsigned)__builtin_amdgcn_update_dpp(0, (int)M[15 - k], 0xB1, 0xF, 0xF, true); R[k] = M[k] > o ? M[k] : o; }
        float rv[16], mx = -INFINITY;
#pragma unroll
        for (int k = 0; k < 16; ++k) { rv[k] = peer::dec32(R[k] & 0xffffff00u); mx = fmaxf(mx, rv[k]); }
        float sum = 0.f;
#pragma unroll
        for (int k = 0; k < 16; ++k) { rv[k] = __builtin_amdgcn_exp2f((rv[k] - mx) * LOG2E); sum += rv[k]; }
        const float isum = 1.0f / sum;
        {
            const int h = hp >> 1;
            const LAS unsigned* la = lists + (lane & ~1) * 16; const LAS unsigned* lb = lists + (lane | 1) * 16;
#pragma unroll
            for (int k = 0; k < 8; ++k) {
                const unsigned fl = 255u - (R[k] & 0xffu);
                const unsigned i1 = 127u - (la[fl >> 4] & 0x7fu), i2 = 127u - (lb[fl & 15u] & 0x7fu);
                const int j = h * 16 + p * 8 + k, sl = j;
                const unsigned short e = (unsigned short)(i1 * 128u + i2);
                Pe_slot[(size_t)tok * 128 + sl] = e;
                Pe_ld[(size_t)tok * 128 + ld_of(j)] = e;
                Pg[(size_t)tok * 128 + sl] = rv[k] * isum;
            }
        }
        if (hp == 0) {
            float s = 0.f;
#pragma unroll
            for (int k = 0; k < 8; ++k) { const f32x4 q = *(const f32x4*)(ssq_h + (size_t)tok * 32 + 4 * k); s += (q.x + q.y) + (q.z + q.w); }
            rstd_h[tok] = 1.0f / sqrtf(s * (1.f / 1024.f) + EPS);
        }
    }
#undef TK_LOAD
#undef TK_WRITE
}

struct UG { u32x4 v[8]; };
struct UIDS { u32x4 e0, e1, b0, b1; };
__device__ __forceinline__ void u_ids(UIDS& I, const unsigned short* __restrict__ Pe_ld, const unsigned char* __restrict__ Hx, int tok, int lane) {
    const u32x4* ip = (const u32x4*)(Pe_ld + (size_t)tok * 128 + (lane >> 3) * 8);
    I.e0 = ip[0]; I.e1 = ip[8];
    const unsigned char* hrow = Hx + (size_t)tok * 128 + 32 * (lane >> 4);
    I.b0 = *(const u32x4*)hrow; I.b1 = *(const u32x4*)(hrow + 16);
}
__device__ __forceinline__ void u_gather(UG& F, const u32x4& w, const unsigned char* __restrict__ Ul  , unsigned emask, unsigned loff = 0u  ) {
#pragma unroll
    for (int i = 0; i < 8; ++i) {
        const unsigned word = (i >> 1) == 0 ? w.x : ((i >> 1) == 1 ? w.y : ((i >> 1) == 2 ? w.z : w.w));
        const unsigned e = ((i & 1) ? (word >> 16) : (word & 0xffffu)) & emask;
        F.v[i] = *(const u32x4*)(Ul + (e * 128u + loff));
    }
}
template <int PM = 0> __device__ __forceinline__ void u_compute(u32x4& z0, u32x4& z1, const UG& F, const u32x4& b0, const u32x4& b1, LAS unsigned char* hl  , int lane) {
    if (PM == 0) {
        LAS unsigned char* wp = hl + (lane >> 3) * 128 + (((lane & 7) ^ (lane >> 3)) << 4);
#pragma unroll
        for (int i = 0; i < 8; ++i) *(LAS u32x4*)(wp + i * 1024) = F.v[i];
    }
    const v8i bfr = {(int)b0.x, (int)b0.y, (int)b0.z, (int)b0.w, (int)b1.x, (int)b1.y, (int)b1.z, (int)b1.w};
    const int r16 = lane & 15, kb = lane >> 4;
    const LAS unsigned char* rp = hl + r16 * 128;
    const int p0 = ((2 * kb) ^ (r16 & 7)) << 4, p1 = ((2 * kb + 1) ^ (r16 & 7)) << 4;
    f32x4 acc[4];
#pragma unroll
    for (int g = 0; g < 4; ++g) {
        u32x4 a0, a1; if (PM == 0) { a0 = *(const LAS u32x4*)(rp + g * 2048 + p0); a1 = *(const LAS u32x4*)(rp + g * 2048 + p1); } else { a0 = F.v[2 * g]; a1 = F.v[2 * g + 1]; }
        const v8i afr = {(int)a0.x, (int)a0.y, (int)a0.z, (int)a0.w, (int)a1.x, (int)a1.y, (int)a1.z, (int)a1.w};
        acc[g] = __builtin_amdgcn_mfma_scale_f32_16x16x128_f8f6f4(afr, bfr, (f32x4){0.f, 0.f, 0.f, 0.f}, 0, 0, 0, 0, 0, 0);
    }
    z0.x = pk_bf16(acc[0][0], acc[0][1]); z0.y = pk_bf16(acc[0][2], acc[0][3]); z0.z = pk_bf16(acc[1][0], acc[1][1]); z0.w = pk_bf16(acc[1][2], acc[1][3]);
    z1.x = pk_bf16(acc[2][0], acc[2][1]); z1.y = pk_bf16(acc[2][2], acc[2][3]); z1.z = pk_bf16(acc[3][0], acc[3][1]); z1.w = pk_bf16(acc[3][2], acc[3][3]);
}
constexpr int U_REC = 512, U_CH = 16, U_STAGE = 8192, U_WLDS = U_STAGE + U_CH * U_REC;
template <int PM = 0> __device__ __forceinline__ void u_phase(LAS unsigned char* lds, const unsigned char* __restrict__ Hb8, const unsigned char* __restrict__ U8, const unsigned short* __restrict__ Pe_ld, bf16_t* __restrict__ Zp, int x, int wg, int nwg, unsigned emask = 0xffffu) {
    const int lane = threadIdx.x & 63, wid = __builtin_amdgcn_readfirstlane(threadIdx.x >> 6);
    LAS unsigned char* wl = lds + wid * U_WLDS;
    LAS unsigned char* rb = wl + U_STAGE;
    const unsigned rb_u = (unsigned)__builtin_amdgcn_readfirstlane((int)(unsigned)(uintptr_t)rb);
    const unsigned char* Hx = Hb8 + (size_t)x * ((size_t)T * 128);
    const unsigned char* Ul = U8 + (size_t)x * ((size_t)16384 * 128); const unsigned loff = 16u * (lane & 7);
    bf16_t* Zx = Zp + (size_t)x * T * 128;
    const int n = (T - wg + nwg - 1) / nwg;
    if (n <= 0) return;
    const int nch = (n + U_CH - 1) / U_CH;
#define UTOK(k) (wg + ((k) < n ? (k) : n - 1) * nwg)
#define USB() __builtin_amdgcn_sched_barrier(0)
    const int w32 = lane & 31, sub = lane >> 5;
    const unsigned char* rbase = w32 < 16 ? (const unsigned char*)Pe_ld + 16 * w32 : (w32 < 24 ? Hx + 16 * (w32 - 16) : (const unsigned char*)Pe_ld);
    const unsigned rstride = (w32 >= 16 && w32 < 24) ? 128u : 256u;
#pragma unroll 1
    for (int c = 0; c < nch; ++c) {
#pragma unroll
        for (int i = 0; i < U_CH / 2; ++i)
            glds16(rbase + (size_t)UTOK(c * U_CH + 2 * i + sub) * rstride, rb_u + i * 1024);
        asm volatile("s_waitcnt vmcnt(0)" ::: "memory");
        UG f0, f1;
        { const u32x4 e0 = *(const LAS u32x4*)(rb + (lane >> 3) * 16); u_gather(f0, e0, Ul, emask, loff); }
#pragma unroll 1
        for (int i = 0; i < U_CH; ++i) {
            const int k = c * U_CH + i;
            const LAS unsigned char* rec = rb + i * U_REC;
            const LAS unsigned char* nrec = (i + 1 < U_CH) ? rec + U_REC : rec;
            const u32x4 e1 = *(const LAS u32x4*)(rec + 128 + (lane >> 3) * 16), e0n = *(const LAS u32x4*)(nrec + (lane >> 3) * 16);
            const u32x4 bk0 = *(const LAS u32x4*)(rec + 256 + 32 * (lane >> 4)), bk1 = *(const LAS u32x4*)(rec + 256 + 32 * (lane >> 4) + 16);
            u32x4 za, zb, zc, zd;
            u_gather(f1, e1, Ul, emask, loff);
            USB(); u_compute<PM>(za, zb, f0, bk0, bk1, wl, lane); USB();
            u_gather(f0, e0n, Ul, emask, loff);
            USB(); u_compute<PM>(zc, zd, f1, bk0, bk1, wl, lane); USB();
            if ((lane & 15) == 0 && k < n) { bf16_t* zr_ = Zx + (size_t)UTOK(k) * 128 + 16 * (lane >> 4); *(u32x4*)zr_ = za; *(u32x4*)(zr_ + 8) = zb; *(u32x4*)(zr_ + 64) = zc; *(u32x4*)(zr_ + 72) = zd; }
        }
        asm volatile("s_waitcnt vmcnt(0) lgkmcnt(0)" ::: "memory");
    }
#undef UTOK
#undef USB
}

__device__ __forceinline__ float dppf(float v, int ctrl_sel) {
    const int s = __builtin_bit_cast(int, v);
    const int r = ctrl_sel == 0 ? __builtin_amdgcn_update_dpp(0, s, 0xB1, 0xF, 0xF, true) : ctrl_sel == 1 ? __builtin_amdgcn_update_dpp(0, s, 0x4E, 0xF, 0xF, true)
                : ctrl_sel == 2 ? __builtin_amdgcn_update_dpp(0, s, 0x141, 0xF, 0xF, true) : ctrl_sel == 3 ? __builtin_amdgcn_update_dpp(0, s, 0x140, 0xF, 0xF, true) : __builtin_amdgcn_update_dpp(0, s, 0x128, 0xF, 0xF, true);
    return __builtin_bit_cast(float, r);
}
constexpr float SA = 64.f;
__device__ __forceinline__ void act_phase(LAS unsigned char* lds, const bf16_t* __restrict__ Zp, const unsigned short* __restrict__ Pe_slot, const float* __restrict__ Pg, const float* __restrict__ ssq_h,
                                          unsigned short* __restrict__ PE2, unsigned char* __restrict__ PA2, int gw, int ngw) {
    const int lane = threadIdx.x & 63, wid = __builtin_amdgcn_readfirstlane(threadIdx.x >> 6);
    LAS unsigned short* lid = (LAS unsigned short*)(lds + wid * 512);
    LAS unsigned char* lw = lds + wid * 512 + 256;
    unsigned zw[8], ew; f32x2 gg; float sp;
#define ACT_LOAD(t_) do { const size_t o_ = (size_t)(t_) * 128 + 2 * lane; _Pragma("unroll") for (int xx = 0; xx < 8; ++xx) zw[xx] = *(const unsigned*)(Zp + (size_t)xx * T * 128 + o_); \
        ew = *(const unsigned*)(Pe_slot + o_); gg = *(const f32x2*)(Pg + o_); sp = ssq_h[(size_t)(t_) * 32 + (lane & 31)]; } while (0)
    if (gw < T) ACT_LOAD(gw);
    for (int tok = gw; tok < T; tok += ngw) {
        float z0 = 0.f, z1 = 0.f;
#pragma unroll
        for (int xx = 0; xx < 8; ++xx) { z0 += bf_lo(zw[xx]); z1 += bf_hi(zw[xx]); }
        const unsigned e2 = ew; const f32x2 g2 = gg;
        float s = sp;
        if (tok + ngw < T) ACT_LOAD(tok + ngw);
        s += dppf(s, 0); s += dppf(s, 1); s += dppf(s, 2); s += dppf(s, 3);
        const int si = __builtin_bit_cast(int, s);
        const float tot = __builtin_bit_cast(float, __builtin_amdgcn_readlane(si, 0)) + __builtin_bit_cast(float, __builtin_amdgcn_readlane(si, 16));
        const float zs = (1.0f / sqrtf(tot * (1.f / 1024.f) + EPS)) * (1.0f / (SU * SX));
        const float w0 = fminf(fmaxf(peer::gelu1(z0 * zs) * g2.x * SA, -440.f), 440.f), w1 = fminf(fmaxf(peer::gelu1(z1 * zs) * g2.y * SA, -440.f), 440.f);
        const unsigned w8 = (unsigned)__builtin_amdgcn_cvt_pk_fp8_f32(w0, w1, 0, false);
        const int sl0 = 2 * lane, d0 = (sl0 & 7) * 16 + (sl0 >> 3), d1 = ((sl0 + 1) & 7) * 16 + (sl0 >> 3);
        lid[d0] = (unsigned short)(e2 & 0xffffu); lid[d1] = (unsigned short)(e2 >> 16);
        lw[d0] = (unsigned char)(w8 & 0xffu); lw[d1] = (unsigned char)((w8 >> 8) & 0xffu);
        const u32x4 ov = *(const LAS u32x4*)(lds + wid * 512 + 16 * lane);
        if (lane < 16) *(u32x4*)(PE2 + (size_t)tok * 128 + 8 * lane) = ov;
        else if (lane < 24) *(u32x4*)(PA2 + (size_t)tok * 128 + 16 * (lane - 16)) = ov;
    }
#undef ACT_LOAD
}

struct VG { u32x4 v[8]; u32x2 w; };
template <int PM = 0> __device__ __forceinline__ void v_gather(VG& Gt, const u32x4& ew, const u32x2& ww, const unsigned char* __restrict__ vb  , unsigned loff  , unsigned emask) {
    Gt.w = ww;
#pragma unroll
    for (int i = 0; i < 8; ++i) {
        const unsigned word = (i >> 1) == 0 ? ew.x : ((i >> 1) == 1 ? ew.y : ((i >> 1) == 2 ? ew.z : ew.w));
        const unsigned e = ((i & 1) ? (word >> 16) : (word & 0xffffu)) & emask;
        if (PM == 1 && (i & 1)) Gt.v[i] = Gt.v[i - 1]; else
        Gt.v[i] = *(const u32x4*)(vb + (e * 128u + loff));
    }
}
struct VSel { unsigned lo[4], hi[4]; };
__device__ __forceinline__ void v_compute(f32x4& accL, f32x4& accH, const VG& Gt, const VSel& S) {
#pragma unroll
    for (int i = 0; i < 8; ++i) {
        const unsigned d = i < 4 ? Gt.w.x : Gt.w.y;
        const unsigned b0 = __builtin_amdgcn_perm(d, d, S.lo[i & 3]), b1 = __builtin_amdgcn_perm(d, d, S.hi[i & 3]);
        const long aL = (long)(((unsigned long long)Gt.v[i].y << 32) | Gt.v[i].x), aH = (long)(((unsigned long long)Gt.v[i].w << 32) | Gt.v[i].z);
        const long bb = (long)(((unsigned long long)b1 << 32) | b0);
        accL = __builtin_amdgcn_mfma_f32_16x16x32_fp8_fp8(aL, bb, accL, 0, 0, 0);
        accH = __builtin_amdgcn_mfma_f32_16x16x32_fp8_fp8(aH, bb, accH, 0, 0, 0);
    }
}
constexpr int V_REC = 512, V_CH = 16, V_WLDS = V_CH * V_REC + 1024;
template <int PM = 0> __device__ __forceinline__ void v_phase(LAS unsigned char* lds, const unsigned char* __restrict__ V8, const unsigned short* __restrict__ PE2, const unsigned char* __restrict__ PA2, bf16_t* __restrict__ Op, int x, int wg, int nwg, unsigned emask = 0xffffu) {
    const int lane = threadIdx.x & 63, wid = __builtin_amdgcn_readfirstlane(threadIdx.x >> 6), seg8 = lane >> 3, bp = lane & 7;
    LAS unsigned char* rb = lds + wid * V_WLDS;
    LAS float* tr = (LAS float*)(rb + V_CH * V_REC);
    const unsigned rb_u = (unsigned)__builtin_amdgcn_readfirstlane((int)(unsigned)(uintptr_t)rb);
    const unsigned char* vb = V8 + (size_t)x * ((size_t)16384 * 128); const unsigned loff = 16u * (lane & 7);
    bf16_t* Ox = Op + (size_t)x * T * 128;
    VSel S;
    { const unsigned none = 0x0c0c0c0cu, keep = none & ~(0xffu << (8 * (bp & 3)));
#pragma unroll
      for (int q = 0; q < 4; ++q) { const unsigned sq = keep | ((unsigned)q << (8 * (bp & 3))); S.lo[q] = bp < 4 ? sq : none; S.hi[q] = bp < 4 ? none : sq; } }
    const bool dvalid = ((lane >> 3) & 1) == (lane >> 5);
    LAS float* trw = tr + (lane >> 5) * 128 + 64 * ((lane >> 4) & 1) + bp;
    const int n = (T - wg + nwg - 1) / nwg;
    if (n <= 0) return;
    const int nch = (n + V_CH - 1) / V_CH;
#define VTOK(k) (wg + ((k) < n ? (k) : n - 1) * nwg)
    const int w32 = lane & 31, sub = lane >> 5;
    const unsigned char* rbase = w32 < 16 ? (const unsigned char*)PE2 + 16 * w32 : (w32 < 24 ? PA2 + 16 * (w32 - 16) : (const unsigned char*)PE2);
    const unsigned rstride = (w32 >= 16 && w32 < 24) ? 128u : 256u;
    const int roff = seg8 * 32, woff = 256 + seg8 * 16;
#pragma unroll 1
    for (int c = 0; c < nch; ++c) {
        if (PM != 2 || c == 0) {
#pragma unroll
        for (int i = 0; i < V_CH / 2; ++i)
            glds16(rbase + (size_t)VTOK(c * V_CH + 2 * i + sub) * rstride, rb_u + i * 1024);
        asm volatile("s_waitcnt vmcnt(0)" ::: "memory");
        }
        VG g0, g1;
        { const u32x4 ea = *(const LAS u32x4*)(rb + roff); const u32x2 wa = *(const LAS u32x2*)(rb + woff); v_gather<PM>(g0, ea, wa, vb, loff, emask); }
#pragma unroll 1
        for (int i = 0; i < V_CH; ++i) {
            const int k = c * V_CH + i, tok = VTOK(k);
            const LAS unsigned char* rec = rb + i * V_REC;
            const LAS unsigned char* nrec = (i + 1 < V_CH) ? rec + V_REC : rec;
            f32x4 accL = {0.f, 0.f, 0.f, 0.f}, accH = {0.f, 0.f, 0.f, 0.f};
            { const u32x4 ea = *(const LAS u32x4*)(rec + roff + 16); const u32x2 wa = *(const LAS u32x2*)(rec + woff + 8); v_gather<PM>(g1, ea, wa, vb, loff, emask); }
            __builtin_amdgcn_sched_barrier(0);
            v_compute(accL, accH, g0, S);
            { const u32x4 ea = *(const LAS u32x4*)(nrec + roff); const u32x2 wa = *(const LAS u32x2*)(nrec + woff); v_gather<PM>(g0, ea, wa, vb, loff, emask); }
            __builtin_amdgcn_sched_barrier(0);
            v_compute(accL, accH, g1, S);
            if (dvalid) {
#pragma unroll
                for (int r = 0; r < 4; ++r) { trw[16 * r] = accL[r]; trw[16 * r + 8] = accH[r]; }
            }
            const f32x4 oa = *(const LAS f32x4*)(tr + 4 * w32), ob = *(const LAS f32x4*)(tr + 128 + 4 * w32);
            if (lane < 32 && k < n) {
                constexpr float sc = 1.0f / (SA * SV);
                u32x2 w; w.x = pk_bf16((oa.x + ob.x) * sc, (oa.y + ob.y) * sc); w.y = pk_bf16((oa.z + ob.z) * sc, (oa.w + ob.w) * sc); *(u32x2*)(Ox + (size_t)tok * 128 + 4 * lane) = w;
            }
        }
        if (PM != 2) asm volatile("s_waitcnt vmcnt(0) lgkmcnt(0)" ::: "memory");
    }
#undef VTOK
}

__device__ __forceinline__ void final_phase(float* __restrict__ Out, const bf16_t* __restrict__ Hb, const bf16_t* __restrict__ Op, const float* __restrict__ g_final, int gw, int ngw) {
    const int lane = threadIdx.x & 63;
    const f32x4* gr = (const f32x4*)g_final + lane;
    const f32x4 g0 = gr[0], g1 = gr[64], g2 = gr[128], g3 = gr[192];
    const bf16_t* ob = Op + (size_t)(lane >> 5) * T * 128 + 4 * (lane & 31);
    for (int t0 = 4 * gw; t0 < T; t0 += 4 * ngw) {
        u32x2 hh[4][4], o[4][4];
#pragma unroll
        for (int r = 0; r < 4; ++r) {
            const int tok = t0 + r < T ? t0 + r : T - 1;
            const bf16_t* hr = Hb + (size_t)tok * DM + 4 * lane;
#pragma unroll
            for (int j = 0; j < 4; ++j) { hh[r][j] = *(const u32x2*)(hr + 256 * j); o[r][j] = *(const u32x2*)(ob + ((size_t)(2 * j) * T + tok) * 128); }
        }
#pragma unroll
        for (int r = 0; r < 4; ++r) {
            if (t0 + r >= T) break;
            f32x4 y[4];
            float s = 0.f;
#pragma unroll
            for (int j = 0; j < 4; ++j) {
                y[j].x = bf_lo(hh[r][j].x) + bf_lo(o[r][j].x); y[j].y = bf_hi(hh[r][j].x) + bf_hi(o[r][j].x); y[j].z = bf_lo(hh[r][j].y) + bf_lo(o[r][j].y); y[j].w = bf_hi(hh[r][j].y) + bf_hi(o[r][j].y);
                s += (y[j].x * y[j].x + y[j].y * y[j].y) + (y[j].z * y[j].z + y[j].w * y[j].w);
            }
            s += dppf(s, 0); s += dppf(s, 1); s += dppf(s, 2); s += dppf(s, 3);
            const int si = __builtin_bit_cast(int, s);
            const float tot = (__builtin_bit_cast(float, __builtin_amdgcn_readlane(si, 0)) + __builtin_bit_cast(float, __builtin_amdgcn_readlane(si, 16)))
                            + (__builtin_bit_cast(float, __builtin_amdgcn_readlane(si, 32)) + __builtin_bit_cast(float, __builtin_amdgcn_readlane(si, 48)));
            const float r2 = 1.0f / sqrtf(tot * (1.f / 1024.f) + EPS);
            f32x4* yr = (f32x4*)(Out + (size_t)(t0 + r) * DM) + lane;
            yr[0] = (f32x4){y[0].x * r2 * g0.x, y[0].y * r2 * g0.y, y[0].z * r2 * g0.z, y[0].w * r2 * g0.w};
            yr[64] = (f32x4){y[1].x * r2 * g1.x, y[1].y * r2 * g1.y, y[1].z * r2 * g1.z, y[1].w * r2 * g1.w};
            yr[128] = (f32x4){y[2].x * r2 * g2.x, y[2].y * r2 * g2.y, y[2].z * r2 * g2.z, y[2].w * r2 * g2.w};
            yr[192] = (f32x4){y[3].x * r2 * g3.x, y[3].y * r2 * g3.y, y[3].z * r2 * g3.z, y[3].w * r2 * g3.w};
        }
    }
}
}


#define XB_TMO      128
#define XB_XCNT(j)  (256  + 64 * (j))
#define XB_XSUB(j)  (1280 + 64 * (j))
#define XB_XGEN(j)  (2304 + 64 * (j))
#define XB_TOP      3328
#define XB_TOPGEN   3392
#define XCD_BAR_WORDS 3456
#define XB_SPIN_CAP (1u << 18)

__device__ __forceinline__ unsigned xb_ld(unsigned* p)              { return __hip_atomic_load(p, __ATOMIC_RELAXED, __HIP_MEMORY_SCOPE_AGENT); }
__device__ __forceinline__ unsigned xb_add(unsigned* p, unsigned v) { return __hip_atomic_fetch_add(p, v, __ATOMIC_RELAXED, __HIP_MEMORY_SCOPE_AGENT); }
__device__ __forceinline__ unsigned xb_xcc_id() { return (unsigned)__builtin_amdgcn_s_getreg((3 << 11) | 20) & 0xFu; }
#define XB_SPIN(cond, bar) do { unsigned _sp = 0; while (cond) { __builtin_amdgcn_s_sleep(1); \
    if ((++_sp & 255u) == 0u) { if (xb_ld(&(bar)[XB_TMO])) break; if (_sp > XB_SPIN_CAP) { atomicAdd(&(bar)[XB_TMO], 1u); break; } } } } while (0)

struct XcdBarrier {
    unsigned* bar; unsigned x;
    volatile LAS unsigned* st;
};

__device__ __forceinline__ XcdBarrier xcd_barrier_post(unsigned* bar, volatile LAS unsigned* st) {
    XcdBarrier b; b.bar = bar; b.x = xb_xcc_id(); b.st = st;
    if (threadIdx.x == 0) (void)xb_add(&bar[XB_XCNT(b.x)], 1u);
    return b;
}
__device__ __forceinline__ void xcd_barrier_complete(unsigned* bar, unsigned x, unsigned& nloc, unsigned& nx) {
    const unsigned G = gridDim.x * gridDim.y * gridDim.z;
    unsigned sum, cnt, mine, sp = 0u;
    for (;;) {
        sum = 0u; cnt = 0u; mine = 0u;
#pragma unroll
        for (unsigned j = 0; j < 16; ++j) { const unsigned c = xb_ld(&bar[XB_XCNT(j)]); sum += c; cnt += (c > 0u) ? 1u : 0u; mine = (j == x) ? c : mine; }
        if (sum == G) break;
        __builtin_amdgcn_s_sleep(1);
        if ((++sp & 255u) == 0u) { if (xb_ld(&bar[XB_TMO])) break; if (sp > XB_SPIN_CAP) { atomicAdd(&bar[XB_TMO], 1u); break; } }
    }
    nloc = mine > 0u ? mine : 1u; nx = cnt > 0u ? cnt : 1u;
}

__device__ __forceinline__ void xcd_barrier(const XcdBarrier& b) {
    asm volatile("s_waitcnt vmcnt(0)" ::: "memory");
    __syncthreads();
    if (threadIdx.x == 0) {
        unsigned* bar = b.bar;
        __builtin_amdgcn_s_waitcnt(0);
        unsigned nloc = b.st[0], nx = b.st[1];
        if (nloc == 0u) { xcd_barrier_complete(bar, b.x, nloc, nx); b.st[0] = nloc; b.st[1] = nx; }
        const unsigned old = xb_add(&bar[XB_XSUB(b.x)], 1u);
        const unsigned gen = old / nloc;
        if (old + 1u == (gen + 1u) * nloc) {
            __builtin_amdgcn_fence(__ATOMIC_RELEASE, "agent");
            asm volatile("s_waitcnt vmcnt(0)" ::: "memory");
            const unsigned og = xb_add(&bar[XB_TOP], 1u);
            const unsigned tg = og / nx;
            if (og + 1u == (tg + 1u) * nx) xb_add(&bar[XB_TOPGEN], 1u);
            else XB_SPIN(xb_ld(&bar[XB_TOPGEN]) == tg, bar);
            __builtin_amdgcn_fence(__ATOMIC_ACQUIRE, "agent");
            xb_add(&bar[XB_XGEN(b.x)], 1u);
            asm volatile("s_waitcnt vmcnt(0)" ::: "memory");
        } else {
            XB_SPIN(xb_ld(&bar[XB_XGEN(b.x)]) == gen, bar);
            __builtin_amdgcn_fence(__ATOMIC_ACQUIRE, "agent");
            asm volatile("s_waitcnt vmcnt(0)" ::: "memory");
        }
    }
    __syncthreads();
}

constexpr int NWAVES = 8;
constexpr int LDS_BYTES = 147456;
constexpr int MISC_OFF = 146432;

struct Args {
    const float *x, *g_mix, *w_in, *g_cq, *w_uq, *g_ckv, *w_ukv, *w_out, *g_ffn, *w_pq, *sub_keys, *u_emb, *v_emb, *g_final;
    const int* pos; float* out; unsigned char* ws; int ph_lo, ph_hi; unsigned probe_mask; int probe_shift;
};

__device__ __forceinline__ void p0_transpose_item(const float* __restrict__ W, int K, int N, const float* __restrict__ gk, bf16_t* __restrict__ WT, LAS float* scr, int item, int lane) {
    const int nblk = N / 32, kb = item / nblk, nb = item % nblk, k0 = 64 * kb, n0 = 32 * nb;
    float wv[32];
#pragma unroll
    for (int i = 0; i < 32; ++i) { const int kk = 2 * i + (lane >> 5); wv[i] = W[(size_t)(k0 + kk) * N + n0 + (lane & 31)]; if (gk) wv[i] *= gk[k0 + kk]; }
#pragma unroll
    for (int i = 0; i < 32; ++i) { const int kk = 2 * i + (lane >> 5); scr[kk * 33 + (lane & 31)] = wv[i]; }
    asm volatile("s_waitcnt lgkmcnt(0)" ::: "memory");
    const int c = lane & 7;
#pragma unroll
    for (int j = 0; j < 4; ++j) { const int n = (lane >> 3) + 8 * j; const LAS float* s = scr + (8 * c) * 33 + n;
        u32x4 o; o.x = pk_bf16(s[0 * 33], s[1 * 33]); o.y = pk_bf16(s[2 * 33], s[3 * 33]); o.z = pk_bf16(s[4 * 33], s[5 * 33]); o.w = pk_bf16(s[6 * 33], s[7 * 33]);
        *(u32x4*)(WT + (size_t)(n0 + n) * K + k0 + 8 * c) = o; }
    asm volatile("s_waitcnt lgkmcnt(0)" ::: "memory");
}
__device__ __forceinline__ bf16x8 cvt8(const float* p, float s) { const f32x4 a = *(const f32x4*)p, b = *(const f32x4*)(p + 4); u32x4 w; w.x = pk_bf16(a.x * s, a.y * s); w.y = pk_bf16(a.z * s, a.w * s); w.z = pk_bf16(b.x * s, b.y * s); w.w = pk_bf16(b.z * s, b.w * s); return __builtin_bit_cast(bf16x8, w); }
__device__ __forceinline__ void p0_wcomb_item(const float* __restrict__ keys, const float* __restrict__ w_pq, const float* __restrict__ g_ffn, bf16_t* __restrict__ Wc, int item, int lane) {
    const int hp = item >> 7, nblk = (item >> 5) & 3, kblk = item & 31, n0 = 32 * nblk, k0 = 32 * kblk, r32 = lane & 31, hi = lane >> 5;
    const float* ar = keys + ((size_t)hp * 128 + n0 + r32) * 128 + 8 * hi;
    const float* br = w_pq + (size_t)(k0 + r32) * 2048 + hp * 128 + 8 * hi;
    const float gk = g_ffn[k0 + r32];
    f32x16 d = {};
#pragma unroll
    for (int cs = 0; cs < 8; ++cs) d = __builtin_amdgcn_mfma_f32_32x32x16_bf16(cvt8(ar + 16 * cs, 1.f), cvt8(br + 16 * cs, 1.f), d, 0, 0, 0);
#pragma unroll
    for (int r = 0; r < 16; ++r) Wc[((size_t)hp * 128 + n0 + crow(r, hi)) * DM + k0 + r32] = (bf16_t)(pk_bf16(d[r] * gk, 0.f) & 0xffffu);
}
__device__ __forceinline__ void p0_prologue(const Args& a, LAS unsigned char* lds, int gw, int ngw, int lane, int wave) {
    unsigned char* ws = a.ws;
    LAS float* scr = (LAS float*)(lds + wave * 16384);
    bf16_t* Wt_in = (bf16_t*)(ws + WS_WIN); bf16_t* Wt_comb = (bf16_t*)(ws + WS_WCOMB); bf16_t* Wt_out = (bf16_t*)(ws + WS_WOUT); bf16_t* Wt_uq = (bf16_t*)(ws + WS_WUQ); bf16_t* Wt_ukv = (bf16_t*)(ws + WS_WUKV);
    constexpr int I_IN = (DM / 64) * (INW / 32), I_UQ = (256 / 64) * (768 / 32), I_UKV = (128 / 64) * (1024 / 32), I_OUT = (DM / 64) * (DM / 32), I_WC = 2048;
    constexpr int NITEMS = I_IN + I_UQ + I_UKV + I_OUT + I_WC;
    for (int it = gw; it < NITEMS; it += ngw) {
        int r = it;
        if (r < I_IN) { p0_transpose_item(a.w_in, DM, INW, nullptr, Wt_in, scr, r, lane); continue; } r -= I_IN;
        if (r < I_UQ) { p0_transpose_item(a.w_uq, 256, 768, a.g_cq, Wt_uq, scr, r, lane); continue; } r -= I_UQ;
        if (r < I_UKV) { p0_transpose_item(a.w_ukv, 128, 1024, a.g_ckv, Wt_ukv, scr, r, lane); continue; } r -= I_UKV;
        if (r < I_OUT) { p0_transpose_item(a.w_out, DM, DM, nullptr, Wt_out, scr, r, lane); continue; } r -= I_OUT;
        p0_wcomb_item(a.sub_keys, a.w_pq, a.g_ffn, Wt_comb, r, lane);
    }
    const int gt = gw * 64 + lane, ngt = ngw * 64;
    for (int i = gt; i < (2048 - INW) * DM / 8; i += ngt) *(u32x4*)(Wt_in + (size_t)INW * DM + (size_t)i * 8) = (u32x4){0u, 0u, 0u, 0u};
    { bf16_t* HN = (bf16_t*)(ws + WS_HN);
      const f32x4* gr = (const f32x4*)a.g_mix + lane;
      const f32x4 g0 = gr[0], g1 = gr[64], g2 = gr[128], g3 = gr[192];
      for (int m0 = 4 * gw; m0 < T; m0 += 4 * ngw) {
          f32x4 v[4][4];
#pragma unroll
          for (int r = 0; r < 4; ++r) { const f32x4* xr = (const f32x4*)(a.x + (size_t)(m0 + r) * DM) + lane; v[r][0] = xr[0]; v[r][1] = xr[64]; v[r][2] = xr[128]; v[r][3] = xr[192]; }
#pragma unroll
          for (int r = 0; r < 4; ++r) {
              float s = 0.f;
#pragma unroll
              for (int j = 0; j < 4; ++j) s += (v[r][j].x * v[r][j].x + v[r][j].y * v[r][j].y) + (v[r][j].z * v[r][j].z + v[r][j].w * v[r][j].w);
              const float rstd = 1.0f / sqrtf(wave_sum(s) * (1.f / DM) + EPS);
              u32x2* o8 = (u32x2*)(HN + (size_t)(m0 + r) * DM) + lane;
              u32x2 w;
              w.x = pk_bf16(v[r][0].x * rstd * g0.x, v[r][0].y * rstd * g0.y); w.y = pk_bf16(v[r][0].z * rstd * g0.z, v[r][0].w * rstd * g0.w); o8[0] = w;
              w.x = pk_bf16(v[r][1].x * rstd * g1.x, v[r][1].y * rstd * g1.y); w.y = pk_bf16(v[r][1].z * rstd * g1.z, v[r][1].w * rstd * g1.w); o8[64] = w;
              w.x = pk_bf16(v[r][2].x * rstd * g2.x, v[r][2].y * rstd * g2.y); w.y = pk_bf16(v[r][2].z * rstd * g2.z, v[r][2].w * rstd * g2.w); o8[128] = w;
              w.x = pk_bf16(v[r][3].x * rstd * g3.x, v[r][3].y * rstd * g3.y); w.y = pk_bf16(v[r][3].z * rstd * g3.z, v[r][3].w * rstd * g3.w); o8[192] = w;
          } } }
    { float* cosA = (float*)(ws + WS_COSA); float* sinA = (float*)(ws + WS_SINA); float* cosM = (float*)(ws + WS_COSM); float* sinM = (float*)(ws + WS_SINM);
      constexpr float INV16[16] = {1.0f, 0.44036659598350525f, 0.1939227432012558f, 0.08539710193872452f, 0.03760603070259094f, 0.016560440883040428f, 0.007292664609849453f, 0.0032114461064338684f,
                                   0.0014142135623842478f, 0.0006227724370546639f, 0.00027424818836152554f, 0.00012076973507646471f, 5.3182957344688475e-05f, 2.34199997066753e-05f, 1.0313385246263351e-05f, 4.541670477919979e-06f};
      for (int i = gt; i < T * 16; i += ngt) {
          const int tok = i >> 4, j = i & 15;
          const float ang = (float)a.pos[tok] * INV16[j];
          float sn, cs; sincosf(ang, &sn, &cs);
          cosM[tok * 16 + j] = cs; sinM[tok * 16 + j] = sn;
          if ((j & 1) == 0) { cosA[tok * 8 + (j >> 1)] = cs; sinA[tok * 8 + (j >> 1)] = sn; } } }
}

__global__ void __launch_bounds__(NWAVES * 64, 2) mk_fwd(Args a) {
    extern __shared__ __attribute__((aligned(16))) unsigned char lds_raw[];
    LAS unsigned char* lds = (LAS unsigned char*)lds_raw;
    volatile LAS unsigned* MISC = (volatile LAS unsigned*)(lds + MISC_OFF);
    const int tid = threadIdx.x, lane = tid & 63, wave = __builtin_amdgcn_readfirstlane(tid >> 6);
    const int G = gridDim.x, bx = blockIdx.x, vcu = (G % 8 == 0) ? (bx % 8) * (G / 8) + bx / 8 : bx;
    unsigned char* ws = a.ws;
    for (int u = tid; u < 64; u += NWAVES * 64) MISC[u] = 0u;
    __syncthreads();
    XcdBarrier bar = xcd_barrier_post((unsigned*)(ws + WS_CTL), MISC + 8);
    const int lo = a.ph_lo, hi = a.ph_hi;
#ifdef PROBE_LO
#define PMASK a.probe_mask
#else
#define PMASK 0xffffu
#endif
#define IN(k) (lo <= (k) && (k) < hi)
#ifdef PROBE_LO
#define RUN(k) (IN(k) && !(a.probe_shift & 16))
#else
#define RUN(k) IN(k)
#endif
#define SEAM(k) do { if (IN(k) && IN((k) + 1)) xcd_barrier(bar); } while (0)
    const int gw = vcu * NWAVES + wave, ngw = G * NWAVES;

    if (RUN(0)) { p0_prologue(a, lds, gw, ngw, lane, wave); }
    SEAM(0);
    if (RUN(1)) {
        pg8::Gemm g{(const bf16_t*)(ws + WS_HN), (const bf16_t*)(ws + WS_WIN), T, 2048, DM}; pg8::StaticOrder S; S.init(T, 2048, G, bx);
        pg8::EpiProj E{(bf16_t*)(ws + WS_QA), (bf16_t*)(ws + WS_KA), (bf16_t*)(ws + WS_VA), (bf16_t*)(ws + WS_CQ), (bf16_t*)(ws + WS_CKV), (bf16_t*)(ws + WS_KR),
                       (float*)(ws + WS_SSQQ), (float*)(ws + WS_SSQKV), (const float*)(ws + WS_COSA), (const float*)(ws + WS_SINA), (const float*)(ws + WS_COSM), (const float*)(ws + WS_SINM)};
        pg8::gemm_phase<pg8::EpiProj, pg8::StaticOrder, true, true>(lds, g, S, E);
    }
    SEAM(1);
    if (RUN(2)) {
        { int kk = 128; asm volatile("" : "+s"(kk));
          pg8::Gemm g{(const bf16_t*)(ws + WS_CKV), (const bf16_t*)(ws + WS_WUKV), T, 1024, kk}; pg8::StaticOrder S; S.init(T, 1024, G, bx);
          pg8::EpiKv E{(bf16_t*)(ws + WS_KN), (bf16_t*)(ws + WS_VM), (const float*)(ws + WS_SSQKV)};
          pg8::gemm_phase<pg8::EpiKv, pg8::StaticOrder, true, true>(lds, g, S, E); }
        __syncthreads();
        { int kk = 256; asm volatile("" : "+s"(kk));
          pg8::Gemm g{(const bf16_t*)(ws + WS_CQ), (const bf16_t*)(ws + WS_WUQ), T, 768, kk}; pg8::StaticOrder S; S.init(T, 768, G, bx);
          pg8::EpiQm E{(bf16_t*)(ws + WS_QM), (const float*)(ws + WS_SSQQ), (const float*)(ws + WS_COSM), (const float*)(ws + WS_SINM)};
          pg8::gemm_phase<pg8::EpiQm, pg8::StaticOrder, true, true>(lds, g, S, E); }
    }
    SEAM(2);
    if (RUN(3)) {
        if (!(a.probe_shift & 1)) for (int pr = vcu; pr < 256; pr += G) {
            const int bh = pr >> 4, s = pr & 15;
            att::mla_unit(lds, (const bf16_t*)(ws + WS_QM), (const bf16_t*)(ws + WS_KN), (const bf16_t*)(ws + WS_KR), (const bf16_t*)(ws + WS_VM), (bf16_t*)(ws + WS_MIXED), bh >> 3, bh & 7, 31 - s,
                          a.u_emb, a.v_emb, a.g_ffn, ws + WS_U8, ws + WS_V8, pr * 528);
            att::mla_unit(lds, (const bf16_t*)(ws + WS_QM), (const bf16_t*)(ws + WS_KN), (const bf16_t*)(ws + WS_KR), (const bf16_t*)(ws + WS_VM), (bf16_t*)(ws + WS_MIXED), bh >> 3, bh & 7, s,
                          a.u_emb, a.v_emb, a.g_ffn, ws + WS_U8, ws + WS_V8, pr * 528 + 16 * (32 - s));
        }
        if (!(a.probe_shift & 2)) for (int sg = vcu; sg < 256; sg += G)
            att::dil_segment(lds, (const bf16_t*)(ws + WS_QA), (const bf16_t*)(ws + WS_KA), (const bf16_t*)(ws + WS_VA), (bf16_t*)(ws + WS_MIXED), sg, wave, lane, a.probe_shift);
    }
    SEAM(3);
    if (RUN(4)) {
        pg8::Gemm g{(const bf16_t*)(ws + WS_MIXED), (const bf16_t*)(ws + WS_WOUT), T, DM, DM}; pg8::StaticOrder S; S.init(T, DM, G, bx);
        pg8::EpiOut E{a.x, (bf16_t*)(ws + WS_HB), ws + WS_HB8, (float*)(ws + WS_SSQH)};
        pg8::gemm_phase<pg8::EpiOut, pg8::StaticOrder, true, true>(lds, g, S, E);
    }
    SEAM(4);
    if (RUN(5)) {
        pg8::Gemm g{(const bf16_t*)(ws + WS_HB), (const bf16_t*)(ws + WS_WCOMB), T, 2048, DM}; pg8::StaticOrder S; S.init(T, 2048, G, bx);
        pg8::EpiSc E{(bf16_t*)(ws + WS_SC), (const float*)(ws + WS_SSQH)};
        pg8::gemm_phase<pg8::EpiSc, pg8::StaticOrder, true, true>(lds, g, S, E);
    }
    SEAM(5);
    if (RUN(6)) {
        peer2::topk_phase(lds, (const bf16_t*)(ws + WS_SC), (const float*)(ws + WS_SSQH), (unsigned short*)(ws + WS_PESLOT), (unsigned short*)(ws + WS_PEROW), (float*)(ws + WS_PG), (float*)(ws + WS_RSTDH), gw, ngw);
    }
    SEAM(6);
    const int sx = bx % 8, smem = (bx / 8) * NWAVES + wave, scnt = ((G - sx + 7) / 8) * NWAVES;
#ifdef PROBE_LO
    if (RUN(7) && (a.probe_shift & 8)) { peer2::u_phase<1>(lds, ws + WS_HB8, ws + WS_U8, (const unsigned short*)(ws + WS_PEROW), (bf16_t*)(ws + 160 * MiB), sx, smem, scnt, PMASK); } else
#endif
    if (RUN(7)) { peer2::u_phase(lds, ws + WS_HB8, ws + WS_U8, (const unsigned short*)(ws + WS_PEROW), (bf16_t*)(ws + WS_ZP), sx, smem, scnt, PMASK); }
    SEAM(7);
    if (RUN(8)) { peer2::act_phase(lds, (const bf16_t*)(ws + WS_ZP), (const unsigned short*)(ws + WS_PESLOT), (const float*)(ws + WS_PG), (const float*)(ws + WS_SSQH), (unsigned short*)(ws + WS_PE2), ws + WS_PA2, gw, ngw); }
    SEAM(8);
#ifdef PROBE_LO
    if (RUN(9) && (a.probe_shift & 128)) { peer2::v_phase<2>(lds, ws + WS_V8, (const unsigned short*)(ws + WS_PE2), ws + WS_PA2, (bf16_t*)(ws + 160 * MiB), sx, smem, scnt, PMASK); } else
    if (RUN(9) && (a.probe_shift & 4)) { peer2::v_phase<1>(lds, ws + WS_V8, (const unsigned short*)(ws + WS_PE2), ws + WS_PA2, (bf16_t*)(ws + WS_OP), sx, smem, scnt, PMASK); } else
#endif
    if (RUN(9)) { peer2::v_phase(lds, ws + WS_V8, (const unsigned short*)(ws + WS_PE2), ws + WS_PA2, (bf16_t*)(ws + WS_OP), sx, smem, scnt, PMASK); }
    SEAM(9);
    if (RUN(10)) { peer2::final_phase(a.out, (const bf16_t*)(ws + WS_HB), (const bf16_t*)(ws + WS_OP), a.g_final, gw, ngw); }
#undef IN
#undef RUN
#undef SEAM
}


#ifndef STAGE
#define STAGE 6
#endif
extern "C" void kernel_launch(void* const* d_in, const int* in_sizes, int n_in, void* d_out, int out_size, void* d_ws, size_t ws_size, hipStream_t stream) {
    static int grid = 0;
    if (grid == 0) {
        if (n_in != 15 || out_size != T * DM || ws_size < 256 * MiB) { fprintf(stderr, "kernel_launch: unexpected problem shape (n_in %d, out %d, ws %zu); nothing launched\n", n_in, out_size, ws_size); grid = -1; return; }
        int dev = 0, cus = 0, per_cu = 0;
        if (hipGetDevice(&dev) != hipSuccess || hipDeviceGetAttribute(&cus, hipDeviceAttributeMultiprocessorCount, dev) != hipSuccess) { grid = -1; return; }
        if (hipFuncSetAttribute((const void*)mk_fwd, hipFuncAttributeMaxDynamicSharedMemorySize, LDS_BYTES) != hipSuccess) { fprintf(stderr, "kernel_launch: hipFuncSetAttribute failed\n"); grid = -1; return; }
        if (hipOccupancyMaxActiveBlocksPerMultiprocessor(&per_cu, (const void*)mk_fwd, NWAVES * 64, LDS_BYTES) != hipSuccess || per_cu < 1) fprintf(stderr, "kernel_launch: note: occupancy query says %d workgroups per CU\n", per_cu);
        (void)hipGetLastError();
        grid = cus;
        if (grid < 8) { fprintf(stderr, "kernel_launch: %d CUs: the PEER slice phases need a grid of at least 8 workgroups; nothing launched\n", grid); grid = -1; return; }
    }
    if (grid < 0) return;
    unsigned char* ws = (unsigned char*)d_ws;
    (void)hipMemsetAsync(ws + WS_CTL, 0, CTL_ZERO_BYTES, stream);
    Args a{};
    a.x = (const float*)d_in[0]; a.pos = (const int*)d_in[1]; a.g_mix = (const float*)d_in[2]; a.w_in = (const float*)d_in[3]; a.g_cq = (const float*)d_in[4]; a.w_uq = (const float*)d_in[5];
    a.g_ckv = (const float*)d_in[6]; a.w_ukv = (const float*)d_in[7]; a.w_out = (const float*)d_in[8]; a.g_ffn = (const float*)d_in[9]; a.w_pq = (const float*)d_in[10]; a.sub_keys = (const float*)d_in[11];
    a.u_emb = (const float*)d_in[12]; a.v_emb = (const float*)d_in[13]; a.g_final = (const float*)d_in[14];
    a.out = (float*)d_out; a.ws = ws; a.ph_lo = 0; a.ph_hi = (STAGE >= 6) ? 11 : STAGE + 1; a.probe_mask = 0xffffu; a.probe_shift = 0;
#if defined(PROBE_LO) && PROBE_LO == 3
    { Args b1 = a; b1.ph_hi = 4; b1.probe_shift = PROBE_SHIFT; hipLaunchKernelGGL(mk_fwd, dim3(grid), dim3(NWAVES * 64), LDS_BYTES, stream, b1);
      (void)hipMemsetAsync(ws + WS_CTL, 0, CTL_ZERO_BYTES, stream); a.ph_lo = 3; }
#endif
    hipLaunchKernelGGL(mk_fwd, dim3(grid), dim3(NWAVES * 64), LDS_BYTES, stream, a);
#if defined(PROBE_LO) && PROBE_LO != 3
#if 0
#else
    { Args b2 = a; b2.ph_lo = PROBE_LO; b2.ph_hi = PROBE_HI; b2.probe_shift = PROBE_SHIFT; b2.probe_mask = PROBE_MASK; (void)hipMemsetAsync(ws + WS_CTL, 0, CTL_ZERO_BYTES, stream); hipLaunchKernelGGL(mk_fwd, dim3(grid), dim3(NWAVES * 64), LDS_BYTES, stream, b2); }
#endif
#endif
#if STAGE < 6
    float* out = (float*)d_out; float* mixed = out;
    const size_t MB = MiB;
#if STAGE == 2
    {
        float* q32 = (float*)(ws + 0 * MB); float* k32 = (float*)(ws + 32 * MB); float* v32 = (float*)(ws + 64 * MB);
        const long n = (long)T * 512;
        nv::k_cvt<<<(int)((n + 255) / 256), 256, 0, stream>>>((const bf16_t*)(ws + WS_QA), q32, n, 1.0f / LOG2E);
        nv::k_cvt<<<(int)((n + 255) / 256), 256, 0, stream>>>((const bf16_t*)(ws + WS_KA), k32, n, 1.0f);
        nv::k_cvt<<<(int)((n + 255) / 256), 256, 0, stream>>>((const bf16_t*)(ws + WS_VA), v32, n, 1.0f);
        nv::k_dilated<<<T * 8 / 4, 256, 0, stream>>>(q32, k32, v32, mixed);
        float* qm32 = (float*)(ws + 112 * MB);
        const long nq = (long)T * 768;
        nv::k_cvt<<<(int)((nq + 255) / 256), 256, 0, stream>>>((const bf16_t*)(ws + WS_QM), qm32, nq, 1.0f / LOG2E);
        float* Kt = (float*)(ws + 0 * MB); float* Vt = Kt + (size_t)NB * 8 * 96 * SEQ;
        nv::k_build_ktvt<<<(int)(((long)NB * 8 * 160 * SEQ + 255) / 256), 256, 0, stream>>>((const bf16_t*)(ws + WS_KN), (const bf16_t*)(ws + WS_VM), (const bf16_t*)(ws + WS_KR), Kt, Vt);
        nv::k_mla<<<NB * 8 * (SEQ / 4), 256, 0, stream>>>(qm32, Kt, Vt, mixed);
    }
#elif STAGE == 3
    { const long n = (long)T * DM; nv::k_cvt<<<(int)((n + 255) / 256), 256, 0, stream>>>((const bf16_t*)(ws + WS_MIXED), mixed, n, 1.0f); }
#endif
    float* hbuf = (float*)(ws + 192 * MB); float* rstd_h = (float*)(ws + 180 * MB);
#if STAGE <= 3
    nv::k_gemm<<<dim3(DM / 64, T / 64), 256, 0, stream>>>(mixed, DM, nullptr, nullptr, a.w_out, DM, hbuf, DM, T, DM, DM, a.x, DM);
#else
    (void)hipMemcpyAsync(hbuf, out, (size_t)T * DM * 4, hipMemcpyDeviceToDevice, stream);
#endif
    float* qp = (float*)(ws + 0 * MB);
    float* vals = (float*)(ws + 128 * MB); int* idxs = (int*)(ws + 145 * MB); int* expert = (int*)(ws + 162 * MB); float* gate = (float*)(ws + 171 * MB);
    nv::k_rstd<<<T / 4, 256, 0, stream>>>(hbuf, DM, DM, rstd_h, T);
    nv::k_gemm<<<dim3(2048 / 64, T / 64), 256, 0, stream>>>(hbuf, DM, rstd_h, a.g_ffn, a.w_pq, 2048, qp, 2048, T, 2048, DM, nullptr, 0);
    (void)hipFuncSetAttribute((const void*)nv::k_topk1, hipFuncAttributeMaxDynamicSharedMemorySize, 65536);
    nv::k_topk1<<<dim3(T / 256, 16), 256, 65536, stream>>>(qp, a.sub_keys, vals, idxs);
    nv::k_topk2<<<T * 8 / 256, 256, 0, stream>>>(vals, idxs, expert, gate);
    nv::k_peer_final<<<T / 4, 256, 0, stream>>>(hbuf, rstd_h, a.g_ffn, a.u_emb, a.v_emb, expert, gate, a.g_final, out);
#endif
}
```

```cpp
#include <hip/hip_runtime.h>
#include <hip/hip_bf16.h>
#include <math.h>
#include <stdio.h>
#include <stdint.h>

#define LAS __attribute__((address_space(3)))
#define GAS __attribute__((address_space(1)))
typedef unsigned short bf16_t;
typedef short bf16x8 __attribute__((ext_vector_type(8)));
typedef short s16x4 __attribute__((ext_vector_type(4)));
typedef float f32x2 __attribute__((ext_vector_type(2)));
typedef float f32x4 __attribute__((ext_vector_type(4)));
typedef float f32x16 __attribute__((ext_vector_type(16)));
typedef unsigned u32x2 __attribute__((ext_vector_type(2)));
typedef unsigned u32x4 __attribute__((ext_vector_type(4)));
typedef __bf16 bf16x2_t __attribute__((ext_vector_type(2)));
typedef _Float16 f16x2_t __attribute__((ext_vector_type(2)));
typedef int v8i __attribute__((ext_vector_type(8)));

constexpr int DM = 1024, NB = 2, SEQ = 8192, T = NB * SEQ;
constexpr int INW = 1952;
constexpr float EPS = 1e-6f;
constexpr float LOG2E = 1.4426950408889634f;
constexpr float QA_SCALE = 0.125f * LOG2E;
constexpr float QM_SCALE = 0.10206207261596577f * LOG2E;

constexpr size_t MiB = 1u << 20;
constexpr size_t WS_CTL = 0, CTL_ZERO_BYTES = 64 * 1024;
constexpr size_t WS_COSA = 1 * MiB, WS_SINA = WS_COSA + 512 * 1024, WS_COSM = 2 * MiB, WS_SINM = 3 * MiB;
constexpr size_t WS_WIN = 4 * MiB, WS_WCOMB = 8 * MiB, WS_WOUT = 12 * MiB, WS_WUQ = 14 * MiB, WS_WUKV = 14 * MiB + 512 * 1024;
constexpr size_t WS_SSQQ = 15 * MiB, WS_SSQKV = 15 * MiB + 512 * 1024;
constexpr size_t WS_U8 = 16 * MiB, WS_V8 = 32 * MiB;
constexpr size_t WS_HN = 80 * MiB, WS_MIXED = 80 * MiB;
constexpr size_t WS_QA = 112 * MiB, WS_KA = 128 * MiB, WS_VA = 144 * MiB;
constexpr size_t WS_CQ = 160 * MiB, WS_CKV = 168 * MiB, WS_KR = 172 * MiB;
constexpr size_t WS_QM = 176 * MiB, WS_KN = 200 * MiB, WS_VM = 216 * MiB;
constexpr size_t WS_SSQH = 232 * MiB;
constexpr size_t WS_HB = 112 * MiB, WS_SC = 144 * MiB;
constexpr size_t WS_HB8 = 208 * MiB;
constexpr size_t WS_ZP = 48 * MiB, WS_PEROW = 80 * MiB, WS_PESLOT = 84 * MiB, WS_PG = 88 * MiB, WS_SSQY = 96 * MiB, WS_RSTDH = 97 * MiB, WS_PE2 = 176 * MiB, WS_PA2 = 180 * MiB;
constexpr size_t WS_OP = 144 * MiB;
constexpr float SU = 64.f, SX = 16.f, SV = 64.f;
constexpr size_t WS_END = 234 * MiB;
static_assert(WS_KA == WS_QA + 16 * MiB && WS_VA == WS_KA + 16 * MiB && WS_VM == WS_KN + 16 * MiB, "epilogues address Ka/Va and Vm relative to Qa and Kn");

__device__ __forceinline__ unsigned pk_bf16(float lo, float hi) { f32x2 v = {lo, hi}; bf16x2_t b = __builtin_convertvector(v, bf16x2_t); return __builtin_bit_cast(unsigned, b); }
__device__ __forceinline__ unsigned pk_f16(float lo, float hi) { f32x2 v = {lo, hi}; f16x2_t b = __builtin_convertvector(v, f16x2_t); return __builtin_bit_cast(unsigned, b); }
__device__ __forceinline__ unsigned pk_fp8x4(float a, float b, float c, float d) { int w = __builtin_amdgcn_cvt_pk_fp8_f32(a, b, 0, false); w = __builtin_amdgcn_cvt_pk_fp8_f32(c, d, w, true); return (unsigned)w; }
__device__ __forceinline__ float bf_lo(unsigned w) { return __builtin_bit_cast(float, w << 16); }
__device__ __forceinline__ float bf_hi(unsigned w) { return __builtin_bit_cast(float, w & 0xffff0000u); }
__device__ __forceinline__ float wave_sum(float v) {
#pragma unroll
    for (int o = 1; o < 64; o <<= 1) v += __shfl_xor(v, o);
    return v;
}
__device__ __forceinline__ int crow(int r, int hi) { return (r & 3) + 8 * (r >> 2) + 4 * hi; }
__device__ __forceinline__ void glds16(const void* gsrc, unsigned lds_dst) { unsigned keep;
    asm volatile("s_mov_b32 %0, m0\n\ts_mov_b32 m0, %2\n\ts_nop 0\n\tglobal_load_lds_dwordx4 %1, off\n\ts_mov_b32 m0, %0" : "=&s"(keep) : "v"(gsrc), "s"(lds_dst) : "memory"); }

#define STAGE 6


namespace pg8 {
#define PG8_LAS __attribute__((address_space(3)))
typedef unsigned short bf16_t;
typedef short bf16x8 __attribute__((ext_vector_type(8)));
typedef float f32x4 __attribute__((ext_vector_type(4)));
typedef unsigned u32x4 __attribute__((ext_vector_type(4)));
constexpr int BM = 256, BK = 64, HALF = 128, HTB = HALF * BK * 2  , STAGE_BYTES = 8 * HTB, NXCD = 8, WGM = 8;

__host__ __device__ __forceinline__ int lds_byte(int r, int c) { const int st = (r >> 4) * 2 + (c >> 5), rr = r & 15, cc = c & 31, ob = rr * 64 + cc * 2; return st * 1024 + (ob ^ (((ob >> 9) & 1) << 5)); }
__host__ __device__ __forceinline__ void stage_rc(int b, int& R, int& C) { const int st = b / 1024, sb = b % 1024, swz = sb ^ (((sb >> 9) & 1) << 5); R = (st >> 1) * 16 + swz / 64; C = (st & 1) * 32 + (swz % 64) / 2; }
__host__ __device__ __forceinline__ int perm32(int rho) { const int n = rho >> 4, i = rho & 15; return 8 * (i >> 2) + 4 * n + (i & 3); }

struct Unit { int pm, pn; };
struct Gemm { const bf16_t* A; const bf16_t* Bt; int M, N, K; };

struct StaticOrder {
    int nM, nN, nwg, G, c;
    __host__ __device__ void init(int M, int N, int G_, int c_) { nM = M / BM; nN = N / BM; nwg = nM * nN; G = G_; c = c_; }
    __host__ __device__ bool next(int i, Unit& u) const {
        const long L = (long)i * G + c; if (L >= nwg) return false;
        int wgid = (int)L; { const int q = nwg / NXCD, r = nwg % NXCD, xcd = wgid % NXCD, off = wgid / NXCD; wgid = (xcd < r ? xcd * (q + 1) : r * (q + 1) + (xcd - r) * q) + off; }
        const int nig = WGM * nN, gid = wgid / nig, fm = gid * WGM, gsz = (nM - fm) < WGM ? (nM - fm) : WGM;
        u.pm = fm + ((wgid % nig) % gsz); u.pn = (wgid % nig) / gsz; return true;
    }
    __device__ __forceinline__ void a_ready(const Unit&) const {}
    __device__ __forceinline__ void done(const Unit&) const {}
};


__device__ __forceinline__ unsigned cvt_pk_bf16(float lo, float hi) { unsigned r; asm volatile("v_cvt_pk_bf16_f32 %0, %1, %2" : "=v"(r) : "v"(lo), "v"(hi)); return r; }
typedef float f32x2 __attribute__((ext_vector_type(2)));

__device__ __forceinline__ void load8(const float* p, float (&o)[8]);

template <class Epi, class Sched, bool ALIGN_EPI = false, bool SP2 = false>
__device__ __forceinline__ void gemm_phase(PG8_LAS unsigned char* lds, const Gemm g, const Sched& S, const Epi& E) {
    const int tid = threadIdx.x, wid = __builtin_amdgcn_readfirstlane(tid >> 6), lane = tid & 63, wr = wid >> 2, wc = wid & 3, fr = lane & 15, fq = lane >> 4;
    const int K = g.K, nt = K / BK;
    unsigned voffA[2], voffB[2];
#pragma unroll
    for (int i = 0; i < 2; ++i) { int R, C; stage_rc(tid * 16 + i * 8192, R, C); const int Rb = Epi::PERM ? ((R & ~31) + perm32(R & 31)) : R;
        voffA[i] = (unsigned)(R * K + C) * 2u; voffB[i] = (unsigned)(Rb * K + C) * 2u; }
    const size_t kstep = (size_t)(BK * 2);
    const size_t hstep = (size_t)HALF * K * 2;
    const size_t tstep = 2 * hstep;
    const unsigned ldsw = (unsigned)wid * 1024u;
    const int aoff = lds_byte(wr * 64 + fr, fq * 8), boff = lds_byte(wc * 32 + fr, fq * 8);
#define PG8_SA(b, h) (((b) * 2 + (h)) * HTB)
#define PG8_SB(b, h) ((4 + (b) * 2 + (h)) * HTB)
#define PG8_STAGE(bufoff, gbase, voff) do { _Pragma("unroll") for (int _i = 0; _i < 2; ++_i) \
        __builtin_amdgcn_global_load_lds((const unsigned*)((const char*)(gbase) + (voff)[_i]), (PG8_LAS unsigned*)(lds + (bufoff) + ldsw + _i * 8192), 16, 0, 0); } while (0)
#define PG8_LDA(dst, b, h) do { _Pragma("unroll") for (int m = 0; m < 4; ++m) _Pragma("unroll") for (int k = 0; k < 2; ++k) dst[m][k] = *(const PG8_LAS bf16x8*)(lds + PG8_SA(b, h) + aoff + m * 2048 + k * 1024); } while (0)
#define PG8_LDB(dst, b, h) do { _Pragma("unroll") for (int n = 0; n < 2; ++n) _Pragma("unroll") for (int k = 0; k < 2; ++k) dst[n][k] = *(const PG8_LAS bf16x8*)(lds + PG8_SB(b, h) + boff + n * 2048 + k * 1024); } while (0)
#define PG8_MMA(ai, bj, At, Bt) do { __builtin_amdgcn_s_setprio(1); _Pragma("unroll") for (int m = 0; m < 4; ++m) _Pragma("unroll") for (int n = 0; n < 2; ++n) _Pragma("unroll") for (int k = 0; k < 2; ++k) \
        acc[ai][bj][m][n] = __builtin_amdgcn_mfma_f32_16x16x32_bf16(Bt[n][k], At[m][k], acc[ai][bj][m][n], 0, 0, 0); __builtin_amdgcn_s_setprio(0); } while (0)
#define PG8_WAIT_V(n) asm volatile("s_waitcnt vmcnt(" #n ")" ::: "memory")
#define PG8_WAIT_L(n) asm volatile("s_waitcnt lgkmcnt(" #n ")" ::: "memory")
#define PG8_BAR __builtin_amdgcn_s_barrier()
#define PG8_SCHED __builtin_amdgcn_sched_barrier(0)
    Unit cur, nxt; int ui = 0;
    if (!S.next(0, cur)) return;
    f32x4 acc[2][2][4][2];
#pragma unroll
    for (int a = 0; a < 2; ++a)
#pragma unroll
        for (int b = 0; b < 2; ++b)
#pragma unroll
            for (int m = 0; m < 4; ++m)
#pragma unroll
                for (int n = 0; n < 2; ++n) acc[a][b][m][n] = (f32x4){0.f, 0.f, 0.f, 0.f};
    bf16x8 At[4][2], B0[2][2], B1[2][2];
    const char* cA = (const char*)g.A + (size_t)cur.pm * tstep; const char* cB = (const char*)g.Bt + (size_t)cur.pn * tstep;
    S.a_ready(cur);
    if constexpr (SP2) {
        PG8_STAGE(PG8_SB(0, 0), cB, voffB); PG8_STAGE(PG8_SB(0, 1), cB + hstep, voffB); PG8_STAGE(PG8_SA(0, 0), cA, voffA); PG8_STAGE(PG8_SA(0, 1), cA + hstep, voffA);
        if (wr == 1) PG8_BAR;
        PG8_WAIT_V(2); PG8_BAR;
        PG8_STAGE(PG8_SB(1, 0), cB + kstep, voffB); PG8_STAGE(PG8_SA(1, 0), cA + kstep, voffA); PG8_STAGE(PG8_SB(1, 1), cB + hstep + kstep, voffB);
        PG8_WAIT_V(6); PG8_BAR;
    } else {
        PG8_STAGE(PG8_SB(0, 0), cB, voffB); PG8_STAGE(PG8_SA(0, 0), cA, voffA); PG8_STAGE(PG8_SB(0, 1), cB + hstep, voffB); PG8_STAGE(PG8_SA(0, 1), cA + hstep, voffA);
        if (wr == 1) PG8_BAR;
        PG8_WAIT_V(4); PG8_BAR;
        PG8_STAGE(PG8_SB(1, 0), cB + kstep, voffB); PG8_STAGE(PG8_SA(1, 0), cA + kstep, voffA); PG8_STAGE(PG8_SB(1, 1), cB + hstep + kstep, voffB);
        PG8_WAIT_V(6); PG8_BAR;
    }
    for (;;) {
        const bool has_next = S.next(ui + 1, nxt);
        const char* nA = has_next ? (const char*)g.A + (size_t)nxt.pm * tstep : cA; const char* nB = has_next ? (const char*)g.Bt + (size_t)nxt.pn * tstep : cB;
        for (int t = 0; t < nt; t += 2) {
            const bool last = (t == nt - 2);
            const char* a1 = cA + (size_t)(t + 1) * kstep;
            const char* a2 = last ? nA : cA + (size_t)(t + 2) * kstep; const char* b2 = last ? nB : cB + (size_t)(t + 2) * kstep;
            const char* a3 = a2 + kstep; const char* b3 = b2 + kstep;
            if (last && has_next) S.a_ready(nxt);
            if constexpr (SP2) {
            PG8_LDB(B0, 0, 0); PG8_LDB(B1, 0, 1); PG8_SCHED; PG8_LDA(At, 0, 0); PG8_STAGE(PG8_SA(1, 1), a1 + hstep, voffA);
            PG8_WAIT_V(8); PG8_WAIT_L(0); PG8_BAR; PG8_MMA(0, 0, At, B0); PG8_MMA(0, 1, At, B1); PG8_BAR; PG8_SCHED;
            PG8_LDA(At, 0, 1); PG8_STAGE(PG8_SB(0, 0), b2, voffB); PG8_STAGE(PG8_SB(0, 1), b2 + hstep, voffB); PG8_STAGE(PG8_SA(0, 0), a2, voffA);
            PG8_WAIT_V(8); PG8_WAIT_L(0); PG8_BAR; PG8_MMA(1, 0, At, B0); PG8_MMA(1, 1, At, B1); PG8_BAR; PG8_SCHED;
            PG8_LDB(B0, 1, 0); PG8_LDB(B1, 1, 1); PG8_SCHED; PG8_LDA(At, 1, 0); PG8_STAGE(PG8_SA(0, 1), a2 + hstep, voffA);
            PG8_WAIT_V(8); PG8_WAIT_L(0); PG8_BAR; PG8_MMA(0, 0, At, B0); PG8_MMA(0, 1, At, B1); PG8_BAR; PG8_SCHED;
            PG8_LDA(At, 1, 1); PG8_STAGE(PG8_SB(1, 0), b3, voffB); PG8_STAGE(PG8_SB(1, 1), b3 + hstep, voffB); PG8_STAGE(PG8_SA(1, 0), a3, voffA);
            PG8_WAIT_V(8); PG8_WAIT_L(0); PG8_BAR; PG8_MMA(1, 0, At, B0); PG8_MMA(1, 1, At, B1); PG8_BAR; PG8_SCHED;
            } else {
            PG8_LDB(B0, 0, 0); PG8_SCHED; PG8_LDA(At, 0, 0); PG8_STAGE(PG8_SA(1, 1), a1 + hstep, voffA);
            PG8_WAIT_L(8); PG8_BAR; PG8_WAIT_L(0); PG8_MMA(0, 0, At, B0); PG8_BAR; PG8_SCHED;
            PG8_LDB(B1, 0, 1); PG8_STAGE(PG8_SB(0, 0), b2, voffB);
            PG8_BAR; PG8_WAIT_L(0); PG8_MMA(0, 1, At, B1); PG8_BAR;
            PG8_LDA(At, 0, 1); PG8_STAGE(PG8_SA(0, 0), a2, voffA);
            PG8_BAR; PG8_WAIT_L(0); PG8_MMA(1, 0, At, B0); PG8_BAR; PG8_SCHED;
            PG8_STAGE(PG8_SB(0, 1), b2 + hstep, voffB);
            PG8_WAIT_V(6); PG8_BAR; PG8_MMA(1, 1, At, B1); PG8_BAR;
            PG8_LDB(B0, 1, 0); PG8_SCHED; PG8_LDA(At, 1, 0); PG8_STAGE(PG8_SA(0, 1), a2 + hstep, voffA);
            PG8_WAIT_L(8); PG8_BAR; PG8_WAIT_L(0); PG8_MMA(0, 0, At, B0); PG8_BAR; PG8_SCHED;
            PG8_LDB(B1, 1, 1); PG8_STAGE(PG8_SB(1, 0), b3, voffB);
            PG8_BAR; PG8_WAIT_L(0); PG8_MMA(0, 1, At, B1); PG8_BAR;
            PG8_LDA(At, 1, 1); PG8_STAGE(PG8_SA(1, 0), a3, voffA);
            PG8_BAR; PG8_WAIT_L(0); PG8_MMA(1, 0, At, B0); PG8_BAR; PG8_SCHED;
            PG8_STAGE(PG8_SB(1, 1), b3 + hstep, voffB);
            PG8_WAIT_V(6); PG8_BAR; PG8_MMA(1, 1, At, B1); PG8_BAR;
            }
        }
        if constexpr (ALIGN_EPI) { if (wr == 0) PG8_BAR; }
        if constexpr (!Epi::AFTER_DRAIN) { E(acc, cur, wr, wc, fr, fq); S.done(cur); }
        if (!has_next) break;
#pragma unroll
        for (int a = 0; a < 2; ++a)
#pragma unroll
            for (int b = 0; b < 2; ++b)
#pragma unroll
                for (int m = 0; m < 4; ++m)
#pragma unroll
                    for (int n = 0; n < 2; ++n) acc[a][b][m][n] = (f32x4){0.f, 0.f, 0.f, 0.f};
        cur = nxt; cA = nA; cB = nB; ++ui;
        if constexpr (ALIGN_EPI) { if (wr == 1) PG8_BAR; }
    }
    PG8_WAIT_V(0);
    if constexpr (!ALIGN_EPI) { if (wr == 0) PG8_BAR; }
    PG8_BAR;
    if constexpr (Epi::AFTER_DRAIN) { E.fused(acc, cur, wr, wc, fr, fq, lds, wid, lane); S.done(cur); }
#undef PG8_SA
#undef PG8_SB
#undef PG8_STAGE
#undef PG8_LDA
#undef PG8_LDB
#undef PG8_MMA
#undef PG8_WAIT_V
#undef PG8_WAIT_L
#undef PG8_BAR
#undef PG8_SCHED
}
}

namespace pg8 {
#define EPI_V8(ai, bj, m) { acc[ai][bj][m][0][0], acc[ai][bj][m][0][1], acc[ai][bj][m][0][2], acc[ai][bj][m][0][3], acc[ai][bj][m][1][0], acc[ai][bj][m][1][1], acc[ai][bj][m][1][2], acc[ai][bj][m][1][3] }
__device__ __forceinline__ u32x4 pack8(const float (&v)[8], float s) { u32x4 w; w.x = pk_bf16(v[0] * s, v[1] * s); w.y = pk_bf16(v[2] * s, v[3] * s); w.z = pk_bf16(v[4] * s, v[5] * s); w.w = pk_bf16(v[6] * s, v[7] * s); return w; }
__device__ __forceinline__ float ssq8(const float (&v)[8]) { return ((v[0] * v[0] + v[1] * v[1]) + (v[2] * v[2] + v[3] * v[3])) + ((v[4] * v[4] + v[5] * v[5]) + (v[6] * v[6] + v[7] * v[7])); }
__device__ __forceinline__ void load8(const float* p, float (&o)[8]) { const f32x4 a = *(const f32x4*)p, b = *(const f32x4*)(p + 4); o[0] = a.x; o[1] = a.y; o[2] = a.z; o[3] = a.w; o[4] = b.x; o[5] = b.y; o[6] = b.z; o[7] = b.w; }

struct EpiProj {
    static constexpr bool PERM = true, AFTER_DRAIN = false;
    bf16_t *Qa, *Ka, *Va, *Cq, *Ckv, *Kr; float *ssq_q, *ssq_kv; const float *cosA, *sinA, *cosM, *sinM;
    __device__ __forceinline__ void operator()(const f32x4 (&acc)[2][2][4][2], const Unit& u, int wr, int wc, int fr, int fq) const {
        const int pn = u.pn, rowb = u.pm * BM + wr * 64 + fr;
        if (pn < 6) {
            const int kind = pn >> 1;
            bf16_t* dst = Qa + (size_t)kind * (size_t)(8u << 20);
            const float sc = kind == 0 ? QA_SCALE : 1.f;
            const bool ropew = (kind < 2) && ((wc & 1) == 0);
            float cq[2][8], sq[2][8];
            if (ropew) {
#pragma unroll
                for (int g = 0; g < 2; ++g) { const size_t r_ = (size_t)(rowb + g * 16) * 8; load8(cosA + r_, cq[g]); load8(sinA + r_, sq[g]); }
            }
#pragma unroll
            for (int ai = 0; ai < 2; ++ai)
#pragma unroll
                for (int m = 0; m < 4; ++m) {
                    const int row = rowb + ai * HALF + m * 16;
                    float cs[8], sn[8];
                    if (ropew) {
#pragma unroll
                        for (int i = 0; i < 8; ++i) { cs[i] = cq[m & 1][i]; sn[i] = sq[m & 1][i]; }
                        if (ai * 4 + m + 2 < 8) { const int g2 = ai * 4 + m + 2; const size_t r_ = (size_t)(rowb + (g2 >> 2) * HALF + (g2 & 3) * 16) * 8; load8(cosA + r_, cq[m & 1]); load8(sinA + r_, sq[m & 1]); }
                    }
#pragma unroll
                    for (int bj = 0; bj < 2; ++bj) {
                        float v[8] = EPI_V8(ai, bj, m);
                        if (ropew) {
#pragma unroll
                            for (int i = 0; i < 8; ++i) { const float pv = __shfl_xor(v[i], 16); if (fq == 0) v[i] = v[i] * cs[i] - pv * sn[i]; else if (fq == 1) v[i] = v[i] * cs[i] + pv * sn[i]; }
                        }
                        *(u32x4*)(dst + ((size_t)((row >> 13) * 8 + (pn & 1) * 4 + bj * 2 + (wc >> 1)) * SEQ + (row & (SEQ - 1))) * 64 + (wc & 1) * 32 + fq * 8) = pack8(v, sc);
                    }
                }
        } else if (pn == 6) {
#pragma unroll
            for (int ai = 0; ai < 2; ++ai)
#pragma unroll
                for (int m = 0; m < 4; ++m) {
                    const int row = rowb + ai * HALF + m * 16;
#pragma unroll
                    for (int bj = 0; bj < 2; ++bj) {
                        float v[8] = EPI_V8(ai, bj, m);
                        float s = ssq8(v); s += __shfl_xor(s, 16); s += __shfl_xor(s, 32);
                        if (fq == 0) ssq_q[(size_t)row * 8 + bj * 4 + wc] = s;
                        *(u32x4*)(Cq + (size_t)row * 256 + bj * HALF + wc * 32 + fq * 8) = pack8(v, 1.f);
                    }
                }
        } else {
#pragma unroll
            for (int ai = 0; ai < 2; ++ai)
#pragma unroll
                for (int m = 0; m < 4; ++m) {
                    const int row = rowb + ai * HALF + m * 16;
                    {
                        float v[8] = EPI_V8(ai, 0, m);
                        float s = ssq8(v); s += __shfl_xor(s, 16); s += __shfl_xor(s, 32);
                        if (fq == 0) ssq_kv[(size_t)row * 4 + wc] = s;
                        *(u32x4*)(Ckv + (size_t)row * 128 + wc * 32 + fq * 8) = pack8(v, 1.f);
                    }
                    if (wc == 0) {
                        float v[8] = EPI_V8(ai, 1, m);
                        float cs[8], sn[8];
                        load8(cosM + (size_t)row * 16 + 8 * (fq & 1), cs); load8(sinM + (size_t)row * 16 + 8 * (fq & 1), sn);
#pragma unroll
                        for (int i = 0; i < 8; ++i) { const float pv = __shfl_xor(v[i], 32); v[i] = (fq < 2) ? (v[i] * cs[i] - pv * sn[i]) : (v[i] * cs[i] + pv * sn[i]); }
                        *(u32x4*)(Kr + (size_t)row * 32 + fq * 8) = pack8(v, 1.f);
                    }
                }
        }
    }
};

struct EpiQm {
    static constexpr bool PERM = true, AFTER_DRAIN = false;
    bf16_t* Qm; const float* ssq_q; const float *cosM, *sinM;
    __device__ __forceinline__ void operator()(const f32x4 (&acc)[2][2][4][2], const Unit& u, int wr, int wc, int fr, int fq) const {
        const int pn = u.pn, rowb = u.pm * BM + wr * 64 + fr;
        f32x2 qa[8];
#pragma unroll
        for (int g = 0; g < 8; ++g) qa[g] = *(const f32x2*)(ssq_q + (size_t)(rowb + (g >> 2) * HALF + (g & 3) * 16) * 8 + 2 * fq);
        float cq[2][8], sq[2][8];
#pragma unroll
        for (int g = 0; g < 2; ++g) { const size_t r_ = (size_t)(rowb + g * 16) * 16 + 8 * (fq & 1); load8(cosM + r_, cq[g]); load8(sinM + r_, sq[g]); }
#pragma unroll
        for (int ai = 0; ai < 2; ++ai)
#pragma unroll
            for (int m = 0; m < 4; ++m) {
                const int row = rowb + ai * HALF + m * 16, g = ai * 4 + m;
                float ssum = qa[g].x + qa[g].y; ssum += __shfl_xor(ssum, 16); ssum += __shfl_xor(ssum, 32);
                const float rs = 1.0f / sqrtf(ssum * (1.f / 256.f) + EPS);
                float cs[8], sn[8];
#pragma unroll
                for (int i = 0; i < 8; ++i) { cs[i] = cq[m & 1][i]; sn[i] = sq[m & 1][i]; }
                if (g + 2 < 8) { const int g2 = g + 2; const size_t r_ = (size_t)(rowb + (g2 >> 2) * HALF + (g2 & 3) * 16) * 16 + 8 * (fq & 1); load8(cosM + r_, cq[m & 1]); load8(sinM + r_, sq[m & 1]); }
#pragma unroll
                for (int bj = 0; bj < 2; ++bj) {
                    const int g32 = pn * 8 + bj * 4 + wc;
                    const bool ropew = (g32 % 3) == 2;
                    float v[8] = EPI_V8(ai, bj, m);
#pragma unroll
                    for (int i = 0; i < 8; ++i) v[i] *= rs;
                    if (ropew) {
#pragma unroll
                        for (int i = 0; i < 8; ++i) { const float pv = __shfl_xor(v[i], 32); v[i] = (fq < 2) ? (v[i] * cs[i] - pv * sn[i]) : (v[i] * cs[i] + pv * sn[i]); }
                    }
                    *(u32x4*)(Qm + (size_t)row * 768 + pn * BM + bj * HALF + wc * 32 + fq * 8) = pack8(v, QM_SCALE);
                }
                asm volatile("" ::: "memory");
            }
    }
};

struct EpiKv {
    static constexpr bool PERM = true, AFTER_DRAIN = false;
    bf16_t *Kn, *Vm; const float* ssq_kv;
    __device__ __forceinline__ void operator()(const f32x4 (&acc)[2][2][4][2], const Unit& u, int wr, int wc, int fr, int fq) const {
        const int pn = u.pn, rowb = u.pm * BM + wr * 64 + fr;
        bf16_t* dst = Kn + (size_t)(wc >> 1) * (size_t)(8u << 20);
        const int within = (wc & 1) * 32 + fq * 8;
        f32x4 q4a[8];
#pragma unroll
        for (int g = 0; g < 8; ++g) q4a[g] = *(const f32x4*)(ssq_kv + (size_t)(rowb + (g >> 2) * HALF + (g & 3) * 16) * 4);
#pragma unroll
        for (int ai = 0; ai < 2; ++ai)
#pragma unroll
            for (int m = 0; m < 4; ++m) {
                const int row = rowb + ai * HALF + m * 16;
                const f32x4 q4 = q4a[ai * 4 + m];
                const float rs = 1.0f / sqrtf(((q4.x + q4.y) + (q4.z + q4.w)) * (1.f / 128.f) + EPS);
#pragma unroll
                for (int bj = 0; bj < 2; ++bj) {
                    float v[8] = EPI_V8(ai, bj, m);
                    *(u32x4*)(dst + ((size_t)((row >> 13) * 8 + pn * 2 + bj) * SEQ + (row & (SEQ - 1))) * 64 + within) = pack8(v, rs);
                }
            }
    }
};

struct EpiOut {
    static constexpr bool PERM = true, AFTER_DRAIN = false;
    const float* x; bf16_t* Hb; unsigned char* Hb8; float* ssq_h;
    __device__ __forceinline__ void operator()(const f32x4 (&acc)[2][2][4][2], const Unit& u, int wr, int wc, int fr, int fq) const {
        const int pn = u.pn, rowb = u.pm * BM + wr * 64 + fr;
        float xq[8][8];
#define XPIECE(t_) (x + (size_t)(rowb + ((t_) >> 3) * HALF + (((t_) >> 1) & 3) * 16) * DM + pn * BM + ((t_) & 1) * HALF + wc * 32 + fq * 8)
#pragma unroll
        for (int t = 0; t < 8; ++t) load8(XPIECE(t), xq[t]);
#pragma unroll
        for (int ai = 0; ai < 2; ++ai)
#pragma unroll
            for (int m = 0; m < 4; ++m) {
                const int row = rowb + ai * HALF + m * 16;
#pragma unroll
                for (int bj = 0; bj < 2; ++bj) {
                    const int col = pn * BM + bj * HALF + wc * 32 + fq * 8, t = (ai * 4 + m) * 2 + bj;
                    float v[8] = EPI_V8(ai, bj, m);
#pragma unroll
                    for (int i = 0; i < 8; ++i) v[i] += xq[t & 7][i];
                    if (t + 8 < 16) load8(XPIECE(t + 8), xq[t & 7]);
                    float s = ssq8(v); s += __shfl_xor(s, 16); s += __shfl_xor(s, 32);
                    if (fq == 0) ssq_h[(size_t)row * 32 + pn * 8 + bj * 4 + wc] = s;
                    *(u32x4*)(Hb + (size_t)row * DM + col) = pack8(v, 1.f);
                    { u32x2 w8; w8.x = pk_fp8x4(v[0] * SX, v[1] * SX, v[2] * SX, v[3] * SX); w8.y = pk_fp8x4(v[4] * SX, v[5] * SX, v[6] * SX, v[7] * SX); *(u32x2*)(Hb8 + (size_t)(col >> 8) * ((size_t)T * 256) + (size_t)row * 256 + (col & 255)) = w8; }
                }
            }
#undef XPIECE
    }
};

struct EpiSc {
    static constexpr bool PERM = true, AFTER_DRAIN = false;
    bf16_t* Sc; const float* ssq_h;
    __device__ __forceinline__ void operator()(const f32x4 (&acc)[2][2][4][2], const Unit& u, int wr, int wc, int fr, int fq) const {
        const int pn = u.pn, rowb = u.pm * BM + wr * 64 + fr;
        f32x4 q[8][2];
#pragma unroll
        for (int g = 0; g < 8; ++g) { const float* qp = ssq_h + (size_t)(rowb + (g >> 2) * HALF + (g & 3) * 16) * 32 + 8 * fq; q[g][0] = *(const f32x4*)qp; q[g][1] = *(const f32x4*)(qp + 4); }
#pragma unroll
        for (int ai = 0; ai < 2; ++ai)
#pragma unroll
            for (int m = 0; m < 4; ++m) {
                const int row = rowb + ai * HALF + m * 16, g = ai * 4 + m;
                float s = ((q[g][0].x + q[g][0].y) + (q[g][0].z + q[g][0].w)) + ((q[g][1].x + q[g][1].y) + (q[g][1].z + q[g][1].w));
                s += __shfl_xor(s, 16); s += __shfl_xor(s, 32);
                const float rs = 1.0f / sqrtf(s * (1.f / 1024.f) + EPS);
#pragma unroll
                for (int bj = 0; bj < 2; ++bj) {
                    float v[8] = EPI_V8(ai, bj, m);
                    u32x4 w; w.x = pk_f16(v[0] * rs, v[1] * rs); w.y = pk_f16(v[2] * rs, v[3] * rs); w.z = pk_f16(v[4] * rs, v[5] * rs); w.w = pk_f16(v[6] * rs, v[7] * rs);
                    *(u32x4*)(Sc + (size_t)row * 2048 + pn * BM + bj * HALF + wc * 32 + fq * 8) = w;
                }
            }
    }
};
#undef EPI_V8
}

namespace att {
constexpr float NEGM = -1.0e30f;
__device__ __forceinline__ s16x4 vtr(const LAS unsigned char* p) { typedef short v4i16_t __attribute__((ext_vector_type(4))); return __builtin_bit_cast(s16x4, __builtin_amdgcn_ds_read_tr16_b64_v4i16((LAS v4i16_t*)p)); }
__device__ __forceinline__ void swap32(unsigned& a, unsigned& b) { asm volatile("s_nop 1\n\tv_permlane32_swap_b32 %0, %1" : "+v"(a), "+v"(b)); }
__device__ __forceinline__ float swapmax(float v) { unsigned a = __builtin_bit_cast(unsigned, v), b = a; swap32(a, b); return fmaxf(__builtin_bit_cast(float, a), __builtin_bit_cast(float, b)); }
__device__ __forceinline__ float swapsum(float v) { unsigned a = __builtin_bit_cast(unsigned, v), b = a; swap32(a, b); return __builtin_bit_cast(float, a) + __builtin_bit_cast(float, b); }
__device__ __forceinline__ float max3f(float a, float b, float c) { return __builtin_fmaxf(__builtin_fmaxf(a, b), c); }
constexpr float THR = 8.0f;
__device__ __forceinline__ bf16x8 pack_p(const f32x16& p, int s) {
    u32x4 w; w.x = pk_bf16(p[8 * s + 0], p[8 * s + 1]); w.y = pk_bf16(p[8 * s + 2], p[8 * s + 3]); w.z = pk_bf16(p[8 * s + 4], p[8 * s + 5]); w.w = pk_bf16(p[8 * s + 6], p[8 * s + 7]);
    return __builtin_bit_cast(bf16x8, w);
}
__device__ __forceinline__ void pv_block(f32x16& o, const LAS unsigned char* vbase, const bf16x8& pb0, const bf16x8& pb1) {
    const s16x4 l0 = vtr(vbase), h0 = vtr(vbase + 8 * 64), l1 = vtr(vbase + 16 * 64), h1 = vtr(vbase + 24 * 64);
    const bf16x8 a0 = {l0[0], l0[1], l0[2], l0[3], h0[0], h0[1], h0[2], h0[3]}, a1 = {l1[0], l1[1], l1[2], l1[3], h1[0], h1[1], h1[2], h1[3]};
    o = __builtin_amdgcn_mfma_f32_32x32x16_bf16(a0, pb0, o, 0, 0, 0);
    o = __builtin_amdgcn_mfma_f32_32x32x16_bf16(a1, pb1, o, 0, 0, 0);
}
__device__ __forceinline__ void store_o(bf16_t* orow, const f32x16& o0, const f32x16& o1, float inv, int hi) {
#pragma unroll
    for (int g = 0; g < 4; ++g) {
        u32x2 a, b; a.x = pk_bf16(o0[4 * g] * inv, o0[4 * g + 1] * inv); a.y = pk_bf16(o0[4 * g + 2] * inv, o0[4 * g + 3] * inv);
        b.x = pk_bf16(o1[4 * g] * inv, o1[4 * g + 1] * inv); b.y = pk_bf16(o1[4 * g + 2] * inv, o1[4 * g + 3] * inv);
        *(u32x2*)(orow + 8 * g + 4 * hi) = a; *(u32x2*)(orow + 32 + 8 * g + 4 * hi) = b;
    }
}

constexpr int KROW = 208;
constexpr int TK = 128, KBYTES = TK * KROW, VBYTES = 2 * TK * 64, BUFB = KBYTES + VBYTES;
constexpr int MLA_LDS = 2 * BUFB;
__device__ __forceinline__ float rowmax64(const f32x16& s0, const f32x16& s1) {
    float mx = max3f(s0[0], s1[0], s0[1]);
#pragma unroll
    for (int r = 1; r < 15; r += 2) { mx = max3f(mx, s1[r], s0[r + 1]); mx = max3f(mx, s1[r + 1], s0[r + 2 < 16 ? r + 2 : 15]); }
    mx = max3f(mx, s1[15], s0[15]);
    return swapmax(mx);
}
__device__ __forceinline__ void scale16(f32x16& t, float a) {
    const f32x2 a2 = {a, a};
#pragma unroll
    for (int i = 0; i < 8; ++i) { f32x2 p = {t[2 * i], t[2 * i + 1]}; asm volatile("v_pk_mul_f32 %0, %0, %1" : "+v"(p) : "v"(a2)); t[2 * i] = p.x; t[2 * i + 1] = p.y; }
}
__device__ __forceinline__ void sub16(f32x16& t, float d) {
    const f32x2 d2 = {d, d};
#pragma unroll
    for (int i = 0; i < 8; ++i) { f32x2 p = {t[2 * i], t[2 * i + 1]}; asm volatile("v_pk_add_f32 %0, %0, %1 neg_lo:[0,1] neg_hi:[0,1]" : "+v"(p) : "v"(d2)); t[2 * i] = p.x; t[2 * i + 1] = p.y; }
}
__device__ __forceinline__ void rescale64(float mx, f32x16& s0, f32x16& s1, float& m, float& l, f32x16& o0, f32x16& o1) {
    if (__builtin_expect(__builtin_amdgcn_ballot_w64(mx > THR) != 0ull, 0)) {
        const float dl = fmaxf(mx, 0.f), alpha = __builtin_amdgcn_exp2f(-dl);
        m += dl; l *= alpha;
        sub16(s0, dl); sub16(s1, dl); scale16(o0, alpha); scale16(o1, alpha);
    }
}
__device__ __forceinline__ void exp64(f32x16& s0, f32x16& s1, float& l) {
    float rs = 0.f;
#pragma unroll
    for (int r = 0; r < 16; ++r) { s0[r] = __builtin_amdgcn_exp2f(s0[r]); s1[r] = __builtin_amdgcn_exp2f(s1[r]); rs += s0[r] + s1[r]; }
    l += rs;
}
__device__ __forceinline__ void sm64(f32x16& s0, f32x16& s1, float& m, float& l, f32x16& o0, f32x16& o1, f32x16& t0, f32x16& t1, bool adj_other) {
    float mx = max3f(s0[0], s1[0], s0[1]);
#pragma unroll
    for (int r = 1; r < 15; r += 2) { mx = max3f(mx, s1[r], s0[r + 1]); mx = max3f(mx, s1[r + 1], s0[r + 2 < 16 ? r + 2 : 15]); }
    mx = max3f(mx, s1[15], s0[15]);
    mx = swapmax(mx);
    if (__builtin_expect(__builtin_amdgcn_ballot_w64(mx > THR) != 0ull, 0)) {
        const float dl = fmaxf(mx, 0.f), alpha = __builtin_amdgcn_exp2f(-dl);
        m += dl; l *= alpha;
#pragma unroll
        for (int r = 0; r < 16; ++r) { s0[r] -= dl; s1[r] -= dl; o0[r] *= alpha; o1[r] *= alpha; }
        if (adj_other) {
#pragma unroll
            for (int r = 0; r < 16; ++r) { t0[r] -= dl; t1[r] -= dl; }
        }
    }
    float rs = 0.f;
#pragma unroll
    for (int r = 0; r < 16; ++r) { s0[r] = __builtin_amdgcn_exp2f(s0[r]); s1[r] = __builtin_amdgcn_exp2f(s1[r]); rs += s0[r] + s1[r]; }
    l += rs;
}
constexpr int MLA_G_OFF = 2 * (TK * 208 + 2 * TK * 64), MLA_PIECE_OFF = MLA_G_OFF + 4096;
__device__ __forceinline__ void mla_unit(LAS unsigned char* lds, const bf16_t* __restrict__ Qm, const bf16_t* __restrict__ Kn, const bf16_t* __restrict__ Kr, const bf16_t* __restrict__ Vm,
                                         bf16_t* __restrict__ Mixed, int b, int h, int qb,
                                         const float* __restrict__ u_emb, const float* __restrict__ v_emb, const float* __restrict__ g_ffn, unsigned char* __restrict__ U8, unsigned char* __restrict__ V8, int slot0) {
    const int tid = threadIdx.x, lane = tid & 63, wid = __builtin_amdgcn_readfirstlane(tid >> 6), r32 = lane & 31, hi = lane >> 5;
    const size_t tok0 = (size_t)b * SEQ;
    const int qpos = 256 * qb + 32 * wid + r32;
    bf16x8 qf[6];
    { const bf16_t* qrow = Qm + (tok0 + qpos) * 768 + h * 96 + 8 * hi;
#pragma unroll
      for (int ds = 0; ds < 6; ++ds) qf[ds] = *(const bf16x8*)(qrow + 16 * ds); }
    float m = 0.f, l = 0.f; f32x16 o0 = {}, o1 = {};
    const int nt = 2 * (qb + 1);
    const int wq0 = 256 * qb + 32 * wid, wqlast = wq0 + 31;
    const int srow = tid >> 3, sch = tid & 7, rrow = tid >> 2, rch = tid & 3;
    const bf16_t* gkn = Kn + ((size_t)(b * 8 + h) * SEQ + srow) * 64 + sch * 8;
    const bf16_t* gv = Vm + ((size_t)(b * 8 + h) * SEQ + srow) * 64 + sch * 8;
    const bf16_t* gkr = Kr + (tok0 + rrow) * 32 + rch * 8;
    const int wkn = srow * KROW + sch * 16, wkr = rrow * KROW + 128 + rch * 16, wv = KBYTES + (sch >> 2) * (TK * 64) + srow * 64 + (sch & 3) * 16;
    const int kfrag = r32 * KROW + hi * 16;
    const int i16 = lane & 15, vfrag = KBYTES + (4 * hi + (i16 >> 2)) * 64 + (16 * ((lane >> 4) & 1) + 4 * (i16 & 3)) * 2;
    u32x4 rk0, rk1, rv0, rv1, rr;
#define MLA_LOAD(t) do { const size_t adv_ = (size_t)(t) * TK; rk0 = *(const u32x4*)(gkn + adv_ * 64); rk1 = *(const u32x4*)(gkn + (adv_ + 64) * 64); \
        rv0 = *(const u32x4*)(gv + adv_ * 64); rv1 = *(const u32x4*)(gv + (adv_ + 64) * 64); rr = *(const u32x4*)(gkr + adv_ * 32); } while (0)
#define MLA_STORE(bp) do { LAS unsigned char* b_ = (bp); *(LAS u32x4*)(b_ + wkn) = rk0; *(LAS u32x4*)(b_ + wkn + 64 * KROW) = rk1; *(LAS u32x4*)(b_ + wv) = rv0; *(LAS u32x4*)(b_ + wv + 64 * 64) = rv1; *(LAS u32x4*)(b_ + wkr) = rr; } while (0)
    if (wid >= 4) __builtin_amdgcn_s_setprio(1);
    MLA_LOAD(0); MLA_STORE(lds);
    for (int u = tid; u < DM / 4; u += 512) *(LAS f32x4*)(lds + MLA_G_OFF + 16 * u) = *(const f32x4*)(g_ffn + 4 * u);
    LAS unsigned char* piece = lds + MLA_PIECE_OFF + wid * 1024;
    const unsigned piece_u = (unsigned)__builtin_amdgcn_readfirstlane((int)(unsigned)(uintptr_t)piece);
    __syncthreads();
    const int nfull = (wq0 + 1) >> 7;
    int kt = 0;
    for (; kt < nfull; ++kt) {
        const LAS unsigned char* buf = lds + (kt & 1) * BUFB;
        if (kt + 1 < nt) MLA_LOAD(kt + 1);
        const int pid = slot0 + 8 * kt + wid;
        if (pid < 131072) glds16(((pid >> 16) ? v_emb : u_emb) + (size_t)(pid & 65535) * 256 + 4 * lane, piece_u);
        {
            f32x16 a0, a1, b0, b1;
            {
                const bf16x8 k0 = *(const LAS bf16x8*)(buf + kfrag), k1 = *(const LAS bf16x8*)(buf + kfrag + 32 * KROW);
                if (__builtin_amdgcn_ballot_w64(m != 0.f) == 0ull) {
                    const f32x16 z = {};
                    a0 = __builtin_amdgcn_mfma_f32_32x32x16_bf16(k0, qf[0], z, 0, 0, 0);
                    a1 = __builtin_amdgcn_mfma_f32_32x32x16_bf16(k1, qf[0], z, 0, 0, 0);
                } else {
                    const float nm = -m; const f32x16 nv = {nm, nm, nm, nm, nm, nm, nm, nm, nm, nm, nm, nm, nm, nm, nm, nm};
                    a0 = __builtin_amdgcn_mfma_f32_32x32x16_bf16(k0, qf[0], nv, 0, 0, 0);
                    a1 = __builtin_amdgcn_mfma_f32_32x32x16_bf16(k1, qf[0], nv, 0, 0, 0);
                }
            }
#pragma unroll
            for (int ds = 1; ds < 6; ++ds) {
                const bf16x8 k0 = *(const LAS bf16x8*)(buf + kfrag + ds * 32), k1 = *(const LAS bf16x8*)(buf + kfrag + 32 * KROW + ds * 32);
                a0 = __builtin_amdgcn_mfma_f32_32x32x16_bf16(k0, qf[ds], a0, 0, 0, 0);
                a1 = __builtin_amdgcn_mfma_f32_32x32x16_bf16(k1, qf[ds], a1, 0, 0, 0);
            }
            rescale64(rowmax64(a0, a1), a0, a1, m, l, o0, o1);
            {
                const bf16x8 k2 = *(const LAS bf16x8*)(buf + kfrag + 64 * KROW), k3 = *(const LAS bf16x8*)(buf + kfrag + 96 * KROW);
                if (__builtin_amdgcn_ballot_w64(m != 0.f) == 0ull) {
                    const f32x16 z = {};
                    b0 = __builtin_amdgcn_mfma_f32_32x32x16_bf16(k2, qf[0], z, 0, 0, 0);
                    b1 = __builtin_amdgcn_mfma_f32_32x32x16_bf16(k3, qf[0], z, 0, 0, 0);
                } else {
                    const float nm = -m; const f32x16 nv = {nm, nm, nm, nm, nm, nm, nm, nm, nm, nm, nm, nm, nm, nm, nm, nm};
                    b0 = __builtin_amdgcn_mfma_f32_32x32x16_bf16(k2, qf[0], nv, 0, 0, 0);
                    b1 = __builtin_amdgcn_mfma_f32_32x32x16_bf16(k3, qf[0], nv, 0, 0, 0);
                }
            }
#pragma unroll
            for (int ds = 1; ds < 6; ++ds) {
                const bf16x8 k2 = *(const LAS bf16x8*)(buf + kfrag + 64 * KROW + ds * 32), k3 = *(const LAS bf16x8*)(buf + kfrag + 96 * KROW + ds * 32);
                b0 = __builtin_amdgcn_mfma_f32_32x32x16_bf16(k2, qf[ds], b0, 0, 0, 0);
                b1 = __builtin_amdgcn_mfma_f32_32x32x16_bf16(k3, qf[ds], b1, 0, 0, 0);
            }
            exp64(a0, a1, l);
            { const float mxb = rowmax64(b0, b1);
              if (__builtin_expect(__builtin_amdgcn_ballot_w64(mxb > THR) != 0ull, 0)) {
                  const float dl = fmaxf(mxb, 0.f), alpha = __builtin_amdgcn_exp2f(-dl);
                  m += dl; l *= alpha;
                  sub16(b0, dl); sub16(b1, dl); scale16(o0, alpha); scale16(o1, alpha); scale16(a0, alpha); scale16(a1, alpha);
              } }
            { const bf16x8 p00 = pack_p(a0, 0), p01 = pack_p(a0, 1), p10 = pack_p(a1, 0), p11 = pack_p(a1, 1);
              pv_block(o0, buf + vfrag, p00, p01); pv_block(o0, buf + vfrag + 2048, p10, p11);
              pv_block(o1, buf + vfrag + TK * 64, p00, p01); pv_block(o1, buf + vfrag + TK * 64 + 2048, p10, p11); }
            exp64(b0, b1, l);
            { const bf16x8 p00 = pack_p(b0, 0), p01 = pack_p(b0, 1), p10 = pack_p(b1, 0), p11 = pack_p(b1, 1);
              pv_block(o0, buf + vfrag + 4096, p00, p01); pv_block(o0, buf + vfrag + 6144, p10, p11);
              pv_block(o1, buf + vfrag + TK * 64 + 4096, p00, p01); pv_block(o1, buf + vfrag + TK * 64 + 6144, p10, p11); }
        }
        if (kt + 1 < nt) MLA_STORE(lds + ((kt + 1) & 1) * BUFB);
        if (pid < 131072) {
            asm volatile("s_waitcnt vmcnt(0)" ::: "memory");
            const f32x4 xv = *(const LAS f32x4*)(piece + 16 * lane);
            const int idx = pid & 65535, col = (idx & 3) * 256 + 4 * lane;
            f32x4 sc = {SV, SV, SV, SV};
            if ((pid >> 16) == 0) { const f32x4 gv_ = *(const LAS f32x4*)(lds + MLA_G_OFF + 4 * col); sc = (f32x4){gv_.x * SU, gv_.y * SU, gv_.z * SU, gv_.w * SU}; }
            if ((pid >> 16) == 0) {
                unsigned w4 = __builtin_amdgcn_cvt_scalef32_pk_fp4_f32(0u, xv.x * sc.x, xv.y * sc.y, 1.0f, 0);
                w4 = __builtin_amdgcn_cvt_scalef32_pk_fp4_f32(w4, xv.z * sc.z, xv.w * sc.w, 1.0f, 1);
                *(unsigned short*)(U8 + (size_t)(idx & 3) * ((size_t)16384 * 128) + (size_t)(idx >> 2) * 128 + 2 * lane) = (unsigned short)(w4 & 0xffffu);
            } else {
                unsigned char* dst = V8 + (size_t)(col >> 7) * ((size_t)16384 * 128) + (size_t)(idx >> 2) * 128 + (col & 127);
                *(unsigned*)dst = pk_fp8x4(xv.x * sc.x, xv.y * sc.y, xv.z * sc.z, xv.w * sc.w);
            }
        }
        __syncthreads();
        }
    for (; kt < nt; ++kt) {
        const LAS unsigned char* buf = lds + (kt & 1) * BUFB;
        if (kt + 1 < nt) MLA_LOAD(kt + 1);
        const int pid = slot0 + 8 * kt + wid;
        if (pid < 131072) glds16(((pid >> 16) ? v_emb : u_emb) + (size_t)(pid & 65535) * 256 + 4 * lane, piece_u);
        if (TK * kt <= wqlast) {
            const bool needB = TK * kt + 64 <= wqlast;
            const float nm = -m; const f32x16 negm = {nm, nm, nm, nm, nm, nm, nm, nm, nm, nm, nm, nm, nm, nm, nm, nm};
            f32x16 a0 = negm, a1 = negm, b0 = negm, b1 = negm;
#pragma unroll
            for (int ds = 0; ds < 6; ++ds) {
                const bf16x8 k0 = *(const LAS bf16x8*)(buf + kfrag + ds * 32), k1 = *(const LAS bf16x8*)(buf + kfrag + 32 * KROW + ds * 32);
                a0 = __builtin_amdgcn_mfma_f32_32x32x16_bf16(k0, qf[ds], a0, 0, 0, 0);
                a1 = __builtin_amdgcn_mfma_f32_32x32x16_bf16(k1, qf[ds], a1, 0, 0, 0);
            }
            if (needB) {
#pragma unroll
                for (int ds = 0; ds < 6; ++ds) {
                    const bf16x8 k2 = *(const LAS bf16x8*)(buf + kfrag + 64 * KROW + ds * 32), k3 = *(const LAS bf16x8*)(buf + kfrag + 96 * KROW + ds * 32);
                    b0 = __builtin_amdgcn_mfma_f32_32x32x16_bf16(k2, qf[ds], b0, 0, 0, 0);
                    b1 = __builtin_amdgcn_mfma_f32_32x32x16_bf16(k3, qf[ds], b1, 0, 0, 0);
                }
            }
#pragma unroll
            for (int r = 0; r < 16; ++r) { const int kp = TK * kt + crow(r, hi); if (kp > qpos) a0[r] = NEGM; if (kp + 32 > qpos) a1[r] = NEGM; if (kp + 64 > qpos) b0[r] = NEGM; if (kp + 96 > qpos) b1[r] = NEGM; }
            sm64(a0, a1, m, l, o0, o1, b0, b1, needB);
            { const bf16x8 p00 = pack_p(a0, 0), p01 = pack_p(a0, 1), p10 = pack_p(a1, 0), p11 = pack_p(a1, 1);
              pv_block(o0, buf + vfrag, p00, p01); pv_block(o0, buf + vfrag + 2048, p10, p11);
              pv_block(o1, buf + vfrag + TK * 64, p00, p01); pv_block(o1, buf + vfrag + TK * 64 + 2048, p10, p11); }
            if (needB) {
                sm64(b0, b1, m, l, o0, o1, a0, a1, false);
                const bf16x8 p00 = pack_p(b0, 0), p01 = pack_p(b0, 1), p10 = pack_p(b1, 0), p11 = pack_p(b1, 1);
                pv_block(o0, buf + vfrag + 4096, p00, p01); pv_block(o0, buf + vfrag + 6144, p10, p11);
                pv_block(o1, buf + vfrag + TK * 64 + 4096, p00, p01); pv_block(o1, buf + vfrag + TK * 64 + 6144, p10, p11);
            }

        }
        if (kt + 1 < nt) MLA_STORE(lds + ((kt + 1) & 1) * BUFB);
        if (pid < 131072) {
            asm volatile("s_waitcnt vmcnt(0)" ::: "memory");
            const f32x4 xv = *(const LAS f32x4*)(piece + 16 * lane);
            const int idx = pid & 65535, col = (idx & 3) * 256 + 4 * lane;
            f32x4 sc = {SV, SV, SV, SV};
            if ((pid >> 16) == 0) { const f32x4 gv_ = *(const LAS f32x4*)(lds + MLA_G_OFF + 4 * col); sc = (f32x4){gv_.x * SU, gv_.y * SU, gv_.z * SU, gv_.w * SU}; }
            if ((pid >> 16) == 0) {
                unsigned w4 = __builtin_amdgcn_cvt_scalef32_pk_fp4_f32(0u, xv.x * sc.x, xv.y * sc.y, 1.0f, 0);
                w4 = __builtin_amdgcn_cvt_scalef32_pk_fp4_f32(w4, xv.z * sc.z, xv.w * sc.w, 1.0f, 1);
                *(unsigned short*)(U8 + (size_t)(idx & 3) * ((size_t)16384 * 128) + (size_t)(idx >> 2) * 128 + 2 * lane) = (unsigned short)(w4 & 0xffffu);
            } else {
                unsigned char* dst = V8 + (size_t)(col >> 7) * ((size_t)16384 * 128) + (size_t)(idx >> 2) * 128 + (col & 127);
                *(unsigned*)dst = pk_fp8x4(xv.x * sc.x, xv.y * sc.y, xv.z * sc.z, xv.w * sc.w);
            }
        }
        __syncthreads();
        }
#undef MLA_LOAD
#undef MLA_STORE
    __builtin_amdgcn_s_setprio(0);
    l = swapsum(l);
    store_o(Mixed + (tok0 + qpos) * DM + 512 + h * 64, o0, o1, 1.0f / l, hi);
}

constexpr int DIL_KR = 144, DIL_VR = 160, DIL_VOFF = 32 * DIL_KR, DIL_WLDS = 32 * DIL_KR + 32 * DIL_VR;
constexpr int DIL_SROW = 132, DIL_STATE_OFF = 8 * DIL_WLDS;
struct DilBlk { u32x4 k[4]; u32x4 v[4]; };
__device__ __forceinline__ void dil_load(DilBlk& B, const bf16_t* __restrict__ Ka, const bf16_t* __restrict__ Va, size_t hrow0  , int rd, int dl  , int imax, int idx0, int lane) {
#pragma unroll
    for (int i = 0; i < 4; ++i) {
        int ik = idx0 + 8 * i + (lane >> 3); ik = ik < 0 ? 0 : ik; ik = ik > imax ? imax : ik;
        const size_t off = (hrow0 + ((size_t)ik << dl) + rd) * 64 + 8 * (lane & 7);
        B.k[i] = *(const u32x4*)(Ka + off); B.v[i] = *(const u32x4*)(Va + off);
    }
}
__device__ __forceinline__ void pv_block_p(f32x16& o, const LAS unsigned char* vbase, const bf16x8& pb0, const bf16x8& pb1) {
    const s16x4 l0 = vtr(vbase), h0 = vtr(vbase + 8 * DIL_VR), l1 = vtr(vbase + 16 * DIL_VR), h1 = vtr(vbase + 24 * DIL_VR);
    const bf16x8 a0 = {l0[0], l0[1], l0[2], l0[3], h0[0], h0[1], h0[2], h0[3]}, a1 = {l1[0], l1[1], l1[2], l1[3], h1[0], h1[1], h1[2], h1[3]};
    o = __builtin_amdgcn_mfma_f32_32x32x16_bf16(a0, pb0, o, 0, 0, 0);
    o = __builtin_amdgcn_mfma_f32_32x32x16_bf16(a1, pb1, o, 0, 0, 0);
}
template <bool MASK>
__device__ __forceinline__ void dil_step(const DilBlk& B, LAS unsigned char* wl, const bf16x8 (&qf)[4], float& m, float& l, f32x16& o0, f32x16& o1, int A, int idx0, int lane) {
    const int r32 = lane & 31, hi = lane >> 5;
    {
        LAS unsigned char* kp = wl + (lane >> 3) * DIL_KR + (lane & 7) * 16;
        LAS unsigned char* vp = wl + DIL_VOFF + (lane >> 3) * DIL_VR + (lane & 7) * 16;
#pragma unroll
        for (int i = 0; i < 4; ++i) { *(LAS u32x4*)(kp + 8 * i * DIL_KR) = B.k[i]; *(LAS u32x4*)(vp + 8 * i * DIL_VR) = B.v[i]; }
    }
    const float nm = -m;
    f32x16 s = {nm, nm, nm, nm, nm, nm, nm, nm, nm, nm, nm, nm, nm, nm, nm, nm};
    { const LAS unsigned char* kfr = wl + r32 * DIL_KR + 16 * hi;
#pragma unroll
      for (int ds = 0; ds < 4; ++ds) s = __builtin_amdgcn_mfma_f32_32x32x16_bf16(*(const LAS bf16x8*)(kfr + 32 * ds), qf[ds], s, 0, 0, 0); }
    if (MASK) {
        const int qi = A + r32;
#pragma unroll
        for (int r = 0; r < 16; ++r) { const int ki = idx0 + crow(r, hi), dist = qi - ki; if (ki < 0 || dist < 0 || dist > 128) s[r] = NEGM; }
    }
    float mx = max3f(s[0], s[1], s[2]);
#pragma unroll
    for (int r = 3; r < 15; r += 2) mx = max3f(mx, s[r], s[r + 1]);
    mx = fmaxf(mx, s[15]);
    mx = swapmax(mx);
    if (__builtin_expect(__builtin_amdgcn_ballot_w64(mx > THR) != 0ull, 0)) {
        const float dl_ = fmaxf(mx, 0.f), alpha = __builtin_amdgcn_exp2f(-dl_);
        m += dl_; l *= alpha;
        sub16(s, dl_); scale16(o0, alpha); scale16(o1, alpha);
    }
    float rs = 0.f;
#pragma unroll
    for (int r = 0; r < 16; ++r) { s[r] = __builtin_amdgcn_exp2f(s[r]); rs += s[r]; }
    l += rs;
    const bf16x8 p0 = pack_p(s, 0), p1 = pack_p(s, 1);
    const int i16 = lane & 15;
    const LAS unsigned char* vb = wl + DIL_VOFF + (4 * hi + (i16 >> 2)) * DIL_VR + (16 * ((lane >> 4) & 1) + 4 * (i16 & 3)) * 2;
    pv_block_p(o0, vb, p0, p1);
    pv_block_p(o1, vb + 64, p0, p1);
}
__device__ __forceinline__ void dil_unit(LAS unsigned char* wl, const bf16_t* __restrict__ Qa, const bf16_t* __restrict__ Ka, const bf16_t* __restrict__ Va, bf16_t* __restrict__ Mixed, LAS unsigned char* state,
                                         int b, int h, int p0, int dl, bool first, bool last, int lane, int pflags = 0) {
    const int r32 = lane & 31, hi = lane >> 5;
    const size_t tok0 = (size_t)b * SEQ, hrow0 = (size_t)(b * 8 + h) * SEQ;
    const int qpos = p0 + (r32 << dl);
    const int rd = p0 & ((1 << dl) - 1), A = p0 >> dl, imax = (SEQ - 1 - rd) >> dl;
    DilBlk b0, b1, b2;
#define DLOAD(B_, k_) dil_load(B_, Ka, Va, hrow0, rd, dl, imax, A - 128 + 32 * (k_), lane)
#define DSTEP(MK_, B_, k_) dil_step<MK_>(B_, wl, qf, m, l, o0, o1, A, A - 128 + 32 * (k_), lane)
    DLOAD(b0, 0); DLOAD(b1, 1);
    bf16x8 qf[4];
    { const bf16_t* qrow = Qa + (hrow0 + qpos) * 64 + 8 * hi;
#pragma unroll
      for (int ds = 0; ds < 4; ++ds) qf[ds] = *(const bf16x8*)(qrow + 16 * ds); }
    float m = 0.f, l = 0.f; f32x16 o0 = {}, o1 = {};
    LAS unsigned* st = (LAS unsigned*)(state + ((qpos & 511) * DIL_SROW));
    if (!first) {
        m = __builtin_bit_cast(float, st[32]); l = hi ? 0.f : 1.f;
#pragma unroll
        for (int g = 0; g < 4; ++g) {
            const unsigned a0 = st[4 * g + 2 * hi], a1 = st[4 * g + 2 * hi + 1], c0 = st[16 + 4 * g + 2 * hi], c1 = st[16 + 4 * g + 2 * hi + 1];
            o0[4 * g] = bf_lo(a0); o0[4 * g + 1] = bf_hi(a0); o0[4 * g + 2] = bf_lo(a1); o0[4 * g + 3] = bf_hi(a1);
            o1[4 * g] = bf_lo(c0); o1[4 * g + 1] = bf_hi(c0); o1[4 * g + 2] = bf_lo(c1); o1[4 * g + 3] = bf_hi(c1);
        }
    }
    const bool early = A - 96 < 0;
#ifdef PROBE_LO
    if (pflags & 32) { o0[0] += __builtin_bit_cast(float, b0.k[0].x ^ b1.k[0].x ^ b0.v[3].w ^ b1.v[3].w); l = 1.f; } else {
#endif
    DLOAD(b2, 2);
    DSTEP(true, b0, 0);
    DLOAD(b0, 3);
    if (early) DSTEP(true, b1, 1); else DSTEP(false, b1, 1);
    DLOAD(b1, 4);
    if (early) DSTEP(true, b2, 2); else DSTEP(false, b2, 2);
    if (early) DSTEP(true, b0, 3); else DSTEP(false, b0, 3);
    DSTEP(true, b1, 4);
#ifdef PROBE_LO
    }
#endif
#undef DLOAD
#undef DSTEP
    l = swapsum(l);
    const float inv = 1.0f / l;
    if (last) store_o(Mixed + (tok0 + qpos) * DM + h * 64, o0, o1, inv, hi);
    else {
#pragma unroll
        for (int g = 0; g < 4; ++g) {
            st[4 * g + 2 * hi] = pk_bf16(o0[4 * g] * inv, o0[4 * g + 1] * inv); st[4 * g + 2 * hi + 1] = pk_bf16(o0[4 * g + 2] * inv, o0[4 * g + 3] * inv);
            st[16 + 4 * g + 2 * hi] = pk_bf16(o1[4 * g] * inv, o1[4 * g + 1] * inv); st[16 + 4 * g + 2 * hi + 1] = pk_bf16(o1[4 * g + 2] * inv, o1[4 * g + 3] * inv);
        }
        if (hi == 0) st[32] = __builtin_bit_cast(unsigned, m + __builtin_amdgcn_logf(l));
    }
}
__device__ __forceinline__ void dil_segment(LAS unsigned char* lds, const bf16_t* __restrict__ Qa, const bf16_t* __restrict__ Ka, const bf16_t* __restrict__ Va, bf16_t* __restrict__ Mixed,
                                            int sg, int wave, int lane, int pflags = 0) {
    const int seg = sg & 15, h = (sg >> 4) & 7, b = sg >> 7, base = 512 * seg;
    LAS unsigned char* wl = lds + wave * DIL_WLDS;
#pragma unroll 1
    for (int pass = 0; pass < ((pflags & 64) ? 1 : 3); ++pass) {
        const int dl = 2 * pass;
#pragma unroll 1
        for (int j = wave; j < 16; j += 8) {
            const int rd = j & ((1 << dl) - 1), cj = j >> dl;
            dil_unit(wl, Qa, Ka, Va, Mixed, lds + DIL_STATE_OFF, b, h, base + rd + ((32 * cj) << dl), dl, pass == 0, pass == 2, lane, pflags);
        }
        if (pass < 2) __syncthreads();
    }
}
}

namespace peer {
__device__ __forceinline__ void ins16(unsigned (&L)[16], unsigned key) {
#pragma unroll
    for (int i = 0; i < 16; ++i) { const unsigned hi_ = L[i] > key ? L[i] : key; key = L[i] > key ? key : L[i]; L[i] = hi_; }
}
__device__ __forceinline__ void ce(unsigned& a, unsigned& b) { const unsigned hi_ = a > b ? a : b, lo_ = a > b ? b : a; a = hi_; b = lo_; }
__device__ __forceinline__ void sort8(unsigned (&v)[8]) {
    ce(v[0], v[1]); ce(v[2], v[3]); ce(v[4], v[5]); ce(v[6], v[7]); ce(v[0], v[2]); ce(v[1], v[3]); ce(v[4], v[6]); ce(v[5], v[7]); ce(v[1], v[2]); ce(v[5], v[6]);
    ce(v[0], v[4]); ce(v[3], v[7]); ce(v[1], v[5]); ce(v[2], v[6]); ce(v[1], v[4]); ce(v[3], v[6]); ce(v[2], v[4]); ce(v[3], v[5]); ce(v[3], v[4]);
}
__device__ __forceinline__ void bmerge16(unsigned (&v)[16]) {
#pragma unroll
    for (int k = 8; k >= 1; k >>= 1)
#pragma unroll
        for (int i = 0; i < 16; ++i) if ((i & k) == 0) ce(v[i], v[i + k]);
}
__device__ __forceinline__ float dec16(unsigned key) { const unsigned s = key >> 16; const unsigned b = (s & 0x8000u) ? (s & 0x7fffu) : (~s & 0xffffu); return (float)__builtin_bit_cast(_Float16, (unsigned short)b); }
__device__ __forceinline__ unsigned enc32(float f) { const unsigned u = __builtin_bit_cast(unsigned, f); return (u & 0x80000000u) ? ~u : (u | 0x80000000u); }
__device__ __forceinline__ float dec32(unsigned s) { const unsigned u = (s & 0x80000000u) ? (s & 0x7fffffffu) : ~s; return __builtin_bit_cast(float, u); }
__device__ __forceinline__ float gelu1(float v) {
    const float av = fabsf(v), t = __builtin_amdgcn_rcpf(av * 0.2316418882f + 1.0f);
    float q = t * 0.5307027145f + (-0.7265760135f); q = q * t + 0.7107068705f; q = q * t + (-0.142248368f); q = q * t + 0.127414796f; q = q * t;
    const float e = __builtin_amdgcn_exp2f((v * v) * (-0.72134752044f));
    const float mm = v * (q * e);
    return v < 0.f ? mm : v - mm;
}
struct CandTab { unsigned char i[52], j[52]; };
__host__ __device__ constexpr CandTab make_cands() {
    CandTab t{}; int n = 0;
    for (int i = 0; i < 16; ++i) for (int j = 0; j < 16; ++j) if ((i + 1) * (j + 1) <= 16) { t.i[n] = (unsigned char)i; t.j[n] = (unsigned char)j; ++n; }
    for (; n < 52; ++n) { t.i[n] = 15; t.j[n] = 15; }
    return t;
}

}

namespace peer2 {
__device__ __forceinline__ int ld_of(int j) { const int rho = 16 * ((j >> 2) & 3) + 4 * ((j >> 4) & 3) + (j & 3); return (j >> 6) * 64 + (rho & 7) * 8 + (rho >> 3); }

__device__ __forceinline__ void topk_phase(LAS unsigned char* lds, const bf16_t* __restrict__ Sc, const float* __restrict__ ssq_h, unsigned short* __restrict__ Pe_slot, unsigned short* __restrict__ Pe_ld,
                                           float* __restrict__ Pg, float* __restrict__ rstd_h, int gw, int ngw) {
    const int lane = threadIdx.x & 63, wid = __builtin_amdgcn_readfirstlane(threadIdx.x >> 6);
    LAS unsigned char* tile = lds + wid * 12288;
    LAS unsigned* lists = (LAS unsigned*)(tile + 8192);
    constexpr peer::CandTab CT = peer::make_cands();
    u32x4 nx[8];
#define TK_LOAD(g_, hh_) do { _Pragma("unroll") for (int i_ = 0; i_ < 8; ++i_) { const int s_ = 8 * i_ + (lane >> 3); \
        nx[i_] = *(const u32x4*)(Sc + (size_t)(4 * (g_) + (s_ >> 4)) * 2048 + (s_ & 15) * 128 + (hh_) * 64 + (lane & 7) * 8); } } while (0)
#define TK_WRITE() do { _Pragma("unroll") for (int i_ = 0; i_ < 8; ++i_) { const int s_ = 8 * i_ + (lane >> 3); *(LAS u32x4*)(tile + s_ * 128 + (((lane & 7) ^ (s_ & 7)) << 4)) = nx[i_]; } } while (0)
    if (gw < T / 4) TK_LOAD(gw, 0);
    for (int g = gw; g < T / 4; g += ngw) {
        const int t4 = lane >> 4, hp = lane & 15, tok = 4 * g + t4;
        unsigned L[16];
        {
            const LAS unsigned char* seg = tile + lane * 128;
#pragma unroll 1
            for (int gq = 0; gq < 8; ++gq) {
                if (gq == 0) { TK_WRITE(); TK_LOAD(g, 1); }
                if (gq == 4) { TK_WRITE(); if (g + ngw < T / 4) TK_LOAD(g + ngw, 0); }
                const int c0 = 2 * (gq & 3);
                const u32x4 w0 = *(const LAS u32x4*)(seg + ((c0 ^ (lane & 7)) << 4)), w1 = *(const LAS u32x4*)(seg + (((c0 + 1) ^ (lane & 7)) << 4));
                unsigned ka[8], kb[8];
#pragma unroll
                for (int e2 = 0; e2 < 4; ++e2) {
                    const unsigned wa = e2 == 0 ? w0.x : (e2 == 1 ? w0.y : (e2 == 2 ? w0.z : w0.w)), wb = e2 == 0 ? w1.x : (e2 == 1 ? w1.y : (e2 == 2 ? w1.z : w1.w));
                    typedef short s16x2_t __attribute__((ext_vector_type(2)));
                    const unsigned ma = __builtin_bit_cast(unsigned, __builtin_bit_cast(s16x2_t, wa) >> (short)15) | 0x80008000u, mb = __builtin_bit_cast(unsigned, __builtin_bit_cast(s16x2_t, wb) >> (short)15) | 0x80008000u;
                    const unsigned sa = wa ^ ma, sb = wb ^ mb;
                    const unsigned i0 = (unsigned)(127 - (16 * gq + 2 * e2));
                    ka[2 * e2] = (sa << 16) | i0; ka[2 * e2 + 1] = (sa & 0xffff0000u) | (i0 - 1u);
                    kb[2 * e2] = (sb << 16) | (i0 - 8u); kb[2 * e2 + 1] = (sb & 0xffff0000u) | (i0 - 9u);
                }
                peer::sort8(ka); peer::sort8(kb);
                unsigned G[16];
#pragma unroll
                for (int i = 0; i < 8; ++i) { G[i] = ka[i]; G[8 + i] = kb[7 - i]; }
                peer::bmerge16(G);
                if (gq == 0) {
#pragma unroll
                    for (int i = 0; i < 16; ++i) L[i] = G[i];
                } else {
#pragma unroll
                    for (int i = 0; i < 16; ++i) L[i] = L[i] > G[15 - i] ? L[i] : G[15 - i];
                    peer::bmerge16(L);
                }
            }
        }
#pragma unroll
        for (int i = 0; i < 16; ++i) lists[lane * 16 + i] = L[i];
        const int p = hp & 1;
        float av[16], bv[16];
#pragma unroll
        for (int i = 0; i < 16; ++i) { const unsigned o = (unsigned)__builtin_amdgcn_update_dpp(0, (int)L[i], 0xB1, 0xF, 0xF, true); av[i] = peer::dec16(p ? o : L[i]); bv[i] = peer::dec16(p ? L[i] : o); }
        unsigned M[16];
        {
            unsigned C[32];
#pragma unroll
            for (int k = 0; k < 25; ++k) {
                const int i0 = CT.i[2 * k], j0 = CT.j[2 * k], i1 = CT.i[2 * k + 1], j1 = CT.j[2 * k + 1];
                const float s0 = av[i0] + bv[j0], s1 = av[i1] + bv[j1];
                const float sm = p ? s1 : s0; const unsigned fl = p ? (unsigned)(i1 * 16 + j1) : (unsigned)(i0 * 16 + j0);
                C[k] = (peer::enc32(sm) & 0xffffff00u) | (255u - fl);
            }
#pragma unroll
            for (int k = 25; k < 32; ++k) C[k] = 0u;
            unsigned g0[8], g1[8], g2[8], g3[8];
#pragma unroll
            for (int i = 0; i < 8; ++i) { g0[i] = C[i]; g1[i] = C[8 + i]; g2[i] = C[16 + i]; g3[i] = C[24 + i]; }
            peer::sort8(g0); peer::sort8(g1); peer::sort8(g2); peer::sort8(g3);
            unsigned H[16];
#pragma unroll
            for (int i = 0; i < 8; ++i) { M[i] = g0[i]; M[8 + i] = g1[7 - i]; H[i] = g2[i]; H[8 + i] = g3[7 - i]; }
            peer::bmerge16(M); peer::bmerge16(H);
#pragma unroll
            for (int i = 0; i < 16; ++i) M[i] = M[i] > H[15 - i] ? M[i] : H[15 - i];
            peer::bmerge16(M);
        }
        unsigned R[16];
#pragma unroll
        for (int k = 0; k < 16; ++k) { const unsigned o = (unsigned)__builtin_amdgcn_update_dpp(0, (int)M[15 - k], 0xB1, 0xF, 0xF, true); R[k] = M[k] > o ? M[k] : o; }
        float rv[16], mx = -INFINITY;
#pragma unroll
        for (int k = 0; k < 16; ++k) { rv[k] = peer::dec32(R[k] & 0xffffff00u); mx = fmaxf(mx, rv[k]); }
        float sum = 0.f;
#pragma unroll
        for (int k = 0; k < 16; ++k) { rv[k] = __builtin_amdgcn_exp2f((rv[k] - mx) * LOG2E); sum += rv[k]; }
        const float isum = 1.0f / sum;
        {
            const int h = hp >> 1;
            const LAS unsigned* la = lists + (lane & ~1) * 16; const LAS unsigned* lb = lists + (lane | 1) * 16;
#pragma unroll
            for (int k = 0; k < 8; ++k) {
                const unsigned fl = 255u - (R[k] & 0xffu);
                const unsigned i1 = 127u - (la[fl >> 4] & 0x7fu), i2 = 127u - (lb[fl & 15u] & 0x7fu);
                const int j = h * 16 + p * 8 + k, sl = j;
                const unsigned short e = (unsigned short)(i1 * 128u + i2);
                Pe_slot[(size_t)tok * 128 + sl] = e;
                Pe_ld[(size_t)tok * 128 + ld_of(j)] = e;
                Pg[(size_t)tok * 128 + sl] = rv[k] * isum;
            }
        }
        if (hp == 0) {
            float s = 0.f;
#pragma unroll
            for (int k = 0; k < 8; ++k) { const f32x4 q = *(const f32x4*)(ssq_h + (size_t)tok * 32 + 4 * k); s += (q.x + q.y) + (q.z + q.w); }
            rstd_h[tok] = 1.0f / sqrtf(s * (1.f / 1024.f) + EPS);
        }
    }
#undef TK_LOAD
#undef TK_WRITE
}

struct UG { u32x4 v[8]; };
__device__ __forceinline__ void u_gather(UG& F, const u32x4& w, const unsigned char* __restrict__ Ul  , unsigned emask, unsigned loff = 0u  ) {
#pragma unroll
    for (int i = 0; i < 8; ++i) {
        const unsigned word = (i >> 1) == 0 ? w.x : ((i >> 1) == 1 ? w.y : ((i >> 1) == 2 ? w.z : w.w));
        const unsigned e = ((i & 1) ? (word >> 16) : (word & 0xffffu)) & emask;
        F.v[i] = *(const u32x4*)(Ul + (e * 128u + loff));
    }
}
template <int PM = 0> __device__ __forceinline__ void u_compute(u32x4& z0, u32x4& z1, const UG& F, const v8i& bf0, const v8i& bf1, LAS unsigned char* hl  , int lane) {
    if (PM == 0) {
        LAS unsigned char* wp = hl + (lane >> 3) * 128 + (((lane & 7) ^ (lane >> 3)) << 4);
#pragma unroll
        for (int i = 0; i < 8; ++i) *(LAS u32x4*)(wp + i * 1024) = F.v[i];
    }
    const int r16 = lane & 15, kq = lane >> 4;
    const LAS unsigned char* rp = hl + r16 * 128;
    const int p0 = (kq ^ (r16 & 7)) << 4, p1 = ((4 + kq) ^ (r16 & 7)) << 4;
    f32x4 acc[4];
#pragma unroll
    for (int g = 0; g < 4; ++g) {
        u32x4 a0, a1; if (PM == 0) { a0 = *(const LAS u32x4*)(rp + g * 2048 + p0); a1 = *(const LAS u32x4*)(rp + g * 2048 + p1); } else { a0 = F.v[2 * g]; a1 = F.v[2 * g + 1]; }
        const v8i af0 = {(int)a0.x, (int)a0.y, (int)a0.z, (int)a0.w, 0, 0, 0, 0}, af1 = {(int)a1.x, (int)a1.y, (int)a1.z, (int)a1.w, 0, 0, 0, 0};
        acc[g] = __builtin_amdgcn_mfma_scale_f32_16x16x128_f8f6f4(af0, bf0, (f32x4){0.f, 0.f, 0.f, 0.f}, 4, 0, 0, 0, 0, 0);
        acc[g] = __builtin_amdgcn_mfma_scale_f32_16x16x128_f8f6f4(af1, bf1, acc[g], 4, 0, 0, 0, 0, 0);
    }
    z0.x = pk_bf16(acc[0][0], acc[0][1]); z0.y = pk_bf16(acc[0][2], acc[0][3]); z0.z = pk_bf16(acc[1][0], acc[1][1]); z0.w = pk_bf16(acc[1][2], acc[1][3]);
    z1.x = pk_bf16(acc[2][0], acc[2][1]); z1.y = pk_bf16(acc[2][2], acc[2][3]); z1.z = pk_bf16(acc[3][0], acc[3][1]); z1.w = pk_bf16(acc[3][2], acc[3][3]);
}
constexpr int U_REC = 512, U_CH = 16, U_STAGE = 8192, U_WLDS = U_STAGE + U_CH * U_REC;
template <int PM = 0> __device__ __forceinline__ void u_phase(LAS unsigned char* lds, const unsigned char* __restrict__ Hb8, const unsigned char* __restrict__ U4, const unsigned short* __restrict__ Pe_ld, bf16_t* __restrict__ Zp, int x, int wg, int nwg, unsigned emask = 0xffffu) {
    const int lane = threadIdx.x & 63, wid = __builtin_amdgcn_readfirstlane(threadIdx.x >> 6);
    LAS unsigned char* wl = lds + wid * U_WLDS;
    LAS unsigned char* rb = wl + U_STAGE;
    const unsigned rb_u = (unsigned)__builtin_amdgcn_readfirstlane((int)(unsigned)(uintptr_t)rb);
    const unsigned char* Hx = Hb8 + (size_t)x * ((size_t)T * 256);
    const unsigned char* Ul = U4 + (size_t)x * ((size_t)16384 * 128); const unsigned loff = 16u * (lane & 7);
    bf16_t* Zx = Zp + (size_t)x * T * 128;
    const int n = (T - wg + nwg - 1) / nwg;
    if (n <= 0) return;
    const int nch = (n + U_CH - 1) / U_CH;
#define UTOK(k) (wg + ((k) < n ? (k) : n - 1) * nwg)
#define USB() __builtin_amdgcn_sched_barrier(0)
    const int w32 = lane & 31, sub = lane >> 5;
    const unsigned char* rbase = w32 < 16 ? (const unsigned char*)Pe_ld + 16 * w32 : Hx + 16 * (w32 - 16);
#pragma unroll 1
    for (int c = 0; c < nch; ++c) {
#pragma unroll
        for (int i = 0; i < U_CH / 2; ++i)
            glds16(rbase + (size_t)UTOK(c * U_CH + 2 * i + sub) * 256u, rb_u + i * 1024);
        asm volatile("s_waitcnt vmcnt(0)" ::: "memory");
        UG f0, f1;
        { const u32x4 e0 = *(const LAS u32x4*)(rb + (lane >> 3) * 16); u_gather(f0, e0, Ul, emask, loff); }
#pragma unroll 1
        for (int i = 0; i < U_CH; ++i) {
            const int k = c * U_CH + i;
            const LAS unsigned char* rec = rb + i * U_REC;
            const LAS unsigned char* nrec = (i + 1 < U_CH) ? rec + U_REC : rec;
            const u32x4 e1 = *(const LAS u32x4*)(rec + 128 + (lane >> 3) * 16), e0n = *(const LAS u32x4*)(nrec + (lane >> 3) * 16);
            const LAS u32x4* hp = (const LAS u32x4*)(rec + 256 + 16 * (lane >> 4));
            const u32x4 h0 = hp[0], h1 = hp[4], h2 = hp[8], h3 = hp[12];
            const v8i bf0 = {(int)h0.x, (int)h0.y, (int)h0.z, (int)h0.w, (int)h1.x, (int)h1.y, (int)h1.z, (int)h1.w}, bf1 = {(int)h2.x, (int)h2.y, (int)h2.z, (int)h2.w, (int)h3.x, (int)h3.y, (int)h3.z, (int)h3.w};
            u32x4 za, zb, zc, zd;
            u_gather(f1, e1, Ul, emask, loff);
            USB(); u_compute<PM>(za, zb, f0, bf0, bf1, wl, lane); USB();
            u_gather(f0, e0n, Ul, emask, loff);
            USB(); u_compute<PM>(zc, zd, f1, bf0, bf1, wl, lane); USB();
            if ((lane & 15) == 0 && k < n) { bf16_t* zr_ = Zx + (size_t)UTOK(k) * 128 + 16 * (lane >> 4); *(u32x4*)zr_ = za; *(u32x4*)(zr_ + 8) = zb; *(u32x4*)(zr_ + 64) = zc; *(u32x4*)(zr_ + 72) = zd; }
        }
        asm volatile("s_waitcnt vmcnt(0) lgkmcnt(0)" ::: "memory");
    }
#undef UTOK
#undef USB
}

__device__ __forceinline__ float dppf(float v, int ctrl_sel) {
    const int s = __builtin_bit_cast(int, v);
    const int r = ctrl_sel == 0 ? __builtin_amdgcn_update_dpp(0, s, 0xB1, 0xF, 0xF, true) : ctrl_sel == 1 ? __builtin_amdgcn_update_dpp(0, s, 0x4E, 0xF, 0xF, true)
                : ctrl_sel == 2 ? __builtin_amdgcn_update_dpp(0, s, 0x141, 0xF, 0xF, true) : ctrl_sel == 3 ? __builtin_amdgcn_update_dpp(0, s, 0x140, 0xF, 0xF, true) : __builtin_amdgcn_update_dpp(0, s, 0x128, 0xF, 0xF, true);
    return __builtin_bit_cast(float, r);
}
constexpr float SA = 64.f;
__device__ __forceinline__ void act_phase(LAS unsigned char* lds, const bf16_t* __restrict__ Zp, const unsigned short* __restrict__ Pe_slot, const float* __restrict__ Pg, const float* __restrict__ ssq_h,
                                          unsigned short* __restrict__ PE2, unsigned char* __restrict__ PA2, int gw, int ngw) {
    const int lane = threadIdx.x & 63, wid = __builtin_amdgcn_readfirstlane(threadIdx.x >> 6);
    LAS unsigned short* lid = (LAS unsigned short*)(lds + wid * 512);
    LAS unsigned char* lw = lds + wid * 512 + 256;
    unsigned zw[4], ew; f32x2 gg; float sp;
#define ACT_LOAD(t_) do { const size_t o_ = (size_t)(t_) * 128 + 2 * lane; _Pragma("unroll") for (int xx = 0; xx < 4; ++xx) zw[xx] = *(const unsigned*)(Zp + (size_t)xx * T * 128 + o_); \
        ew = *(const unsigned*)(Pe_slot + o_); gg = *(const f32x2*)(Pg + o_); sp = ssq_h[(size_t)(t_) * 32 + (lane & 31)]; } while (0)
    if (gw < T) ACT_LOAD(gw);
    for (int tok = gw; tok < T; tok += ngw) {
        float z0 = 0.f, z1 = 0.f;
#pragma unroll
        for (int xx = 0; xx < 4; ++xx) { z0 += bf_lo(zw[xx]); z1 += bf_hi(zw[xx]); }
        const unsigned e2 = ew; const f32x2 g2 = gg;
        float s = sp;
        if (tok + ngw < T) ACT_LOAD(tok + ngw);
        s += dppf(s, 0); s += dppf(s, 1); s += dppf(s, 2); s += dppf(s, 3);
        const int si = __builtin_bit_cast(int, s);
        const float tot = __builtin_bit_cast(float, __builtin_amdgcn_readlane(si, 0)) + __builtin_bit_cast(float, __builtin_amdgcn_readlane(si, 16));
        const float zs = (1.0f / sqrtf(tot * (1.f / 1024.f) + EPS)) * (1.0f / (SU * SX));
        const float w0 = fminf(fmaxf(peer::gelu1(z0 * zs) * g2.x * SA, -440.f), 440.f), w1 = fminf(fmaxf(peer::gelu1(z1 * zs) * g2.y * SA, -440.f), 440.f);
        const unsigned w8 = (unsigned)__builtin_amdgcn_cvt_pk_fp8_f32(w0, w1, 0, false);
        const int sl0 = 2 * lane, d0 = (sl0 & 7) * 16 + (sl0 >> 3), d1 = ((sl0 + 1) & 7) * 16 + (sl0 >> 3);
        lid[d0] = (unsigned short)(e2 & 0xffffu); lid[d1] = (unsigned short)(e2 >> 16);
        lw[d0] = (unsigned char)(w8 & 0xffu); lw[d1] = (unsigned char)((w8 >> 8) & 0xffu);
        const u32x4 ov = *(const LAS u32x4*)(lds + wid * 512 + 16 * lane);
        if (lane < 16) *(u32x4*)(PE2 + (size_t)tok * 128 + 8 * lane) = ov;
        else if (lane < 24) *(u32x4*)(PA2 + (size_t)tok * 128 + 16 * (lane - 16)) = ov;
    }
#undef ACT_LOAD
}

struct VG { u32x4 v[8]; u32x2 w; };
template <int PM = 0> __device__ __forceinline__ void v_gather(VG& Gt, const u32x4& ew, const u32x2& ww, const unsigned char* __restrict__ vb  , unsigned loff  , unsigned emask) {
    Gt.w = ww;
#pragma unroll
    for (int i = 0; i < 8; ++i) {
        const unsigned word = (i >> 1) == 0 ? ew.x : ((i >> 1) == 1 ? ew.y : ((i >> 1) == 2 ? ew.z : ew.w));
        const unsigned e = ((i & 1) ? (word >> 16) : (word & 0xffffu)) & emask;
        if (PM == 1 && (i & 1)) Gt.v[i] = Gt.v[i - 1]; else
        Gt.v[i] = *(const u32x4*)(vb + (e * 128u + loff));
    }
}
struct VSel { unsigned lo[4], hi[4]; };
__device__ __forceinline__ void v_compute(f32x4& accL, f32x4& accH, const VG& Gt, const VSel& S) {
#pragma unroll
    for (int i = 0; i < 8; ++i) {
        const unsigned d = i < 4 ? Gt.w.x : Gt.w.y;
        const unsigned b0 = __builtin_amdgcn_perm(d, d, S.lo[i & 3]), b1 = __builtin_amdgcn_perm(d, d, S.hi[i & 3]);
        const long aL = (long)(((unsigned long long)Gt.v[i].y << 32) | Gt.v[i].x), aH = (long)(((unsigned long long)Gt.v[i].w << 32) | Gt.v[i].z);
        const long bb = (long)(((unsigned long long)b1 << 32) | b0);
        accL = __builtin_amdgcn_mfma_f32_16x16x32_fp8_fp8(aL, bb, accL, 0, 0, 0);
        accH = __builtin_amdgcn_mfma_f32_16x16x32_fp8_fp8(aH, bb, accH, 0, 0, 0);
    }
}
constexpr int V_REC = 512, V_CH = 16, V_WLDS = V_CH * V_REC + 1024;
template <int PM = 0> __device__ __forceinline__ void v_phase(LAS unsigned char* lds, const unsigned char* __restrict__ V8, const unsigned short* __restrict__ PE2, const unsigned char* __restrict__ PA2, bf16_t* __restrict__ Op, int x, int wg, int nwg, unsigned emask = 0xffffu) {
    const int lane = threadIdx.x & 63, wid = __builtin_amdgcn_readfirstlane(threadIdx.x >> 6), seg8 = lane >> 3, bp = lane & 7;
    LAS unsigned char* rb = lds + wid * V_WLDS;
    LAS float* tr = (LAS float*)(rb + V_CH * V_REC);
    const unsigned rb_u = (unsigned)__builtin_amdgcn_readfirstlane((int)(unsigned)(uintptr_t)rb);
    const unsigned char* vb = V8 + (size_t)x * ((size_t)16384 * 128); const unsigned loff = 16u * (lane & 7);
    bf16_t* Ox = Op + (size_t)x * T * 128;
    VSel S;
    { const unsigned none = 0x0c0c0c0cu, keep = none & ~(0xffu << (8 * (bp & 3)));
#pragma unroll
      for (int q = 0; q < 4; ++q) { const unsigned sq = keep | ((unsigned)q << (8 * (bp & 3))); S.lo[q] = bp < 4 ? sq : none; S.hi[q] = bp < 4 ? none : sq; } }
    const bool dvalid = ((lane >> 3) & 1) == (lane >> 5);
    LAS float* trw = tr + (lane >> 5) * 128 + 64 * ((lane >> 4) & 1) + bp;
    const int n = (T - wg + nwg - 1) / nwg;
    if (n <= 0) return;
    const int nch = (n + V_CH - 1) / V_CH;
#define VTOK(k) (wg + ((k) < n ? (k) : n - 1) * nwg)
    const int w32 = lane & 31, sub = lane >> 5;
    const unsigned char* rbase = w32 < 16 ? (const unsigned char*)PE2 + 16 * w32 : (w32 < 24 ? PA2 + 16 * (w32 - 16) : (const unsigned char*)PE2);
    const unsigned rstride = (w32 >= 16 && w32 < 24) ? 128u : 256u;
    const int roff = seg8 * 32, woff = 256 + seg8 * 16;
#pragma unroll 1
    for (int c = 0; c < nch; ++c) {
        if (PM != 2 || c == 0) {
#pragma unroll
        for (int i = 0; i < V_CH / 2; ++i)
            glds16(rbase + (size_t)VTOK(c * V_CH + 2 * i + sub) * rstride, rb_u + i * 1024);
        asm volatile("s_waitcnt vmcnt(0)" ::: "memory");
        }
        VG g0, g1;
        { const u32x4 ea = *(const LAS u32x4*)(rb + roff); const u32x2 wa = *(const LAS u32x2*)(rb + woff); v_gather<PM>(g0, ea, wa, vb, loff, emask); }
#pragma unroll 1
        for (int i = 0; i < V_CH; ++i) {
            const int k = c * V_CH + i, tok = VTOK(k);
            const LAS unsigned char* rec = rb + i * V_REC;
            const LAS unsigned char* nrec = (i + 1 < V_CH) ? rec + V_REC : rec;
            f32x4 accL = {0.f, 0.f, 0.f, 0.f}, accH = {0.f, 0.f, 0.f, 0.f};
            { const u32x4 ea = *(const LAS u32x4*)(rec + roff + 16); const u32x2 wa = *(const LAS u32x2*)(rec + woff + 8); v_gather<PM>(g1, ea, wa, vb, loff, emask); }
            __builtin_amdgcn_sched_barrier(0);
            v_compute(accL, accH, g0, S);
            { const u32x4 ea = *(const LAS u32x4*)(nrec + roff); const u32x2 wa = *(const LAS u32x2*)(nrec + woff); v_gather<PM>(g0, ea, wa, vb, loff, emask); }
            __builtin_amdgcn_sched_barrier(0);
            v_compute(accL, accH, g1, S);
            if (dvalid) {
#pragma unroll
                for (int r = 0; r < 4; ++r) { trw[16 * r] = accL[r]; trw[16 * r + 8] = accH[r]; }
            }
            const f32x4 oa = *(const LAS f32x4*)(tr + 4 * w32), ob = *(const LAS f32x4*)(tr + 128 + 4 * w32);
            if (lane < 32 && k < n) {
                constexpr float sc = 1.0f / (SA * SV);
                u32x2 w; w.x = pk_bf16((oa.x + ob.x) * sc, (oa.y + ob.y) * sc); w.y = pk_bf16((oa.z + ob.z) * sc, (oa.w + ob.w) * sc); *(u32x2*)(Ox + (size_t)tok * 128 + 4 * lane) = w;
            }
        }
        if (PM != 2) asm volatile("s_waitcnt vmcnt(0) lgkmcnt(0)" ::: "memory");
    }
#undef VTOK
}

__device__ __forceinline__ void final_phase(float* __restrict__ Out, const bf16_t* __restrict__ Hb, const bf16_t* __restrict__ Op, const float* __restrict__ g_final, int gw, int ngw) {
    const int lane = threadIdx.x & 63;
    const f32x4* gr = (const f32x4*)g_final + lane;
    const f32x4 g0 = gr[0], g1 = gr[64], g2 = gr[128], g3 = gr[192];
    const bf16_t* ob = Op + (size_t)(lane >> 5) * T * 128 + 4 * (lane & 31);
    for (int t0 = 4 * gw; t0 < T; t0 += 4 * ngw) {
        u32x2 hh[4][4], o[4][4];
#pragma unroll
        for (int r = 0; r < 4; ++r) {
            const int tok = t0 + r < T ? t0 + r : T - 1;
            const bf16_t* hr = Hb + (size_t)tok * DM + 4 * lane;
#pragma unroll
            for (int j = 0; j < 4; ++j) { hh[r][j] = *(const u32x2*)(hr + 256 * j); o[r][j] = *(const u32x2*)(ob + ((size_t)(2 * j) * T + tok) * 128); }
        }
#pragma unroll
        for (int r = 0; r < 4; ++r) {
            if (t0 + r >= T) break;
            f32x4 y[4];
            float s = 0.f;
#pragma unroll
            for (int j = 0; j < 4; ++j) {
                y[j].x = bf_lo(hh[r][j].x) + bf_lo(o[r][j].x); y[j].y = bf_hi(hh[r][j].x) + bf_hi(o[r][j].x); y[j].z = bf_lo(hh[r][j].y) + bf_lo(o[r][j].y); y[j].w = bf_hi(hh[r][j].y) + bf_hi(o[r][j].y);
                s += (y[j].x * y[j].x + y[j].y * y[j].y) + (y[j].z * y[j].z + y[j].w * y[j].w);
            }
            s += dppf(s, 0); s += dppf(s, 1); s += dppf(s, 2); s += dppf(s, 3);
            const int si = __builtin_bit_cast(int, s);
            const float tot = (__builtin_bit_cast(float, __builtin_amdgcn_readlane(si, 0)) + __builtin_bit_cast(float, __builtin_amdgcn_readlane(si, 16)))
                            + (__builtin_bit_cast(float, __builtin_amdgcn_readlane(si, 32)) + __builtin_bit_cast(float, __builtin_amdgcn_readlane(si, 48)));
            const float r2 = 1.0f / sqrtf(tot * (1.f / 1024.f) + EPS);
            f32x4* yr = (f32x4*)(Out + (size_t)(t0 + r) * DM) + lane;
            yr[0] = (f32x4){y[0].x * r2 * g0.x, y[0].y * r2 * g0.y, y[0].z * r2 * g0.z, y[0].w * r2 * g0.w};
            yr[64] = (f32x4){y[1].x * r2 * g1.x, y[1].y * r2 * g1.y, y[1].z * r2 * g1.z, y[1].w * r2 * g1.w};
            yr[128] = (f32x4){y[2].x * r2 * g2.x, y[2].y * r2 * g2.y, y[2].z * r2 * g2.z, y[2].w * r2 * g2.w};
            yr[192] = (f32x4){y[3].x * r2 * g3.x, y[3].y * r2 * g3.y, y[3].z * r2 * g3.z, y[3].w * r2 * g3.w};
        }
    }
}
}


#define XB_TMO      128
#define XB_XCNT(j)  (256  + 64 * (j))
#define XB_XSUB(j)  (1280 + 64 * (j))
#define XB_XGEN(j)  (2304 + 64 * (j))
#define XB_TOP      3328
#define XB_TOPGEN   3392
#define XCD_BAR_WORDS 3456
#define XB_SPIN_CAP (1u << 18)

__device__ __forceinline__ unsigned xb_ld(unsigned* p)              { return __hip_atomic_load(p, __ATOMIC_RELAXED, __HIP_MEMORY_SCOPE_AGENT); }
__device__ __forceinline__ unsigned xb_add(unsigned* p, unsigned v) { return __hip_atomic_fetch_add(p, v, __ATOMIC_RELAXED, __HIP_MEMORY_SCOPE_AGENT); }
__device__ __forceinline__ unsigned xb_xcc_id() { return (unsigned)__builtin_amdgcn_s_getreg((3 << 11) | 20) & 0xFu; }
#define XB_SPIN(cond, bar) do { unsigned _sp = 0; while (cond) { __builtin_amdgcn_s_sleep(1); \
    if ((++_sp & 255u) == 0u) { if (xb_ld(&(bar)[XB_TMO])) break; if (_sp > XB_SPIN_CAP) { atomicAdd(&(bar)[XB_TMO], 1u); break; } } } } while (0)

struct XcdBarrier {
    unsigned* bar; unsigned x;
    volatile LAS unsigned* st;
};

__device__ __forceinline__ XcdBarrier xcd_barrier_post(unsigned* bar, volatile LAS unsigned* st) {
    XcdBarrier b; b.bar = bar; b.x = xb_xcc_id(); b.st = st;
    if (threadIdx.x == 0) (void)xb_add(&bar[XB_XCNT(b.x)], 1u);
    return b;
}
__device__ __forceinline__ void xcd_barrier_complete(unsigned* bar, unsigned x, unsigned& nloc, unsigned& nx) {
    const unsigned G = gridDim.x * gridDim.y * gridDim.z;
    unsigned sum, cnt, mine, sp = 0u;
    for (;;) {
        sum = 0u; cnt = 0u; mine = 0u;
#pragma unroll
        for (unsigned j = 0; j < 16; ++j) { const unsigned c = xb_ld(&bar[XB_XCNT(j)]); sum += c; cnt += (c > 0u) ? 1u : 0u; mine = (j == x) ? c : mine; }
        if (sum == G) break;
        __builtin_amdgcn_s_sleep(1);
        if ((++sp & 255u) == 0u) { if (xb_ld(&bar[XB_TMO])) break; if (sp > XB_SPIN_CAP) { atomicAdd(&bar[XB_TMO], 1u); break; } }
    }
    nloc = mine > 0u ? mine : 1u; nx = cnt > 0u ? cnt : 1u;
}

__device__ __forceinline__ void xcd_barrier(const XcdBarrier& b) {
    asm volatile("s_waitcnt vmcnt(0)" ::: "memory");
    __syncthreads();
    if (threadIdx.x == 0) {
        unsigned* bar = b.bar;
        __builtin_amdgcn_s_waitcnt(0);
        unsigned nloc = b.st[0], nx = b.st[1];
        if (nloc == 0u) { xcd_barrier_complete(bar, b.x, nloc, nx); b.st[0] = nloc; b.st[1] = nx; }
        const unsigned old = xb_add(&bar[XB_XSUB(b.x)], 1u);
        const unsigned gen = old / nloc;
        if (old + 1u == (gen + 1u) * nloc) {
            __builtin_amdgcn_fence(__ATOMIC_RELEASE, "agent");
            asm volatile("s_waitcnt vmcnt(0)" ::: "memory");
            const unsigned og = xb_add(&bar[XB_TOP], 1u);
            const unsigned tg = og / nx;
            if (og + 1u == (tg + 1u) * nx) xb_add(&bar[XB_TOPGEN], 1u);
            else XB_SPIN(xb_ld(&bar[XB_TOPGEN]) == tg, bar);
            __builtin_amdgcn_fence(__ATOMIC_ACQUIRE, "agent");
            xb_add(&bar[XB_XGEN(b.x)], 1u);
            asm volatile("s_waitcnt vmcnt(0)" ::: "memory");
        } else {
            XB_SPIN(xb_ld(&bar[XB_XGEN(b.x)]) == gen, bar);
            __builtin_amdgcn_fence(__ATOMIC_ACQUIRE, "agent");
            asm volatile("s_waitcnt vmcnt(0)" ::: "memory");
        }
    }
    __syncthreads();
}

constexpr int NWAVES = 8;
constexpr int LDS_BYTES = 147456;
constexpr int MISC_OFF = 146432;

struct Args {
    const float *x, *g_mix, *w_in, *g_cq, *w_uq, *g_ckv, *w_ukv, *w_out, *g_ffn, *w_pq, *sub_keys, *u_emb, *v_emb, *g_final;
    const int* pos; float* out; unsigned char* ws; int ph_lo, ph_hi; unsigned probe_mask; int probe_shift;
};

__device__ __forceinline__ void p0_transpose_item(const float* __restrict__ W, int K, int N, const float* __restrict__ gk, bf16_t* __restrict__ WT, LAS float* scr, int item, int lane) {
    const int nblk = N / 32, kb = item / nblk, nb = item % nblk, k0 = 64 * kb, n0 = 32 * nb;
    float wv[32];
#pragma unroll
    for (int i = 0; i < 32; ++i) { const int kk = 2 * i + (lane >> 5); wv[i] = W[(size_t)(k0 + kk) * N + n0 + (lane & 31)]; if (gk) wv[i] *= gk[k0 + kk]; }
#pragma unroll
    for (int i = 0; i < 32; ++i) { const int kk = 2 * i + (lane >> 5); scr[kk * 33 + (lane & 31)] = wv[i]; }
    asm volatile("s_waitcnt lgkmcnt(0)" ::: "memory");
    const int c = lane & 7;
#pragma unroll
    for (int j = 0; j < 4; ++j) { const int n = (lane >> 3) + 8 * j; const LAS float* s = scr + (8 * c) * 33 + n;
        u32x4 o; o.x = pk_bf16(s[0 * 33], s[1 * 33]); o.y = pk_bf16(s[2 * 33], s[3 * 33]); o.z = pk_bf16(s[4 * 33], s[5 * 33]); o.w = pk_bf16(s[6 * 33], s[7 * 33]);
        *(u32x4*)(WT + (size_t)(n0 + n) * K + k0 + 8 * c) = o; }
    asm volatile("s_waitcnt lgkmcnt(0)" ::: "memory");
}
__device__ __forceinline__ bf16x8 cvt8(const float* p, float s) { const f32x4 a = *(const f32x4*)p, b = *(const f32x4*)(p + 4); u32x4 w; w.x = pk_bf16(a.x * s, a.y * s); w.y = pk_bf16(a.z * s, a.w * s); w.z = pk_bf16(b.x * s, b.y * s); w.w = pk_bf16(b.z * s, b.w * s); return __builtin_bit_cast(bf16x8, w); }
__device__ __forceinline__ void p0_wcomb_item(const float* __restrict__ keys, const float* __restrict__ w_pq, const float* __restrict__ g_ffn, bf16_t* __restrict__ Wc, int item, int lane) {
    const int hp = item >> 7, nblk = (item >> 5) & 3, kblk = item & 31, n0 = 32 * nblk, k0 = 32 * kblk, r32 = lane & 31, hi = lane >> 5;
    const float* ar = keys + ((size_t)hp * 128 + n0 + r32) * 128 + 8 * hi;
    const float* br = w_pq + (size_t)(k0 + r32) * 2048 + hp * 128 + 8 * hi;
    const float gk = g_ffn[k0 + r32];
    f32x16 d = {};
#pragma unroll
    for (int cs = 0; cs < 8; ++cs) d = __builtin_amdgcn_mfma_f32_32x32x16_bf16(cvt8(ar + 16 * cs, 1.f), cvt8(br + 16 * cs, 1.f), d, 0, 0, 0);
#pragma unroll
    for (int r = 0; r < 16; ++r) Wc[((size_t)hp * 128 + n0 + crow(r, hi)) * DM + k0 + r32] = (bf16_t)(pk_bf16(d[r] * gk, 0.f) & 0xffffu);
}
__device__ __forceinline__ void p0_prologue(const Args& a, LAS unsigned char* lds, int gw, int ngw, int lane, int wave) {
    unsigned char* ws = a.ws;
    LAS float* scr = (LAS float*)(lds + wave * 16384);
    bf16_t* Wt_in = (bf16_t*)(ws + WS_WIN); bf16_t* Wt_comb = (bf16_t*)(ws + WS_WCOMB); bf16_t* Wt_out = (bf16_t*)(ws + WS_WOUT); bf16_t* Wt_uq = (bf16_t*)(ws + WS_WUQ); bf16_t* Wt_ukv = (bf16_t*)(ws + WS_WUKV);
    constexpr int I_IN = (DM / 64) * (INW / 32), I_UQ = (256 / 64) * (768 / 32), I_UKV = (128 / 64) * (1024 / 32), I_OUT = (DM / 64) * (DM / 32), I_WC = 2048;
    constexpr int NITEMS = I_IN + I_UQ + I_UKV + I_OUT + I_WC;
    for (int it = gw; it < NITEMS; it += ngw) {
        int r = it;
        if (r < I_IN) { p0_transpose_item(a.w_in, DM, INW, nullptr, Wt_in, scr, r, lane); continue; } r -= I_IN;
        if (r < I_UQ) { p0_transpose_item(a.w_uq, 256, 768, a.g_cq, Wt_uq, scr, r, lane); continue; } r -= I_UQ;
        if (r < I_UKV) { p0_transpose_item(a.w_ukv, 128, 1024, a.g_ckv, Wt_ukv, scr, r, lane); continue; } r -= I_UKV;
        if (r < I_OUT) { p0_transpose_item(a.w_out, DM, DM, nullptr, Wt_out, scr, r, lane); continue; } r -= I_OUT;
        p0_wcomb_item(a.sub_keys, a.w_pq, a.g_ffn, Wt_comb, r, lane);
    }
    const int gt = gw * 64 + lane, ngt = ngw * 64;
    for (int i = gt; i < (2048 - INW) * DM / 8; i += ngt) *(u32x4*)(Wt_in + (size_t)INW * DM + (size_t)i * 8) = (u32x4){0u, 0u, 0u, 0u};
    { bf16_t* HN = (bf16_t*)(ws + WS_HN);
      const f32x4* gr = (const f32x4*)a.g_mix + lane;
      const f32x4 g0 = gr[0], g1 = gr[64], g2 = gr[128], g3 = gr[192];
      for (int m0 = 4 * gw; m0 < T; m0 += 4 * ngw) {
          f32x4 v[4][4];
#pragma unroll
          for (int r = 0; r < 4; ++r) { const f32x4* xr = (const f32x4*)(a.x + (size_t)(m0 + r) * DM) + lane; v[r][0] = xr[0]; v[r][1] = xr[64]; v[r][2] = xr[128]; v[r][3] = xr[192]; }
#pragma unroll
          for (int r = 0; r < 4; ++r) {
              float s = 0.f;
#pragma unroll
              for (int j = 0; j < 4; ++j) s += (v[r][j].x * v[r][j].x + v[r][j].y * v[r][j].y) + (v[r][j].z * v[r][j].z + v[r][j].w * v[r][j].w);
              const float rstd = 1.0f / sqrtf(wave_sum(s) * (1.f / DM) + EPS);
              u32x2* o8 = (u32x2*)(HN + (size_t)(m0 + r) * DM) + lane;
              u32x2 w;
              w.x = pk_bf16(v[r][0].x * rstd * g0.x, v[r][0].y * rstd * g0.y); w.y = pk_bf16(v[r][0].z * rstd * g0.z, v[r][0].w * rstd * g0.w); o8[0] = w;
              w.x = pk_bf16(v[r][1].x * rstd * g1.x, v[r][1].y * rstd * g1.y); w.y = pk_bf16(v[r][1].z * rstd * g1.z, v[r][1].w * rstd * g1.w); o8[64] = w;
              w.x = pk_bf16(v[r][2].x * rstd * g2.x, v[r][2].y * rstd * g2.y); w.y = pk_bf16(v[r][2].z * rstd * g2.z, v[r][2].w * rstd * g2.w); o8[128] = w;
              w.x = pk_bf16(v[r][3].x * rstd * g3.x, v[r][3].y * rstd * g3.y); w.y = pk_bf16(v[r][3].z * rstd * g3.z, v[r][3].w * rstd * g3.w); o8[192] = w;
          } } }
    { float* cosA = (float*)(ws + WS_COSA); float* sinA = (float*)(ws + WS_SINA); float* cosM = (float*)(ws + WS_COSM); float* sinM = (float*)(ws + WS_SINM);
      constexpr float INV16[16] = {1.0f, 0.44036659598350525f, 0.1939227432012558f, 0.08539710193872452f, 0.03760603070259094f, 0.016560440883040428f, 0.007292664609849453f, 0.0032114461064338684f,
                                   0.0014142135623842478f, 0.0006227724370546639f, 0.00027424818836152554f, 0.00012076973507646471f, 5.3182957344688475e-05f, 2.34199997066753e-05f, 1.0313385246263351e-05f, 4.541670477919979e-06f};
      for (int i = gt; i < T * 16; i += ngt) {
          const int tok = i >> 4, j = i & 15;
          const float ang = (float)a.pos[tok] * INV16[j];
          float sn, cs; sincosf(ang, &sn, &cs);
          cosM[tok * 16 + j] = cs; sinM[tok * 16 + j] = sn;
          if ((j & 1) == 0) { cosA[tok * 8 + (j >> 1)] = cs; sinA[tok * 8 + (j >> 1)] = sn; } } }
}

__global__ void __launch_bounds__(NWAVES * 64, 2) mk_fwd(Args a) {
    extern __shared__ __attribute__((aligned(16))) unsigned char lds_raw[];
    LAS unsigned char* lds = (LAS unsigned char*)lds_raw;
    volatile LAS unsigned* MISC = (volatile LAS unsigned*)(lds + MISC_OFF);
    const int tid = threadIdx.x, lane = tid & 63, wave = __builtin_amdgcn_readfirstlane(tid >> 6);
    const int G = gridDim.x, bx = blockIdx.x, vcu = (G % 8 == 0) ? (bx % 8) * (G / 8) + bx / 8 : bx;
    unsigned char* ws = a.ws;
    for (int u = tid; u < 64; u += NWAVES * 64) MISC[u] = 0u;
    __syncthreads();
    XcdBarrier bar = xcd_barrier_post((unsigned*)(ws + WS_CTL), MISC + 8);
    const int lo = a.ph_lo, hi = a.ph_hi;
#ifdef PROBE_LO
#define PMASK a.probe_mask
#else
#define PMASK 0xffffu
#endif
#define IN(k) (lo <= (k) && (k) < hi)
#ifdef PROBE_LO
#define RUN(k) (IN(k) && !(a.probe_shift & 16))
#else
#define RUN(k) IN(k)
#endif
#define SEAM(k) do { if (IN(k) && IN((k) + 1)) xcd_barrier(bar); } while (0)
    const int gw = vcu * NWAVES + wave, ngw = G * NWAVES;

    if (RUN(0)) { p0_prologue(a, lds, gw, ngw, lane, wave); }
    SEAM(0);
    if (RUN(1)) {
        pg8::Gemm g{(const bf16_t*)(ws + WS_HN), (const bf16_t*)(ws + WS_WIN), T, 2048, DM}; pg8::StaticOrder S; S.init(T, 2048, G, bx);
        pg8::EpiProj E{(bf16_t*)(ws + WS_QA), (bf16_t*)(ws + WS_KA), (bf16_t*)(ws + WS_VA), (bf16_t*)(ws + WS_CQ), (bf16_t*)(ws + WS_CKV), (bf16_t*)(ws + WS_KR),
                       (float*)(ws + WS_SSQQ), (float*)(ws + WS_SSQKV), (const float*)(ws + WS_COSA), (const float*)(ws + WS_SINA), (const float*)(ws + WS_COSM), (const float*)(ws + WS_SINM)};
        pg8::gemm_phase<pg8::EpiProj, pg8::StaticOrder, true, true>(lds, g, S, E);
    }
    SEAM(1);
    if (RUN(2)) {
        { int kk = 128; asm volatile("" : "+s"(kk));
          pg8::Gemm g{(const bf16_t*)(ws + WS_CKV), (const bf16_t*)(ws + WS_WUKV), T, 1024, kk}; pg8::StaticOrder S; S.init(T, 1024, G, bx);
          pg8::EpiKv E{(bf16_t*)(ws + WS_KN), (bf16_t*)(ws + WS_VM), (const float*)(ws + WS_SSQKV)};
          pg8::gemm_phase<pg8::EpiKv, pg8::StaticOrder, true, true>(lds, g, S, E); }
        __syncthreads();
        { int kk = 256; asm volatile("" : "+s"(kk));
          pg8::Gemm g{(const bf16_t*)(ws + WS_CQ), (const bf16_t*)(ws + WS_WUQ), T, 768, kk}; pg8::StaticOrder S; S.init(T, 768, G, bx);
          pg8::EpiQm E{(bf16_t*)(ws + WS_QM), (const float*)(ws + WS_SSQQ), (const float*)(ws + WS_COSM), (const float*)(ws + WS_SINM)};
          pg8::gemm_phase<pg8::EpiQm, pg8::StaticOrder, true, true>(lds, g, S, E); }
    }
    SEAM(2);
    if (RUN(3)) {
        if (!(a.probe_shift & 1)) for (int pr = vcu; pr < 256; pr += G) {
            const int bh = pr >> 4, s = pr & 15;
            att::mla_unit(lds, (const bf16_t*)(ws + WS_QM), (const bf16_t*)(ws + WS_KN), (const bf16_t*)(ws + WS_KR), (const bf16_t*)(ws + WS_VM), (bf16_t*)(ws + WS_MIXED), bh >> 3, bh & 7, 31 - s,
                          a.u_emb, a.v_emb, a.g_ffn, ws + WS_U8, ws + WS_V8, pr * 528);
            att::mla_unit(lds, (const bf16_t*)(ws + WS_QM), (const bf16_t*)(ws + WS_KN), (const bf16_t*)(ws + WS_KR), (const bf16_t*)(ws + WS_VM), (bf16_t*)(ws + WS_MIXED), bh >> 3, bh & 7, s,
                          a.u_emb, a.v_emb, a.g_ffn, ws + WS_U8, ws + WS_V8, pr * 528 + 16 * (32 - s));
        }
        if (!(a.probe_shift & 2)) for (int sg = vcu; sg < 256; sg += G)
            att::dil_segment(lds, (const bf16_t*)(ws + WS_QA), (const bf16_t*)(ws + WS_KA), (const bf16_t*)(ws + WS_VA), (bf16_t*)(ws + WS_MIXED), sg, wave, lane, a.probe_shift);
    }
    SEAM(3);
    if (RUN(4)) {
        pg8::Gemm g{(const bf16_t*)(ws + WS_MIXED), (const bf16_t*)(ws + WS_WOUT), T, DM, DM}; pg8::StaticOrder S; S.init(T, DM, G, bx);
        pg8::EpiOut E{a.x, (bf16_t*)(ws + WS_HB), ws + WS_HB8, (float*)(ws + WS_SSQH)};
        pg8::gemm_phase<pg8::EpiOut, pg8::StaticOrder, true, true>(lds, g, S, E);
    }
    SEAM(4);
    if (RUN(5)) {
        pg8::Gemm g{(const bf16_t*)(ws + WS_HB), (const bf16_t*)(ws + WS_WCOMB), T, 2048, DM}; pg8::StaticOrder S; S.init(T, 2048, G, bx);
        pg8::EpiSc E{(bf16_t*)(ws + WS_SC), (const float*)(ws + WS_SSQH)};
        pg8::gemm_phase<pg8::EpiSc, pg8::StaticOrder, true, true>(lds, g, S, E);
    }
    SEAM(5);
    if (RUN(6)) {
        peer2::topk_phase(lds, (const bf16_t*)(ws + WS_SC), (const float*)(ws + WS_SSQH), (unsigned short*)(ws + WS_PESLOT), (unsigned short*)(ws + WS_PEROW), (float*)(ws + WS_PG), (float*)(ws + WS_RSTDH), gw, ngw);
    }
    SEAM(6);
    const int sx = bx % 8, smem = (bx / 8) * NWAVES + wave, scnt = ((G - sx + 7) / 8) * NWAVES;
    const int usl = sx >> 1, un0 = (G - 2 * usl + 7) / 8, un1 = (G - (2 * usl + 1) + 7) / 8;
    const int usmem = ((sx & 1) ? un0 + bx / 8 : bx / 8) * NWAVES + wave, uscnt = (un0 + un1) * NWAVES;
#ifdef PROBE_LO
    if (RUN(7) && (a.probe_shift & 8)) { peer2::u_phase<1>(lds, ws + WS_HB8, ws + WS_U8, (const unsigned short*)(ws + WS_PEROW), (bf16_t*)(ws + 160 * MiB), usl, usmem, uscnt, PMASK); } else
#endif
    if (RUN(7)) { peer2::u_phase(lds, ws + WS_HB8, ws + WS_U8, (const unsigned short*)(ws + WS_PEROW), (bf16_t*)(ws + WS_ZP), usl, usmem, uscnt, PMASK); }
    SEAM(7);
    if (RUN(8)) { peer2::act_phase(lds, (const bf16_t*)(ws + WS_ZP), (const unsigned short*)(ws + WS_PESLOT), (const float*)(ws + WS_PG), (const float*)(ws + WS_SSQH), (unsigned short*)(ws + WS_PE2), ws + WS_PA2, gw, ngw); }
    SEAM(8);
#ifdef PROBE_LO
    if (RUN(9) && (a.probe_shift & 128)) { peer2::v_phase<2>(lds, ws + WS_V8, (const unsigned short*)(ws + WS_PE2), ws + WS_PA2, (bf16_t*)(ws + 160 * MiB), sx, smem, scnt, PMASK); } else
    if (RUN(9) && (a.probe_shift & 4)) { peer2::v_phase<1>(lds, ws + WS_V8, (const unsigned short*)(ws + WS_PE2), ws + WS_PA2, (bf16_t*)(ws + WS_OP), sx, smem, scnt, PMASK); } else
#endif
    if (RUN(9)) { peer2::v_phase(lds, ws + WS_V8, (const unsigned short*)(ws + WS_PE2), ws + WS_PA2, (bf16_t*)(ws + WS_OP), sx, smem, scnt, PMASK); }
    SEAM(9);
    if (RUN(10)) { peer2::final_phase(a.out, (const bf16_t*)(ws + WS_HB), (const bf16_t*)(ws + WS_OP), a.g_final, gw, ngw); }
#undef IN
#undef RUN
#undef SEAM
}


#ifndef STAGE
#define STAGE 6
#endif
extern "C" void kernel_launch(void* const* d_in, const int* in_sizes, int n_in, void* d_out, int out_size, void* d_ws, size_t ws_size, hipStream_t stream) {
    static int grid = 0;
    if (grid == 0) {
        if (n_in != 15 || out_size != T * DM || ws_size < 256 * MiB) { fprintf(stderr, "kernel_launch: unexpected problem shape (n_in %d, out %d, ws %zu); nothing launched\n", n_in, out_size, ws_size); grid = -1; return; }
        int dev = 0, cus = 0, per_cu = 0;
        if (hipGetDevice(&dev) != hipSuccess || hipDeviceGetAttribute(&cus, hipDeviceAttributeMultiprocessorCount, dev) != hipSuccess) { grid = -1; return; }
        if (hipFuncSetAttribute((const void*)mk_fwd, hipFuncAttributeMaxDynamicSharedMemorySize, LDS_BYTES) != hipSuccess) { fprintf(stderr, "kernel_launch: hipFuncSetAttribute failed\n"); grid = -1; return; }
        if (hipOccupancyMaxActiveBlocksPerMultiprocessor(&per_cu, (const void*)mk_fwd, NWAVES * 64, LDS_BYTES) != hipSuccess || per_cu < 1) fprintf(stderr, "kernel_launch: note: occupancy query says %d workgroups per CU\n", per_cu);
        (void)hipGetLastError();
        grid = cus;
        if (grid < 8) { fprintf(stderr, "kernel_launch: %d CUs: the PEER slice phases need a grid of at least 8 workgroups; nothing launched\n", grid); grid = -1; return; }
    }
    if (grid < 0) return;
    unsigned char* ws = (unsigned char*)d_ws;
    (void)hipMemsetAsync(ws + WS_CTL, 0, CTL_ZERO_BYTES, stream);
    Args a{};
    a.x = (const float*)d_in[0]; a.pos = (const int*)d_in[1]; a.g_mix = (const float*)d_in[2]; a.w_in = (const float*)d_in[3]; a.g_cq = (const float*)d_in[4]; a.w_uq = (const float*)d_in[5];
    a.g_ckv = (const float*)d_in[6]; a.w_ukv = (const float*)d_in[7]; a.w_out = (const float*)d_in[8]; a.g_ffn = (const float*)d_in[9]; a.w_pq = (const float*)d_in[10]; a.sub_keys = (const float*)d_in[11];
    a.u_emb = (const float*)d_in[12]; a.v_emb = (const float*)d_in[13]; a.g_final = (const float*)d_in[14];
    a.out = (float*)d_out; a.ws = ws; a.ph_lo = 0; a.ph_hi = (STAGE >= 6) ? 11 : STAGE + 1; a.probe_mask = 0xffffu; a.probe_shift = 0;
#if defined(PROBE_LO) && PROBE_LO == 3
    { Args b1 = a; b1.ph_hi = 4; b1.probe_shift = PROBE_SHIFT; hipLaunchKernelGGL(mk_fwd, dim3(grid), dim3(NWAVES * 64), LDS_BYTES, stream, b1);
      (void)hipMemsetAsync(ws + WS_CTL, 0, CTL_ZERO_BYTES, stream); a.ph_lo = 3; }
#endif
    hipLaunchKernelGGL(mk_fwd, dim3(grid), dim3(NWAVES * 64), LDS_BYTES, stream, a);
#if defined(PROBE_LO) && PROBE_LO != 3
#if 0
#else
    { Args b2 = a; b2.ph_lo = PROBE_LO; b2.ph_hi = PROBE_HI; b2.probe_shift = PROBE_SHIFT; b2.probe_mask = PROBE_MASK; (void)hipMemsetAsync(ws + WS_CTL, 0, CTL_ZERO_BYTES, stream); hipLaunchKernelGGL(mk_fwd, dim3(grid), dim3(NWAVES * 64), LDS_BYTES, stream, b2); }
#endif
#endif
#if STAGE < 6
    float* out = (float*)d_out; float* mixed = out;
    const size_t MB = MiB;
#if STAGE == 2
    {
        float* q32 = (float*)(ws + 0 * MB); float* k32 = (float*)(ws + 32 * MB); float* v32 = (float*)(ws + 64 * MB);
        const long n = (long)T * 512;
        nv::k_cvt<<<(int)((n + 255) / 256), 256, 0, stream>>>((const bf16_t*)(ws + WS_QA), q32, n, 1.0f / LOG2E);
        nv::k_cvt<<<(int)((n + 255) / 256), 256, 0, stream>>>((const bf16_t*)(ws + WS_KA), k32, n, 1.0f);
        nv::k_cvt<<<(int)((n + 255) / 256), 256, 0, stream>>>((const bf16_t*)(ws + WS_VA), v32, n, 1.0f);
        nv::k_dilated<<<T * 8 / 4, 256, 0, stream>>>(q32, k32, v32, mixed);
        float* qm32 = (float*)(ws + 112 * MB);
        const long nq = (long)T * 768;
        nv::k_cvt<<<(int)((nq + 255) / 256), 256, 0, stream>>>((const bf16_t*)(ws + WS_QM), qm32, nq, 1.0f / LOG2E);
        float* Kt = (float*)(ws + 0 * MB); float* Vt = Kt + (size_t)NB * 8 * 96 * SEQ;
        nv::k_build_ktvt<<<(int)(((long)NB * 8 * 160 * SEQ + 255) / 256), 256, 0, stream>>>((const bf16_t*)(ws + WS_KN), (const bf16_t*)(ws + WS_VM), (const bf16_t*)(ws + WS_KR), Kt, Vt);
        nv::k_mla<<<NB * 8 * (SEQ / 4), 256, 0, stream>>>(qm32, Kt, Vt, mixed);
    }
#elif STAGE == 3
    { const long n = (long)T * DM; nv::k_cvt<<<(int)((n + 255) / 256), 256, 0, stream>>>((const bf16_t*)(ws + WS_MIXED), mixed, n, 1.0f); }
#endif
    float* hbuf = (float*)(ws + 192 * MB); float* rstd_h = (float*)(ws + 180 * MB);
#if STAGE <= 3
    nv::k_gemm<<<dim3(DM / 64, T / 64), 256, 0, stream>>>(mixed, DM, nullptr, nullptr, a.w_out, DM, hbuf, DM, T, DM, DM, a.x, DM);
#else
    (void)hipMemcpyAsync(hbuf, out, (size_t)T * DM * 4, hipMemcpyDeviceToDevice, stream);
#endif
    float* qp = (float*)(ws + 0 * MB);
    float* vals = (float*)(ws + 128 * MB); int* idxs = (int*)(ws + 145 * MB); int* expert = (int*)(ws + 162 * MB); float* gate = (float*)(ws + 171 * MB);
    nv::k_rstd<<<T / 4, 256, 0, stream>>>(hbuf, DM, DM, rstd_h, T);
    nv::k_gemm<<<dim3(2048 / 64, T / 64), 256, 0, stream>>>(hbuf, DM, rstd_h, a.g_ffn, a.w_pq, 2048, qp, 2048, T, 2048, DM, nullptr, 0);
    (void)hipFuncSetAttribute((const void*)nv::k_topk1, hipFuncAttributeMaxDynamicSharedMemorySize, 65536);
    nv::k_topk1<<<dim3(T / 256, 16), 256, 65536, stream>>>(qp, a.sub_keys, vals, idxs);
    nv::k_topk2<<<T * 8 / 256, 256, 0, stream>>>(vals, idxs, expert, gate);
    nv::k_peer_final<<<T / 4, 256, 0, stream>>>(hbuf, rstd_h, a.g_ffn, a.u_emb, a.v_emb, expert, gate, a.g_final, out);
#endif
}
```

```cpp
#include <hip/hip_runtime.h>
#include <hip/hip_bf16.h>
#include <math.h>
#include <stdio.h>
#include <stdint.h>

#define LAS __attribute__((address_space(3)))
#define GAS __attribute__((address_space(1)))
typedef unsigned short bf16_t;
typedef short bf16x8 __attribute__((ext_vector_type(8)));
typedef short s16x4 __attribute__((ext_vector_type(4)));
typedef float f32x2 __attribute__((ext_vector_type(2)));
typedef float f32x4 __attribute__((ext_vector_type(4)));
typedef float f32x16 __attribute__((ext_vector_type(16)));
typedef unsigned u32x2 __attribute__((ext_vector_type(2)));
typedef unsigned u32x4 __attribute__((ext_vector_type(4)));
typedef __bf16 bf16x2_t __attribute__((ext_vector_type(2)));
typedef _Float16 f16x2_t __attribute__((ext_vector_type(2)));
typedef int v8i __attribute__((ext_vector_type(8)));

constexpr int DM = 1024, NB = 2, SEQ = 8192, T = NB * SEQ;
constexpr int INW = 1952;
constexpr float EPS = 1e-6f;
constexpr float LOG2E = 1.4426950408889634f;
constexpr float QA_SCALE = 0.125f * LOG2E;
constexpr float QM_SCALE = 0.10206207261596577f * LOG2E;

constexpr size_t MiB = 1u << 20;
constexpr size_t WS_CTL = 0, CTL_ZERO_BYTES = 64 * 1024;
constexpr size_t WS_COSA = 1 * MiB, WS_SINA = WS_COSA + 512 * 1024, WS_COSM = 2 * MiB, WS_SINM = 3 * MiB;
constexpr size_t WS_WIN = 4 * MiB, WS_WCOMB = 8 * MiB, WS_WOUT = 12 * MiB, WS_WUQ = 14 * MiB, WS_WUKV = 14 * MiB + 512 * 1024;
constexpr size_t WS_SSQQ = 15 * MiB, WS_SSQKV = 15 * MiB + 512 * 1024;
constexpr size_t WS_U8 = 16 * MiB, WS_V8 = 32 * MiB;
constexpr size_t WS_HN = 80 * MiB, WS_MIXED = 80 * MiB;
constexpr size_t WS_QA = 112 * MiB, WS_KA = 128 * MiB, WS_VA = 144 * MiB;
constexpr size_t WS_CQ = 160 * MiB, WS_CKV = 168 * MiB, WS_KR = 172 * MiB;
constexpr size_t WS_QM = 176 * MiB, WS_KN = 200 * MiB, WS_VM = 216 * MiB;
constexpr size_t WS_SSQH = 232 * MiB;
constexpr size_t WS_HB = 112 * MiB, WS_SC = 144 * MiB;
constexpr size_t WS_HB8 = 208 * MiB;
constexpr size_t WS_ZP = 48 * MiB, WS_PEROW = 80 * MiB, WS_PESLOT = 84 * MiB, WS_PG = 88 * MiB, WS_SSQY = 96 * MiB, WS_RSTDH = 97 * MiB, WS_PE2 = 176 * MiB, WS_PA2 = 180 * MiB;
constexpr size_t WS_OP = 144 * MiB;
constexpr float SU = 64.f, SX = 16.f, SV = 5.657f;
constexpr size_t WS_END = 234 * MiB;
static_assert(WS_KA == WS_QA + 16 * MiB && WS_VA == WS_KA + 16 * MiB && WS_VM == WS_KN + 16 * MiB, "epilogues address Ka/Va and Vm relative to Qa and Kn");

__device__ __forceinline__ unsigned pk_bf16(float lo, float hi) { f32x2 v = {lo, hi}; bf16x2_t b = __builtin_convertvector(v, bf16x2_t); return __builtin_bit_cast(unsigned, b); }
__device__ __forceinline__ unsigned pk_f16(float lo, float hi) { f32x2 v = {lo, hi}; f16x2_t b = __builtin_convertvector(v, f16x2_t); return __builtin_bit_cast(unsigned, b); }
__device__ __forceinline__ unsigned pk_fp8x4(float a, float b, float c, float d) { int w = __builtin_amdgcn_cvt_pk_fp8_f32(a, b, 0, false); w = __builtin_amdgcn_cvt_pk_fp8_f32(c, d, w, true); return (unsigned)w; }
__device__ __forceinline__ float bf_lo(unsigned w) { return __builtin_bit_cast(float, w << 16); }
__device__ __forceinline__ float bf_hi(unsigned w) { return __builtin_bit_cast(float, w & 0xffff0000u); }
__device__ __forceinline__ float wave_sum(float v) {
#pragma unroll
    for (int o = 1; o < 64; o <<= 1) v += __shfl_xor(v, o);
    return v;
}
__device__ __forceinline__ int crow(int r, int hi) { return (r & 3) + 8 * (r >> 2) + 4 * hi; }
__device__ __forceinline__ void glds16(const void* gsrc, unsigned lds_dst) { unsigned keep;
    asm volatile("s_mov_b32 %0, m0\n\ts_mov_b32 m0, %2\n\ts_nop 0\n\tglobal_load_lds_dwordx4 %1, off\n\ts_mov_b32 m0, %0" : "=&s"(keep) : "v"(gsrc), "s"(lds_dst) : "memory"); }

#define STAGE 6


namespace pg8 {
#define PG8_LAS __attribute__((address_space(3)))
typedef unsigned short bf16_t;
typedef short bf16x8 __attribute__((ext_vector_type(8)));
typedef float f32x4 __attribute__((ext_vector_type(4)));
typedef unsigned u32x4 __attribute__((ext_vector_type(4)));
constexpr int BM = 256, BK = 64, HALF = 128, HTB = HALF * BK * 2  , STAGE_BYTES = 8 * HTB, NXCD = 8, WGM = 8;

__host__ __device__ __forceinline__ int lds_byte(int r, int c) { const int st = (r >> 4) * 2 + (c >> 5), rr = r & 15, cc = c & 31, ob = rr * 64 + cc * 2; return st * 1024 + (ob ^ (((ob >> 9) & 1) << 5)); }
__host__ __device__ __forceinline__ void stage_rc(int b, int& R, int& C) { const int st = b / 1024, sb = b % 1024, swz = sb ^ (((sb >> 9) & 1) << 5); R = (st >> 1) * 16 + swz / 64; C = (st & 1) * 32 + (swz % 64) / 2; }
__host__ __device__ __forceinline__ int perm32(int rho) { const int n = rho >> 4, i = rho & 15; return 8 * (i >> 2) + 4 * n + (i & 3); }

struct Unit { int pm, pn; };
struct Gemm { const bf16_t* A; const bf16_t* Bt; int M, N, K; };

struct StaticOrder {
    int nM, nN, nwg, G, c;
    __host__ __device__ void init(int M, int N, int G_, int c_) { nM = M / BM; nN = N / BM; nwg = nM * nN; G = G_; c = c_; }
    __host__ __device__ bool next(int i, Unit& u) const {
        const long L = (long)i * G + c; if (L >= nwg) return false;
        int wgid = (int)L; { const int q = nwg / NXCD, r = nwg % NXCD, xcd = wgid % NXCD, off = wgid / NXCD; wgid = (xcd < r ? xcd * (q + 1) : r * (q + 1) + (xcd - r) * q) + off; }
        const int nig = WGM * nN, gid = wgid / nig, fm = gid * WGM, gsz = (nM - fm) < WGM ? (nM - fm) : WGM;
        u.pm = fm + ((wgid % nig) % gsz); u.pn = (wgid % nig) / gsz; return true;
    }
    __device__ __forceinline__ void a_ready(const Unit&) const {}
    __device__ __forceinline__ void done(const Unit&) const {}
};


__device__ __forceinline__ unsigned cvt_pk_bf16(float lo, float hi) { unsigned r; asm volatile("v_cvt_pk_bf16_f32 %0, %1, %2" : "=v"(r) : "v"(lo), "v"(hi)); return r; }
typedef float f32x2 __attribute__((ext_vector_type(2)));

__device__ __forceinline__ void load8(const float* p, float (&o)[8]);

template <class Epi, class Sched, bool ALIGN_EPI = false, bool SP2 = false>
__device__ __forceinline__ void gemm_phase(PG8_LAS unsigned char* lds, const Gemm g, const Sched& S, const Epi& E) {
    const int tid = threadIdx.x, wid = __builtin_amdgcn_readfirstlane(tid >> 6), lane = tid & 63, wr = wid >> 2, wc = wid & 3, fr = lane & 15, fq = lane >> 4;
    const int K = g.K, nt = K / BK;
    unsigned voffA[2], voffB[2];
#pragma unroll
    for (int i = 0; i < 2; ++i) { int R, C; stage_rc(tid * 16 + i * 8192, R, C); const int Rb = Epi::PERM ? ((R & ~31) + perm32(R & 31)) : R;
        voffA[i] = (unsigned)(R * K + C) * 2u; voffB[i] = (unsigned)(Rb * K + C) * 2u; }
    const size_t kstep = (size_t)(BK * 2);
    const size_t hstep = (size_t)HALF * K * 2;
    const size_t tstep = 2 * hstep;
    const unsigned ldsw = (unsigned)wid * 1024u;
    const int aoff = lds_byte(wr * 64 + fr, fq * 8), boff = lds_byte(wc * 32 + fr, fq * 8);
#define PG8_SA(b, h) (((b) * 2 + (h)) * HTB)
#define PG8_SB(b, h) ((4 + (b) * 2 + (h)) * HTB)
#define PG8_STAGE(bufoff, gbase, voff) do { _Pragma("unroll") for (int _i = 0; _i < 2; ++_i) \
        __builtin_amdgcn_global_load_lds((const unsigned*)((const char*)(gbase) + (voff)[_i]), (PG8_LAS unsigned*)(lds + (bufoff) + ldsw + _i * 8192), 16, 0, 0); } while (0)
#define PG8_LDA(dst, b, h) do { _Pragma("unroll") for (int m = 0; m < 4; ++m) _Pragma("unroll") for (int k = 0; k < 2; ++k) dst[m][k] = *(const PG8_LAS bf16x8*)(lds + PG8_SA(b, h) + aoff + m * 2048 + k * 1024); } while (0)
#define PG8_LDB(dst, b, h) do { _Pragma("unroll") for (int n = 0; n < 2; ++n) _Pragma("unroll") for (int k = 0; k < 2; ++k) dst[n][k] = *(const PG8_LAS bf16x8*)(lds + PG8_SB(b, h) + boff + n * 2048 + k * 1024); } while (0)
#define PG8_MMA(ai, bj, At, Bt) do { __builtin_amdgcn_s_setprio(1); _Pragma("unroll") for (int m = 0; m < 4; ++m) _Pragma("unroll") for (int n = 0; n < 2; ++n) _Pragma("unroll") for (int k = 0; k < 2; ++k) \
        acc[ai][bj][m][n] = __builtin_amdgcn_mfma_f32_16x16x32_bf16(Bt[n][k], At[m][k], acc[ai][bj][m][n], 0, 0, 0); __builtin_amdgcn_s_setprio(0); } while (0)
#define PG8_WAIT_V(n) asm volatile("s_waitcnt vmcnt(" #n ")" ::: "memory")
#define PG8_WAIT_L(n) asm volatile("s_waitcnt lgkmcnt(" #n ")" ::: "memory")
#define PG8_BAR __builtin_amdgcn_s_barrier()
#define PG8_SCHED __builtin_amdgcn_sched_barrier(0)
    Unit cur, nxt; int ui = 0;
    if (!S.next(0, cur)) return;
    f32x4 acc[2][2][4][2];
#pragma unroll
    for (int a = 0; a < 2; ++a)
#pragma unroll
        for (int b = 0; b < 2; ++b)
#pragma unroll
            for (int m = 0; m < 4; ++m)
#pragma unroll
                for (int n = 0; n < 2; ++n) acc[a][b][m][n] = (f32x4){0.f, 0.f, 0.f, 0.f};
    bf16x8 At[4][2], B0[2][2], B1[2][2];
    const char* cA = (const char*)g.A + (size_t)cur.pm * tstep; const char* cB = (const char*)g.Bt + (size_t)cur.pn * tstep;
    S.a_ready(cur);
    if constexpr (SP2) {
        PG8_STAGE(PG8_SB(0, 0), cB, voffB); PG8_STAGE(PG8_SB(0, 1), cB + hstep, voffB); PG8_STAGE(PG8_SA(0, 0), cA, voffA); PG8_STAGE(PG8_SA(0, 1), cA + hstep, voffA);
        if (wr == 1) PG8_BAR;
        PG8_WAIT_V(2); PG8_BAR;
        PG8_STAGE(PG8_SB(1, 0), cB + kstep, voffB); PG8_STAGE(PG8_SA(1, 0), cA + kstep, voffA); PG8_STAGE(PG8_SB(1, 1), cB + hstep + kstep, voffB);
        PG8_WAIT_V(6); PG8_BAR;
    } else {
        PG8_STAGE(PG8_SB(0, 0), cB, voffB); PG8_STAGE(PG8_SA(0, 0), cA, voffA); PG8_STAGE(PG8_SB(0, 1), cB + hstep, voffB); PG8_STAGE(PG8_SA(0, 1), cA + hstep, voffA);
        if (wr == 1) PG8_BAR;
        PG8_WAIT_V(4); PG8_BAR;
        PG8_STAGE(PG8_SB(1, 0), cB + kstep, voffB); PG8_STAGE(PG8_SA(1, 0), cA + kstep, voffA); PG8_STAGE(PG8_SB(1, 1), cB + hstep + kstep, voffB);
        PG8_WAIT_V(6); PG8_BAR;
    }
    for (;;) {
        const bool has_next = S.next(ui + 1, nxt);
        const char* nA = has_next ? (const char*)g.A + (size_t)nxt.pm * tstep : cA; const char* nB = has_next ? (const char*)g.Bt + (size_t)nxt.pn * tstep : cB;
        for (int t = 0; t < nt; t += 2) {
            const bool last = (t == nt - 2);
            const char* a1 = cA + (size_t)(t + 1) * kstep;
            const char* a2 = last ? nA : cA + (size_t)(t + 2) * kstep; const char* b2 = last ? nB : cB + (size_t)(t + 2) * kstep;
            const char* a3 = a2 + kstep; const char* b3 = b2 + kstep;
            if (last && has_next) S.a_ready(nxt);
            if constexpr (SP2) {
            PG8_LDB(B0, 0, 0); PG8_LDB(B1, 0, 1); PG8_SCHED; PG8_LDA(At, 0, 0); PG8_STAGE(PG8_SA(1, 1), a1 + hstep, voffA);
            PG8_WAIT_V(8); PG8_WAIT_L(0); PG8_BAR; PG8_MMA(0, 0, At, B0); PG8_MMA(0, 1, At, B1); PG8_BAR; PG8_SCHED;
            PG8_LDA(At, 0, 1); PG8_STAGE(PG8_SB(0, 0), b2, voffB); PG8_STAGE(PG8_SB(0, 1), b2 + hstep, voffB); PG8_STAGE(PG8_SA(0, 0), a2, voffA);
            PG8_WAIT_V(8); PG8_WAIT_L(0); PG8_BAR; PG8_MMA(1, 0, At, B0); PG8_MMA(1, 1, At, B1); PG8_BAR; PG8_SCHED;
            PG8_LDB(B0, 1, 0); PG8_LDB(B1, 1, 1); PG8_SCHED; PG8_LDA(At, 1, 0); PG8_STAGE(PG8_SA(0, 1), a2 + hstep, voffA);
            PG8_WAIT_V(8); PG8_WAIT_L(0); PG8_BAR; PG8_MMA(0, 0, At, B0); PG8_MMA(0, 1, At, B1); PG8_BAR; PG8_SCHED;
            PG8_LDA(At, 1, 1); PG8_STAGE(PG8_SB(1, 0), b3, voffB); PG8_STAGE(PG8_SB(1, 1), b3 + hstep, voffB); PG8_STAGE(PG8_SA(1, 0), a3, voffA);
            PG8_WAIT_V(8); PG8_WAIT_L(0); PG8_BAR; PG8_MMA(1, 0, At, B0); PG8_MMA(1, 1, At, B1); PG8_BAR; PG8_SCHED;
            } else {
            PG8_LDB(B0, 0, 0); PG8_SCHED; PG8_LDA(At, 0, 0); PG8_STAGE(PG8_SA(1, 1), a1 + hstep, voffA);
            PG8_WAIT_L(8); PG8_BAR; PG8_WAIT_L(0); PG8_MMA(0, 0, At, B0); PG8_BAR; PG8_SCHED;
            PG8_LDB(B1, 0, 1); PG8_STAGE(PG8_SB(0, 0), b2, voffB);
            PG8_BAR; PG8_WAIT_L(0); PG8_MMA(0, 1, At, B1); PG8_BAR;
            PG8_LDA(At, 0, 1); PG8_STAGE(PG8_SA(0, 0), a2, voffA);
            PG8_BAR; PG8_WAIT_L(0); PG8_MMA(1, 0, At, B0); PG8_BAR; PG8_SCHED;
            PG8_STAGE(PG8_SB(0, 1), b2 + hstep, voffB);
            PG8_WAIT_V(6); PG8_BAR; PG8_MMA(1, 1, At, B1); PG8_BAR;
            PG8_LDB(B0, 1, 0); PG8_SCHED; PG8_LDA(At, 1, 0); PG8_STAGE(PG8_SA(0, 1), a2 + hstep, voffA);
            PG8_WAIT_L(8); PG8_BAR; PG8_WAIT_L(0); PG8_MMA(0, 0, At, B0); PG8_BAR; PG8_SCHED;
            PG8_LDB(B1, 1, 1); PG8_STAGE(PG8_SB(1, 0), b3, voffB);
            PG8_BAR; PG8_WAIT_L(0); PG8_MMA(0, 1, At, B1); PG8_BAR;
            PG8_LDA(At, 1, 1); PG8_STAGE(PG8_SA(1, 0), a3, voffA);
            PG8_BAR; PG8_WAIT_L(0); PG8_MMA(1, 0, At, B0); PG8_BAR; PG8_SCHED;
            PG8_STAGE(PG8_SB(1, 1), b3 + hstep, voffB);
            PG8_WAIT_V(6); PG8_BAR; PG8_MMA(1, 1, At, B1); PG8_BAR;
            }
        }
        if constexpr (ALIGN_EPI) { if (wr == 0) PG8_BAR; }
        if constexpr (!Epi::AFTER_DRAIN) { E(acc, cur, wr, wc, fr, fq); S.done(cur); }
        if (!has_next) break;
#pragma unroll
        for (int a = 0; a < 2; ++a)
#pragma unroll
            for (int b = 0; b < 2; ++b)
#pragma unroll
                for (int m = 0; m < 4; ++m)
#pragma unroll
                    for (int n = 0; n < 2; ++n) acc[a][b][m][n] = (f32x4){0.f, 0.f, 0.f, 0.f};
        cur = nxt; cA = nA; cB = nB; ++ui;
        if constexpr (ALIGN_EPI) { if (wr == 1) PG8_BAR; }
    }
    PG8_WAIT_V(0);
    if constexpr (!ALIGN_EPI) { if (wr == 0) PG8_BAR; }
    PG8_BAR;
    if constexpr (Epi::AFTER_DRAIN) { E.fused(acc, cur, wr, wc, fr, fq, lds, wid, lane); S.done(cur); }
#undef PG8_SA
#undef PG8_SB
#undef PG8_STAGE
#undef PG8_LDA
#undef PG8_LDB
#undef PG8_MMA
#undef PG8_WAIT_V
#undef PG8_WAIT_L
#undef PG8_BAR
#undef PG8_SCHED
}
}

namespace pg8 {
#define EPI_V8(ai, bj, m) { acc[ai][bj][m][0][0], acc[ai][bj][m][0][1], acc[ai][bj][m][0][2], acc[ai][bj][m][0][3], acc[ai][bj][m][1][0], acc[ai][bj][m][1][1], acc[ai][bj][m][1][2], acc[ai][bj][m][1][3] }
__device__ __forceinline__ u32x4 pack8(const float (&v)[8], float s) { u32x4 w; w.x = pk_bf16(v[0] * s, v[1] * s); w.y = pk_bf16(v[2] * s, v[3] * s); w.z = pk_bf16(v[4] * s, v[5] * s); w.w = pk_bf16(v[6] * s, v[7] * s); return w; }
__device__ __forceinline__ float ssq8(const float (&v)[8]) { return ((v[0] * v[0] + v[1] * v[1]) + (v[2] * v[2] + v[3] * v[3])) + ((v[4] * v[4] + v[5] * v[5]) + (v[6] * v[6] + v[7] * v[7])); }
__device__ __forceinline__ void load8(const float* p, float (&o)[8]) { const f32x4 a = *(const f32x4*)p, b = *(const f32x4*)(p + 4); o[0] = a.x; o[1] = a.y; o[2] = a.z; o[3] = a.w; o[4] = b.x; o[5] = b.y; o[6] = b.z; o[7] = b.w; }

struct EpiProj {
    static constexpr bool PERM = true, AFTER_DRAIN = false;
    bf16_t *Qa, *Ka, *Va, *Cq, *Ckv, *Kr; float *ssq_q, *ssq_kv; const float *cosA, *sinA, *cosM, *sinM;
    __device__ __forceinline__ void operator()(const f32x4 (&acc)[2][2][4][2], const Unit& u, int wr, int wc, int fr, int fq) const {
        const int pn = u.pn, rowb = u.pm * BM + wr * 64 + fr;
        if (pn < 6) {
            const int kind = pn >> 1;
            bf16_t* dst = Qa + (size_t)kind * (size_t)(8u << 20);
            const float sc = kind == 0 ? QA_SCALE : 1.f;
            const bool ropew = (kind < 2) && ((wc & 1) == 0);
            float cq[2][8], sq[2][8];
            if (ropew) {
#pragma unroll
                for (int g = 0; g < 2; ++g) { const size_t r_ = (size_t)(rowb + g * 16) * 8; load8(cosA + r_, cq[g]); load8(sinA + r_, sq[g]); }
            }
#pragma unroll
            for (int ai = 0; ai < 2; ++ai)
#pragma unroll
                for (int m = 0; m < 4; ++m) {
                    const int row = rowb + ai * HALF + m * 16;
                    float cs[8], sn[8];
                    if (ropew) {
#pragma unroll
                        for (int i = 0; i < 8; ++i) { cs[i] = cq[m & 1][i]; sn[i] = sq[m & 1][i]; }
                        if (ai * 4 + m + 2 < 8) { const int g2 = ai * 4 + m + 2; const size_t r_ = (size_t)(rowb + (g2 >> 2) * HALF + (g2 & 3) * 16) * 8; load8(cosA + r_, cq[m & 1]); load8(sinA + r_, sq[m & 1]); }
                    }
#pragma unroll
                    for (int bj = 0; bj < 2; ++bj) {
                        float v[8] = EPI_V8(ai, bj, m);
                        if (ropew) {
#pragma unroll
                            for (int i = 0; i < 8; ++i) { const float pv = __shfl_xor(v[i], 16); if (fq == 0) v[i] = v[i] * cs[i] - pv * sn[i]; else if (fq == 1) v[i] = v[i] * cs[i] + pv * sn[i]; }
                        }
                        *(u32x4*)(dst + ((size_t)((row >> 13) * 8 + (pn & 1) * 4 + bj * 2 + (wc >> 1)) * SEQ + (row & (SEQ - 1))) * 64 + (wc & 1) * 32 + fq * 8) = pack8(v, sc);
                    }
                }
        } else if (pn == 6) {
#pragma unroll
            for (int ai = 0; ai < 2; ++ai)
#pragma unroll
                for (int m = 0; m < 4; ++m) {
                    const int row = rowb + ai * HALF + m * 16;
#pragma unroll
                    for (int bj = 0; bj < 2; ++bj) {
                        float v[8] = EPI_V8(ai, bj, m);
                        float s = ssq8(v); s += __shfl_xor(s, 16); s += __shfl_xor(s, 32);
                        if (fq == 0) ssq_q[(size_t)row * 8 + bj * 4 + wc] = s;
                        *(u32x4*)(Cq + (size_t)row * 256 + bj * HALF + wc * 32 + fq * 8) = pack8(v, 1.f);
                    }
                }
        } else {
#pragma unroll
            for (int ai = 0; ai < 2; ++ai)
#pragma unroll
                for (int m = 0; m < 4; ++m) {
                    const int row = rowb + ai * HALF + m * 16;
                    {
                        float v[8] = EPI_V8(ai, 0, m);
                        float s = ssq8(v); s += __shfl_xor(s, 16); s += __shfl_xor(s, 32);
                        if (fq == 0) ssq_kv[(size_t)row * 4 + wc] = s;
                        *(u32x4*)(Ckv + (size_t)row * 128 + wc * 32 + fq * 8) = pack8(v, 1.f);
                    }
                    if (wc == 0) {
                        float v[8] = EPI_V8(ai, 1, m);
                        float cs[8], sn[8];
                        load8(cosM + (size_t)row * 16 + 8 * (fq & 1), cs); load8(sinM + (size_t)row * 16 + 8 * (fq & 1), sn);
#pragma unroll
                        for (int i = 0; i < 8; ++i) { const float pv = __shfl_xor(v[i], 32); v[i] = (fq < 2) ? (v[i] * cs[i] - pv * sn[i]) : (v[i] * cs[i] + pv * sn[i]); }
                        *(u32x4*)(Kr + (size_t)row * 32 + fq * 8) = pack8(v, 1.f);
                    }
                }
        }
    }
};

struct EpiQm {
    static constexpr bool PERM = true, AFTER_DRAIN = false;
    bf16_t* Qm; const float* ssq_q; const float *cosM, *sinM;
    __device__ __forceinline__ void operator()(const f32x4 (&acc)[2][2][4][2], const Unit& u, int wr, int wc, int fr, int fq) const {
        const int pn = u.pn, rowb = u.pm * BM + wr * 64 + fr;
        f32x2 qa[8];
#pragma unroll
        for (int g = 0; g < 8; ++g) qa[g] = *(const f32x2*)(ssq_q + (size_t)(rowb + (g >> 2) * HALF + (g & 3) * 16) * 8 + 2 * fq);
        float cq[2][8], sq[2][8];
#pragma unroll
        for (int g = 0; g < 2; ++g) { const size_t r_ = (size_t)(rowb + g * 16) * 16 + 8 * (fq & 1); load8(cosM + r_, cq[g]); load8(sinM + r_, sq[g]); }
#pragma unroll
        for (int ai = 0; ai < 2; ++ai)
#pragma unroll
            for (int m = 0; m < 4; ++m) {
                const int row = rowb + ai * HALF + m * 16, g = ai * 4 + m;
                float ssum = qa[g].x + qa[g].y; ssum += __shfl_xor(ssum, 16); ssum += __shfl_xor(ssum, 32);
                const float rs = 1.0f / sqrtf(ssum * (1.f / 256.f) + EPS);
                float cs[8], sn[8];
#pragma unroll
                for (int i = 0; i < 8; ++i) { cs[i] = cq[m & 1][i]; sn[i] = sq[m & 1][i]; }
                if (g + 2 < 8) { const int g2 = g + 2; const size_t r_ = (size_t)(rowb + (g2 >> 2) * HALF + (g2 & 3) * 16) * 16 + 8 * (fq & 1); load8(cosM + r_, cq[m & 1]); load8(sinM + r_, sq[m & 1]); }
#pragma unroll
                for (int bj = 0; bj < 2; ++bj) {
                    const int g32 = pn * 8 + bj * 4 + wc;
                    const bool ropew = (g32 % 3) == 2;
                    float v[8] = EPI_V8(ai, bj, m);
#pragma unroll
                    for (int i = 0; i < 8; ++i) v[i] *= rs;
                    if (ropew) {
#pragma unroll
                        for (int i = 0; i < 8; ++i) { const float pv = __shfl_xor(v[i], 32); v[i] = (fq < 2) ? (v[i] * cs[i] - pv * sn[i]) : (v[i] * cs[i] + pv * sn[i]); }
                    }
                    *(u32x4*)(Qm + (size_t)row * 768 + pn * BM + bj * HALF + wc * 32 + fq * 8) = pack8(v, QM_SCALE);
                }
                asm volatile("" ::: "memory");
            }
    }
};

struct EpiKv {
    static constexpr bool PERM = true, AFTER_DRAIN = false;
    bf16_t *Kn, *Vm; const float* ssq_kv;
    __device__ __forceinline__ void operator()(const f32x4 (&acc)[2][2][4][2], const Unit& u, int wr, int wc, int fr, int fq) const {
        const int pn = u.pn, rowb = u.pm * BM + wr * 64 + fr;
        bf16_t* dst = Kn + (size_t)(wc >> 1) * (size_t)(8u << 20);
        const int within = (wc & 1) * 32 + fq * 8;
        f32x4 q4a[8];
#pragma unroll
        for (int g = 0; g < 8; ++g) q4a[g] = *(const f32x4*)(ssq_kv + (size_t)(rowb + (g >> 2) * HALF + (g & 3) * 16) * 4);
#pragma unroll
        for (int ai = 0; ai < 2; ++ai)
#pragma unroll
            for (int m = 0; m < 4; ++m) {
                const int row = rowb + ai * HALF + m * 16;
                const f32x4 q4 = q4a[ai * 4 + m];
                const float rs = 1.0f / sqrtf(((q4.x + q4.y) + (q4.z + q4.w)) * (1.f / 128.f) + EPS);
#pragma unroll
                for (int bj = 0; bj < 2; ++bj) {
                    float v[8] = EPI_V8(ai, bj, m);
                    *(u32x4*)(dst + ((size_t)((row >> 13) * 8 + pn * 2 + bj) * SEQ + (row & (SEQ - 1))) * 64 + within) = pack8(v, rs);
                }
            }
    }
};

struct EpiOut {
    static constexpr bool PERM = true, AFTER_DRAIN = false;
    const float* x; bf16_t* Hb; unsigned char* Hb8; float* ssq_h;
    __device__ __forceinline__ void operator()(const f32x4 (&acc)[2][2][4][2], const Unit& u, int wr, int wc, int fr, int fq) const {
        const int pn = u.pn, rowb = u.pm * BM + wr * 64 + fr;
        float xq[8][8];
#define XPIECE(t_) (x + (size_t)(rowb + ((t_) >> 3) * HALF + (((t_) >> 1) & 3) * 16) * DM + pn * BM + ((t_) & 1) * HALF + wc * 32 + fq * 8)
#pragma unroll
        for (int t = 0; t < 8; ++t) load8(XPIECE(t), xq[t]);
#pragma unroll
        for (int ai = 0; ai < 2; ++ai)
#pragma unroll
            for (int m = 0; m < 4; ++m) {
                const int row = rowb + ai * HALF + m * 16;
#pragma unroll
                for (int bj = 0; bj < 2; ++bj) {
                    const int col = pn * BM + bj * HALF + wc * 32 + fq * 8, t = (ai * 4 + m) * 2 + bj;
                    float v[8] = EPI_V8(ai, bj, m);
#pragma unroll
                    for (int i = 0; i < 8; ++i) v[i] += xq[t & 7][i];
                    if (t + 8 < 16) load8(XPIECE(t + 8), xq[t & 7]);
                    float s = ssq8(v); s += __shfl_xor(s, 16); s += __shfl_xor(s, 32);
                    if (fq == 0) ssq_h[(size_t)row * 32 + pn * 8 + bj * 4 + wc] = s;
                    *(u32x4*)(Hb + (size_t)row * DM + col) = pack8(v, 1.f);
                    { u32x2 w8; w8.x = pk_fp8x4(v[0] * SX, v[1] * SX, v[2] * SX, v[3] * SX); w8.y = pk_fp8x4(v[4] * SX, v[5] * SX, v[6] * SX, v[7] * SX); *(u32x2*)(Hb8 + (size_t)(col >> 8) * ((size_t)T * 256) + (size_t)row * 256 + (col & 255)) = w8; }
                }
            }
#undef XPIECE
    }
};

struct EpiSc {
    static constexpr bool PERM = true, AFTER_DRAIN = false;
    bf16_t* Sc; const float* ssq_h;
    __device__ __forceinline__ void operator()(const f32x4 (&acc)[2][2][4][2], const Unit& u, int wr, int wc, int fr, int fq) const {
        const int pn = u.pn, rowb = u.pm * BM + wr * 64 + fr;
        f32x4 q[8][2];
#pragma unroll
        for (int g = 0; g < 8; ++g) { const float* qp = ssq_h + (size_t)(rowb + (g >> 2) * HALF + (g & 3) * 16) * 32 + 8 * fq; q[g][0] = *(const f32x4*)qp; q[g][1] = *(const f32x4*)(qp + 4); }
#pragma unroll
        for (int ai = 0; ai < 2; ++ai)
#pragma unroll
            for (int m = 0; m < 4; ++m) {
                const int row = rowb + ai * HALF + m * 16, g = ai * 4 + m;
                float s = ((q[g][0].x + q[g][0].y) + (q[g][0].z + q[g][0].w)) + ((q[g][1].x + q[g][1].y) + (q[g][1].z + q[g][1].w));
                s += __shfl_xor(s, 16); s += __shfl_xor(s, 32);
                const float rs = 1.0f / sqrtf(s * (1.f / 1024.f) + EPS);
#pragma unroll
                for (int bj = 0; bj < 2; ++bj) {
                    float v[8] = EPI_V8(ai, bj, m);
                    u32x4 w; w.x = pk_f16(v[0] * rs, v[1] * rs); w.y = pk_f16(v[2] * rs, v[3] * rs); w.z = pk_f16(v[4] * rs, v[5] * rs); w.w = pk_f16(v[6] * rs, v[7] * rs);
                    *(u32x4*)(Sc + (size_t)row * 2048 + pn * BM + bj * HALF + wc * 32 + fq * 8) = w;
                }
            }
    }
};
#undef EPI_V8
}

namespace att {
constexpr float NEGM = -1.0e30f;
__device__ __forceinline__ s16x4 vtr(const LAS unsigned char* p) { typedef short v4i16_t __attribute__((ext_vector_type(4))); return __builtin_bit_cast(s16x4, __builtin_amdgcn_ds_read_tr16_b64_v4i16((LAS v4i16_t*)p)); }
__device__ __forceinline__ void swap32(unsigned& a, unsigned& b) { asm volatile("s_nop 1\n\tv_permlane32_swap_b32 %0, %1" : "+v"(a), "+v"(b)); }
__device__ __forceinline__ float swapmax(float v) { unsigned a = __builtin_bit_cast(unsigned, v), b = a; swap32(a, b); return fmaxf(__builtin_bit_cast(float, a), __builtin_bit_cast(float, b)); }
__device__ __forceinline__ float swapsum(float v) { unsigned a = __builtin_bit_cast(unsigned, v), b = a; swap32(a, b); return __builtin_bit_cast(float, a) + __builtin_bit_cast(float, b); }
__device__ __forceinline__ float max3f(float a, float b, float c) { return __builtin_fmaxf(__builtin_fmaxf(a, b), c); }
constexpr float THR = 8.0f;
__device__ __forceinline__ bf16x8 pack_p(const f32x16& p, int s) {
    u32x4 w; w.x = pk_bf16(p[8 * s + 0], p[8 * s + 1]); w.y = pk_bf16(p[8 * s + 2], p[8 * s + 3]); w.z = pk_bf16(p[8 * s + 4], p[8 * s + 5]); w.w = pk_bf16(p[8 * s + 6], p[8 * s + 7]);
    return __builtin_bit_cast(bf16x8, w);
}
__device__ __forceinline__ void pv_block(f32x16& o, const LAS unsigned char* vbase, const bf16x8& pb0, const bf16x8& pb1) {
    const s16x4 l0 = vtr(vbase), h0 = vtr(vbase + 8 * 64), l1 = vtr(vbase + 16 * 64), h1 = vtr(vbase + 24 * 64);
    const bf16x8 a0 = {l0[0], l0[1], l0[2], l0[3], h0[0], h0[1], h0[2], h0[3]}, a1 = {l1[0], l1[1], l1[2], l1[3], h1[0], h1[1], h1[2], h1[3]};
    o = __builtin_amdgcn_mfma_f32_32x32x16_bf16(a0, pb0, o, 0, 0, 0);
    o = __builtin_amdgcn_mfma_f32_32x32x16_bf16(a1, pb1, o, 0, 0, 0);
}
__device__ __forceinline__ void store_o(bf16_t* orow, const f32x16& o0, const f32x16& o1, float inv, int hi) {
#pragma unroll
    for (int g = 0; g < 4; ++g) {
        u32x2 a, b; a.x = pk_bf16(o0[4 * g] * inv, o0[4 * g + 1] * inv); a.y = pk_bf16(o0[4 * g + 2] * inv, o0[4 * g + 3] * inv);
        b.x = pk_bf16(o1[4 * g] * inv, o1[4 * g + 1] * inv); b.y = pk_bf16(o1[4 * g + 2] * inv, o1[4 * g + 3] * inv);
        *(u32x2*)(orow + 8 * g + 4 * hi) = a; *(u32x2*)(orow + 32 + 8 * g + 4 * hi) = b;
    }
}

constexpr int KROW = 208;
constexpr int TK = 128, KBYTES = TK * KROW, VBYTES = 2 * TK * 64, BUFB = KBYTES + VBYTES;
constexpr int MLA_LDS = 2 * BUFB;
__device__ __forceinline__ float rowmax64(const f32x16& s0, const f32x16& s1) {
    float mx = max3f(s0[0], s1[0], s0[1]);
#pragma unroll
    for (int r = 1; r < 15; r += 2) { mx = max3f(mx, s1[r], s0[r + 1]); mx = max3f(mx, s1[r + 1], s0[r + 2 < 16 ? r + 2 : 15]); }
    mx = max3f(mx, s1[15], s0[15]);
    return swapmax(mx);
}
__device__ __forceinline__ void scale16(f32x16& t, float a) {
    const f32x2 a2 = {a, a};
#pragma unroll
    for (int i = 0; i < 8; ++i) { f32x2 p = {t[2 * i], t[2 * i + 1]}; asm volatile("v_pk_mul_f32 %0, %0, %1" : "+v"(p) : "v"(a2)); t[2 * i] = p.x; t[2 * i + 1] = p.y; }
}
__device__ __forceinline__ void sub16(f32x16& t, float d) {
    const f32x2 d2 = {d, d};
#pragma unroll
    for (int i = 0; i < 8; ++i) { f32x2 p = {t[2 * i], t[2 * i + 1]}; asm volatile("v_pk_add_f32 %0, %0, %1 neg_lo:[0,1] neg_hi:[0,1]" : "+v"(p) : "v"(d2)); t[2 * i] = p.x; t[2 * i + 1] = p.y; }
}
__device__ __forceinline__ void rescale64(float mx, f32x16& s0, f32x16& s1, float& m, float& l, f32x16& o0, f32x16& o1) {
    if (__builtin_expect(__builtin_amdgcn_ballot_w64(mx > THR) != 0ull, 0)) {
        const float dl = fmaxf(mx, 0.f), alpha = __builtin_amdgcn_exp2f(-dl);
        m += dl; l *= alpha;
        sub16(s0, dl); sub16(s1, dl); scale16(o0, alpha); scale16(o1, alpha);
    }
}
__device__ __forceinline__ void exp64(f32x16& s0, f32x16& s1, float& l) {
    float rs = 0.f;
#pragma unroll
    for (int r = 0; r < 16; ++r) { s0[r] = __builtin_amdgcn_exp2f(s0[r]); s1[r] = __builtin_amdgcn_exp2f(s1[r]); rs += s0[r] + s1[r]; }
    l += rs;
}
__device__ __forceinline__ void sm64(f32x16& s0, f32x16& s1, float& m, float& l, f32x16& o0, f32x16& o1, f32x16& t0, f32x16& t1, bool adj_other) {
    float mx = max3f(s0[0], s1[0], s0[1]);
#pragma unroll
    for (int r = 1; r < 15; r += 2) { mx = max3f(mx, s1[r], s0[r + 1]); mx = max3f(mx, s1[r + 1], s0[r + 2 < 16 ? r + 2 : 15]); }
    mx = max3f(mx, s1[15], s0[15]);
    mx = swapmax(mx);
    if (__builtin_expect(__builtin_amdgcn_ballot_w64(mx > THR) != 0ull, 0)) {
        const float dl = fmaxf(mx, 0.f), alpha = __builtin_amdgcn_exp2f(-dl);
        m += dl; l *= alpha;
#pragma unroll
        for (int r = 0; r < 16; ++r) { s0[r] -= dl; s1[r] -= dl; o0[r] *= alpha; o1[r] *= alpha; }
        if (adj_other) {
#pragma unroll
            for (int r = 0; r < 16; ++r) { t0[r] -= dl; t1[r] -= dl; }
        }
    }
    float rs = 0.f;
#pragma unroll
    for (int r = 0; r < 16; ++r) { s0[r] = __builtin_amdgcn_exp2f(s0[r]); s1[r] = __builtin_amdgcn_exp2f(s1[r]); rs += s0[r] + s1[r]; }
    l += rs;
}
constexpr int MLA_G_OFF = 2 * (TK * 208 + 2 * TK * 64), MLA_PIECE_OFF = MLA_G_OFF + 4096;
__device__ __forceinline__ void mla_unit(LAS unsigned char* lds, const bf16_t* __restrict__ Qm, const bf16_t* __restrict__ Kn, const bf16_t* __restrict__ Kr, const bf16_t* __restrict__ Vm,
                                         bf16_t* __restrict__ Mixed, int b, int h, int qb,
                                         const float* __restrict__ u_emb, const float* __restrict__ v_emb, const float* __restrict__ g_ffn, unsigned char* __restrict__ U8, unsigned char* __restrict__ V8, int slot0) {
    const int tid = threadIdx.x, lane = tid & 63, wid = __builtin_amdgcn_readfirstlane(tid >> 6), r32 = lane & 31, hi = lane >> 5;
    const size_t tok0 = (size_t)b * SEQ;
    const int qpos = 256 * qb + 32 * wid + r32;
    bf16x8 qf[6];
    { const bf16_t* qrow = Qm + (tok0 + qpos) * 768 + h * 96 + 8 * hi;
#pragma unroll
      for (int ds = 0; ds < 6; ++ds) qf[ds] = *(const bf16x8*)(qrow + 16 * ds); }
    float m = 0.f, l = 0.f; f32x16 o0 = {}, o1 = {};
    const int nt = 2 * (qb + 1);
    const int wq0 = 256 * qb + 32 * wid, wqlast = wq0 + 31;
    const int srow = tid >> 3, sch = tid & 7, rrow = tid >> 2, rch = tid & 3;
    const bf16_t* gkn = Kn + ((size_t)(b * 8 + h) * SEQ + srow) * 64 + sch * 8;
    const bf16_t* gv = Vm + ((size_t)(b * 8 + h) * SEQ + srow) * 64 + sch * 8;
    const bf16_t* gkr = Kr + (tok0 + rrow) * 32 + rch * 8;
    const int wkn = srow * KROW + sch * 16, wkr = rrow * KROW + 128 + rch * 16, wv = KBYTES + (sch >> 2) * (TK * 64) + srow * 64 + (sch & 3) * 16;
    const int kfrag = r32 * KROW + hi * 16;
    const int i16 = lane & 15, vfrag = KBYTES + (4 * hi + (i16 >> 2)) * 64 + (16 * ((lane >> 4) & 1) + 4 * (i16 & 3)) * 2;
    u32x4 rk0, rk1, rv0, rv1, rr;
#define MLA_LOAD(t) do { const size_t adv_ = (size_t)(t) * TK; rk0 = *(const u32x4*)(gkn + adv_ * 64); rk1 = *(const u32x4*)(gkn + (adv_ + 64) * 64); \
        rv0 = *(const u32x4*)(gv + adv_ * 64); rv1 = *(const u32x4*)(gv + (adv_ + 64) * 64); rr = *(const u32x4*)(gkr + adv_ * 32); } while (0)
#define MLA_STORE(bp) do { LAS unsigned char* b_ = (bp); *(LAS u32x4*)(b_ + wkn) = rk0; *(LAS u32x4*)(b_ + wkn + 64 * KROW) = rk1; *(LAS u32x4*)(b_ + wv) = rv0; *(LAS u32x4*)(b_ + wv + 64 * 64) = rv1; *(LAS u32x4*)(b_ + wkr) = rr; } while (0)
    if (wid >= 4) __builtin_amdgcn_s_setprio(1);
    MLA_LOAD(0); MLA_STORE(lds);
    for (int u = tid; u < DM / 4; u += 512) *(LAS f32x4*)(lds + MLA_G_OFF + 16 * u) = *(const f32x4*)(g_ffn + 4 * u);
    LAS unsigned char* piece = lds + MLA_PIECE_OFF + wid * 1024;
    const unsigned piece_u = (unsigned)__builtin_amdgcn_readfirstlane((int)(unsigned)(uintptr_t)piece);
    __syncthreads();
    const int nfull = (wq0 + 1) >> 7;
    int kt = 0;
    for (; kt < nfull; ++kt) {
        const LAS unsigned char* buf = lds + (kt & 1) * BUFB;
        if (kt + 1 < nt) MLA_LOAD(kt + 1);
        const int pid = slot0 + 8 * kt + wid;
        if (pid < 131072) glds16(((pid >> 16) ? v_emb : u_emb) + (size_t)(pid & 65535) * 256 + 4 * lane, piece_u);
        {
            f32x16 a0, a1, b0, b1;
            {
                const bf16x8 k0 = *(const LAS bf16x8*)(buf + kfrag), k1 = *(const LAS bf16x8*)(buf + kfrag + 32 * KROW);
                if (__builtin_amdgcn_ballot_w64(m != 0.f) == 0ull) {
                    const f32x16 z = {};
                    a0 = __builtin_amdgcn_mfma_f32_32x32x16_bf16(k0, qf[0], z, 0, 0, 0);
                    a1 = __builtin_amdgcn_mfma_f32_32x32x16_bf16(k1, qf[0], z, 0, 0, 0);
                } else {
                    const float nm = -m; const f32x16 nv = {nm, nm, nm, nm, nm, nm, nm, nm, nm, nm, nm, nm, nm, nm, nm, nm};
                    a0 = __builtin_amdgcn_mfma_f32_32x32x16_bf16(k0, qf[0], nv, 0, 0, 0);
                    a1 = __builtin_amdgcn_mfma_f32_32x32x16_bf16(k1, qf[0], nv, 0, 0, 0);
                }
            }
#pragma unroll
            for (int ds = 1; ds < 6; ++ds) {
                const bf16x8 k0 = *(const LAS bf16x8*)(buf + kfrag + ds * 32), k1 = *(const LAS bf16x8*)(buf + kfrag + 32 * KROW + ds * 32);
                a0 = __builtin_amdgcn_mfma_f32_32x32x16_bf16(k0, qf[ds], a0, 0, 0, 0);
                a1 = __builtin_amdgcn_mfma_f32_32x32x16_bf16(k1, qf[ds], a1, 0, 0, 0);
            }
            rescale64(rowmax64(a0, a1), a0, a1, m, l, o0, o1);
            {
                const bf16x8 k2 = *(const LAS bf16x8*)(buf + kfrag + 64 * KROW), k3 = *(const LAS bf16x8*)(buf + kfrag + 96 * KROW);
                if (__builtin_amdgcn_ballot_w64(m != 0.f) == 0ull) {
                    const f32x16 z = {};
                    b0 = __builtin_amdgcn_mfma_f32_32x32x16_bf16(k2, qf[0], z, 0, 0, 0);
                    b1 = __builtin_amdgcn_mfma_f32_32x32x16_bf16(k3, qf[0], z, 0, 0, 0);
                } else {
                    const float nm = -m; const f32x16 nv = {nm, nm, nm, nm, nm, nm, nm, nm, nm, nm, nm, nm, nm, nm, nm, nm};
                    b0 = __builtin_amdgcn_mfma_f32_32x32x16_bf16(k2, qf[0], nv, 0, 0, 0);
                    b1 = __builtin_amdgcn_mfma_f32_32x32x16_bf16(k3, qf[0], nv, 0, 0, 0);
                }
            }
#pragma unroll
            for (int ds = 1; ds < 6; ++ds) {
                const bf16x8 k2 = *(const LAS bf16x8*)(buf + kfrag + 64 * KROW + ds * 32), k3 = *(const LAS bf16x8*)(buf + kfrag + 96 * KROW + ds * 32);
                b0 = __builtin_amdgcn_mfma_f32_32x32x16_bf16(k2, qf[ds], b0, 0, 0, 0);
                b1 = __builtin_amdgcn_mfma_f32_32x32x16_bf16(k3, qf[ds], b1, 0, 0, 0);
            }
            exp64(a0, a1, l);
            { const float mxb = rowmax64(b0, b1);
              if (__builtin_expect(__builtin_amdgcn_ballot_w64(mxb > THR) != 0ull, 0)) {
                  const float dl = fmaxf(mxb, 0.f), alpha = __builtin_amdgcn_exp2f(-dl);
                  m += dl; l *= alpha;
                  sub16(b0, dl); sub16(b1, dl); scale16(o0, alpha); scale16(o1, alpha); scale16(a0, alpha); scale16(a1, alpha);
              } }
            { const bf16x8 p00 = pack_p(a0, 0), p01 = pack_p(a0, 1), p10 = pack_p(a1, 0), p11 = pack_p(a1, 1);
              pv_block(o0, buf + vfrag, p00, p01); pv_block(o0, buf + vfrag + 2048, p10, p11);
              pv_block(o1, buf + vfrag + TK * 64, p00, p01); pv_block(o1, buf + vfrag + TK * 64 + 2048, p10, p11); }
            exp64(b0, b1, l);
            { const bf16x8 p00 = pack_p(b0, 0), p01 = pack_p(b0, 1), p10 = pack_p(b1, 0), p11 = pack_p(b1, 1);
              pv_block(o0, buf + vfrag + 4096, p00, p01); pv_block(o0, buf + vfrag + 6144, p10, p11);
              pv_block(o1, buf + vfrag + TK * 64 + 4096, p00, p01); pv_block(o1, buf + vfrag + TK * 64 + 6144, p10, p11); }
        }
        if (kt + 1 < nt) MLA_STORE(lds + ((kt + 1) & 1) * BUFB);
        if (pid < 131072) {
            asm volatile("s_waitcnt vmcnt(0)" ::: "memory");
            const f32x4 xv = *(const LAS f32x4*)(piece + 16 * lane);
            const int idx = pid & 65535, col = (idx & 3) * 256 + 4 * lane;
            f32x4 sc = {SV, SV, SV, SV};
            if ((pid >> 16) == 0) { const f32x4 gv_ = *(const LAS f32x4*)(lds + MLA_G_OFF + 4 * col); sc = (f32x4){gv_.x * SU, gv_.y * SU, gv_.z * SU, gv_.w * SU}; }
            if ((pid >> 16) == 0) {
                unsigned w4 = __builtin_amdgcn_cvt_scalef32_pk_fp4_f32(0u, xv.x * sc.x, xv.y * sc.y, 1.0f, 0);
                w4 = __builtin_amdgcn_cvt_scalef32_pk_fp4_f32(w4, xv.z * sc.z, xv.w * sc.w, 1.0f, 1);
                *(unsigned short*)(U8 + (size_t)(idx & 3) * ((size_t)16384 * 128) + (size_t)(idx >> 2) * 128 + 2 * lane) = (unsigned short)(w4 & 0xffffu);
            } else {
                unsigned w4 = __builtin_amdgcn_cvt_scalef32_pk_fp4_f32(0u, xv.x * sc.x, xv.y * sc.y, 1.0f, 0);
                w4 = __builtin_amdgcn_cvt_scalef32_pk_fp4_f32(w4, xv.z * sc.z, xv.w * sc.w, 1.0f, 1);
                *(unsigned short*)(V8 + (size_t)(idx & 3) * ((size_t)16384 * 128) + (size_t)(idx >> 2) * 128 + 2 * lane) = (unsigned short)(w4 & 0xffffu);
            }
        }
        __syncthreads();
        }
    for (; kt < nt; ++kt) {
        const LAS unsigned char* buf = lds + (kt & 1) * BUFB;
        if (kt + 1 < nt) MLA_LOAD(kt + 1);
        const int pid = slot0 + 8 * kt + wid;
        if (pid < 131072) glds16(((pid >> 16) ? v_emb : u_emb) + (size_t)(pid & 65535) * 256 + 4 * lane, piece_u);
        if (TK * kt <= wqlast) {
            const bool needB = TK * kt + 64 <= wqlast;
            const float nm = -m; const f32x16 negm = {nm, nm, nm, nm, nm, nm, nm, nm, nm, nm, nm, nm, nm, nm, nm, nm};
            f32x16 a0 = negm, a1 = negm, b0 = negm, b1 = negm;
#pragma unroll
            for (int ds = 0; ds < 6; ++ds) {
                const bf16x8 k0 = *(const LAS bf16x8*)(buf + kfrag + ds * 32), k1 = *(const LAS bf16x8*)(buf + kfrag + 32 * KROW + ds * 32);
                a0 = __builtin_amdgcn_mfma_f32_32x32x16_bf16(k0, qf[ds], a0, 0, 0, 0);
                a1 = __builtin_amdgcn_mfma_f32_32x32x16_bf16(k1, qf[ds], a1, 0, 0, 0);
            }
            if (needB) {
#pragma unroll
                for (int ds = 0; ds < 6; ++ds) {
                    const bf16x8 k2 = *(const LAS bf16x8*)(buf + kfrag + 64 * KROW + ds * 32), k3 = *(const LAS bf16x8*)(buf + kfrag + 96 * KROW + ds * 32);
                    b0 = __builtin_amdgcn_mfma_f32_32x32x16_bf16(k2, qf[ds], b0, 0, 0, 0);
                    b1 = __builtin_amdgcn_mfma_f32_32x32x16_bf16(k3, qf[ds], b1, 0, 0, 0);
                }
            }
#pragma unroll
            for (int r = 0; r < 16; ++r) { const int kp = TK * kt + crow(r, hi); if (kp > qpos) a0[r] = NEGM; if (kp + 32 > qpos) a1[r] = NEGM; if (kp + 64 > qpos) b0[r] = NEGM; if (kp + 96 > qpos) b1[r] = NEGM; }
            sm64(a0, a1, m, l, o0, o1, b0, b1, needB);
            { const bf16x8 p00 = pack_p(a0, 0), p01 = pack_p(a0, 1), p10 = pack_p(a1, 0), p11 = pack_p(a1, 1);
              pv_block(o0, buf + vfrag, p00, p01); pv_block(o0, buf + vfrag + 2048, p10, p11);
              pv_block(o1, buf + vfrag + TK * 64, p00, p01); pv_block(o1, buf + vfrag + TK * 64 + 2048, p10, p11); }
            if (needB) {
                sm64(b0, b1, m, l, o0, o1, a0, a1, false);
                const bf16x8 p00 = pack_p(b0, 0), p01 = pack_p(b0, 1), p10 = pack_p(b1, 0), p11 = pack_p(b1, 1);
                pv_block(o0, buf + vfrag + 4096, p00, p01); pv_block(o0, buf + vfrag + 6144, p10, p11);
                pv_block(o1, buf + vfrag + TK * 64 + 4096, p00, p01); pv_block(o1, buf + vfrag + TK * 64 + 6144, p10, p11);
            }

        }
        if (kt + 1 < nt) MLA_STORE(lds + ((kt + 1) & 1) * BUFB);
        if (pid < 131072) {
            asm volatile("s_waitcnt vmcnt(0)" ::: "memory");
            const f32x4 xv = *(const LAS f32x4*)(piece + 16 * lane);
            const int idx = pid & 65535, col = (idx & 3) * 256 + 4 * lane;
            f32x4 sc = {SV, SV, SV, SV};
            if ((pid >> 16) == 0) { const f32x4 gv_ = *(const LAS f32x4*)(lds + MLA_G_OFF + 4 * col); sc = (f32x4){gv_.x * SU, gv_.y * SU, gv_.z * SU, gv_.w * SU}; }
            if ((pid >> 16) == 0) {
                unsigned w4 = __builtin_amdgcn_cvt_scalef32_pk_fp4_f32(0u, xv.x * sc.x, xv.y * sc.y, 1.0f, 0);
                w4 = __builtin_amdgcn_cvt_scalef32_pk_fp4_f32(w4, xv.z * sc.z, xv.w * sc.w, 1.0f, 1);
                *(unsigned short*)(U8 + (size_t)(idx & 3) * ((size_t)16384 * 128) + (size_t)(idx >> 2) * 128 + 2 * lane) = (unsigned short)(w4 & 0xffffu);
            } else {
                unsigned w4 = __builtin_amdgcn_cvt_scalef32_pk_fp4_f32(0u, xv.x * sc.x, xv.y * sc.y, 1.0f, 0);
                w4 = __builtin_amdgcn_cvt_scalef32_pk_fp4_f32(w4, xv.z * sc.z, xv.w * sc.w, 1.0f, 1);
                *(unsigned short*)(V8 + (size_t)(idx & 3) * ((size_t)16384 * 128) + (size_t)(idx >> 2) * 128 + 2 * lane) = (unsigned short)(w4 & 0xffffu);
            }
        }
        __syncthreads();
        }
#undef MLA_LOAD
#undef MLA_STORE
    __builtin_amdgcn_s_setprio(0);
    l = swapsum(l);
    store_o(Mixed + (tok0 + qpos) * DM + 512 + h * 64, o0, o1, 1.0f / l, hi);
}

constexpr int DIL_KR = 144, DIL_VR = 160, DIL_VOFF = 32 * DIL_KR, DIL_WLDS = 32 * DIL_KR + 32 * DIL_VR;
constexpr int DIL_SROW = 132, DIL_STATE_OFF = 8 * DIL_WLDS;
struct DilBlk { u32x4 k[4]; u32x4 v[4]; };
__device__ __forceinline__ void dil_load(DilBlk& B, const bf16_t* __restrict__ Ka, const bf16_t* __restrict__ Va, size_t hrow0  , int rd, int dl  , int imax, int idx0, int lane) {
#pragma unroll
    for (int i = 0; i < 4; ++i) {
        int ik = idx0 + 8 * i + (lane >> 3); ik = ik < 0 ? 0 : ik; ik = ik > imax ? imax : ik;
        const size_t off = (hrow0 + ((size_t)ik << dl) + rd) * 64 + 8 * (lane & 7);
        B.k[i] = *(const u32x4*)(Ka + off); B.v[i] = *(const u32x4*)(Va + off);
    }
}
__device__ __forceinline__ void pv_block_p(f32x16& o, const LAS unsigned char* vbase, const bf16x8& pb0, const bf16x8& pb1) {
    const s16x4 l0 = vtr(vbase), h0 = vtr(vbase + 8 * DIL_VR), l1 = vtr(vbase + 16 * DIL_VR), h1 = vtr(vbase + 24 * DIL_VR);
    const bf16x8 a0 = {l0[0], l0[1], l0[2], l0[3], h0[0], h0[1], h0[2], h0[3]}, a1 = {l1[0], l1[1], l1[2], l1[3], h1[0], h1[1], h1[2], h1[3]};
    o = __builtin_amdgcn_mfma_f32_32x32x16_bf16(a0, pb0, o, 0, 0, 0);
    o = __builtin_amdgcn_mfma_f32_32x32x16_bf16(a1, pb1, o, 0, 0, 0);
}
template <bool MASK>
__device__ __forceinline__ void dil_step(const DilBlk& B, LAS unsigned char* wl, const bf16x8 (&qf)[4], float& m, float& l, f32x16& o0, f32x16& o1, int A, int idx0, int lane) {
    const int r32 = lane & 31, hi = lane >> 5;
    {
        LAS unsigned char* kp = wl + (lane >> 3) * DIL_KR + (lane & 7) * 16;
        LAS unsigned char* vp = wl + DIL_VOFF + (lane >> 3) * DIL_VR + (lane & 7) * 16;
#pragma unroll
        for (int i = 0; i < 4; ++i) { *(LAS u32x4*)(kp + 8 * i * DIL_KR) = B.k[i]; *(LAS u32x4*)(vp + 8 * i * DIL_VR) = B.v[i]; }
    }
    const float nm = -m;
    f32x16 s = {nm, nm, nm, nm, nm, nm, nm, nm, nm, nm, nm, nm, nm, nm, nm, nm};
    { const LAS unsigned char* kfr = wl + r32 * DIL_KR + 16 * hi;
#pragma unroll
      for (int ds = 0; ds < 4; ++ds) s = __builtin_amdgcn_mfma_f32_32x32x16_bf16(*(const LAS bf16x8*)(kfr + 32 * ds), qf[ds], s, 0, 0, 0); }
    if (MASK) {
        const int qi = A + r32;
#pragma unroll
        for (int r = 0; r < 16; ++r) { const int ki = idx0 + crow(r, hi), dist = qi - ki; if (ki < 0 || dist < 0 || dist > 128) s[r] = NEGM; }
    }
    float mx = max3f(s[0], s[1], s[2]);
#pragma unroll
    for (int r = 3; r < 15; r += 2) mx = max3f(mx, s[r], s[r + 1]);
    mx = fmaxf(mx, s[15]);
    mx = swapmax(mx);
    if (__builtin_expect(__builtin_amdgcn_ballot_w64(mx > THR) != 0ull, 0)) {
        const float dl_ = fmaxf(mx, 0.f), alpha = __builtin_amdgcn_exp2f(-dl_);
        m += dl_; l *= alpha;
        sub16(s, dl_); scale16(o0, alpha); scale16(o1, alpha);
    }
    float rs = 0.f;
#pragma unroll
    for (int r = 0; r < 16; ++r) { s[r] = __builtin_amdgcn_exp2f(s[r]); rs += s[r]; }
    l += rs;
    const bf16x8 p0 = pack_p(s, 0), p1 = pack_p(s, 1);
    const int i16 = lane & 15;
    const LAS unsigned char* vb = wl + DIL_VOFF + (4 * hi + (i16 >> 2)) * DIL_VR + (16 * ((lane >> 4) & 1) + 4 * (i16 & 3)) * 2;
    pv_block_p(o0, vb, p0, p1);
    pv_block_p(o1, vb + 64, p0, p1);
}
__device__ __forceinline__ void dil_unit(LAS unsigned char* wl, const bf16_t* __restrict__ Qa, const bf16_t* __restrict__ Ka, const bf16_t* __restrict__ Va, bf16_t* __restrict__ Mixed, LAS unsigned char* state,
                                         int b, int h, int p0, int dl, bool first, bool last, int lane, int pflags = 0) {
    const int r32 = lane & 31, hi = lane >> 5;
    const size_t tok0 = (size_t)b * SEQ, hrow0 = (size_t)(b * 8 + h) * SEQ;
    const int qpos = p0 + (r32 << dl);
    const int rd = p0 & ((1 << dl) - 1), A = p0 >> dl, imax = (SEQ - 1 - rd) >> dl;
    DilBlk b0, b1, b2;
#define DLOAD(B_, k_) dil_load(B_, Ka, Va, hrow0, rd, dl, imax, A - 128 + 32 * (k_), lane)
#define DSTEP(MK_, B_, k_) dil_step<MK_>(B_, wl, qf, m, l, o0, o1, A, A - 128 + 32 * (k_), lane)
    DLOAD(b0, 0); DLOAD(b1, 1);
    bf16x8 qf[4];
    { const bf16_t* qrow = Qa + (hrow0 + qpos) * 64 + 8 * hi;
#pragma unroll
      for (int ds = 0; ds < 4; ++ds) qf[ds] = *(const bf16x8*)(qrow + 16 * ds); }
    float m = 0.f, l = 0.f; f32x16 o0 = {}, o1 = {};
    LAS unsigned* st = (LAS unsigned*)(state + ((qpos & 511) * DIL_SROW));
    if (!first) {
        m = __builtin_bit_cast(float, st[32]); l = hi ? 0.f : 1.f;
#pragma unroll
        for (int g = 0; g < 4; ++g) {
            const unsigned a0 = st[4 * g + 2 * hi], a1 = st[4 * g + 2 * hi + 1], c0 = st[16 + 4 * g + 2 * hi], c1 = st[16 + 4 * g + 2 * hi + 1];
            o0[4 * g] = bf_lo(a0); o0[4 * g + 1] = bf_hi(a0); o0[4 * g + 2] = bf_lo(a1); o0[4 * g + 3] = bf_hi(a1);
            o1[4 * g] = bf_lo(c0); o1[4 * g + 1] = bf_hi(c0); o1[4 * g + 2] = bf_lo(c1); o1[4 * g + 3] = bf_hi(c1);
        }
    }
    const bool early = A - 96 < 0;
#ifdef PROBE_LO
    if (pflags & 32) { o0[0] += __builtin_bit_cast(float, b0.k[0].x ^ b1.k[0].x ^ b0.v[3].w ^ b1.v[3].w); l = 1.f; } else {
#endif
    DLOAD(b2, 2);
    DSTEP(true, b0, 0);
    DLOAD(b0, 3);
    if (early) DSTEP(true, b1, 1); else DSTEP(false, b1, 1);
    DLOAD(b1, 4);
    if (early) DSTEP(true, b2, 2); else DSTEP(false, b2, 2);
    if (early) DSTEP(true, b0, 3); else DSTEP(false, b0, 3);
    DSTEP(true, b1, 4);
#ifdef PROBE_LO
    }
#endif
#undef DLOAD
#undef DSTEP
    l = swapsum(l);
    const float inv = 1.0f / l;
    if (last) store_o(Mixed + (tok0 + qpos) * DM + h * 64, o0, o1, inv, hi);
    else {
#pragma unroll
        for (int g = 0; g < 4; ++g) {
            st[4 * g + 2 * hi] = pk_bf16(o0[4 * g] * inv, o0[4 * g + 1] * inv); st[4 * g + 2 * hi + 1] = pk_bf16(o0[4 * g + 2] * inv, o0[4 * g + 3] * inv);
            st[16 + 4 * g + 2 * hi] = pk_bf16(o1[4 * g] * inv, o1[4 * g + 1] * inv); st[16 + 4 * g + 2 * hi + 1] = pk_bf16(o1[4 * g + 2] * inv, o1[4 * g + 3] * inv);
        }
        if (hi == 0) st[32] = __builtin_bit_cast(unsigned, m + __builtin_amdgcn_logf(l));
    }
}
__device__ __forceinline__ void dil_segment(LAS unsigned char* lds, const bf16_t* __restrict__ Qa, const bf16_t* __restrict__ Ka, const bf16_t* __restrict__ Va, bf16_t* __restrict__ Mixed,
                                            int sg, int wave, int lane, int pflags = 0) {
    const int seg = sg & 15, h = (sg >> 4) & 7, b = sg >> 7, base = 512 * seg;
    LAS unsigned char* wl = lds + wave * DIL_WLDS;
#pragma unroll 1
    for (int pass = 0; pass < ((pflags & 64) ? 1 : 3); ++pass) {
        const int dl = 2 * pass;
#pragma unroll 1
        for (int j = wave; j < 16; j += 8) {
            const int rd = j & ((1 << dl) - 1), cj = j >> dl;
            dil_unit(wl, Qa, Ka, Va, Mixed, lds + DIL_STATE_OFF, b, h, base + rd + ((32 * cj) << dl), dl, pass == 0, pass == 2, lane, pflags);
        }
        if (pass < 2) __syncthreads();
    }
}
}

namespace peer {
__device__ __forceinline__ void ins16(unsigned (&L)[16], unsigned key) {
#pragma unroll
    for (int i = 0; i < 16; ++i) { const unsigned hi_ = L[i] > key ? L[i] : key; key = L[i] > key ? key : L[i]; L[i] = hi_; }
}
__device__ __forceinline__ void ce(unsigned& a, unsigned& b) { const unsigned hi_ = a > b ? a : b, lo_ = a > b ? b : a; a = hi_; b = lo_; }
__device__ __forceinline__ void sort8(unsigned (&v)[8]) {
    ce(v[0], v[1]); ce(v[2], v[3]); ce(v[4], v[5]); ce(v[6], v[7]); ce(v[0], v[2]); ce(v[1], v[3]); ce(v[4], v[6]); ce(v[5], v[7]); ce(v[1], v[2]); ce(v[5], v[6]);
    ce(v[0], v[4]); ce(v[3], v[7]); ce(v[1], v[5]); ce(v[2], v[6]); ce(v[1], v[4]); ce(v[3], v[6]); ce(v[2], v[4]); ce(v[3], v[5]); ce(v[3], v[4]);
}
__device__ __forceinline__ void bmerge16(unsigned (&v)[16]) {
#pragma unroll
    for (int k = 8; k >= 1; k >>= 1)
#pragma unroll
        for (int i = 0; i < 16; ++i) if ((i & k) == 0) ce(v[i], v[i + k]);
}
__device__ __forceinline__ float dec16(unsigned key) { const unsigned s = key >> 16; const unsigned b = (s & 0x8000u) ? (s & 0x7fffu) : (~s & 0xffffu); return (float)__builtin_bit_cast(_Float16, (unsigned short)b); }
__device__ __forceinline__ unsigned enc32(float f) { const unsigned u = __builtin_bit_cast(unsigned, f); return (u & 0x80000000u) ? ~u : (u | 0x80000000u); }
__device__ __forceinline__ float dec32(unsigned s) { const unsigned u = (s & 0x80000000u) ? (s & 0x7fffffffu) : ~s; return __builtin_bit_cast(float, u); }
__device__ __forceinline__ float gelu1(float v) {
    const float av = fabsf(v), t = __builtin_amdgcn_rcpf(av * 0.2316418882f + 1.0f);
    float q = t * 0.5307027145f + (-0.7265760135f); q = q * t + 0.7107068705f; q = q * t + (-0.142248368f); q = q * t + 0.127414796f; q = q * t;
    const float e = __builtin_amdgcn_exp2f((v * v) * (-0.72134752044f));
    const float mm = v * (q * e);
    return v < 0.f ? mm : v - mm;
}
struct CandTab { unsigned char i[52], j[52]; };
__host__ __device__ constexpr CandTab make_cands() {
    CandTab t{}; int n = 0;
    for (int i = 0; i < 16; ++i) for (int j = 0; j < 16; ++j) if ((i + 1) * (j + 1) <= 16) { t.i[n] = (unsigned char)i; t.j[n] = (unsigned char)j; ++n; }
    for (; n < 52; ++n) { t.i[n] = 15; t.j[n] = 15; }
    return t;
}

}

namespace peer2 {
__device__ __forceinline__ int ld_of(int j) { const int rho = 16 * ((j >> 2) & 3) + 4 * ((j >> 4) & 3) + (j & 3); return (j >> 6) * 64 + (rho & 7) * 8 + (rho >> 3); }

__device__ __forceinline__ void topk_phase(LAS unsigned char* lds, const bf16_t* __restrict__ Sc, const float* __restrict__ ssq_h, unsigned short* __restrict__ Pe_slot, unsigned short* __restrict__ Pe_ld,
                                           float* __restrict__ Pg, float* __restrict__ rstd_h, int gw, int ngw) {
    const int lane = threadIdx.x & 63, wid = __builtin_amdgcn_readfirstlane(threadIdx.x >> 6);
    LAS unsigned char* tile = lds + wid * 12288;
    LAS unsigned* lists = (LAS unsigned*)(tile + 8192);
    constexpr peer::CandTab CT = peer::make_cands();
    u32x4 nx[8];
#define TK_LOAD(g_, hh_) do { _Pragma("unroll") for (int i_ = 0; i_ < 8; ++i_) { const int s_ = 8 * i_ + (lane >> 3); \
        nx[i_] = *(const u32x4*)(Sc + (size_t)(4 * (g_) + (s_ >> 4)) * 2048 + (s_ & 15) * 128 + (hh_) * 64 + (lane & 7) * 8); } } while (0)
#define TK_WRITE() do { _Pragma("unroll") for (int i_ = 0; i_ < 8; ++i_) { const int s_ = 8 * i_ + (lane >> 3); *(LAS u32x4*)(tile + s_ * 128 + (((lane & 7) ^ (s_ & 7)) << 4)) = nx[i_]; } } while (0)
    if (gw < T / 4) TK_LOAD(gw, 0);
    for (int g = gw; g < T / 4; g += ngw) {
        const int t4 = lane >> 4, hp = lane & 15, tok = 4 * g + t4;
        unsigned L[16];
        {
            const LAS unsigned char* seg = tile + lane * 128;
#pragma unroll 1
            for (int gq = 0; gq < 8; ++gq) {
                if (gq == 0) { TK_WRITE(); TK_LOAD(g, 1); }
                if (gq == 4) { TK_WRITE(); if (g + ngw < T / 4) TK_LOAD(g + ngw, 0); }
                const int c0 = 2 * (gq & 3);
                const u32x4 w0 = *(const LAS u32x4*)(seg + ((c0 ^ (lane & 7)) << 4)), w1 = *(const LAS u32x4*)(seg + (((c0 + 1) ^ (lane & 7)) << 4));
                unsigned ka[8], kb[8];
#pragma unroll
                for (int e2 = 0; e2 < 4; ++e2) {
                    const unsigned wa = e2 == 0 ? w0.x : (e2 == 1 ? w0.y : (e2 == 2 ? w0.z : w0.w)), wb = e2 == 0 ? w1.x : (e2 == 1 ? w1.y : (e2 == 2 ? w1.z : w1.w));
                    typedef short s16x2_t __attribute__((ext_vector_type(2)));
                    const unsigned ma = __builtin_bit_cast(unsigned, __builtin_bit_cast(s16x2_t, wa) >> (short)15) | 0x80008000u, mb = __builtin_bit_cast(unsigned, __builtin_bit_cast(s16x2_t, wb) >> (short)15) | 0x80008000u;
                    const unsigned sa = wa ^ ma, sb = wb ^ mb;
                    const unsigned i0 = (unsigned)(127 - (16 * gq + 2 * e2));
                    ka[2 * e2] = (sa << 16) | i0; ka[2 * e2 + 1] = (sa & 0xffff0000u) | (i0 - 1u);
                    kb[2 * e2] = (sb << 16) | (i0 - 8u); kb[2 * e2 + 1] = (sb & 0xffff0000u) | (i0 - 9u);
                }
                peer::sort8(ka); peer::sort8(kb);
                unsigned G[16];
#pragma unroll
                for (int i = 0; i < 8; ++i) { G[i] = ka[i]; G[8 + i] = kb[7 - i]; }
                peer::bmerge16(G);
                if (gq == 0) {
#pragma unroll
                    for (int i = 0; i < 16; ++i) L[i] = G[i];
                } else {
#pragma unroll
                    for (int i = 0; i < 16; ++i) L[i] = L[i] > G[15 - i] ? L[i] : G[15 - i];
                    peer::bmerge16(L);
                }
            }
        }
#pragma unroll
        for (int i = 0; i < 16; ++i) lists[lane * 16 + i] = L[i];
        const int p = hp & 1;
        float av[16], bv[16];
#pragma unroll
        for (int i = 0; i < 16; ++i) { const unsigned o = (unsigned)__builtin_amdgcn_update_dpp(0, (int)L[i], 0xB1, 0xF, 0xF, true); av[i] = peer::dec16(p ? o : L[i]); bv[i] = peer::dec16(p ? L[i] : o); }
        unsigned M[16];
        {
            unsigned C[32];
#pragma unroll
            for (int k = 0; k < 25; ++k) {
                const int i0 = CT.i[2 * k], j0 = CT.j[2 * k], i1 = CT.i[2 * k + 1], j1 = CT.j[2 * k + 1];
                const float s0 = av[i0] + bv[j0], s1 = av[i1] + bv[j1];
                const float sm = p ? s1 : s0; const unsigned fl = p ? (unsigned)(i1 * 16 + j1) : (unsigned)(i0 * 16 + j0);
                C[k] = (peer::enc32(sm) & 0xffffff00u) | (255u - fl);
            }
#pragma unroll
            for (int k = 25; k < 32; ++k) C[k] = 0u;
            unsigned g0[8], g1[8], g2[8], g3[8];
#pragma unroll
            for (int i = 0; i < 8; ++i) { g0[i] = C[i]; g1[i] = C[8 + i]; g2[i] = C[16 + i]; g3[i] = C[24 + i]; }
            peer::sort8(g0); peer::sort8(g1); peer::sort8(g2); peer::sort8(g3);
            unsigned H[16];
#pragma unroll
            for (int i = 0; i < 8; ++i) { M[i] = g0[i]; M[8 + i] = g1[7 - i]; H[i] = g2[i]; H[8 + i] = g3[7 - i]; }
            peer::bmerge16(M); peer::bmerge16(H);
#pragma unroll
            for (int i = 0; i < 16; ++i) M[i] = M[i] > H[15 - i] ? M[i] : H[15 - i];
            peer::bmerge16(M);
        }
        unsigned R[16];
#pragma unroll
        for (int k = 0; k < 16; ++k) { const unsigned o = (unsigned)__builtin_amdgcn_update_dpp(0, (int)M[15 - k], 0xB1, 0xF, 0xF, true); R[k] = M[k] > o ? M[k] : o; }
        float rv[16], mx = -INFINITY;
#pragma unroll
        for (int k = 0; k < 16; ++k) { rv[k] = peer::dec32(R[k] & 0xffffff00u); mx = fmaxf(mx, rv[k]); }
        float sum = 0.f;
#pragma unroll
        for (int k = 0; k < 16; ++k) { rv[k] = __builtin_amdgcn_exp2f((rv[k] - mx) * LOG2E); sum += rv[k]; }
        const float isum = 1.0f / sum;
        {
            const int h = hp >> 1;
            const LAS unsigned* la = lists + (lane & ~1) * 16; const LAS unsigned* lb = lists + (lane | 1) * 16;
#pragma unroll
            for (int k = 0; k < 8; ++k) {
                const unsigned fl = 255u - (R[k] & 0xffu);
                const unsigned i1 = 127u - (la[fl >> 4] & 0x7fu), i2 = 127u - (lb[fl & 15u] & 0x7fu);
                const int j = h * 16 + p * 8 + k, sl = j;
                const unsigned short e = (unsigned short)(i1 * 128u + i2);
                Pe_slot[(size_t)tok * 128 + sl] = e;
                Pe_ld[(size_t)tok * 128 + ld_of(j)] = e;
                Pg[(size_t)tok * 128 + sl] = rv[k] * isum;
            }
        }
        if (hp == 0) {
            float s = 0.f;
#pragma unroll
            for (int k = 0; k < 8; ++k) { const f32x4 q = *(const f32x4*)(ssq_h + (size_t)tok * 32 + 4 * k); s += (q.x + q.y) + (q.z + q.w); }
            rstd_h[tok] = 1.0f / sqrtf(s * (1.f / 1024.f) + EPS);
        }
    }
#undef TK_LOAD
#undef TK_WRITE
}

struct UG { u32x4 v[8]; };
__device__ __forceinline__ void u_gather(UG& F, const u32x4& w, const unsigned char* __restrict__ Ul  , unsigned emask, unsigned loff = 0u  ) {
#pragma unroll
    for (int i = 0; i < 8; ++i) {
        const unsigned word = (i >> 1) == 0 ? w.x : ((i >> 1) == 1 ? w.y : ((i >> 1) == 2 ? w.z : w.w));
        const unsigned e = ((i & 1) ? (word >> 16) : (word & 0xffffu)) & emask;
        F.v[i] = *(const u32x4*)(Ul + (e * 128u + loff));
    }
}
template <int PM = 0> __device__ __forceinline__ void u_compute(u32x4& z0, u32x4& z1, const UG& F, const v8i& bf0, const v8i& bf1, LAS unsigned char* hl  , int lane) {
    if (PM == 0) {
        LAS unsigned char* wp = hl + (lane >> 3) * 128 + (((lane & 7) ^ (lane >> 3)) << 4);
#pragma unroll
        for (int i = 0; i < 8; ++i) *(LAS u32x4*)(wp + i * 1024) = F.v[i];
    }
    const int r16 = lane & 15, kq = lane >> 4;
    const LAS unsigned char* rp = hl + r16 * 128;
    const int p0 = (kq ^ (r16 & 7)) << 4, p1 = ((4 + kq) ^ (r16 & 7)) << 4;
    f32x4 acc[4];
#pragma unroll
    for (int g = 0; g < 4; ++g) {
        u32x4 a0, a1; if (PM == 0) { a0 = *(const LAS u32x4*)(rp + g * 2048 + p0); a1 = *(const LAS u32x4*)(rp + g * 2048 + p1); } else { a0 = F.v[2 * g]; a1 = F.v[2 * g + 1]; }
        const v8i af0 = {(int)a0.x, (int)a0.y, (int)a0.z, (int)a0.w, 0, 0, 0, 0}, af1 = {(int)a1.x, (int)a1.y, (int)a1.z, (int)a1.w, 0, 0, 0, 0};
        acc[g] = __builtin_amdgcn_mfma_scale_f32_16x16x128_f8f6f4(af0, bf0, (f32x4){0.f, 0.f, 0.f, 0.f}, 4, 0, 0, 0, 0, 0);
        acc[g] = __builtin_amdgcn_mfma_scale_f32_16x16x128_f8f6f4(af1, bf1, acc[g], 4, 0, 0, 0, 0, 0);
    }
    z0.x = pk_bf16(acc[0][0], acc[0][1]); z0.y = pk_bf16(acc[0][2], acc[0][3]); z0.z = pk_bf16(acc[1][0], acc[1][1]); z0.w = pk_bf16(acc[1][2], acc[1][3]);
    z1.x = pk_bf16(acc[2][0], acc[2][1]); z1.y = pk_bf16(acc[2][2], acc[2][3]); z1.z = pk_bf16(acc[3][0], acc[3][1]); z1.w = pk_bf16(acc[3][2], acc[3][3]);
}
constexpr int U_REC = 512, U_CH = 16, U_STAGE = 8192, U_WLDS = U_STAGE + U_CH * U_REC;
template <int PM = 0> __device__ __forceinline__ void u_phase(LAS unsigned char* lds, const unsigned char* __restrict__ Hb8, const unsigned char* __restrict__ U4, const unsigned short* __restrict__ Pe_ld, bf16_t* __restrict__ Zp, int x, int wg, int nwg, unsigned emask = 0xffffu) {
    const int lane = threadIdx.x & 63, wid = __builtin_amdgcn_readfirstlane(threadIdx.x >> 6);
    LAS unsigned char* wl = lds + wid * U_WLDS;
    LAS unsigned char* rb = wl + U_STAGE;
    const unsigned rb_u = (unsigned)__builtin_amdgcn_readfirstlane((int)(unsigned)(uintptr_t)rb);
    const unsigned char* Hx = Hb8 + (size_t)x * ((size_t)T * 256);
    const unsigned char* Ul = U4 + (size_t)x * ((size_t)16384 * 128); const unsigned loff = 16u * (lane & 7);
    bf16_t* Zx = Zp + (size_t)x * T * 128;
    const int n = (T - wg + nwg - 1) / nwg;
    if (n <= 0) return;
    const int nch = (n + U_CH - 1) / U_CH;
#define UTOK(k) (wg + ((k) < n ? (k) : n - 1) * nwg)
#define USB() __builtin_amdgcn_sched_barrier(0)
    const int w32 = lane & 31, sub = lane >> 5;
    const unsigned char* rbase = w32 < 16 ? (const unsigned char*)Pe_ld + 16 * w32 : Hx + 16 * (w32 - 16);
#pragma unroll 1
    for (int c = 0; c < nch; ++c) {
#pragma unroll
        for (int i = 0; i < U_CH / 2; ++i)
            glds16(rbase + (size_t)UTOK(c * U_CH + 2 * i + sub) * 256u, rb_u + i * 1024);
        asm volatile("s_waitcnt vmcnt(0)" ::: "memory");
        UG f0, f1;
        { const u32x4 e0 = *(const LAS u32x4*)(rb + (lane >> 3) * 16); u_gather(f0, e0, Ul, emask, loff); }
#pragma unroll 1
        for (int i = 0; i < U_CH; ++i) {
            const int k = c * U_CH + i;
            const LAS unsigned char* rec = rb + i * U_REC;
            const LAS unsigned char* nrec = (i + 1 < U_CH) ? rec + U_REC : rec;
            const u32x4 e1 = *(const LAS u32x4*)(rec + 128 + (lane >> 3) * 16), e0n = *(const LAS u32x4*)(nrec + (lane >> 3) * 16);
            const LAS u32x4* hp = (const LAS u32x4*)(rec + 256 + 16 * (lane >> 4));
            const u32x4 h0 = hp[0], h1 = hp[4], h2 = hp[8], h3 = hp[12];
            const v8i bf0 = {(int)h0.x, (int)h0.y, (int)h0.z, (int)h0.w, (int)h1.x, (int)h1.y, (int)h1.z, (int)h1.w}, bf1 = {(int)h2.x, (int)h2.y, (int)h2.z, (int)h2.w, (int)h3.x, (int)h3.y, (int)h3.z, (int)h3.w};
            u32x4 za, zb, zc, zd;
            u_gather(f1, e1, Ul, emask, loff);
            USB(); u_compute<PM>(za, zb, f0, bf0, bf1, wl, lane); USB();
            u_gather(f0, e0n, Ul, emask, loff);
            USB(); u_compute<PM>(zc, zd, f1, bf0, bf1, wl, lane); USB();
            if ((lane & 15) == 0 && k < n) { bf16_t* zr_ = Zx + (size_t)UTOK(k) * 128 + 16 * (lane >> 4); *(u32x4*)zr_ = za; *(u32x4*)(zr_ + 8) = zb; *(u32x4*)(zr_ + 64) = zc; *(u32x4*)(zr_ + 72) = zd; }
        }
        asm volatile("s_waitcnt vmcnt(0) lgkmcnt(0)" ::: "memory");
    }
#undef UTOK
#undef USB
}

__device__ __forceinline__ float dppf(float v, int ctrl_sel) {
    const int s = __builtin_bit_cast(int, v);
    const int r = ctrl_sel == 0 ? __builtin_amdgcn_update_dpp(0, s, 0xB1, 0xF, 0xF, true) : ctrl_sel == 1 ? __builtin_amdgcn_update_dpp(0, s, 0x4E, 0xF, 0xF, true)
                : ctrl_sel == 2 ? __builtin_amdgcn_update_dpp(0, s, 0x141, 0xF, 0xF, true) : ctrl_sel == 3 ? __builtin_amdgcn_update_dpp(0, s, 0x140, 0xF, 0xF, true) : __builtin_amdgcn_update_dpp(0, s, 0x128, 0xF, 0xF, true);
    return __builtin_bit_cast(float, r);
}
constexpr float SA = 64.f;
__device__ __forceinline__ void act_phase(LAS unsigned char* lds, const bf16_t* __restrict__ Zp, const unsigned short* __restrict__ Pe_slot, const float* __restrict__ Pg, const float* __restrict__ ssq_h,
                                          unsigned short* __restrict__ PE2, unsigned char* __restrict__ PA2, int gw, int ngw) {
    const int lane = threadIdx.x & 63, wid = __builtin_amdgcn_readfirstlane(threadIdx.x >> 6);
    LAS unsigned short* lid = (LAS unsigned short*)(lds + wid * 512);
    LAS unsigned char* lw = lds + wid * 512 + 256;
    unsigned zw[4], ew; f32x2 gg; float sp;
#define ACT_LOAD(t_) do { const size_t o_ = (size_t)(t_) * 128 + 2 * lane; _Pragma("unroll") for (int xx = 0; xx < 4; ++xx) zw[xx] = *(const unsigned*)(Zp + (size_t)xx * T * 128 + o_); \
        ew = *(const unsigned*)(Pe_slot + o_); gg = *(const f32x2*)(Pg + o_); sp = ssq_h[(size_t)(t_) * 32 + (lane & 31)]; } while (0)
    if (gw < T) ACT_LOAD(gw);
    for (int tok = gw; tok < T; tok += ngw) {
        float z0 = 0.f, z1 = 0.f;
#pragma unroll
        for (int xx = 0; xx < 4; ++xx) { z0 += bf_lo(zw[xx]); z1 += bf_hi(zw[xx]); }
        const unsigned e2 = ew; const f32x2 g2 = gg;
        float s = sp;
        if (tok + ngw < T) ACT_LOAD(tok + ngw);
        s += dppf(s, 0); s += dppf(s, 1); s += dppf(s, 2); s += dppf(s, 3);
        const int si = __builtin_bit_cast(int, s);
        const float tot = __builtin_bit_cast(float, __builtin_amdgcn_readlane(si, 0)) + __builtin_bit_cast(float, __builtin_amdgcn_readlane(si, 16));
        const float zs = (1.0f / sqrtf(tot * (1.f / 1024.f) + EPS)) * (1.0f / (SU * SX));
        const float w0 = fminf(fmaxf(peer::gelu1(z0 * zs) * g2.x * SA, -440.f), 440.f), w1 = fminf(fmaxf(peer::gelu1(z1 * zs) * g2.y * SA, -440.f), 440.f);
        const unsigned w8 = (unsigned)__builtin_amdgcn_cvt_pk_fp8_f32(w0, w1, 0, false);
        const int sl0 = 2 * lane, d0 = (sl0 & 7) * 16 + (sl0 >> 3), d1 = ((sl0 + 1) & 7) * 16 + (sl0 >> 3);
        lid[d0] = (unsigned short)(e2 & 0xffffu); lid[d1] = (unsigned short)(e2 >> 16);
        { const int n0 = sl0 >> 3;
          lw[(n0 >> 3) * 64 + 8 * (n0 & 7) + (sl0 & 7)] = (unsigned char)(w8 & 0xffu); lw[(n0 >> 3) * 64 + 8 * (n0 & 7) + ((sl0 + 1) & 7)] = (unsigned char)((w8 >> 8) & 0xffu); }
        const u32x4 ov = *(const LAS u32x4*)(lds + wid * 512 + 16 * lane);
        if (lane < 16) *(u32x4*)(PE2 + (size_t)tok * 128 + 8 * lane) = ov;
        else if (lane < 24) *(u32x4*)(PA2 + (size_t)tok * 128 + 16 * (lane - 16)) = ov;
    }
#undef ACT_LOAD
}

struct VG { u32x4 v[8]; };
template <int PM = 0> __device__ __forceinline__ void v_gather(VG& Gt, const u32x4& ew, const unsigned char* __restrict__ vb  , unsigned loff  , unsigned emask) {
#pragma unroll
    for (int i = 0; i < 8; ++i) {
        const unsigned word = (i >> 1) == 0 ? ew.x : ((i >> 1) == 1 ? ew.y : ((i >> 1) == 2 ? ew.z : ew.w));
        const unsigned e = ((i & 1) ? (word >> 16) : (word & 0xffffu)) & emask;
        if (PM == 1 && (i & 1)) Gt.v[i] = Gt.v[i - 1]; else
        Gt.v[i] = *(const u32x4*)(vb + (e * 128u + loff));
    }
}
typedef int v2i_t __attribute__((ext_vector_type(2)));
__device__ __forceinline__ void v_compute(f32x4 (&acc)[8], const VG& Gt, const u32x4& wts, LAS unsigned char* hl  , int lane) {
    {
        LAS unsigned char* wp = hl + (lane >> 3) * 128 + (((lane & 7) ^ (lane >> 3)) << 4);
#pragma unroll
        for (int i = 0; i < 8; ++i) *(LAS u32x4*)(wp + i * 1024) = Gt.v[i];
    }
    const bool up = (lane & 8) != 0;
    const v8i af = {up ? 0 : (int)wts.x, up ? 0 : (int)wts.y, up ? 0 : (int)wts.z, up ? 0 : (int)wts.w, up ? (int)wts.x : 0, up ? (int)wts.y : 0, up ? (int)wts.z : 0, up ? (int)wts.w : 0};
    const LAS unsigned char* r0 = hl + (32 * ((lane >> 4) & 1) + (lane & 15)) * 128;
    const int x7 = lane & 7, oxr = (lane >> 5) << 6;
#pragma unroll
    for (int cb = 0; cb < 8; ++cb) {
        const int off = ((((cb >> 1) ^ x7) << 4) + 8 * (cb & 1)) ^ oxr;
        const v2i_t t0 = __builtin_amdgcn_ds_read_tr4_b64_v2i32((LAS v2i_t*)(r0 + off)), t1 = __builtin_amdgcn_ds_read_tr4_b64_v2i32((LAS v2i_t*)(r0 + 16 * 128 + off));
        const v8i bfr = {t0.x, t0.y, t1.x, t1.y, 0, 0, 0, 0};
        acc[cb] = __builtin_amdgcn_mfma_scale_f32_16x16x128_f8f6f4(af, bfr, acc[cb], 0, 4, 0, 0, 0, 0);
    }
}
constexpr int V_REC = 512, V_CH = 16, V_STAGE = 8192, V_WLDS = V_STAGE + V_CH * V_REC + 1024;
template <int PM = 0> __device__ __forceinline__ void v_phase(LAS unsigned char* lds, const unsigned char* __restrict__ V4, const unsigned short* __restrict__ PE2, const unsigned char* __restrict__ PA2, bf16_t* __restrict__ Op, int x, int wg, int nwg, unsigned emask = 0xffffu) {
    const int lane = threadIdx.x & 63, wid = __builtin_amdgcn_readfirstlane(threadIdx.x >> 6), seg8 = lane >> 3;
    LAS unsigned char* wl = lds + wid * V_WLDS;
    LAS unsigned char* rb = wl + V_STAGE;
    LAS float* tr = (LAS float*)(rb + V_CH * V_REC);
    const unsigned rb_u = (unsigned)__builtin_amdgcn_readfirstlane((int)(unsigned)(uintptr_t)rb);
    const unsigned char* vb = V4 + (size_t)x * ((size_t)16384 * 128); const unsigned loff = 16u * (lane & 7);
    bf16_t* Ox = Op + (size_t)x * T * 256;
    const int n = (T - wg + nwg - 1) / nwg;
    if (n <= 0) return;
    const int nch = (n + V_CH - 1) / V_CH;
#define VTOK(k) (wg + ((k) < n ? (k) : n - 1) * nwg)
#define VSB() __builtin_amdgcn_sched_barrier(0)
    const int w32 = lane & 31, sub = lane >> 5;
    const unsigned char* rbase = w32 < 16 ? (const unsigned char*)PE2 + 16 * w32 : (w32 < 24 ? PA2 + 16 * (w32 - 16) : (const unsigned char*)PE2);
    const unsigned rstride = (w32 >= 16 && w32 < 24) ? 128u : 256u;
    const int roff = seg8 * 32, woff = 256 + 16 * (lane >> 4);
#pragma unroll 1
    for (int c = 0; c < nch; ++c) {
#pragma unroll
        for (int i = 0; i < V_CH / 2; ++i)
            glds16(rbase + (size_t)VTOK(c * V_CH + 2 * i + sub) * rstride, rb_u + i * 1024);
        asm volatile("s_waitcnt vmcnt(0)" ::: "memory");
        VG g0, g1;
        { const u32x4 ea = *(const LAS u32x4*)(rb + roff); v_gather<PM>(g0, ea, vb, loff, emask); }
#pragma unroll 1
        for (int i = 0; i < V_CH; ++i) {
            const int k = c * V_CH + i, tok = VTOK(k);
            const LAS unsigned char* rec = rb + i * V_REC;
            const LAS unsigned char* nrec = (i + 1 < V_CH) ? rec + V_REC : rec;
            f32x4 acc[8];
#pragma unroll
            for (int cb = 0; cb < 8; ++cb) acc[cb] = (f32x4){0.f, 0.f, 0.f, 0.f};
            const u32x4 e1 = *(const LAS u32x4*)(rec + roff + 16), e0n = *(const LAS u32x4*)(nrec + roff);
            const u32x4 w0 = *(const LAS u32x4*)(rec + woff), w1 = *(const LAS u32x4*)(rec + woff + 64);
            v_gather<PM>(g1, e1, vb, loff, emask);
            VSB(); v_compute(acc, g0, w0, wl, lane); VSB();
            v_gather<PM>(g0, e0n, vb, loff, emask);
            VSB(); v_compute(acc, g1, w1, wl, lane); VSB();
            if ((lane & 16) == 0) {
#pragma unroll
                for (int cb = 0; cb < 8; ++cb) tr[16 * cb + (lane & 15) + 128 * (lane >> 5)] = acc[cb][0];
            }
            const f32x4 o4 = *(const LAS f32x4*)(tr + 4 * lane);
            if (k < n) {
                constexpr float sc = 1.0f / (SA * SV);
                u32x2 w; w.x = pk_bf16(o4.x * sc, o4.y * sc); w.y = pk_bf16(o4.z * sc, o4.w * sc); *(u32x2*)(Ox + (size_t)tok * 256 + 4 * lane) = w;
            }
        }
        asm volatile("s_waitcnt vmcnt(0) lgkmcnt(0)" ::: "memory");
    }
#undef VTOK
#undef VSB
}

__device__ __forceinline__ void final_phase(float* __restrict__ Out, const bf16_t* __restrict__ Hb, const bf16_t* __restrict__ Op, const float* __restrict__ g_final, int gw, int ngw) {
    const int lane = threadIdx.x & 63;
    const f32x4* gr = (const f32x4*)g_final + lane;
    const f32x4 g0 = gr[0], g1 = gr[64], g2 = gr[128], g3 = gr[192];
    const bf16_t* ob = Op + 4 * lane;
    for (int t0 = 4 * gw; t0 < T; t0 += 4 * ngw) {
        u32x2 hh[4][4], o[4][4];
#pragma unroll
        for (int r = 0; r < 4; ++r) {
            const int tok = t0 + r < T ? t0 + r : T - 1;
            const bf16_t* hr = Hb + (size_t)tok * DM + 4 * lane;
#pragma unroll
            for (int j = 0; j < 4; ++j) { hh[r][j] = *(const u32x2*)(hr + 256 * j); o[r][j] = *(const u32x2*)(ob + ((size_t)j * T + tok) * 256); }
        }
#pragma unroll
        for (int r = 0; r < 4; ++r) {
            if (t0 + r >= T) break;
            f32x4 y[4];
            float s = 0.f;
#pragma unroll
            for (int j = 0; j < 4; ++j) {
                y[j].x = bf_lo(hh[r][j].x) + bf_lo(o[r][j].x); y[j].y = bf_hi(hh[r][j].x) + bf_hi(o[r][j].x); y[j].z = bf_lo(hh[r][j].y) + bf_lo(o[r][j].y); y[j].w = bf_hi(hh[r][j].y) + bf_hi(o[r][j].y);
                s += (y[j].x * y[j].x + y[j].y * y[j].y) + (y[j].z * y[j].z + y[j].w * y[j].w);
            }
            s += dppf(s, 0); s += dppf(s, 1); s += dppf(s, 2); s += dppf(s, 3);
            const int si = __builtin_bit_cast(int, s);
            const float tot = (__builtin_bit_cast(float, __builtin_amdgcn_readlane(si, 0)) + __builtin_bit_cast(float, __builtin_amdgcn_readlane(si, 16)))
                            + (__builtin_bit_cast(float, __builtin_amdgcn_readlane(si, 32)) + __builtin_bit_cast(float, __builtin_amdgcn_readlane(si, 48)));
            const float r2 = 1.0f / sqrtf(tot * (1.f / 1024.f) + EPS);
            f32x4* yr = (f32x4*)(Out + (size_t)(t0 + r) * DM) + lane;
            yr[0] = (f32x4){y[0].x * r2 * g0.x, y[0].y * r2 * g0.y, y[0].z * r2 * g0.z, y[0].w * r2 * g0.w};
            yr[64] = (f32x4){y[1].x * r2 * g1.x, y[1].y * r2 * g1.y, y[1].z * r2 * g1.z, y[1].w * r2 * g1.w};
            yr[128] = (f32x4){y[2].x * r2 * g2.x, y[2].y * r2 * g2.y, y[2].z * r2 * g2.z, y[2].w * r2 * g2.w};
            yr[192] = (f32x4){y[3].x * r2 * g3.x, y[3].y * r2 * g3.y, y[3].z * r2 * g3.z, y[3].w * r2 * g3.w};
        }
    }
}
}


#define XB_TMO      128
#define XB_XCNT(j)  (256  + 64 * (j))
#define XB_XSUB(j)  (1280 + 64 * (j))
#define XB_XGEN(j)  (2304 + 64 * (j))
#define XB_TOP      3328
#define XB_TOPGEN   3392
#define XCD_BAR_WORDS 3456
#define XB_SPIN_CAP (1u << 18)

__device__ __forceinline__ unsigned xb_ld(unsigned* p)              { return __hip_atomic_load(p, __ATOMIC_RELAXED, __HIP_MEMORY_SCOPE_AGENT); }
__device__ __forceinline__ unsigned xb_add(unsigned* p, unsigned v) { return __hip_atomic_fetch_add(p, v, __ATOMIC_RELAXED, __HIP_MEMORY_SCOPE_AGENT); }
__device__ __forceinline__ unsigned xb_xcc_id() { return (unsigned)__builtin_amdgcn_s_getreg((3 << 11) | 20) & 0xFu; }
#define XB_SPIN(cond, bar) do { unsigned _sp = 0; while (cond) { __builtin_amdgcn_s_sleep(1); \
    if ((++_sp & 255u) == 0u) { if (xb_ld(&(bar)[XB_TMO])) break; if (_sp > XB_SPIN_CAP) { atomicAdd(&(bar)[XB_TMO], 1u); break; } } } } while (0)

struct XcdBarrier {
    unsigned* bar; unsigned x;
    volatile LAS unsigned* st;
};

__device__ __forceinline__ XcdBarrier xcd_barrier_post(unsigned* bar, volatile LAS unsigned* st) {
    XcdBarrier b; b.bar = bar; b.x = xb_xcc_id(); b.st = st;
    if (threadIdx.x == 0) (void)xb_add(&bar[XB_XCNT(b.x)], 1u);
    return b;
}
__device__ __forceinline__ void xcd_barrier_complete(unsigned* bar, unsigned x, unsigned& nloc, unsigned& nx) {
    const unsigned G = gridDim.x * gridDim.y * gridDim.z;
    unsigned sum, cnt, mine, sp = 0u;
    for (;;) {
        sum = 0u; cnt = 0u; mine = 0u;
#pragma unroll
        for (unsigned j = 0; j < 16; ++j) { const unsigned c = xb_ld(&bar[XB_XCNT(j)]); sum += c; cnt += (c > 0u) ? 1u : 0u; mine = (j == x) ? c : mine; }
        if (sum == G) break;
        __builtin_amdgcn_s_sleep(1);
        if ((++sp & 255u) == 0u) { if (xb_ld(&bar[XB_TMO])) break; if (sp > XB_SPIN_CAP) { atomicAdd(&bar[XB_TMO], 1u); break; } }
    }
    nloc = mine > 0u ? mine : 1u; nx = cnt > 0u ? cnt : 1u;
}

__device__ __forceinline__ void xcd_barrier(const XcdBarrier& b) {
    asm volatile("s_waitcnt vmcnt(0)" ::: "memory");
    __syncthreads();
    if (threadIdx.x == 0) {
        unsigned* bar = b.bar;
        __builtin_amdgcn_s_waitcnt(0);
        unsigned nloc = b.st[0], nx = b.st[1];
        if (nloc == 0u) { xcd_barrier_complete(bar, b.x, nloc, nx); b.st[0] = nloc; b.st[1] = nx; }
        const unsigned old = xb_add(&bar[XB_XSUB(b.x)], 1u);
        const unsigned gen = old / nloc;
        if (old + 1u == (gen + 1u) * nloc) {
            __builtin_amdgcn_fence(__ATOMIC_RELEASE, "agent");
            asm volatile("s_waitcnt vmcnt(0)" ::: "memory");
            const unsigned og = xb_add(&bar[XB_TOP], 1u);
            const unsigned tg = og / nx;
            if (og + 1u == (tg + 1u) * nx) xb_add(&bar[XB_TOPGEN], 1u);
            else XB_SPIN(xb_ld(&bar[XB_TOPGEN]) == tg, bar);
            __builtin_amdgcn_fence(__ATOMIC_ACQUIRE, "agent");
            xb_add(&bar[XB_XGEN(b.x)], 1u);
            asm volatile("s_waitcnt vmcnt(0)" ::: "memory");
        } else {
            XB_SPIN(xb_ld(&bar[XB_XGEN(b.x)]) == gen, bar);
            __builtin_amdgcn_fence(__ATOMIC_ACQUIRE, "agent");
            asm volatile("s_waitcnt vmcnt(0)" ::: "memory");
        }
    }
    __syncthreads();
}

constexpr int NWAVES = 8;
constexpr int LDS_BYTES = 147456;
constexpr int MISC_OFF = 146432;

struct Args {
    const float *x, *g_mix, *w_in, *g_cq, *w_uq, *g_ckv, *w_ukv, *w_out, *g_ffn, *w_pq, *sub_keys, *u_emb, *v_emb, *g_final;
    const int* pos; float* out; unsigned char* ws; int ph_lo, ph_hi; unsigned probe_mask; int probe_shift;
};

__device__ __forceinline__ void p0_transpose_item(const float* __restrict__ W, int K, int N, const float* __restrict__ gk, bf16_t* __restrict__ WT, LAS float* scr, int item, int lane) {
    const int nblk = N / 32, kb = item / nblk, nb = item % nblk, k0 = 64 * kb, n0 = 32 * nb;
    float wv[32];
#pragma unroll
    for (int i = 0; i < 32; ++i) { const int kk = 2 * i + (lane >> 5); wv[i] = W[(size_t)(k0 + kk) * N + n0 + (lane & 31)]; if (gk) wv[i] *= gk[k0 + kk]; }
#pragma unroll
    for (int i = 0; i < 32; ++i) { const int kk = 2 * i + (lane >> 5); scr[kk * 33 + (lane & 31)] = wv[i]; }
    asm volatile("s_waitcnt lgkmcnt(0)" ::: "memory");
    const int c = lane & 7;
#pragma unroll
    for (int j = 0; j < 4; ++j) { const int n = (lane >> 3) + 8 * j; const LAS float* s = scr + (8 * c) * 33 + n;
        u32x4 o; o.x = pk_bf16(s[0 * 33], s[1 * 33]); o.y = pk_bf16(s[2 * 33], s[3 * 33]); o.z = pk_bf16(s[4 * 33], s[5 * 33]); o.w = pk_bf16(s[6 * 33], s[7 * 33]);
        *(u32x4*)(WT + (size_t)(n0 + n) * K + k0 + 8 * c) = o; }
    asm volatile("s_waitcnt lgkmcnt(0)" ::: "memory");
}
__device__ __forceinline__ bf16x8 cvt8(const float* p, float s) { const f32x4 a = *(const f32x4*)p, b = *(const f32x4*)(p + 4); u32x4 w; w.x = pk_bf16(a.x * s, a.y * s); w.y = pk_bf16(a.z * s, a.w * s); w.z = pk_bf16(b.x * s, b.y * s); w.w = pk_bf16(b.z * s, b.w * s); return __builtin_bit_cast(bf16x8, w); }
__device__ __forceinline__ void p0_wcomb_item(const float* __restrict__ keys, const float* __restrict__ w_pq, const float* __restrict__ g_ffn, bf16_t* __restrict__ Wc, int item, int lane) {
    const int hp = item >> 7, nblk = (item >> 5) & 3, kblk = item & 31, n0 = 32 * nblk, k0 = 32 * kblk, r32 = lane & 31, hi = lane >> 5;
    const float* ar = keys + ((size_t)hp * 128 + n0 + r32) * 128 + 8 * hi;
    const float* br = w_pq + (size_t)(k0 + r32) * 2048 + hp * 128 + 8 * hi;
    const float gk = g_ffn[k0 + r32];
    f32x16 d = {};
#pragma unroll
    for (int cs = 0; cs < 8; ++cs) d = __builtin_amdgcn_mfma_f32_32x32x16_bf16(cvt8(ar + 16 * cs, 1.f), cvt8(br + 16 * cs, 1.f), d, 0, 0, 0);
#pragma unroll
    for (int r = 0; r < 16; ++r) Wc[((size_t)hp * 128 + n0 + crow(r, hi)) * DM + k0 + r32] = (bf16_t)(pk_bf16(d[r] * gk, 0.f) & 0xffffu);
}
__device__ __forceinline__ void p0_prologue(const Args& a, LAS unsigned char* lds, int gw, int ngw, int lane, int wave) {
    unsigned char* ws = a.ws;
    LAS float* scr = (LAS float*)(lds + wave * 16384);
    bf16_t* Wt_in = (bf16_t*)(ws + WS_WIN); bf16_t* Wt_comb = (bf16_t*)(ws + WS_WCOMB); bf16_t* Wt_out = (bf16_t*)(ws + WS_WOUT); bf16_t* Wt_uq = (bf16_t*)(ws + WS_WUQ); bf16_t* Wt_ukv = (bf16_t*)(ws + WS_WUKV);
    constexpr int I_IN = (DM / 64) * (INW / 32), I_UQ = (256 / 64) * (768 / 32), I_UKV = (128 / 64) * (1024 / 32), I_OUT = (DM / 64) * (DM / 32), I_WC = 2048;
    constexpr int NITEMS = I_IN + I_UQ + I_UKV + I_OUT + I_WC;
    for (int it = gw; it < NITEMS; it += ngw) {
        int r = it;
        if (r < I_IN) { p0_transpose_item(a.w_in, DM, INW, nullptr, Wt_in, scr, r, lane); continue; } r -= I_IN;
        if (r < I_UQ) { p0_transpose_item(a.w_uq, 256, 768, a.g_cq, Wt_uq, scr, r, lane); continue; } r -= I_UQ;
        if (r < I_UKV) { p0_transpose_item(a.w_ukv, 128, 1024, a.g_ckv, Wt_ukv, scr, r, lane); continue; } r -= I_UKV;
        if (r < I_OUT) { p0_transpose_item(a.w_out, DM, DM, nullptr, Wt_out, scr, r, lane); continue; } r -= I_OUT;
        p0_wcomb_item(a.sub_keys, a.w_pq, a.g_ffn, Wt_comb, r, lane);
    }
    const int gt = gw * 64 + lane, ngt = ngw * 64;
    for (int i = gt; i < (2048 - INW) * DM / 8; i += ngt) *(u32x4*)(Wt_in + (size_t)INW * DM + (size_t)i * 8) = (u32x4){0u, 0u, 0u, 0u};
    { bf16_t* HN = (bf16_t*)(ws + WS_HN);
      const f32x4* gr = (const f32x4*)a.g_mix + lane;
      const f32x4 g0 = gr[0], g1 = gr[64], g2 = gr[128], g3 = gr[192];
      for (int m0 = 4 * gw; m0 < T; m0 += 4 * ngw) {
          f32x4 v[4][4];
#pragma unroll
          for (int r = 0; r < 4; ++r) { const f32x4* xr = (const f32x4*)(a.x + (size_t)(m0 + r) * DM) + lane; v[r][0] = xr[0]; v[r][1] = xr[64]; v[r][2] = xr[128]; v[r][3] = xr[192]; }
#pragma unroll
          for (int r = 0; r < 4; ++r) {
              float s = 0.f;
#pragma unroll
              for (int j = 0; j < 4; ++j) s += (v[r][j].x * v[r][j].x + v[r][j].y * v[r][j].y) + (v[r][j].z * v[r][j].z + v[r][j].w * v[r][j].w);
              const float rstd = 1.0f / sqrtf(wave_sum(s) * (1.f / DM) + EPS);
              u32x2* o8 = (u32x2*)(HN + (size_t)(m0 + r) * DM) + lane;
              u32x2 w;
              w.x = pk_bf16(v[r][0].x * rstd * g0.x, v[r][0].y * rstd * g0.y); w.y = pk_bf16(v[r][0].z * rstd * g0.z, v[r][0].w * rstd * g0.w); o8[0] = w;
              w.x = pk_bf16(v[r][1].x * rstd * g1.x, v[r][1].y * rstd * g1.y); w.y = pk_bf16(v[r][1].z * rstd * g1.z, v[r][1].w * rstd * g1.w); o8[64] = w;
              w.x = pk_bf16(v[r][2].x * rstd * g2.x, v[r][2].y * rstd * g2.y); w.y = pk_bf16(v[r][2].z * rstd * g2.z, v[r][2].w * rstd * g2.w); o8[128] = w;
              w.x = pk_bf16(v[r][3].x * rstd * g3.x, v[r][3].y * rstd * g3.y); w.y = pk_bf16(v[r][3].z * rstd * g3.z, v[r][3].w * rstd * g3.w); o8[192] = w;
          } } }
    { float* cosA = (float*)(ws + WS_COSA); float* sinA = (float*)(ws + WS_SINA); float* cosM = (float*)(ws + WS_COSM); float* sinM = (float*)(ws + WS_SINM);
      constexpr float INV16[16] = {1.0f, 0.44036659598350525f, 0.1939227432012558f, 0.08539710193872452f, 0.03760603070259094f, 0.016560440883040428f, 0.007292664609849453f, 0.0032114461064338684f,
                                   0.0014142135623842478f, 0.0006227724370546639f, 0.00027424818836152554f, 0.00012076973507646471f, 5.3182957344688475e-05f, 2.34199997066753e-05f, 1.0313385246263351e-05f, 4.541670477919979e-06f};
      for (int i = gt; i < T * 16; i += ngt) {
          const int tok = i >> 4, j = i & 15;
          const float ang = (float)a.pos[tok] * INV16[j];
          float sn, cs; sincosf(ang, &sn, &cs);
          cosM[tok * 16 + j] = cs; sinM[tok * 16 + j] = sn;
          if ((j & 1) == 0) { cosA[tok * 8 + (j >> 1)] = cs; sinA[tok * 8 + (j >> 1)] = sn; } } }
}

__global__ void __launch_bounds__(NWAVES * 64, 2) mk_fwd(Args a) {
    extern __shared__ __attribute__((aligned(16))) unsigned char lds_raw[];
    LAS unsigned char* lds = (LAS unsigned char*)lds_raw;
    volatile LAS unsigned* MISC = (volatile LAS unsigned*)(lds + MISC_OFF);
    const int tid = threadIdx.x, lane = tid & 63, wave = __builtin_amdgcn_readfirstlane(tid >> 6);
    const int G = gridDim.x, bx = blockIdx.x, vcu = (G % 8 == 0) ? (bx % 8) * (G / 8) + bx / 8 : bx;
    unsigned char* ws = a.ws;
    for (int u = tid; u < 64; u += NWAVES * 64) MISC[u] = 0u;
    __syncthreads();
    XcdBarrier bar = xcd_barrier_post((unsigned*)(ws + WS_CTL), MISC + 8);
    const int lo = a.ph_lo, hi = a.ph_hi;
#ifdef PROBE_LO
#define PMASK a.probe_mask
#else
#define PMASK 0xffffu
#endif
#define IN(k) (lo <= (k) && (k) < hi)
#ifdef PROBE_LO
#define RUN(k) (IN(k) && !(a.probe_shift & 16))
#else
#define RUN(k) IN(k)
#endif
#define SEAM(k) do { if (IN(k) && IN((k) + 1)) xcd_barrier(bar); } while (0)
    const int gw = vcu * NWAVES + wave, ngw = G * NWAVES;

    if (RUN(0)) { p0_prologue(a, lds, gw, ngw, lane, wave); }
    SEAM(0);
    if (RUN(1)) {
        pg8::Gemm g{(const bf16_t*)(ws + WS_HN), (const bf16_t*)(ws + WS_WIN), T, 2048, DM}; pg8::StaticOrder S; S.init(T, 2048, G, bx);
        pg8::EpiProj E{(bf16_t*)(ws + WS_QA), (bf16_t*)(ws + WS_KA), (bf16_t*)(ws + WS_VA), (bf16_t*)(ws + WS_CQ), (bf16_t*)(ws + WS_CKV), (bf16_t*)(ws + WS_KR),
                       (float*)(ws + WS_SSQQ), (float*)(ws + WS_SSQKV), (const float*)(ws + WS_COSA), (const float*)(ws + WS_SINA), (const float*)(ws + WS_COSM), (const float*)(ws + WS_SINM)};
        pg8::gemm_phase<pg8::EpiProj, pg8::StaticOrder, true, true>(lds, g, S, E);
    }
    SEAM(1);
    if (RUN(2)) {
        { int kk = 128; asm volatile("" : "+s"(kk));
          pg8::Gemm g{(const bf16_t*)(ws + WS_CKV), (const bf16_t*)(ws + WS_WUKV), T, 1024, kk}; pg8::StaticOrder S; S.init(T, 1024, G, bx);
          pg8::EpiKv E{(bf16_t*)(ws + WS_KN), (bf16_t*)(ws + WS_VM), (const float*)(ws + WS_SSQKV)};
          pg8::gemm_phase<pg8::EpiKv, pg8::StaticOrder, true, true>(lds, g, S, E); }
        __syncthreads();
        { int kk = 256; asm volatile("" : "+s"(kk));
          pg8::Gemm g{(const bf16_t*)(ws + WS_CQ), (const bf16_t*)(ws + WS_WUQ), T, 768, kk}; pg8::StaticOrder S; S.init(T, 768, G, bx);
          pg8::EpiQm E{(bf16_t*)(ws + WS_QM), (const float*)(ws + WS_SSQQ), (const float*)(ws + WS_COSM), (const float*)(ws + WS_SINM)};
          pg8::gemm_phase<pg8::EpiQm, pg8::StaticOrder, true, true>(lds, g, S, E); }
    }
    SEAM(2);
    if (RUN(3)) {
        if (!(a.probe_shift & 1)) for (int pr = vcu; pr < 256; pr += G) {
            const int bh = pr >> 4, s = pr & 15;
            att::mla_unit(lds, (const bf16_t*)(ws + WS_QM), (const bf16_t*)(ws + WS_KN), (const bf16_t*)(ws + WS_KR), (const bf16_t*)(ws + WS_VM), (bf16_t*)(ws + WS_MIXED), bh >> 3, bh & 7, 31 - s,
                          a.u_emb, a.v_emb, a.g_ffn, ws + WS_U8, ws + WS_V8, pr * 528);
            att::mla_unit(lds, (const bf16_t*)(ws + WS_QM), (const bf16_t*)(ws + WS_KN), (const bf16_t*)(ws + WS_KR), (const bf16_t*)(ws + WS_VM), (bf16_t*)(ws + WS_MIXED), bh >> 3, bh & 7, s,
                          a.u_emb, a.v_emb, a.g_ffn, ws + WS_U8, ws + WS_V8, pr * 528 + 16 * (32 - s));
        }
        if (!(a.probe_shift & 2)) for (int sg = vcu; sg < 256; sg += G)
            att::dil_segment(lds, (const bf16_t*)(ws + WS_QA), (const bf16_t*)(ws + WS_KA), (const bf16_t*)(ws + WS_VA), (bf16_t*)(ws + WS_MIXED), sg, wave, lane, a.probe_shift);
    }
    SEAM(3);
    if (RUN(4)) {
        pg8::Gemm g{(const bf16_t*)(ws + WS_MIXED), (const bf16_t*)(ws + WS_WOUT), T, DM, DM}; pg8::StaticOrder S; S.init(T, DM, G, bx);
        pg8::EpiOut E{a.x, (bf16_t*)(ws + WS_HB), ws + WS_HB8, (float*)(ws + WS_SSQH)};
        pg8::gemm_phase<pg8::EpiOut, pg8::StaticOrder, true, true>(lds, g, S, E);
    }
    SEAM(4);
    if (RUN(5)) {
        pg8::Gemm g{(const bf16_t*)(ws + WS_HB), (const bf16_t*)(ws + WS_WCOMB), T, 2048, DM}; pg8::StaticOrder S; S.init(T, 2048, G, bx);
        pg8::EpiSc E{(bf16_t*)(ws + WS_SC), (const float*)(ws + WS_SSQH)};
        pg8::gemm_phase<pg8::EpiSc, pg8::StaticOrder, true, true>(lds, g, S, E);
    }
    SEAM(5);
    if (RUN(6)) {
        peer2::topk_phase(lds, (const bf16_t*)(ws + WS_SC), (const float*)(ws + WS_SSQH), (unsigned short*)(ws + WS_PESLOT), (unsigned short*)(ws + WS_PEROW), (float*)(ws + WS_PG), (float*)(ws + WS_RSTDH), gw, ngw);
    }
    SEAM(6);
    const int sx = bx % 8, smem = (bx / 8) * NWAVES + wave, scnt = ((G - sx + 7) / 8) * NWAVES;
    const int usl = sx >> 1, un0 = (G - 2 * usl + 7) / 8, un1 = (G - (2 * usl + 1) + 7) / 8;
    const int usmem = ((sx & 1) ? un0 + bx / 8 : bx / 8) * NWAVES + wave, uscnt = (un0 + un1) * NWAVES;
#ifdef PROBE_LO
    if (RUN(7) && (a.probe_shift & 8)) { peer2::u_phase<1>(lds, ws + WS_HB8, ws + WS_U8, (const unsigned short*)(ws + WS_PEROW), (bf16_t*)(ws + 160 * MiB), usl, usmem, uscnt, PMASK); } else
#endif
    if (RUN(7)) { peer2::u_phase(lds, ws + WS_HB8, ws + WS_U8, (const unsigned short*)(ws + WS_PEROW), (bf16_t*)(ws + WS_ZP), usl, usmem, uscnt, PMASK); }
    SEAM(7);
    if (RUN(8)) { peer2::act_phase(lds, (const bf16_t*)(ws + WS_ZP), (const unsigned short*)(ws + WS_PESLOT), (const float*)(ws + WS_PG), (const float*)(ws + WS_SSQH), (unsigned short*)(ws + WS_PE2), ws + WS_PA2, gw, ngw); }
    SEAM(8);
#ifdef PROBE_LO
    if (RUN(9) && (a.probe_shift & 128)) { peer2::v_phase<2>(lds, ws + WS_V8, (const unsigned short*)(ws + WS_PE2), ws + WS_PA2, (bf16_t*)(ws + 160 * MiB), usl, usmem, uscnt, PMASK); } else
    if (RUN(9) && (a.probe_shift & 4)) { peer2::v_phase<1>(lds, ws + WS_V8, (const unsigned short*)(ws + WS_PE2), ws + WS_PA2, (bf16_t*)(ws + WS_OP), usl, usmem, uscnt, PMASK); } else
#endif
    if (RUN(9)) { peer2::v_phase(lds, ws + WS_V8, (const unsigned short*)(ws + WS_PE2), ws + WS_PA2, (bf16_t*)(ws + WS_OP), usl, usmem, uscnt, PMASK); }
    SEAM(9);
    if (RUN(10)) { peer2::final_phase(a.out, (const bf16_t*)(ws + WS_HB), (const bf16_t*)(ws + WS_OP), a.g_final, gw, ngw); }
#undef IN
#undef RUN
#undef SEAM
}


#ifndef STAGE
#define STAGE 6
#endif
extern "C" void kernel_launch(void* const* d_in, const int* in_sizes, int n_in, void* d_out, int out_size, void* d_ws, size_t ws_size, hipStream_t stream) {
    static int grid = 0;
    if (grid == 0) {
        if (n_in != 15 || out_size != T * DM || ws_size < 256 * MiB) { fprintf(stderr, "kernel_launch: unexpected problem shape (n_in %d, out %d, ws %zu); nothing launched\n", n_in, out_size, ws_size); grid = -1; return; }
        int dev = 0, cus = 0, per_cu = 0;
        if (hipGetDevice(&dev) != hipSuccess || hipDeviceGetAttribute(&cus, hipDeviceAttributeMultiprocessorCount, dev) != hipSuccess) { grid = -1; return; }
        if (hipFuncSetAttribute((const void*)mk_fwd, hipFuncAttributeMaxDynamicSharedMemorySize, LDS_BYTES) != hipSuccess) { fprintf(stderr, "kernel_launch: hipFuncSetAttribute failed\n"); grid = -1; return; }
        if (hipOccupancyMaxActiveBlocksPerMultiprocessor(&per_cu, (const void*)mk_fwd, NWAVES * 64, LDS_BYTES) != hipSuccess || per_cu < 1) fprintf(stderr, "kernel_launch: note: occupancy query says %d workgroups per CU\n", per_cu);
        (void)hipGetLastError();
        grid = cus;
        if (grid < 8) { fprintf(stderr, "kernel_launch: %d CUs: the PEER slice phases need a grid of at least 8 workgroups; nothing launched\n", grid); grid = -1; return; }
    }
    if (grid < 0) return;
    unsigned char* ws = (unsigned char*)d_ws;
    (void)hipMemsetAsync(ws + WS_CTL, 0, CTL_ZERO_BYTES, stream);
    Args a{};
    a.x = (const float*)d_in[0]; a.pos = (const int*)d_in[1]; a.g_mix = (const float*)d_in[2]; a.w_in = (const float*)d_in[3]; a.g_cq = (const float*)d_in[4]; a.w_uq = (const float*)d_in[5];
    a.g_ckv = (const float*)d_in[6]; a.w_ukv = (const float*)d_in[7]; a.w_out = (const float*)d_in[8]; a.g_ffn = (const float*)d_in[9]; a.w_pq = (const float*)d_in[10]; a.sub_keys = (const float*)d_in[11];
    a.u_emb = (const float*)d_in[12]; a.v_emb = (const float*)d_in[13]; a.g_final = (const float*)d_in[14];
    a.out = (float*)d_out; a.ws = ws; a.ph_lo = 0; a.ph_hi = (STAGE >= 6) ? 11 : STAGE + 1; a.probe_mask = 0xffffu; a.probe_shift = 0;
#if defined(PROBE_LO) && PROBE_LO == 3
    { Args b1 = a; b1.ph_hi = 4; b1.probe_shift = PROBE_SHIFT; hipLaunchKernelGGL(mk_fwd, dim3(grid), dim3(NWAVES * 64), LDS_BYTES, stream, b1);
      (void)hipMemsetAsync(ws + WS_CTL, 0, CTL_ZERO_BYTES, stream); a.ph_lo = 3; }
#endif
    hipLaunchKernelGGL(mk_fwd, dim3(grid), dim3(NWAVES * 64), LDS_BYTES, stream, a);
#if defined(PROBE_LO) && PROBE_LO != 3
#if 0
#else
    { Args b2 = a; b2.ph_lo = PROBE_LO; b2.ph_hi = PROBE_HI; b2.probe_shift = PROBE_SHIFT; b2.probe_mask = PROBE_MASK; (void)hipMemsetAsync(ws + WS_CTL, 0, CTL_ZERO_BYTES, stream); hipLaunchKernelGGL(mk_fwd, dim3(grid), dim3(NWAVES * 64), LDS_BYTES, stream, b2); }
#endif
#endif
#if STAGE < 6
    float* out = (float*)d_out; float* mixed = out;
    const size_t MB = MiB;
#if STAGE == 2
    {
        float* q32 = (float*)(ws + 0 * MB); float* k32 = (float*)(ws + 32 * MB); float* v32 = (float*)(ws + 64 * MB);
        const long n = (long)T * 512;
        nv::k_cvt<<<(int)((n + 255) / 256), 256, 0, stream>>>((const bf16_t*)(ws + WS_QA), q32, n, 1.0f / LOG2E);
        nv::k_cvt<<<(int)((n + 255) / 256), 256, 0, stream>>>((const bf16_t*)(ws + WS_KA), k32, n, 1.0f);
        nv::k_cvt<<<(int)((n + 255) / 256), 256, 0, stream>>>((const bf16_t*)(ws + WS_VA), v32, n, 1.0f);
        nv::k_dilated<<<T * 8 / 4, 256, 0, stream>>>(q32, k32, v32, mixed);
        float* qm32 = (float*)(ws + 112 * MB);
        const long nq = (long)T * 768;
        nv::k_cvt<<<(int)((nq + 255) / 256), 256, 0, stream>>>((const bf16_t*)(ws + WS_QM), qm32, nq, 1.0f / LOG2E);
        float* Kt = (float*)(ws + 0 * MB); float* Vt = Kt + (size_t)NB * 8 * 96 * SEQ;
        nv::k_build_ktvt<<<(int)(((long)NB * 8 * 160 * SEQ + 255) / 256), 256, 0, stream>>>((const bf16_t*)(ws + WS_KN), (const bf16_t*)(ws + WS_VM), (const bf16_t*)(ws + WS_KR), Kt, Vt);
        nv::k_mla<<<NB * 8 * (SEQ / 4), 256, 0, stream>>>(qm32, Kt, Vt, mixed);
    }
#elif STAGE == 3
    { const long n = (long)T * DM; nv::k_cvt<<<(int)((n + 255) / 256), 256, 0, stream>>>((const bf16_t*)(ws + WS_MIXED), mixed, n, 1.0f); }
#endif
    float* hbuf = (float*)(ws + 192 * MB); float* rstd_h = (float*)(ws + 180 * MB);
#if STAGE <= 3
    nv::k_gemm<<<dim3(DM / 64, T / 64), 256, 0, stream>>>(mixed, DM, nullptr, nullptr, a.w_out, DM, hbuf, DM, T, DM, DM, a.x, DM);
#else
    (void)hipMemcpyAsync(hbuf, out, (size_t)T * DM * 4, hipMemcpyDeviceToDevice, stream);
#endif
    float* qp = (float*)(ws + 0 * MB);
    float* vals = (float*)(ws + 128 * MB); int* idxs = (int*)(ws + 145 * MB); int* expert = (int*)(ws + 162 * MB); float* gate = (float*)(ws + 171 * MB);
    nv::k_rstd<<<T / 4, 256, 0, stream>>>(hbuf, DM, DM, rstd_h, T);
    nv::k_gemm<<<dim3(2048 / 64, T / 64), 256, 0, stream>>>(hbuf, DM, rstd_h, a.g_ffn, a.w_pq, 2048, qp, 2048, T, 2048, DM, nullptr, 0);
    (void)hipFuncSetAttribute((const void*)nv::k_topk1, hipFuncAttributeMaxDynamicSharedMemorySize, 65536);
    nv::k_topk1<<<dim3(T / 256, 16), 256, 65536, stream>>>(qp, a.sub_keys, vals, idxs);
    nv::k_topk2<<<T * 8 / 256, 256, 0, stream>>>(vals, idxs, expert, gate);
    nv::k_peer_final<<<T / 4, 256, 0, stream>>>(hbuf, rstd_h, a.g_ffn, a.u_emb, a.v_emb, expert, gate, a.g_final, out);
#endif
}
```
